# Optimizing an MI355X kernel written in HIP

```python
import math
import jax, jax.numpy as jnp
from jax import lax
import numpy as np


D_MODEL = 1024
BATCH = 16
SEQ = 2048
DEPTH = 4

N_EVEN = (DEPTH + 1) // 2
N_ODD = DEPTH // 2
HEAD_DIM = 64
EPS = 1e-6

A_WIDTH = D_MODEL // 2
A_EXPAND = 128
A_HEADS = A_WIDTH // A_EXPAND
A_HEAD_V = A_WIDTH // A_HEADS
A_CHUNK = 32

B_WIDTH = D_MODEL - A_WIDTH
B_HEADS = B_WIDTH // HEAD_DIM
DILATED_PATTERNS = ((128, 1), (512, 4), (2048, 16))
B_QBLOCK = 128
EVEN_IN = 4 * A_WIDTH + 3 * B_WIDTH

C_HEADS = D_MODEL // HEAD_DIM
C_KV_HEADS = 4
C_GROUP = C_HEADS // C_KV_HEADS
C_KV_WIDTH = C_KV_HEADS * HEAD_DIM
CMP_LEN = 32
CMP_STRIDE = 16
CMP_HIDDEN = 2 * HEAD_DIM
SLC_BLOCK = 64
SLC_TOPN = 8
SLC_QBLOCK = 32
WIN = 512
WIN_QBLOCK = 128
ODD_IN = D_MODEL + 6 * C_KV_WIDTH + 3 * C_HEADS

D_FF = -(-8 * D_MODEL // (3 * 256)) * 256

kernel_name = 'hybrid_hgrn2_dilated_nsa_trunk'


def rms_norm(x, g):
    xf = x.astype(jnp.float32)
    y = xf * lax.rsqrt(jnp.mean(xf * xf, axis=-1, keepdims=True) + EPS)
    return (y * g.astype(jnp.float32)).astype(x.dtype)


def alibi_slopes(n):
    return 2.0 ** (-8.0 * jnp.arange(1, n + 1, dtype=jnp.float32) / n)


def hgrn2(q, f_logit, v, gate, lb, o_gain):
    Bn, S, _ = q.shape
    f32 = jnp.float32
    f = lb + (1.0 - lb) * jax.nn.sigmoid(f_logit.astype(f32))
    log_f = jnp.log(f)
    k = 1.0 - f
    q = jax.nn.silu(q.astype(f32))
    v = v.astype(f32)
    n_chunk = S // A_CHUNK

    def chunks(t, d):
        return t.reshape(Bn, n_chunk, A_CHUNK, A_HEADS, d).transpose(1, 0, 3, 2, 4)

    qc, kc, lc = chunks(q, A_EXPAND), chunks(k, A_EXPAND), chunks(log_f, A_EXPAND)
    vc = chunks(v, A_HEAD_V)
    causal = jnp.tril(jnp.ones((A_CHUNK, A_CHUNK), dtype=bool))[:, :, None]

    def step(state, inp):
        qb, kb, vb, lf = inp
        b = jnp.cumsum(lf, axis=-2)
        b_last = b[..., -1:, :]
        diff = b[..., :, None, :] - b[..., None, :, :]
        decay = jnp.exp(jnp.where(causal, diff, -jnp.inf))
        scores = jnp.einsum('bhtk,bhsk,bhtsk->bhts', qb, kb, decay)
        out = (jnp.einsum('bhts,bhsv->bhtv', scores, vb)
               + jnp.einsum('bhtk,bhkv->bhtv', qb * jnp.exp(b), state))
        new_state = (jnp.exp(b_last)[..., 0, :, None] * state
                     + jnp.einsum('bhsk,bhsv->bhkv', kb * jnp.exp(b_last - b), vb))
        return new_state, out

    state0 = jnp.zeros((Bn, A_HEADS, A_EXPAND, A_HEAD_V), f32)
    _, o = lax.scan(step, state0, (qc, kc, vc, lc))
    o = o.transpose(1, 0, 3, 2, 4).reshape(Bn, S, A_HEADS, A_HEAD_V)
    o = o * lax.rsqrt(jnp.mean(o * o, axis=-1, keepdims=True) + EPS)
    return o.reshape(Bn, S, A_WIDTH) * o_gain.astype(f32) * jax.nn.silu(gate.astype(f32))


def dilated_branch(q, k, v, window, dilation, slopes):
    Bn, H, S, dh = q.shape
    L = S // dilation
    w = window // dilation
    qb = min(B_QBLOCK, L)
    nb = L // qb

    def sub(t):
        return t.reshape(Bn, H, L, dilation, dh).transpose(0, 1, 3, 2, 4)

    pad = ((0, 0), (0, 0), (0, 0), (w, 0), (0, 0))
    kp = jnp.pad(sub(k), pad)
    vp = jnp.pad(sub(v), pad)
    kidx = jnp.arange(nb)[:, None] * qb + jnp.arange(qb + w)[None, :]
    k_band = kp[:, :, :, kidx]
    v_band = vp[:, :, :, kidx]
    q_blk = sub(q).reshape(Bn, H, dilation, nb, qb, dh)
    j = jnp.arange(qb)[:, None] - jnp.arange(qb + w)[None, :] + w
    valid = (j >= 0) & (j <= w) & (kidx[:, None, :] >= w)
    s = (jnp.einsum('bhrnqd,bhrnkd->bhrnqk', q_blk, k_band) * dh ** -0.5
         - slopes[:, None, None, None, None] * (j * dilation).astype(jnp.float32))
    s = jnp.where(valid, s, -jnp.inf)
    m = jnp.max(s, axis=-1, keepdims=True)
    e = jnp.exp(s - m)
    l = jnp.sum(e, axis=-1, keepdims=True)
    o = jnp.einsum('bhrnqk,bhrnkd->bhrnqd', e, v_band) / l
    lse = (m + jnp.log(l))[..., 0]
    o = o.reshape(Bn, H, dilation, L, dh).transpose(0, 1, 3, 2, 4).reshape(Bn, H, S, dh)
    lse = lse.reshape(Bn, H, dilation, L).transpose(0, 1, 3, 2).reshape(Bn, H, S)
    return o, lse


def hybrid_mixer(h, w_in, lb, o_gain, q_gain, k_gain, w_out):
    Bn, S, _ = h.shape
    dt = h.dtype
    proj = h @ w_in
    split_at = [A_WIDTH * i for i in range(1, 5)] + [4 * A_WIDTH + B_WIDTH * i for i in range(1, 3)]
    a_q, a_f, a_i, a_g, b_q, b_k, b_v = jnp.split(proj, split_at, axis=-1)
    a_out = hgrn2(a_q, a_f, a_i, a_g, lb, o_gain)

    def heads(t):
        return t.reshape(Bn, S, B_HEADS, HEAD_DIM).transpose(0, 2, 1, 3).astype(jnp.float32)

    q = rms_norm(heads(b_q), q_gain)
    k = rms_norm(heads(b_k), k_gain)
    v = heads(b_v)
    slopes = alibi_slopes(B_HEADS)
    outs, lses = zip(*[dilated_branch(q, k, v, win, dil, slopes) for (win, dil) in DILATED_PATTERNS])
    wts = jax.nn.softmax(jnp.stack(lses), axis=0)
    b_out = jnp.einsum('nbhs,nbhsd->bshd', wts, jnp.stack(outs)).reshape(Bn, S, B_WIDTH)
    mixed = jnp.concatenate([a_out, b_out], axis=-1).astype(dt)
    return mixed @ w_out


def nsa_mixer(h, w_in, q_gain, k_gain, cmp_pe, cmp_w1, cmp_w2, w_out):
    Bn, S, _ = h.shape
    dt = h.dtype
    f32 = jnp.float32
    scale = HEAD_DIM ** -0.5
    proj = h @ w_in
    q, kc, vc, ks, vs, kw, vw, g = jnp.split(
        proj, [D_MODEL + C_KV_WIDTH * i for i in range(7)], axis=-1)
    q = rms_norm(q.reshape(Bn, S, C_KV_HEADS, C_GROUP, HEAD_DIM)
                 .transpose(0, 2, 3, 1, 4).astype(f32), q_gain)

    def kv_heads(t):
        return t.reshape(Bn, S, C_KV_HEADS, HEAD_DIM).transpose(0, 2, 1, 3).astype(f32)

    kc, vc, ks, vs, kw, vw = (kv_heads(t) for t in (kc, vc, ks, vs, kw, vw))
    ks = rms_norm(ks, k_gain[1])
    kw = rms_norm(kw, k_gain[2])
    gates = jax.nn.sigmoid(g.astype(f32)).reshape(Bn, S, 3, C_KV_HEADS, C_GROUP).transpose(2, 0, 3, 4, 1)[..., None]
    slopes = alibi_slopes(C_HEADS).reshape(C_KV_HEADS, C_GROUP)
    pos = jnp.arange(S)

    n_cmp = (S - CMP_LEN) // CMP_STRIDE + 1
    cidx = jnp.arange(n_cmp)[:, None] * CMP_STRIDE + jnp.arange(CMP_LEN)[None, :]

    def compress(t, pe, w1, w2):
        blocks = t[:, :, cidx] + pe.astype(f32)
        blocks = blocks.reshape(Bn, C_KV_HEADS, n_cmp, CMP_LEN * HEAD_DIM)
        return jax.nn.silu(blocks @ w1.astype(f32)) @ w2.astype(f32)

    k_cmp = rms_norm(compress(kc, cmp_pe[0], cmp_w1[0], cmp_w2[0]), k_gain[0])
    v_cmp = compress(vc, cmp_pe[1], cmp_w1[1], cmp_w2[1])
    dist_c = (pos[:, None] - cidx[:, -1][None, :]).astype(f32)
    s_c = (jnp.einsum('bgjtd,bgnd->bgjtn', q, k_cmp) * scale
           - slopes[None, :, :, None, None] * dist_c)
    s_c = jnp.where(dist_c >= 0, s_c, -jnp.inf)
    m_c = jnp.max(s_c, axis=-1, keepdims=True)
    e_c = jnp.exp(s_c - jnp.where(jnp.isfinite(m_c), m_c, 0.0))
    l_c = jnp.sum(e_c, axis=-1, keepdims=True)
    p_c = e_c / jnp.where(l_c > 0, l_c, 1.0)
    o_cmp = jnp.einsum('bgjtn,bgnd->bgjtd', p_c, v_cmp)

    n_slc = S // SLC_BLOCK
    blk = jnp.arange(n_slc)
    c_start = cidx[:, 0]
    overlap = ((c_start[:, None] < (blk[None, :] + 1) * SLC_BLOCK)
               & (c_start[:, None] + CMP_LEN > blk[None, :] * SLC_BLOCK)).astype(f32)
    importance = jnp.einsum('bgjtn,nm->bgtm', p_c, overlap)
    cur = (pos // SLC_BLOCK)[:, None]
    forced = (blk[None, :] == 0) | (blk[None, :] == cur) | (blk[None, :] == cur - 1)
    score = jnp.where(blk[None, :] > cur, -jnp.inf, jnp.where(forced, jnp.inf, importance))
    n_top = min(SLC_TOPN, n_slc)
    top_s, top_i = lax.top_k(score, n_top)
    top_ok = top_s > -jnp.inf
    k_blocks = ks.reshape(Bn, C_KV_HEADS, n_slc, SLC_BLOCK, HEAD_DIM)
    v_blocks = vs.reshape(Bn, C_KV_HEADS, n_slc, SLC_BLOCK, HEAD_DIM)
    gather = jax.vmap(jax.vmap(lambda tb, idx: tb[idx]))
    n_sel_keys = n_top * SLC_BLOCK

    def sel_block(args):
        qb, ib, okb, tb = args
        kg = gather(k_blocks, ib).reshape(Bn, C_KV_HEADS, SLC_QBLOCK, n_sel_keys, HEAD_DIM)
        vg = gather(v_blocks, ib).reshape(Bn, C_KV_HEADS, SLC_QBLOCK, n_sel_keys, HEAD_DIM)
        kpos = (ib[..., None] * SLC_BLOCK + jnp.arange(SLC_BLOCK)).reshape(Bn, C_KV_HEADS, SLC_QBLOCK, n_sel_keys)
        ok = jnp.broadcast_to(okb[..., None], ib.shape + (SLC_BLOCK,)).reshape(Bn, C_KV_HEADS, SLC_QBLOCK, n_sel_keys)
        dist = tb[:, None] - kpos
        valid = (dist >= 0) & ok
        s = (jnp.einsum('bgjqd,bgqmd->bgjqm', qb, kg) * scale
             - slopes[None, :, :, None, None] * dist[:, :, None].astype(f32))
        s = jnp.where(valid[:, :, None], s, -jnp.inf)
        return jnp.einsum('bgjqm,bgqmd->bgjqd', jax.nn.softmax(s, axis=-1), vg)

    n_qb = S // SLC_QBLOCK
    q_r = q.reshape(Bn, C_KV_HEADS, C_GROUP, n_qb, SLC_QBLOCK, HEAD_DIM).transpose(3, 0, 1, 2, 4, 5)
    i_r = top_i.reshape(Bn, C_KV_HEADS, n_qb, SLC_QBLOCK, n_top).transpose(2, 0, 1, 3, 4)
    ok_r = top_ok.reshape(Bn, C_KV_HEADS, n_qb, SLC_QBLOCK, n_top).transpose(2, 0, 1, 3, 4)
    t_r = pos.reshape(n_qb, SLC_QBLOCK)
    o_slc = lax.map(sel_block, (q_r, i_r, ok_r, t_r)).transpose(1, 2, 3, 0, 4, 5).reshape(
        Bn, C_KV_HEADS, C_GROUP, S, HEAD_DIM)

    pad = ((0, 0), (0, 0), (WIN, 0), (0, 0))
    kw_p = jnp.pad(kw, pad)
    vw_p = jnp.pad(vw, pad)
    band = jnp.arange(WIN_QBLOCK + WIN)

    def win_block(args):
        qb, start = args
        kb = lax.dynamic_slice_in_dim(kw_p, start, WIN_QBLOCK + WIN, axis=2)
        vb = lax.dynamic_slice_in_dim(vw_p, start, WIN_QBLOCK + WIN, axis=2)
        qpos = start + jnp.arange(WIN_QBLOCK)
        kpos = start - WIN + band
        dist = qpos[:, None] - kpos[None, :]
        valid = (dist >= 0) & (dist < WIN) & (kpos[None, :] >= 0)
        s = (jnp.einsum('bgjqd,bgkd->bgjqk', qb, kb) * scale
             - slopes[None, :, :, None, None] * dist.astype(f32))
        s = jnp.where(valid, s, -jnp.inf)
        return jnp.einsum('bgjqk,bgkd->bgjqd', jax.nn.softmax(s, axis=-1), vb)

    n_wb = S // WIN_QBLOCK
    q_w = q.reshape(Bn, C_KV_HEADS, C_GROUP, n_wb, WIN_QBLOCK, HEAD_DIM).transpose(3, 0, 1, 2, 4, 5)
    starts = jnp.arange(n_wb) * WIN_QBLOCK
    o_win = lax.map(win_block, (q_w, starts)).transpose(1, 2, 3, 0, 4, 5).reshape(
        Bn, C_KV_HEADS, C_GROUP, S, HEAD_DIM)

    o = gates[0] * o_cmp + gates[1] * o_slc + gates[2] * o_win
    o = o.transpose(0, 3, 1, 2, 4).reshape(Bn, S, D_MODEL).astype(dt)
    return o @ w_out


def swiglu(h, w_gate, w_up, w_down):
    return (jax.nn.silu(h @ w_gate) * (h @ w_up)) @ w_down


def setup_inputs(seed: int = 0) -> dict:
    key = jax.random.key(seed)
    ks = jax.random.split(key, 20)

    def nrm(k, shape, scale):
        return jax.random.normal(k, shape, jnp.float32) * scale

    def gain(k, shape):
        return 1.0 + 0.02 * jax.random.normal(k, shape, jnp.float32)

    return {
        'x': nrm(ks[0], (BATCH, SEQ, D_MODEL), 1.0),
        'attn_norm': gain(ks[1], (DEPTH, D_MODEL)),
        'ffn_norm': gain(ks[2], (DEPTH, D_MODEL)),
        'hy_w_in': nrm(ks[3], (N_EVEN, D_MODEL, EVEN_IN), D_MODEL ** -0.5),
        'hy_lb_logits': nrm(ks[4], (N_EVEN, A_WIDTH), 0.1),
        'hy_o_gain': gain(ks[5], (N_EVEN, A_WIDTH)),
        'hy_q_gain': gain(ks[6], (N_EVEN, HEAD_DIM)),
        'hy_k_gain': gain(ks[7], (N_EVEN, HEAD_DIM)),
        'hy_w_out': nrm(ks[8], (N_EVEN, D_MODEL, D_MODEL), D_MODEL ** -0.5),
        'nsa_w_in': nrm(ks[9], (N_ODD, D_MODEL, ODD_IN), D_MODEL ** -0.5),
        'nsa_q_gain': gain(ks[10], (N_ODD, HEAD_DIM)),
        'nsa_k_gain': gain(ks[11], (N_ODD, 3, HEAD_DIM)),
        'nsa_cmp_pe': nrm(ks[12], (N_ODD, 2, CMP_LEN, HEAD_DIM), 0.1),
        'nsa_cmp_w1': nrm(ks[13], (N_ODD, 2, CMP_LEN * HEAD_DIM, CMP_HIDDEN), (CMP_LEN * HEAD_DIM) ** -0.5),
        'nsa_cmp_w2': nrm(ks[14], (N_ODD, 2, CMP_HIDDEN, HEAD_DIM), CMP_HIDDEN ** -0.5),
        'nsa_w_out': nrm(ks[15], (N_ODD, D_MODEL, D_MODEL), D_MODEL ** -0.5),
        'ffn_w_gate': nrm(ks[16], (DEPTH, D_MODEL, D_FF), D_MODEL ** -0.5),
        'ffn_w_up': nrm(ks[17], (DEPTH, D_MODEL, D_FF), D_MODEL ** -0.5),
        'ffn_w_down': nrm(ks[18], (DEPTH, D_FF, D_MODEL), D_FF ** -0.5),
    }


def reference(x, attn_norm, ffn_norm, hy_w_in, hy_lb_logits, hy_o_gain, hy_q_gain, hy_k_gain, hy_w_out,
              nsa_w_in, nsa_q_gain, nsa_k_gain, nsa_cmp_pe, nsa_cmp_w1, nsa_cmp_w2, nsa_w_out,
              ffn_w_gate, ffn_w_up, ffn_w_down):
    p_lb = jax.nn.softmax(hy_lb_logits.astype(jnp.float32), axis=0)
    lower_bounds = jnp.cumsum(p_lb, axis=0) - p_lb[0]
    for layer in range(DEPTH):
        h = rms_norm(x, attn_norm[layer])
        i = layer // 2
        if layer % 2 == 0:
            x = x + hybrid_mixer(h, hy_w_in[i], lower_bounds[i], hy_o_gain[i], hy_q_gain[i],
                                 hy_k_gain[i], hy_w_out[i])
        else:
            x = x + nsa_mixer(h, nsa_w_in[i], nsa_q_gain[i], nsa_k_gain[i], nsa_cmp_pe[i],
                              nsa_cmp_w1[i], nsa_cmp_w2[i], nsa_w_out[i])
        h = rms_norm(x, ffn_norm[layer])
        x = x + swiglu(h, ffn_w_gate[layer], ffn_w_up[layer], ffn_w_down[layer])
    return x
```

```cpp
#include <hip/hip_runtime.h>
#include <hip/hip_cooperative_groups.h>
#include <cstdio>
#include <cstdint>
#include <cstring>
namespace cg = cooperative_groups;

typedef unsigned short u16;
using bf16x8 = __attribute__((ext_vector_type(8))) short;
using f32x16 = __attribute__((ext_vector_type(16))) float;
using u32x4v = __attribute__((ext_vector_type(4))) unsigned;
#define DI __device__ __forceinline__
#define MFMA32(a, b, c) __builtin_amdgcn_mfma_f32_32x32x16_bf16((a), (b), (c), 0, 0, 0)

#ifndef MK_MULTI
#define MK_MULTI 0
#endif

constexpr int T_ = 32768, S_ = 2048;
constexpr float EPSF = 1e-6f;
constexpr float LOG2E = 1.4426950408889634f, LN2 = 0.6931471805599453f;
constexpr int LD_EVEN = 3584, LD_ODD = 2688, DFF = 2816;

struct Params {
  const float* x; const float* attn_norm; const float* ffn_norm;
  const float* hy_w_in; const float* hy_lb; const float* hy_og; const float* hy_qg; const float* hy_kg; const float* hy_w_out;
  const float* nsa_w_in; const float* nsa_qg; const float* nsa_kg; const float* cmp_pe; const float* cmp_w1; const float* cmp_w2; const float* nsa_w_out;
  const float* ffn_g; const float* ffn_u; const float* ffn_d;
  float* out;
  u16* wt_hy_in; u16* wt_hy_out; u16* wt_nsa_in; u16* wt_nsa_out; u16* wt_gu; u16* wt_dn; u16* wt_c1; u16* wt_c2;
  float* c1; float* lb; float* lse;
  u16* proj; u16* hbuf; u16* obr; u16* kcmp; u16* vcmp;
  int phase_lo; int phase_hi;
};

DI int tidx() { int t = __builtin_amdgcn_workitem_id_x(); asm volatile("" : "+v"(t)); return t; }
DI float bf2f(u16 h) { return __uint_as_float(((unsigned)h) << 16); }
DI u16 f2bf(float x) { unsigned u = __float_as_uint(x); u += 0x7fffu + ((u >> 16) & 1u); return (u16)(u >> 16); }
DI unsigned pack2(float a, float b) { return (unsigned)f2bf(a) | ((unsigned)f2bf(b) << 16); }
DI float fsigmoid(float x) { return 1.f / (1.f + __expf(-x)); }
DI float fsilu(float x) { return x / (1.f + __expf(-x)); }
DI float fexp2(float x) { return __builtin_amdgcn_exp2f(x); }
DI void unpack8(uint4 v, float (&f)[8]) {
  f[0] = __uint_as_float(v.x << 16); f[1] = __uint_as_float(v.x & 0xffff0000u);
  f[2] = __uint_as_float(v.y << 16); f[3] = __uint_as_float(v.y & 0xffff0000u);
  f[4] = __uint_as_float(v.z << 16); f[5] = __uint_as_float(v.z & 0xffff0000u);
  f[6] = __uint_as_float(v.w << 16); f[7] = __uint_as_float(v.w & 0xffff0000u);
}
DI uint4 pack8(const float (&f)[8]) {
  uint4 o; o.x = pack2(f[0], f[1]); o.y = pack2(f[2], f[3]); o.z = pack2(f[4], f[5]); o.w = pack2(f[6], f[7]); return o;
}
DI bf16x8 as_bf16x8(uint4 v) { u32x4v t; t[0] = v.x; t[1] = v.y; t[2] = v.z; t[3] = v.w; return __builtin_bit_cast(bf16x8, t); }
DI f32x16 zero16() { f32x16 z;
#pragma unroll
  for (int i = 0; i < 16; ++i) z[i] = 0.f; return z; }

DI void prep_tile(const float* __restrict__ src, u16* __restrict__ dst, int K, int N, int mode, int tk, int tn, float* sm) {
  const int tid = tidx();
  __syncthreads();
  {
    const int c = tid & 63; const int n = tn * 64 + c;
#pragma unroll 4
    for (int r = tid >> 6; r < 64; r += 4)
      sm[r * 65 + c] = (n < N) ? src[(size_t)(tk * 64 + r) * N + n] : 0.f;
  }
  __syncthreads();
#pragma unroll
  for (int pi = tid; pi < 512; pi += 256) {
    const int nl = pi >> 3, kp = pi & 7;
    const int n = tn * 64 + nl;
    int nd = n;
    if (mode == 1) nd = (n >> 5) * 64 + (n & 31);
    else if (mode == 2) nd = (n >> 5) * 64 + 32 + (n & 31);
    float v[8];
#pragma unroll
    for (int j = 0; j < 8; ++j) v[j] = sm[(kp * 8 + j) * 65 + nl];
    *(uint4*)(dst + (size_t)nd * K + tk * 64 + kp * 8) = pack8(v);
  }
}

DI void prep_phase(const Params& p, char* smem) {
  float* sm = (float*)smem;
  constexpr int G0 = 1792, G1 = 2304, G2 = 3648, G3 = 4160, G4 = 6976, G5 = 9792, G6 = 12608, G7 = 12864, G8 = 12872;
  for (int tile = blockIdx.x; tile < G8; tile += gridDim.x) {
    const float* src; u16* dst; int K, N, Np, mode = 0, lt;
    if (tile < G0) { int i = tile / 896; lt = tile % 896; src = p.hy_w_in + (size_t)i * 1024 * 3584; dst = p.wt_hy_in + (size_t)i * 3584 * 1024; K = 1024; N = 3584; Np = 3584; }
    else if (tile < G1) { int t = tile - G0; int i = t / 256; lt = t % 256; src = p.hy_w_out + (size_t)i * 1048576; dst = p.wt_hy_out + (size_t)i * 1048576; K = 1024; N = 1024; Np = 1024; }
    else if (tile < G2) { int t = tile - G1; int i = t / 672; lt = t % 672; src = p.nsa_w_in + (size_t)i * 1024 * 2608; dst = p.wt_nsa_in + (size_t)i * 2688 * 1024; K = 1024; N = 2608; Np = 2688; }
    else if (tile < G3) { int t = tile - G2; int i = t / 256; lt = t % 256; src = p.nsa_w_out + (size_t)i * 1048576; dst = p.wt_nsa_out + (size_t)i * 1048576; K = 1024; N = 1024; Np = 1024; }
    else if (tile < G4) { int t = tile - G3; int i = t / 704; lt = t % 704; src = p.ffn_g + (size_t)i * 1024 * 2816; dst = p.wt_gu + (size_t)i * 5632 * 1024; K = 1024; N = 2816; Np = 2816; mode = 1; }
    else if (tile < G5) { int t = tile - G4; int i = t / 704; lt = t % 704; src = p.ffn_u + (size_t)i * 1024 * 2816; dst = p.wt_gu + (size_t)i * 5632 * 1024; K = 1024; N = 2816; Np = 2816; mode = 2; }
    else if (tile < G6) { int t = tile - G5; int i = t / 704; lt = t % 704; src = p.ffn_d + (size_t)i * 2816 * 1024; dst = p.wt_dn + (size_t)i * 1024 * 2816; K = 2816; N = 1024; Np = 1024; }
    else if (tile < G7) { int t = tile - G6; int i = t / 64; lt = t % 64; src = p.cmp_w1 + (size_t)i * 2048 * 128; dst = p.wt_c1 + (size_t)i * 128 * 2048; K = 2048; N = 128; Np = 128; }
    else { int t = tile - G7; int i = t / 2; lt = t % 2; src = p.cmp_w2 + (size_t)i * 128 * 64; dst = p.wt_c2 + (size_t)i * 64 * 128; K = 128; N = 64; Np = 64; }
    const int ntn = Np / 64;
    prep_tile(src, dst, K, N, mode, lt / ntn, lt % ntn, sm);
  }
  __syncthreads();
  if (blockIdx.x < 4) {
    const int mi = blockIdx.x;
    const float* pe = p.cmp_pe + (size_t)mi * 2048;
    const float* w1 = p.cmp_w1 + (size_t)mi * 2048 * 128;
    const int o = tidx() & 127, half = tidx() >> 7;
    float a0 = 0.f, a1 = 0.f, a2 = 0.f, a3 = 0.f;
    for (int k = half * 1024; k < half * 1024 + 1024; k += 4) {
      a0 += pe[k] * w1[(size_t)k * 128 + o]; a1 += pe[k + 1] * w1[(size_t)(k + 1) * 128 + o];
      a2 += pe[k + 2] * w1[(size_t)(k + 2) * 128 + o]; a3 += pe[k + 3] * w1[(size_t)(k + 3) * 128 + o];
    }
    sm[tidx()] = (a0 + a1) + (a2 + a3);
    __syncthreads();
    if (tidx() < 128) p.c1[mi * 128 + tidx()] = sm[tidx()] + sm[tidx() + 128];
    __syncthreads();
  }
  if (blockIdx.x == 4 || (gridDim.x <= 4 && blockIdx.x == 0)) {
    for (int c = tidx(); c < 512; c += 256) {
      float l0 = p.hy_lb[c], l1 = p.hy_lb[512 + c];
      float mx = fmaxf(l0, l1); float e0 = __expf(l0 - mx), e1 = __expf(l1 - mx); float inv = 1.f / (e0 + e1);
      float p0 = e0 * inv, p1 = e1 * inv;
      p.lb[c] = p0 - p0; p.lb[512 + c] = (p0 + p1) - p0;
    }
  }
}

DI void rmsnorm_phase(const float* x, const float* __restrict__ g, u16* h) {
  const int wave = tidx() >> 6, lane = tidx() & 63;
  for (int row = blockIdx.x * 4 + wave; row < T_; row += gridDim.x * 4) {
    const float4* xr = (const float4*)(x + (size_t)row * 1024);
    float4 v[4]; float ss = 0.f;
#pragma unroll
    for (int j = 0; j < 4; ++j) { v[j] = xr[lane + 64 * j]; ss += v[j].x * v[j].x + v[j].y * v[j].y + v[j].z * v[j].z + v[j].w * v[j].w; }
#pragma unroll
    for (int off = 32; off >= 1; off >>= 1) ss += __shfl_xor(ss, off);
    const float rs = rsqrtf(ss * (1.f / 1024.f) + EPSF);
#pragma unroll
    for (int j = 0; j < 4; ++j) {
      float4 gg = ((const float4*)g)[lane + 64 * j];
      uint2 o; o.x = pack2(v[j].x * rs * gg.x, v[j].y * rs * gg.y); o.y = pack2(v[j].z * rs * gg.z, v[j].w * rs * gg.w);
      *(uint2*)(h + (size_t)row * 1024 + (lane + 64 * j) * 4) = o;
    }
  }
}

template <int EPI>
DI void gemm_phase(const u16* A, int lda, const u16* __restrict__ Bt, int K, int ntn,
                           u16* outb, int ldc, const float* res, float* outf, char* smem) {
  typedef u16 (*TileP)[128][72];
  TileP As = (TileP)smem;
  TileP Bs = (TileP)(smem + 2 * 128 * 72 * 2);
  const int tid = tidx(), lane = tid & 63, w = tid >> 6, hh = lane >> 5, lr = lane & 31, wm = w >> 1, wn = w & 1;
  const int nk = K / 64;
  const int ntiles = 256 * ntn;
  const int lrow = tid >> 3, lcol = (tid & 7) * 8;
  for (int tile = blockIdx.x; tile < ntiles; tile += gridDim.x) {
    const int tm = tile / ntn, tn = tile % ntn;
    const int m0 = tm * 128, n0 = tn * 128;
    f32x16 acc[2][2];
#pragma unroll
    for (int a = 0; a < 2; ++a)
#pragma unroll
      for (int b = 0; b < 2; ++b) acc[a][b] = zero16();
    const u16* Ag = A + (size_t)(m0 + lrow) * lda + lcol;
    const u16* Bg = Bt + (size_t)(n0 + lrow) * K + lcol;
    u32x4v ra0, ra1, ra2, ra3, rb0, rb1, rb2, rb3;
    ra0 = *(const u32x4v*)(Ag); ra1 = *(const u32x4v*)(Ag + (size_t)32 * lda); ra2 = *(const u32x4v*)(Ag + (size_t)64 * lda); ra3 = *(const u32x4v*)(Ag + (size_t)96 * lda);
    rb0 = *(const u32x4v*)(Bg); rb1 = *(const u32x4v*)(Bg + (size_t)32 * K); rb2 = *(const u32x4v*)(Bg + (size_t)64 * K); rb3 = *(const u32x4v*)(Bg + (size_t)96 * K);
    __syncthreads();
    *(u32x4v*)&As[0][lrow][lcol] = ra0; *(u32x4v*)&As[0][lrow + 32][lcol] = ra1; *(u32x4v*)&As[0][lrow + 64][lcol] = ra2; *(u32x4v*)&As[0][lrow + 96][lcol] = ra3;
    *(u32x4v*)&Bs[0][lrow][lcol] = rb0; *(u32x4v*)&Bs[0][lrow + 32][lcol] = rb1; *(u32x4v*)&Bs[0][lrow + 64][lcol] = rb2; *(u32x4v*)&Bs[0][lrow + 96][lcol] = rb3;
    __syncthreads();
    for (int kt = 0; kt < nk; ++kt) {
      const int buf = kt & 1;
      if (kt + 1 < nk) {
        const u16* Ak = Ag + (kt + 1) * 64; const u16* Bk = Bg + (kt + 1) * 64;
        ra0 = *(const u32x4v*)(Ak); ra1 = *(const u32x4v*)(Ak + (size_t)32 * lda); ra2 = *(const u32x4v*)(Ak + (size_t)64 * lda); ra3 = *(const u32x4v*)(Ak + (size_t)96 * lda);
        rb0 = *(const u32x4v*)(Bk); rb1 = *(const u32x4v*)(Bk + (size_t)32 * K); rb2 = *(const u32x4v*)(Bk + (size_t)64 * K); rb3 = *(const u32x4v*)(Bk + (size_t)96 * K);
      }
#pragma unroll
      for (int kk = 0; kk < 4; ++kk) {
        bf16x8 a0 = *(const bf16x8*)&As[buf][wm * 64 + lr][kk * 16 + hh * 8];
        bf16x8 a1 = *(const bf16x8*)&As[buf][wm * 64 + 32 + lr][kk * 16 + hh * 8];
        bf16x8 b0 = *(const bf16x8*)&Bs[buf][wn * 64 + lr][kk * 16 + hh * 8];
        bf16x8 b1 = *(const bf16x8*)&Bs[buf][wn * 64 + 32 + lr][kk * 16 + hh * 8];
        acc[0][0] = MFMA32(a0, b0, acc[0][0]);
        acc[0][1] = MFMA32(a0, b1, acc[0][1]);
        acc[1][0] = MFMA32(a1, b0, acc[1][0]);
        acc[1][1] = MFMA32(a1, b1, acc[1][1]);
      }
      if (kt + 1 < nk) {
        *(u32x4v*)&As[buf ^ 1][lrow][lcol] = ra0; *(u32x4v*)&As[buf ^ 1][lrow + 32][lcol] = ra1; *(u32x4v*)&As[buf ^ 1][lrow + 64][lcol] = ra2; *(u32x4v*)&As[buf ^ 1][lrow + 96][lcol] = ra3;
        *(u32x4v*)&Bs[buf ^ 1][lrow][lcol] = rb0; *(u32x4v*)&Bs[buf ^ 1][lrow + 32][lcol] = rb1; *(u32x4v*)&Bs[buf ^ 1][lrow + 64][lcol] = rb2; *(u32x4v*)&Bs[buf ^ 1][lrow + 96][lcol] = rb3;
      }
      __syncthreads();
    }
#pragma unroll
    for (int mt = 0; mt < 2; ++mt) {
#pragma unroll
      for (int i = 0; i < 16; ++i) {
        const int m = m0 + wm * 64 + mt * 32 + (i & 3) + 8 * (i >> 2) + 4 * hh;
        if (EPI == 0) {
#pragma unroll
          for (int nt = 0; nt < 2; ++nt) outb[(size_t)m * ldc + n0 + wn * 64 + nt * 32 + lr] = f2bf(acc[mt][nt][i]);
        } else if (EPI == 1) {
#pragma unroll
          for (int nt = 0; nt < 2; ++nt) { size_t idx = (size_t)m * 1024 + n0 + wn * 64 + nt * 32 + lr; outf[idx] = res[idx] + acc[mt][nt][i]; }
        } else {
          const float gv = acc[mt][0][i], uv = acc[mt][1][i];
          outb[(size_t)m * DFF + (n0 >> 1) + wn * 32 + lr] = f2bf(fsilu(gv) * uv);
        }
      }
    }
  }
}

DI void hgrn_item(const Params& p, int li, int item, char* smem) {
  float* qs = (float*)smem;
  float* fs = qs + 2 * 16 * 128;
  float* vsm = fs + 2 * 16 * 128;
  float* opart = vsm + 2 * 16 * 16;
  const int tid = tidx(), lane = tid & 63, w = tid >> 6;
  const int vs = item & 7, h = (item >> 3) & 3, b = item >> 5;
  const int kq = lane >> 4, vc = lane & 15;
  const int k0 = 32 * w + 8 * kq;
  const int tok = tid >> 4, piece = tid & 15;
  const u16* base = p.proj + (size_t)b * S_ * LD_EVEN;
  float lbv[8];
#pragma unroll
  for (int j = 0; j < 8; ++j) lbv[j] = p.lb[li * 512 + h * 128 + piece * 8 + j];
  float st[8];
#pragma unroll
  for (int j = 0; j < 8; ++j) st[j] = 0.f;
  uint4 rq, rf, rv = make_uint4(0, 0, 0, 0);
  {
    const u16* r = base + (size_t)tok * LD_EVEN + h * 128 + piece * 8;
    rq = *(const uint4*)r; rf = *(const uint4*)(r + 512);
    if (tid < 32) rv = *(const uint4*)(base + (size_t)(tid >> 1) * LD_EVEN + 1024 + h * 128 + vs * 16 + (tid & 1) * 8);
  }
  __syncthreads();
  for (int c = 0; c < 128; ++c) {
    const int buf = c & 1;
    {
      float q8[8], f8[8];
      unpack8(rq, q8); unpack8(rf, f8);
#pragma unroll
      for (int j = 0; j < 8; ++j) { q8[j] = fsilu(q8[j]); f8[j] = lbv[j] + (1.f - lbv[j]) * fsigmoid(f8[j]); }
      float4* qd = (float4*)(qs + (buf * 16 + tok) * 128 + piece * 8);
      qd[0] = make_float4(q8[0], q8[1], q8[2], q8[3]); qd[1] = make_float4(q8[4], q8[5], q8[6], q8[7]);
      float4* fd = (float4*)(fs + (buf * 16 + tok) * 128 + piece * 8);
      fd[0] = make_float4(f8[0], f8[1], f8[2], f8[3]); fd[1] = make_float4(f8[4], f8[5], f8[6], f8[7]);
      if (tid < 32) {
        float v8[8]; unpack8(rv, v8);
        float4* vd = (float4*)(vsm + (buf * 16 + (tid >> 1)) * 16 + (tid & 1) * 8);
        vd[0] = make_float4(v8[0], v8[1], v8[2], v8[3]); vd[1] = make_float4(v8[4], v8[5], v8[6], v8[7]);
      }
    }
    __syncthreads();
    if (c + 1 < 128) {
      const u16* r = base + (size_t)((c + 1) * 16 + tok) * LD_EVEN + h * 128 + piece * 8;
      rq = *(const uint4*)r; rf = *(const uint4*)(r + 512);
      if (tid < 32) rv = *(const uint4*)(base + (size_t)((c + 1) * 16 + (tid >> 1)) * LD_EVEN + 1024 + h * 128 + vs * 16 + (tid & 1) * 8);
    }
#pragma unroll 4
    for (int t = 0; t < 16; ++t) {
      const float4* q4 = (const float4*)(qs + (buf * 16 + t) * 128 + k0);
      const float4* f4 = (const float4*)(fs + (buf * 16 + t) * 128 + k0);
      const float4 qa = q4[0], qb = q4[1], fa = f4[0], fb = f4[1];
      const float v = vsm[(buf * 16 + t) * 16 + vc];
      st[0] = fa.x * (st[0] - v) + v; st[1] = fa.y * (st[1] - v) + v; st[2] = fa.z * (st[2] - v) + v; st[3] = fa.w * (st[3] - v) + v;
      st[4] = fb.x * (st[4] - v) + v; st[5] = fb.y * (st[5] - v) + v; st[6] = fb.z * (st[6] - v) + v; st[7] = fb.w * (st[7] - v) + v;
      float o = qa.x * st[0];
      o += qa.y * st[1]; o += qa.z * st[2]; o += qa.w * st[3]; o += qb.x * st[4]; o += qb.y * st[5]; o += qb.z * st[6]; o += qb.w * st[7];
      opart[(t * 16 + w * 4 + kq) * 16 + vc] = o;
    }
    __syncthreads();
    {
      const int t = tid >> 4, v2 = tid & 15;
      float s = 0.f;
#pragma unroll
      for (int jj = 0; jj < 16; ++jj) s += opart[(t * 16 + jj) * 16 + v2];
      p.hbuf[(size_t)(b * S_ + c * 16 + t) * 1024 + h * 128 + vs * 16 + v2] = f2bf(s);
    }
  }
  __syncthreads();
}

DI void load_q(const u16* qrow, const float* __restrict__ gain, int hh, bf16x8 (&qf)[4]) {
  float f[4][8]; float ss = 0.f;
#pragma unroll
  for (int kk = 0; kk < 4; ++kk) {
    uint4 raw = *(const uint4*)(qrow + kk * 16 + hh * 8);
    unpack8(raw, f[kk]);
#pragma unroll
    for (int j = 0; j < 8; ++j) ss += f[kk][j] * f[kk][j];
  }
  ss += __shfl_xor(ss, 32);
  const float rs = rsqrtf(ss * (1.f / 64.f) + EPSF) * (0.125f * LOG2E);
#pragma unroll
  for (int kk = 0; kk < 4; ++kk) {
#pragma unroll
    for (int j = 0; j < 8; ++j) f[kk][j] *= rs * gain[kk * 16 + hh * 8 + j];
    qf[kk] = as_bf16x8(pack8(f[kk]));
  }
}

DI void stage_kv(const u16* kb, const u16* vb, size_t stride, int r0, int rlo, int rhi, const float* __restrict__ kgain, u16* Ks, u16* Vts) {
  const int tid = tidx(); const int dp = tid & 7;
#pragma unroll
  for (int j = 0; j < 2; ++j) {
    const int key = (tid >> 3) + 32 * j; const int r = r0 + key;
    uint4 kv = make_uint4(0, 0, 0, 0), vv = make_uint4(0, 0, 0, 0);
    if (r >= rlo && r < rhi) { kv = *(const uint4*)(kb + (size_t)r * stride + dp * 8); vv = *(const uint4*)(vb + (size_t)r * stride + dp * 8); }
    if (kgain) {
      float f[8]; unpack8(kv, f);
      float ss = 0.f;
#pragma unroll
      for (int e = 0; e < 8; ++e) ss += f[e] * f[e];
      ss += __shfl_xor(ss, 1); ss += __shfl_xor(ss, 2); ss += __shfl_xor(ss, 4);
      const float rs = rsqrtf(ss * (1.f / 64.f) + EPSF);
#pragma unroll
      for (int e = 0; e < 8; ++e) f[e] *= rs * kgain[dp * 8 + e];
      kv = pack8(f);
    }
    *(uint4*)(Ks + key * 72 + dp * 8) = kv;
    u16* vd = Vts + (dp * 8) * 72 + key;
    vd[0 * 72] = (u16)(vv.x & 0xffffu); vd[1 * 72] = (u16)(vv.x >> 16);
    vd[2 * 72] = (u16)(vv.y & 0xffffu); vd[3 * 72] = (u16)(vv.y >> 16);
    vd[4 * 72] = (u16)(vv.z & 0xffffu); vd[5 * 72] = (u16)(vv.z >> 16);
    vd[6 * 72] = (u16)(vv.w & 0xffffu); vd[7 * 72] = (u16)(vv.w >> 16);
  }
}

template <class MF>
DI void score_stage(const bf16x8 (&qf)[4], const u16* Ks, int lane, MF maskf, f32x16 (&s)[2], float& mx) {
  const int lr = lane & 31, hh = lane >> 5;
#pragma unroll
  for (int sub = 0; sub < 2; ++sub) {
    s[sub] = zero16();
#pragma unroll
    for (int kk = 0; kk < 4; ++kk) {
      bf16x8 kf = *(const bf16x8*)(Ks + (sub * 32 + lr) * 72 + kk * 16 + hh * 8);
      s[sub] = MFMA32(kf, qf[kk], s[sub]);
    }
  }
  mx = -INFINITY;
#pragma unroll
  for (int sub = 0; sub < 2; ++sub)
#pragma unroll
    for (int i = 0; i < 16; ++i) {
      const int ko = sub * 32 + (i & 3) + 8 * (i >> 2) + 4 * hh;
      const float v = maskf(s[sub][i], ko);
      s[sub][i] = v; mx = fmaxf(mx, v);
    }
  mx = fmaxf(mx, __shfl_xor(mx, 32));
}

DI void pv_stage(const f32x16 (&s)[2], const u16* Vts, f32x16 (&o)[2], int lane) {
  const int lr = lane & 31, hh = lane >> 5;
#pragma unroll
  for (int sub = 0; sub < 2; ++sub)
#pragma unroll
    for (int st = 0; st < 2; ++st) {
      uint4 pk;
      pk.x = pack2(s[sub][8 * st + 0], s[sub][8 * st + 1]); pk.y = pack2(s[sub][8 * st + 2], s[sub][8 * st + 3]);
      pk.z = pack2(s[sub][8 * st + 4], s[sub][8 * st + 5]); pk.w = pack2(s[sub][8 * st + 6], s[sub][8 * st + 7]);
      const bf16x8 pf = as_bf16x8(pk);
#pragma unroll
      for (int dt = 0; dt < 2; ++dt) {
        const u16* vp = Vts + (dt * 32 + lr) * 72 + sub * 32 + 16 * st + 4 * hh;
        const uint2 lo = *(const uint2*)vp, hi = *(const uint2*)(vp + 8);
        const bf16x8 vf = as_bf16x8(make_uint4(lo.x, lo.y, hi.x, hi.y));
        o[dt] = MFMA32(vf, pf, o[dt]);
      }
    }
}

template <class MF>
DI void flash_stage(const bf16x8 (&qf)[4], const u16* Ks, const u16* Vts, f32x16 (&o)[2], float& m, float& l, int lane, MF maskf) {
  f32x16 s[2]; float mx;
  score_stage(qf, Ks, lane, maskf, s, mx);
  const float mn = fmaxf(m, mx);
  const float alpha = fexp2(m - mn);
  m = mn;
  float ls = 0.f;
#pragma unroll
  for (int sub = 0; sub < 2; ++sub)
#pragma unroll
    for (int i = 0; i < 16; ++i) { const float pv = fexp2(s[sub][i] - mn); s[sub][i] = pv; ls += pv; }
  l = l * alpha + ls;
#pragma unroll
  for (int dt = 0; dt < 2; ++dt)
#pragma unroll
    for (int i = 0; i < 16; ++i) o[dt][i] *= alpha;
  pv_stage(s, Vts, o, lane);
}

DI void dilated_item(const Params& p, int li, int item, char* smem) {
  u16* Ks = (u16*)smem; u16* Vts = Ks + 64 * 72;
  const int tid = tidx(), lane = tid & 63, w = tid >> 6, lr = lane & 31, hh = lane >> 5;
  const int idx16 = item & 15; const int br = (item >> 4) % 3; const int hb = (item / 48) & 7; const int b = item / 384;
  const int d = br == 0 ? 1 : (br == 1 ? 4 : 16);
  const int tiles = 16 / d;
  const int resid = idx16 / tiles, tile = idx16 % tiles;
  const int u0 = tile * 128;
  const int uq = u0 + 32 * w + lr; const int tq = uq * d + resid;
  const u16* prow = p.proj + (size_t)(b * S_ + tq) * LD_EVEN;
  bf16x8 qf[4];
  load_q(prow + 2048 + hb * 64, p.hy_qg + li * 64, hh, qf);
  const float slope2 = fexp2(-(float)(hb + 1)) * LOG2E * (float)d;
  const u16* kb = p.proj + (size_t)(b * S_ + resid) * LD_EVEN + 2560 + hb * 64;
  const u16* vb = kb + 512;
  const size_t stride = (size_t)d * LD_EVEN;
  f32x16 o[2]; o[0] = zero16(); o[1] = zero16();
  float m = -1e30f, l = 0.f;
  const int uw = u0 + 32 * w;
  for (int st = 0; st < 4; ++st) {
    const int ub = u0 - 128 + 64 * st;
    if (ub + 63 < 0) continue;
    __syncthreads();
    stage_kv(kb, vb, stride, ub, 0, 1 << 30, p.hy_kg + li * 64, Ks, Vts);
    __syncthreads();
    if (ub <= uw + 31 && ub + 63 >= uw - 128) {
      flash_stage(qf, Ks, Vts, o, m, l, lane, [&](float sv, int ko) -> float {
        const int kp = ub + ko; const int dist = uq - kp;
        return (dist >= 0 && dist <= 128 && kp >= 0) ? sv - slope2 * (float)dist : -INFINITY; });
    }
  }
  const float lt = l + __shfl_xor(l, 32);
  const float inv = 1.f / lt;
  const size_t trow = (size_t)br * T_ + (size_t)b * S_ + tq;
  if (hh == 0) p.lse[trow * 8 + hb] = (m + log2f(lt)) * LN2;
  u16* orow = p.obr + trow * 512 + hb * 64;
#pragma unroll
  for (int dt = 0; dt < 2; ++dt)
#pragma unroll
    for (int q4 = 0; q4 < 4; ++q4) {
      uint2 ov; ov.x = pack2(o[dt][4 * q4] * inv, o[dt][4 * q4 + 1] * inv); ov.y = pack2(o[dt][4 * q4 + 2] * inv, o[dt][4 * q4 + 3] * inv);
      *(uint2*)(orow + dt * 32 + 8 * q4 + 4 * hh) = ov;
    }
  __syncthreads();
}

DI void post_even_phase(const Params& p, int li) {
  const int tid = tidx();
  const int rsel = tid >> 7, c8 = tid & 127;
  for (int it = blockIdx.x; it < T_ / 2; it += gridDim.x) {
    const int t = it * 2 + rsel;
    const int c = c8 * 8;
    float val[8];
    if (c8 < 64) {
      uint4 raw = *(const uint4*)(p.hbuf + (size_t)t * 1024 + c);
      float o[8]; unpack8(raw, o);
      float ss = 0.f;
#pragma unroll
      for (int j = 0; j < 8; ++j) ss += o[j] * o[j];
      ss += __shfl_xor(ss, 1); ss += __shfl_xor(ss, 2); ss += __shfl_xor(ss, 4); ss += __shfl_xor(ss, 8);
      const float rs = rsqrtf(ss * (1.f / 128.f) + EPSF);
      uint4 graw = *(const uint4*)(p.proj + (size_t)t * LD_EVEN + 1536 + c);
      float gt[8]; unpack8(graw, gt);
#pragma unroll
      for (int j = 0; j < 8; ++j) val[j] = o[j] * rs * p.hy_og[li * 512 + c + j] * fsilu(gt[j]);
    } else {
      const int cb = c - 512, hb = cb >> 6;
      float l0 = p.lse[((size_t)0 * T_ + t) * 8 + hb], l1 = p.lse[((size_t)1 * T_ + t) * 8 + hb], l2 = p.lse[((size_t)2 * T_ + t) * 8 + hb];
      const float mx = fmaxf(l0, fmaxf(l1, l2));
      float w0 = __expf(l0 - mx), w1 = __expf(l1 - mx), w2 = __expf(l2 - mx);
      const float inv = 1.f / (w0 + w1 + w2);
      w0 *= inv; w1 *= inv; w2 *= inv;
      float a[8], bq[8], cq[8];
      unpack8(*(const uint4*)(p.obr + ((size_t)0 * T_ + t) * 512 + cb), a);
      unpack8(*(const uint4*)(p.obr + ((size_t)1 * T_ + t) * 512 + cb), bq);
      unpack8(*(const uint4*)(p.obr + ((size_t)2 * T_ + t) * 512 + cb), cq);
#pragma unroll
      for (int j = 0; j < 8; ++j) val[j] = w0 * a[j] + w1 * bq[j] + w2 * cq[j];
    }
    *(uint4*)(p.hbuf + (size_t)t * 1024 + c) = pack8(val);
  }
}

DI void compress_item(const Params& p, int li, int item, char* smem) {
  u16* hs = (u16*)smem;
  float* outs = (float*)(smem + 32 * 136 * 2);
  const int tid = tidx(), lane = tid & 63, w = tid >> 6, lr = lane & 31, hh = lane >> 5;
  const int nt = item & 3, g = (item >> 2) & 3, b = (item >> 4) & 15, kv = item >> 8;
  const int n = nt * 32 + lr; const int nc = n > 126 ? 126 : n;
  const int col = 1024 + kv * 256 + g * 64;
  const u16* arow = p.proj + (size_t)(b * S_ + 16 * nc) * LD_ODD + col;
  const u16* w1t = p.wt_c1 + (size_t)(li * 2 + kv) * 128 * 2048 + (size_t)(32 * w + lr) * 2048;
  f32x16 acc = zero16();
#pragma unroll 4
  for (int ks = 0; ks < 128; ++ks) {
    const int lidx = ks >> 2, dd = (ks & 3) * 16 + hh * 8;
    const bf16x8 a = as_bf16x8(*(const uint4*)(arow + (size_t)lidx * LD_ODD + dd));
    const bf16x8 bb = as_bf16x8(*(const uint4*)(w1t + ks * 16 + hh * 8));
    acc = MFMA32(a, bb, acc);
  }
  const float cb = p.c1[(li * 2 + kv) * 128 + 32 * w + lr];
  __syncthreads();
#pragma unroll
  for (int i = 0; i < 16; ++i) {
    const int r = (i & 3) + 8 * (i >> 2) + 4 * hh;
    hs[r * 136 + 32 * w + lr] = f2bf(fsilu(acc[i] + cb));
  }
  __syncthreads();
  if (w < 2) {
    const u16* w2t = p.wt_c2 + (size_t)(li * 2 + kv) * 64 * 128 + (size_t)(w * 32 + lr) * 128;
    f32x16 a2 = zero16();
#pragma unroll
    for (int kk = 0; kk < 8; ++kk) {
      const bf16x8 a = *(const bf16x8*)(hs + lr * 136 + kk * 16 + hh * 8);
      const bf16x8 bb = as_bf16x8(*(const uint4*)(w2t + kk * 16 + hh * 8));
      a2 = MFMA32(a, bb, a2);
    }
#pragma unroll
    for (int i = 0; i < 16; ++i) {
      const int r = (i & 3) + 8 * (i >> 2) + 4 * hh;
      outs[r * 65 + w * 32 + lr] = a2[i];
    }
  }
  __syncthreads();
  {
    const int r = tid >> 3, c8 = tid & 7;
    float v[8]; float ss = 0.f;
#pragma unroll
    for (int j = 0; j < 8; ++j) { v[j] = outs[r * 65 + c8 * 8 + j]; ss += v[j] * v[j]; }
    ss += __shfl_xor(ss, 1); ss += __shfl_xor(ss, 2); ss += __shfl_xor(ss, 4);
    if (kv == 0) {
      const float rs = rsqrtf(ss * (1.f / 64.f) + EPSF);
#pragma unroll
      for (int j = 0; j < 8; ++j) v[j] *= rs * p.nsa_kg[(li * 3 + 0) * 64 + c8 * 8 + j];
    }
    const int nn = nt * 32 + r;
    if (nn >= 127) {
#pragma unroll
      for (int j = 0; j < 8; ++j) v[j] = 0.f;
    }
    u16* dst = (kv == 0 ? p.kcmp : p.vcmp) + ((size_t)(b * 4 + g) * 128 + nn) * 64 + c8 * 8;
    *(uint4*)dst = pack8(v);
  }
  __syncthreads();
}

DI void nsa_item(const Params& p, int li, int item, char* smem) {
  u16* Ks = (u16*)smem; u16* Vts = Ks + 64 * 72;
  float* impA = (float*)(smem + 18432);
  float* impB = impA + 4096;
  float* imp = impB + 4096;
  unsigned* selm = (unsigned*)(imp + 32 * 33);
  const int tid = tidx(), lane = tid & 63, w = tid >> 6, lr = lane & 31, hh = lane >> 5;
  const int tt = item & 63, g = (item >> 6) & 3, b = item >> 8;
  const int t0 = tt * 32; const int cur = t0 >> 6;
  const int hd = g * 4 + w;
  const int tq = t0 + lr;
  const u16* pb = p.proj + (size_t)b * S_ * LD_ODD;
  const u16* prow = pb + (size_t)tq * LD_ODD;
  bf16x8 qf[4];
  load_q(prow + g * 256 + w * 64, p.nsa_qg + li * 64, hh, qf);
  const float slope2 = fexp2(-0.5f * (float)(hd + 1)) * LOG2E;
  const float g0 = fsigmoid(bf2f(prow[2560 + 0 + g * 4 + w]));
  const float g1 = fsigmoid(bf2f(prow[2560 + 16 + g * 4 + w]));
  const float g2 = fsigmoid(bf2f(prow[2560 + 32 + g * 4 + w]));
  f32x16 ot[2]; ot[0] = zero16(); ot[1] = zero16();
  {
    const u16* kb = p.kcmp + (size_t)(b * 4 + g) * 128 * 64;
    const u16* vb = p.vcmp + (size_t)(b * 4 + g) * 128 * 64;
    float m = -1e30f, l = 0.f;
#pragma unroll
    for (int st = 0; st < 2; ++st) {
      if (1024 * st > t0) continue;
      __syncthreads();
      stage_kv(kb, vb, 64, 64 * st, 0, 128, nullptr, Ks, Vts);
      __syncthreads();
      f32x16 s[2]; float mx;
      score_stage(qf, Ks, lane, [&](float sv, int ko) -> float {
        const int n = 64 * st + ko; const int dist = tq - (16 * n + 31);
        return (dist >= 0 && n < 127) ? sv - slope2 * (float)dist : -INFINITY; }, s, mx);
      const float mn = fmaxf(m, mx);
      float ls = 0.f;
#pragma unroll
      for (int sub = 0; sub < 2; ++sub)
#pragma unroll
        for (int i = 0; i < 16; ++i) ls += fexp2(s[sub][i] - mn);
      l = l * fexp2(m - mn) + ls;
      m = mn;
    }
    const float lt = l + __shfl_xor(l, 32);
    const float inv = lt > 0.f ? 1.f / lt : 0.f;
    f32x16 o[2]; o[0] = zero16(); o[1] = zero16();
#pragma unroll
    for (int st = 0; st < 2; ++st) {
      if (1024 * st > t0) {
#pragma unroll
        for (int G = 0; G < 16; ++G) {
          if ((G & 1) == hh) { impA[(w * 32 + lr) * 32 + 16 * st + G] = 0.f; impB[(w * 32 + lr) * 32 + 16 * st + G] = 0.f; }
        }
        continue;
      }
      __syncthreads();
      stage_kv(kb, vb, 64, 64 * st, 0, 128, nullptr, Ks, Vts);
      __syncthreads();
      f32x16 s[2]; float mx;
      score_stage(qf, Ks, lane, [&](float sv, int ko) -> float {
        const int n = 64 * st + ko; const int dist = tq - (16 * n + 31);
        return (dist >= 0 && n < 127) ? sv - slope2 * (float)dist : -INFINITY; }, s, mx);
#pragma unroll
      for (int sub = 0; sub < 2; ++sub)
#pragma unroll
        for (int i = 0; i < 16; ++i) s[sub][i] = fexp2(s[sub][i] - m) * inv;
#pragma unroll
      for (int sub = 0; sub < 2; ++sub)
#pragma unroll
        for (int q4 = 0; q4 < 4; ++q4) {
          const int G = 16 * st + 8 * sub + 2 * q4 + hh;
          impA[(w * 32 + lr) * 32 + G] = (s[sub][4 * q4] + s[sub][4 * q4 + 1]) + (s[sub][4 * q4 + 2] + s[sub][4 * q4 + 3]);
          impB[(w * 32 + lr) * 32 + G] = s[sub][4 * q4 + 3];
        }
      pv_stage(s, Vts, o, lane);
    }
#pragma unroll
    for (int dt = 0; dt < 2; ++dt)
#pragma unroll
      for (int i = 0; i < 16; ++i) ot[dt][i] += g0 * o[dt][i];
  }
  __syncthreads();
  for (int idx = tid; idx < 1024; idx += 256) {
    const int tok = idx >> 5, mm = idx & 31;
    float a = 0.f;
#pragma unroll
    for (int ww = 0; ww < 4; ++ww) a += impA[(ww * 32 + tok) * 32 + mm] + (mm > 0 ? impB[(ww * 32 + tok) * 32 + mm - 1] : 0.f);
    imp[tok * 33 + mm] = a;
  }
  __syncthreads();
  if (tid < 32) {
    unsigned sel = 1u | (1u << cur) | (cur > 0 ? (1u << (cur - 1)) : 0u);
    int cnt = __popc(sel);
    const float* im = imp + tid * 33;
    for (int r = cnt; r < 8; ++r) {
      int best = -1; float bv = 0.f;
      for (int mm = 0; mm <= cur; ++mm) {
        if ((sel >> mm) & 1u) continue;
        const float v = im[mm];
        if (best < 0 || v > bv) { best = mm; bv = v; }
      }
      if (best < 0) break;
      sel |= 1u << best;
    }
    selm[tid] = sel;
  }
  __syncthreads();
  const unsigned myMask = selm[lr];
  unsigned uni = 0u;
#pragma unroll 8
  for (int i = 0; i < 32; ++i) uni |= selm[i];
  {
    f32x16 o[2]; o[0] = zero16(); o[1] = zero16();
    float m = -1e30f, l = 0.f;
    const u16* kb = pb + 1536 + g * 64; const u16* vb = pb + 1792 + g * 64;
    for (int mb = 0; mb <= cur; ++mb) {
      if (!((uni >> mb) & 1u)) continue;
      __syncthreads();
      stage_kv(kb, vb, LD_ODD, 64 * mb, 0, S_, p.nsa_kg + (li * 3 + 1) * 64, Ks, Vts);
      __syncthreads();
      const bool selb = (myMask >> mb) & 1u;
      flash_stage(qf, Ks, Vts, o, m, l, lane, [&](float s, int ko) -> float {
        const int dist = tq - (64 * mb + ko);
        return (selb && dist >= 0) ? s - slope2 * (float)dist : -INFINITY; });
    }
    const float lt = l + __shfl_xor(l, 32);
    const float sc = g1 / lt;
#pragma unroll
    for (int dt = 0; dt < 2; ++dt)
#pragma unroll
      for (int i = 0; i < 16; ++i) ot[dt][i] += sc * o[dt][i];
  }
  {
    f32x16 o[2]; o[0] = zero16(); o[1] = zero16();
    float m = -1e30f, l = 0.f;
    const u16* kb = pb + 2048 + g * 64; const u16* vb = pb + 2304 + g * 64;
    const int mlo = (t0 - 511) < 0 ? 0 : ((t0 - 511) >> 6);
    for (int mb = mlo; mb <= cur; ++mb) {
      __syncthreads();
      stage_kv(kb, vb, LD_ODD, 64 * mb, 0, S_, p.nsa_kg + (li * 3 + 2) * 64, Ks, Vts);
      __syncthreads();
      flash_stage(qf, Ks, Vts, o, m, l, lane, [&](float s, int ko) -> float {
        const int dist = tq - (64 * mb + ko);
        return (dist >= 0 && dist <= 511) ? s - slope2 * (float)dist : -INFINITY; });
    }
    const float lt = l + __shfl_xor(l, 32);
    const float sc = g2 / lt;
#pragma unroll
    for (int dt = 0; dt < 2; ++dt)
#pragma unroll
      for (int i = 0; i < 16; ++i) ot[dt][i] += sc * o[dt][i];
  }
  u16* orow = p.hbuf + (size_t)(b * S_ + tq) * 1024 + g * 256 + w * 64;
#pragma unroll
  for (int dt = 0; dt < 2; ++dt)
#pragma unroll
    for (int q4 = 0; q4 < 4; ++q4) {
      uint2 ov; ov.x = pack2(ot[dt][4 * q4], ot[dt][4 * q4 + 1]); ov.y = pack2(ot[dt][4 * q4 + 2], ot[dt][4 * q4 + 3]);
      *(uint2*)(orow + dt * 32 + 8 * q4 + 4 * hh) = ov;
    }
  __syncthreads();
}

DI void run_phase(const Params& p, int ph, char* smem) {
  if (ph == 0) { prep_phase(p, smem); return; }
  const int l = (ph - 1) >> 3, s = (ph - 1) & 7, li = l >> 1;
  const bool even = (l & 1) == 0;
  const float* xin = (l == 0) ? p.x : p.out;
  switch (s) {
    case 0: rmsnorm_phase(xin, p.attn_norm + l * 1024, p.hbuf); break;
    case 1:
      if (even) gemm_phase<0>(p.hbuf, 1024, p.wt_hy_in + (size_t)li * 3584 * 1024, 1024, 28, p.proj, LD_EVEN, nullptr, nullptr, smem);
      else gemm_phase<0>(p.hbuf, 1024, p.wt_nsa_in + (size_t)li * 2688 * 1024, 1024, 21, p.proj, LD_ODD, nullptr, nullptr, smem);
      break;
    case 2:
      if (even) {
        for (int item = blockIdx.x; item < 512 + 6144; item += gridDim.x) {
          if (item < 512) hgrn_item(p, li, item, smem); else dilated_item(p, li, item - 512, smem);
        }
      } else {
        for (int item = blockIdx.x; item < 512; item += gridDim.x) compress_item(p, li, item, smem);
      }
      break;
    case 3:
      if (even) post_even_phase(p, li);
      else { for (int item = blockIdx.x; item < 4096; item += gridDim.x) nsa_item(p, li, item, smem); }
      break;
    case 4:
      gemm_phase<1>(p.hbuf, 1024, (even ? p.wt_hy_out : p.wt_nsa_out) + (size_t)li * 1048576, 1024, 8, nullptr, 0, xin, p.out, smem);
      break;
    case 5: rmsnorm_phase(p.out, p.ffn_norm + l * 1024, p.hbuf); break;
    case 6: gemm_phase<2>(p.hbuf, 1024, p.wt_gu + (size_t)l * 5632 * 1024, 1024, 44, p.proj, DFF, nullptr, nullptr, smem); break;
    case 7: gemm_phase<1>(p.proj, DFF, p.wt_dn + (size_t)l * 1024 * 2816, 2816, 8, nullptr, 0, p.out, p.out, smem); break;
  }
}

__global__ void __launch_bounds__(256, 2) mk_forward(Params p) {
  __shared__ __attribute__((aligned(16))) char smem[73728];
  cg::grid_group grid = cg::this_grid();
  for (int ph = p.phase_lo; ph < p.phase_hi; ++ph) {
    run_phase(p, ph, smem);
    if (ph + 1 < p.phase_hi) grid.sync();
  }
}

extern "C" void kernel_launch(void* const* d_in, const int* in_sizes, int n_in, void* d_out, int out_size,
                              void* d_ws, size_t ws_size, hipStream_t stream) {
  static int grid_blocks = 0;
  if (!grid_blocks) {
    int dev = 0, cus = 0, per_cu = 0;
    hipGetDevice(&dev);
    hipDeviceGetAttribute(&cus, hipDeviceAttributeMultiprocessorCount, dev);
    hipOccupancyMaxActiveBlocksPerMultiprocessor(&per_cu, mk_forward, 256, 0);
    if (per_cu > 2) per_cu = 2;
    if (per_cu < 1) per_cu = 1;
    grid_blocks = cus * per_cu;
  }
  Params p;
  memset(&p, 0, sizeof(p));
  p.x = (const float*)d_in[0]; p.attn_norm = (const float*)d_in[1]; p.ffn_norm = (const float*)d_in[2];
  p.hy_w_in = (const float*)d_in[3]; p.hy_lb = (const float*)d_in[4]; p.hy_og = (const float*)d_in[5];
  p.hy_qg = (const float*)d_in[6]; p.hy_kg = (const float*)d_in[7]; p.hy_w_out = (const float*)d_in[8];
  p.nsa_w_in = (const float*)d_in[9]; p.nsa_qg = (const float*)d_in[10]; p.nsa_kg = (const float*)d_in[11];
  p.cmp_pe = (const float*)d_in[12]; p.cmp_w1 = (const float*)d_in[13]; p.cmp_w2 = (const float*)d_in[14];
  p.nsa_w_out = (const float*)d_in[15]; p.ffn_g = (const float*)d_in[16]; p.ffn_u = (const float*)d_in[17]; p.ffn_d = (const float*)d_in[18];
  p.out = (float*)d_out;
  char* ws = (char*)d_ws; size_t off = 0;
  auto take = [&](size_t bytes) { char* r = ws + off; off += (bytes + 255) & ~(size_t)255; return r; };
  p.wt_hy_in = (u16*)take((size_t)2 * 3584 * 1024 * 2);
  p.wt_hy_out = (u16*)take((size_t)2 * 1048576 * 2);
  p.wt_nsa_in = (u16*)take((size_t)2 * 2688 * 1024 * 2);
  p.wt_nsa_out = (u16*)take((size_t)2 * 1048576 * 2);
  p.wt_gu = (u16*)take((size_t)4 * 5632 * 1024 * 2);
  p.wt_dn = (u16*)take((size_t)4 * 1024 * 2816 * 2);
  p.wt_c1 = (u16*)take((size_t)4 * 128 * 2048 * 2);
  p.wt_c2 = (u16*)take((size_t)4 * 64 * 128 * 2);
  p.c1 = (float*)take(4 * 128 * 4);
  p.lb = (float*)take(2 * 512 * 4);
  p.lse = (float*)take((size_t)3 * T_ * 8 * 4);
  p.proj = (u16*)take((size_t)T_ * 3584 * 2);
  p.hbuf = (u16*)take((size_t)T_ * 1024 * 2);
  p.obr = (u16*)take((size_t)3 * T_ * 512 * 2);
  p.kcmp = (u16*)take((size_t)16 * 4 * 128 * 64 * 2);
  p.vcmp = (u16*)take((size_t)16 * 4 * 128 * 64 * 2);
  if (off > ws_size) { fprintf(stderr, "workspace too small: need %zu have %zu\n", off, ws_size); return; }
  const int NPH = 33;
#if MK_MULTI
  for (int ph = 0; ph < NPH; ++ph) {
    p.phase_lo = ph; p.phase_hi = ph + 1;
    hipLaunchKernelGGL(mk_forward, dim3(grid_blocks), dim3(256), 0, stream, p);
  }
#else
  p.phase_lo = 0; p.phase_hi = NPH;
  void* args[] = {&p};
  hipError_t e = hipLaunchCooperativeKernel((void*)mk_forward, dim3(grid_blocks), dim3(256), args, 0, stream);
  if (e != hipSuccess) fprintf(stderr, "cooperative launch failed: %s (grid %d)\n", hipGetErrorString(e), grid_blocks);
#endif
}
```

```cpp
#include <hip/hip_runtime.h>
#include <hip/hip_cooperative_groups.h>
#include <cstdio>
#include <cstdint>
#include <cstring>
namespace cg = cooperative_groups;

typedef unsigned short u16;
using bf16x8 = __attribute__((ext_vector_type(8))) short;
using f32x16 = __attribute__((ext_vector_type(16))) float;
using u32x4v = __attribute__((ext_vector_type(4))) unsigned;
#define DI __device__ __forceinline__
#define MFMA32(a, b, c) __builtin_amdgcn_mfma_f32_32x32x16_bf16((a), (b), (c), 0, 0, 0)

#ifndef MK_MULTI
#define MK_MULTI 0
#endif

constexpr int T_ = 32768, S_ = 2048;
constexpr float EPSF = 1e-6f;
constexpr float LOG2E = 1.4426950408889634f, LN2 = 0.6931471805599453f;
constexpr int LD_EVEN = 3584, LD_ODD = 2816, DFF = 2816;
constexpr int NT = 512;
#define LAS __attribute__((address_space(3)))
using f32x4v = __attribute__((ext_vector_type(4))) float;

struct Params {
  const float* x; const float* attn_norm; const float* ffn_norm;
  const float* hy_w_in; const float* hy_lb; const float* hy_og; const float* hy_qg; const float* hy_kg; const float* hy_w_out;
  const float* nsa_w_in; const float* nsa_qg; const float* nsa_kg; const float* cmp_pe; const float* cmp_w1; const float* cmp_w2; const float* nsa_w_out;
  const float* ffn_g; const float* ffn_u; const float* ffn_d;
  float* out;
  u16* wt_hy_in; u16* wt_hy_out; u16* wt_nsa_in; u16* wt_nsa_out; u16* wt_gu; u16* wt_dn; u16* wt_c1; u16* wt_c2;
  float* c1; float* lb; float* lse;
  u16* proj; u16* hbuf; u16* obr; u16* kcmp; u16* vcmp;
  int phase_lo; int phase_hi;
};

DI int tidx() { int t = __builtin_amdgcn_workitem_id_x(); asm volatile("" : "+v"(t)); return t; }
DI float bf2f(u16 h) { return __uint_as_float(((unsigned)h) << 16); }
DI u16 f2bf(float x) { unsigned u = __float_as_uint(x); u += 0x7fffu + ((u >> 16) & 1u); return (u16)(u >> 16); }
DI unsigned pack2(float a, float b) { return (unsigned)f2bf(a) | ((unsigned)f2bf(b) << 16); }
DI float fsigmoid(float x) { return 1.f / (1.f + __expf(-x)); }
DI float fsilu(float x) { return x / (1.f + __expf(-x)); }
DI float fexp2(float x) { return __builtin_amdgcn_exp2f(x); }
DI void unpack8(uint4 v, float (&f)[8]) {
  f[0] = __uint_as_float(v.x << 16); f[1] = __uint_as_float(v.x & 0xffff0000u);
  f[2] = __uint_as_float(v.y << 16); f[3] = __uint_as_float(v.y & 0xffff0000u);
  f[4] = __uint_as_float(v.z << 16); f[5] = __uint_as_float(v.z & 0xffff0000u);
  f[6] = __uint_as_float(v.w << 16); f[7] = __uint_as_float(v.w & 0xffff0000u);
}
DI uint4 pack8(const float (&f)[8]) {
  uint4 o; o.x = pack2(f[0], f[1]); o.y = pack2(f[2], f[3]); o.z = pack2(f[4], f[5]); o.w = pack2(f[6], f[7]); return o;
}
DI bf16x8 as_bf16x8(uint4 v) { u32x4v t; t[0] = v.x; t[1] = v.y; t[2] = v.z; t[3] = v.w; return __builtin_bit_cast(bf16x8, t); }
DI f32x16 zero16() { f32x16 z;
#pragma unroll
  for (int i = 0; i < 16; ++i) z[i] = 0.f; return z; }

DI void prep_tile(const float* __restrict__ src, u16* __restrict__ dst, int K, int N, int mode, int tk, int tn, float* sm) {
  const int tid = tidx();
  __syncthreads();
  {
    const int c = tid & 63; const int n = tn * 64 + c;
#pragma unroll 4
    for (int r = tid >> 6; r < 64; r += 8)
      sm[r * 65 + c] = (n < N) ? src[(size_t)(tk * 64 + r) * N + n] : 0.f;
  }
  __syncthreads();
  {
    const int pi = tid;
    const int nl = pi >> 3, kp = pi & 7;
    const int n = tn * 64 + nl;
    int nd = n;
    if (mode == 1) nd = (n >> 4) * 32 + (n & 15);
    else if (mode == 2) nd = (n >> 4) * 32 + 16 + (n & 15);
    float v[8];
#pragma unroll
    for (int j = 0; j < 8; ++j) v[j] = sm[(kp * 8 + j) * 65 + nl];
    *(uint4*)(dst + (size_t)nd * K + tk * 64 + kp * 8) = pack8(v);
  }
}

DI void prep_phase(const Params& p, char* smem) {
  float* sm = (float*)smem;
  constexpr int G0 = 1792, G1 = 2304, G2 = 3712, G3 = 4224, G4 = 7040, G5 = 9856, G6 = 12672, G7 = 12928, G8 = 12936;
  for (int tile = blockIdx.x; tile < G8; tile += gridDim.x) {
    const float* src; u16* dst; int K, N, Np, mode = 0, lt;
    if (tile < G0) { int i = tile / 896; lt = tile % 896; src = p.hy_w_in + (size_t)i * 1024 * 3584; dst = p.wt_hy_in + (size_t)i * 3584 * 1024; K = 1024; N = 3584; Np = 3584; }
    else if (tile < G1) { int t = tile - G0; int i = t / 256; lt = t % 256; src = p.hy_w_out + (size_t)i * 1048576; dst = p.wt_hy_out + (size_t)i * 1048576; K = 1024; N = 1024; Np = 1024; }
    else if (tile < G2) { int t = tile - G1; int i = t / 704; lt = t % 704; src = p.nsa_w_in + (size_t)i * 1024 * 2608; dst = p.wt_nsa_in + (size_t)i * 2816 * 1024; K = 1024; N = 2608; Np = 2816; }
    else if (tile < G3) { int t = tile - G2; int i = t / 256; lt = t % 256; src = p.nsa_w_out + (size_t)i * 1048576; dst = p.wt_nsa_out + (size_t)i * 1048576; K = 1024; N = 1024; Np = 1024; }
    else if (tile < G4) { int t = tile - G3; int i = t / 704; lt = t % 704; src = p.ffn_g + (size_t)i * 1024 * 2816; dst = p.wt_gu + (size_t)i * 5632 * 1024; K = 1024; N = 2816; Np = 2816; mode = 1; }
    else if (tile < G5) { int t = tile - G4; int i = t / 704; lt = t % 704; src = p.ffn_u + (size_t)i * 1024 * 2816; dst = p.wt_gu + (size_t)i * 5632 * 1024; K = 1024; N = 2816; Np = 2816; mode = 2; }
    else if (tile < G6) { int t = tile - G5; int i = t / 704; lt = t % 704; src = p.ffn_d + (size_t)i * 2816 * 1024; dst = p.wt_dn + (size_t)i * 1024 * 2816; K = 2816; N = 1024; Np = 1024; }
    else if (tile < G7) { int t = tile - G6; int i = t / 64; lt = t % 64; src = p.cmp_w1 + (size_t)i * 2048 * 128; dst = p.wt_c1 + (size_t)i * 128 * 2048; K = 2048; N = 128; Np = 128; }
    else { int t = tile - G7; int i = t / 2; lt = t % 2; src = p.cmp_w2 + (size_t)i * 128 * 64; dst = p.wt_c2 + (size_t)i * 64 * 128; K = 128; N = 64; Np = 64; }
    const int ntn = Np / 64;
    prep_tile(src, dst, K, N, mode, lt / ntn, lt % ntn, sm);
  }
  __syncthreads();
  if (blockIdx.x < 4) {
    const int mi = blockIdx.x;
    const float* pe = p.cmp_pe + (size_t)mi * 2048;
    const float* w1 = p.cmp_w1 + (size_t)mi * 2048 * 128;
    const int tq_ = tidx();
    const int o = tq_ & 127, half = tq_ >> 7;
    float a0 = 0.f, a1 = 0.f, a2 = 0.f, a3 = 0.f;
    for (int k = half * 512; k < half * 512 + 512; k += 4) {
      a0 += pe[k] * w1[(size_t)k * 128 + o]; a1 += pe[k + 1] * w1[(size_t)(k + 1) * 128 + o];
      a2 += pe[k + 2] * w1[(size_t)(k + 2) * 128 + o]; a3 += pe[k + 3] * w1[(size_t)(k + 3) * 128 + o];
    }
    sm[tq_] = (a0 + a1) + (a2 + a3);
    __syncthreads();
    if (tq_ < 128) p.c1[mi * 128 + tq_] = (sm[tq_] + sm[tq_ + 128]) + (sm[tq_ + 256] + sm[tq_ + 384]);
    __syncthreads();
  }
  if (blockIdx.x == 4 || (gridDim.x <= 4 && blockIdx.x == 0)) {
    for (int c = tidx(); c < 512; c += NT) {
      float l0 = p.hy_lb[c], l1 = p.hy_lb[512 + c];
      float mx = fmaxf(l0, l1); float e0 = __expf(l0 - mx), e1 = __expf(l1 - mx); float inv = 1.f / (e0 + e1);
      float p0 = e0 * inv, p1 = e1 * inv;
      p.lb[c] = p0 - p0; p.lb[512 + c] = (p0 + p1) - p0;
    }
  }
}

DI void rmsnorm_phase(const float* x, const float* __restrict__ g, u16* h) {
  const int t_ = tidx();
  const int wave = t_ >> 6, lane = t_ & 63;
  for (int row = blockIdx.x * 8 + wave; row < T_; row += gridDim.x * 8) {
    const float4* xr = (const float4*)(x + (size_t)row * 1024);
    float4 v[4]; float ss = 0.f;
#pragma unroll
    for (int j = 0; j < 4; ++j) { v[j] = xr[lane + 64 * j]; ss += v[j].x * v[j].x + v[j].y * v[j].y + v[j].z * v[j].z + v[j].w * v[j].w; }
#pragma unroll
    for (int off = 32; off >= 1; off >>= 1) ss += __shfl_xor(ss, off);
    const float rs = rsqrtf(ss * (1.f / 1024.f) + EPSF);
#pragma unroll
    for (int j = 0; j < 4; ++j) {
      float4 gg = ((const float4*)g)[lane + 64 * j];
      uint2 o; o.x = pack2(v[j].x * rs * gg.x, v[j].y * rs * gg.y); o.y = pack2(v[j].z * rs * gg.z, v[j].w * rs * gg.w);
      *(uint2*)(h + (size_t)row * 1024 + (lane + 64 * j) * 4) = o;
    }
  }
}

DI int lds_byte(int r, int c) { const int st = (r >> 4) * 2 + (c >> 5), rr = r & 15, cc = c & 31, ob = rr * 64 + cc * 2; return st * 1024 + (ob ^ (((ob >> 9) & 1) << 5)); }
DI void stage_rc(int b, int& R, int& C) { const int st = b / 1024, sb = b % 1024, swz = sb ^ (((sb >> 9) & 1) << 5); R = (st >> 1) * 16 + swz / 64; C = (st & 1) * 32 + (swz % 64) / 2; }

template <int EPI>
DI void gemm_phase(const u16* A, const u16* Bt, const int K, const int nN, u16* outb, const int ldc, const float* res, float* outf, char* smem) {
  constexpr int HTB = 16384;
  const int tid = tidx();
  const int wid = tid >> 6, lane = tid & 63, wr = wid >> 2, wc = wid & 3, fr = lane & 15, fq = lane >> 4;
  const int nM = 128, nwg = nM * nN, nt = K / 64;
  int sR0, sC0, sR1, sC1; stage_rc(tid * 16, sR0, sC0); stage_rc(tid * 16 + 8192, sR1, sC1);
  const unsigned vo0 = (unsigned)((sR0 * K + sC0) * 2), vo1 = (unsigned)((sR1 * K + sC1) * 2);
#define SA_(b, h) (smem + ((b) * 2 + (h)) * HTB)
#define SB_(b, h) (smem + (4 + (b) * 2 + (h)) * HTB)
#define STAGE(P, BASE, br, kt) do { const char* _g = (const char*)((BASE) + (size_t)(br) * K + (size_t)(kt) * 64); \
    unsigned _o0 = vo0, _o1 = vo1; asm volatile("" : "+v"(_o0), "+v"(_o1)); \
    __builtin_amdgcn_global_load_lds((const unsigned*)(_g + _o0), (LAS unsigned*)((P) + tid * 16), 16, 0, 0); \
    __builtin_amdgcn_global_load_lds((const unsigned*)(_g + _o1), (LAS unsigned*)((P) + tid * 16 + 8192), 16, 0, 0); } while (0)
#define LDA(dst, b, h) _Pragma("unroll") for (int m = 0; m < 4; ++m) _Pragma("unroll") for (int k = 0; k < 2; ++k) \
    dst[m][k] = *(const bf16x8*)(SA_(b, h) + lds_byte(wr * 64 + m * 16 + fr, k * 32 + fq * 8))
#define LDB(dst, b, h) _Pragma("unroll") for (int n = 0; n < 2; ++n) _Pragma("unroll") for (int k = 0; k < 2; ++k) \
    dst[n][k] = *(const bf16x8*)(SB_(b, h) + lds_byte(wc * 32 + n * 16 + fr, k * 32 + fq * 8))
#define MMA(ai, bj, At_, Bx_) do { __builtin_amdgcn_s_setprio(1); \
    _Pragma("unroll") for (int m = 0; m < 4; ++m) _Pragma("unroll") for (int n = 0; n < 2; ++n) _Pragma("unroll") for (int k = 0; k < 2; ++k) \
      acc[ai][bj][m][n] = __builtin_amdgcn_mfma_f32_16x16x32_bf16(Bx_[n][k], At_[m][k], acc[ai][bj][m][n], 0, 0, 0); \
    __builtin_amdgcn_s_setprio(0); } while (0)
#define WAIT_V(n) asm volatile("s_waitcnt vmcnt(" #n ")" ::: "memory")
#define WAIT_L(n) asm volatile("s_waitcnt lgkmcnt(" #n ")" ::: "memory")
#define BAR __builtin_amdgcn_s_barrier()
#define SCHED __builtin_amdgcn_sched_barrier(0)
  for (int it = 0;; ++it) {
    const long L = (long)it * gridDim.x + blockIdx.x;
    if (L >= nwg) break;
    int wgid = (int)L;
    { const int q = nwg / 8, r = nwg % 8, xcd = wgid % 8, off = wgid / 8; wgid = (xcd < r ? xcd * (q + 1) : r * (q + 1) + (xcd - r) * q) + off; }
    const int nig = 8 * nN, gid = wgid / nig, fm = gid * 8, gsz = (nM - fm) < 8 ? (nM - fm) : 8;
    const int pm = fm + ((wgid % nig) % gsz), pn = (wgid % nig) / gsz;
    const int brow = pm * 256, bcol = pn * 256;
    f32x4v acc[2][2][4][2];
#pragma unroll
    for (int a = 0; a < 2; ++a)
#pragma unroll
      for (int b = 0; b < 2; ++b)
#pragma unroll
        for (int m = 0; m < 4; ++m)
#pragma unroll
          for (int n = 0; n < 2; ++n) acc[a][b][m][n] = (f32x4v){0.f, 0.f, 0.f, 0.f};
    bf16x8 At[4][2], B0[2][2], B1[2][2];
    __syncthreads();
    STAGE(SB_(0, 0), Bt, bcol, 0); STAGE(SA_(0, 0), A, brow, 0);
    STAGE(SB_(0, 1), Bt, bcol + 128, 0); STAGE(SA_(0, 1), A, brow + 128, 0);
    if (wr == 1) BAR;
    WAIT_V(4); BAR;
    STAGE(SB_(1, 0), Bt, bcol, 1); STAGE(SA_(1, 0), A, brow, 1); STAGE(SB_(1, 1), Bt, bcol + 128, 1);
    WAIT_V(6); BAR;
    for (int t = 0; t < nt - 2; t += 2) {
      LDB(B0, 0, 0); SCHED; LDA(At, 0, 0); STAGE(SA_(1, 1), A, brow + 128, t + 1);
      WAIT_L(8); BAR; WAIT_L(0); MMA(0, 0, At, B0); BAR; SCHED;
      LDB(B1, 0, 1); STAGE(SB_(0, 0), Bt, bcol, t + 2);
      BAR; WAIT_L(0); MMA(0, 1, At, B1); BAR;
      LDA(At, 0, 1); STAGE(SA_(0, 0), A, brow, t + 2);
      BAR; WAIT_L(0); MMA(1, 0, At, B0); BAR; SCHED;
      STAGE(SB_(0, 1), Bt, bcol + 128, t + 2);
      WAIT_V(6); BAR; MMA(1, 1, At, B1); BAR;
      LDB(B0, 1, 0); SCHED; LDA(At, 1, 0); STAGE(SA_(0, 1), A, brow + 128, t + 2);
      WAIT_L(8); BAR; WAIT_L(0); MMA(0, 0, At, B0); BAR; SCHED;
      LDB(B1, 1, 1); STAGE(SB_(1, 0), Bt, bcol, t + 3);
      BAR; WAIT_L(0); MMA(0, 1, At, B1); BAR;
      LDA(At, 1, 1); STAGE(SA_(1, 0), A, brow, t + 3);
      BAR; WAIT_L(0); MMA(1, 0, At, B0); BAR; SCHED;
      STAGE(SB_(1, 1), Bt, bcol + 128, t + 3);
      WAIT_V(6); BAR; MMA(1, 1, At, B1); BAR;
    }
    { LDB(B0, 0, 0); LDA(At, 0, 0); STAGE(SA_(1, 1), A, brow + 128, nt - 1);
      BAR; WAIT_L(0); MMA(0, 0, At, B0); BAR;
      LDB(B1, 0, 1); BAR; WAIT_L(0); MMA(0, 1, At, B1); BAR;
      LDA(At, 0, 1); WAIT_V(4); BAR; WAIT_L(0); MMA(1, 0, At, B0); MMA(1, 1, At, B1); BAR; }
    { LDB(B0, 1, 0); LDA(At, 1, 0); WAIT_V(2); BAR; WAIT_L(0); MMA(0, 0, At, B0); BAR;
      LDB(B1, 1, 1); WAIT_V(0); BAR; WAIT_L(0); MMA(0, 1, At, B1); BAR;
      LDA(At, 1, 1); BAR; WAIT_L(0); MMA(1, 0, At, B0); MMA(1, 1, At, B1); BAR; }
    if (wr == 0) BAR;
    int tid2 = tid; asm volatile("" : "+v"(tid2));
    const int fr2 = tid2 & 15, fq2 = (tid2 >> 4) & 3, wc2 = (tid2 >> 6) & 3, wr2 = tid2 >> 8;
#pragma unroll
    for (int ai = 0; ai < 2; ++ai)
#pragma unroll
      for (int m = 0; m < 4; ++m) {
        const size_t row = (size_t)(brow + ai * 128 + wr2 * 64 + m * 16 + fr2);
#pragma unroll
        for (int bj = 0; bj < 2; ++bj) {
          const int cb = bcol + bj * 128 + wc2 * 32 + fq2 * 4;
          if (EPI == 0) {
#pragma unroll
            for (int n = 0; n < 2; ++n) {
              uint2 o; o.x = pack2(acc[ai][bj][m][n][0], acc[ai][bj][m][n][1]); o.y = pack2(acc[ai][bj][m][n][2], acc[ai][bj][m][n][3]);
              *(uint2*)(outb + row * ldc + cb + n * 16) = o;
            }
          } else if (EPI == 1) {
#pragma unroll
            for (int n = 0; n < 2; ++n) {
              const size_t idx = row * 1024 + cb + n * 16;
              const f32x4v r4 = *(const f32x4v*)(res + idx);
              *(f32x4v*)(outf + idx) = r4 + acc[ai][bj][m][n];
            }
          } else {
            const f32x4v gv = acc[ai][bj][m][0], uv = acc[ai][bj][m][1];
            uint2 o; o.x = pack2(fsilu(gv[0]) * uv[0], fsilu(gv[1]) * uv[1]); o.y = pack2(fsilu(gv[2]) * uv[2], fsilu(gv[3]) * uv[3]);
            *(uint2*)(outb + row * DFF + ((bcol + bj * 128 + wc2 * 32) >> 1) + fq2 * 4) = o;
          }
        }
      }
  }
  __syncthreads();
#undef SA_
#undef SB_
#undef STAGE
#undef LDA
#undef LDB
#undef MMA
}

DI void hgrn_item(const Params& p, int li, int item, char* smem) {
  float* qs = (float*)smem;
  float* fs = qs + 2 * 16 * 128;
  float* vsm = fs + 2 * 16 * 128;
  float* opart = vsm + 2 * 16 * 32;
  const int tid = tidx(), lane = tid & 63, w = tid >> 6;
  const int vs = item & 3, h = (item >> 2) & 3, b = item >> 4;
  const int kq = lane >> 5, vc = lane & 31;
  const int k0 = 16 * w + 8 * kq;
  const int role = tid >> 8, t2 = tid & 255;
  const int tok = t2 >> 4, piece = t2 & 15;
  const u16* base = p.proj + (size_t)b * S_ * LD_EVEN;
  float lbv[8];
#pragma unroll
  for (int j = 0; j < 8; ++j) lbv[j] = p.lb[li * 512 + h * 128 + piece * 8 + j];
  float st[8];
#pragma unroll
  for (int j = 0; j < 8; ++j) st[j] = 0.f;
  const int colqf = role * 512 + h * 128 + piece * 8;
  const int colv = 1024 + h * 128 + vs * 32 + (tid & 3) * 8;
  uint4 rq, rv = make_uint4(0, 0, 0, 0);
  rq = *(const uint4*)(base + (size_t)tok * LD_EVEN + colqf);
  if (tid < 64) rv = *(const uint4*)(base + (size_t)(tid >> 2) * LD_EVEN + colv);
  __syncthreads();
  for (int c = 0; c < 128; ++c) {
    const int buf = c & 1;
    {
      float q8[8];
      unpack8(rq, q8);
      if (role == 0) {
#pragma unroll
        for (int j = 0; j < 8; ++j) q8[j] = fsilu(q8[j]);
      } else {
#pragma unroll
        for (int j = 0; j < 8; ++j) q8[j] = lbv[j] + (1.f - lbv[j]) * fsigmoid(q8[j]);
      }
      float4* qd = (float4*)((role == 0 ? qs : fs) + (buf * 16 + tok) * 128 + piece * 8);
      qd[0] = make_float4(q8[0], q8[1], q8[2], q8[3]); qd[1] = make_float4(q8[4], q8[5], q8[6], q8[7]);
      if (tid < 64) {
        float v8[8]; unpack8(rv, v8);
        float4* vd = (float4*)(vsm + (buf * 16 + (tid >> 2)) * 32 + (tid & 3) * 8);
        vd[0] = make_float4(v8[0], v8[1], v8[2], v8[3]); vd[1] = make_float4(v8[4], v8[5], v8[6], v8[7]);
      }
    }
    __syncthreads();
    if (c + 1 < 128) {
      rq = *(const uint4*)(base + (size_t)((c + 1) * 16 + tok) * LD_EVEN + colqf);
      if (tid < 64) rv = *(const uint4*)(base + (size_t)((c + 1) * 16 + (tid >> 2)) * LD_EVEN + colv);
    }
#pragma unroll 4
    for (int t = 0; t < 16; ++t) {
      const float4* q4 = (const float4*)(qs + (buf * 16 + t) * 128 + k0);
      const float4* f4 = (const float4*)(fs + (buf * 16 + t) * 128 + k0);
      const float4 qa = q4[0], qb = q4[1], fa = f4[0], fb = f4[1];
      const float v = vsm[(buf * 16 + t) * 32 + vc];
      st[0] = fa.x * (st[0] - v) + v; st[1] = fa.y * (st[1] - v) + v; st[2] = fa.z * (st[2] - v) + v; st[3] = fa.w * (st[3] - v) + v;
      st[4] = fb.x * (st[4] - v) + v; st[5] = fb.y * (st[5] - v) + v; st[6] = fb.z * (st[6] - v) + v; st[7] = fb.w * (st[7] - v) + v;
      float o = qa.x * st[0];
      o += qa.y * st[1]; o += qa.z * st[2]; o += qa.w * st[3]; o += qb.x * st[4]; o += qb.y * st[5]; o += qb.z * st[6]; o += qb.w * st[7];
      opart[(t * 16 + w * 2 + kq) * 32 + vc] = o;
    }
    __syncthreads();
    {
      const int t = tid >> 5, v2 = tid & 31;
      float sacc = 0.f;
#pragma unroll
      for (int jj = 0; jj < 16; ++jj) sacc += opart[(t * 16 + jj) * 32 + v2];
      p.hbuf[(size_t)(b * S_ + c * 16 + t) * 1024 + h * 128 + vs * 32 + v2] = f2bf(sacc);
    }
  }
  __syncthreads();
}

DI void load_q(const u16* qrow, const float* __restrict__ gain, int hh, bf16x8 (&qf)[4]) {
  float f[4][8]; float ss = 0.f;
#pragma unroll
  for (int kk = 0; kk < 4; ++kk) {
    uint4 raw = *(const uint4*)(qrow + kk * 16 + hh * 8);
    unpack8(raw, f[kk]);
#pragma unroll
    for (int j = 0; j < 8; ++j) ss += f[kk][j] * f[kk][j];
  }
  ss += __shfl_xor(ss, 32);
  const float rs = rsqrtf(ss * (1.f / 64.f) + EPSF) * (0.125f * LOG2E);
#pragma unroll
  for (int kk = 0; kk < 4; ++kk) {
#pragma unroll
    for (int j = 0; j < 8; ++j) f[kk][j] *= rs * gain[kk * 16 + hh * 8 + j];
    qf[kk] = as_bf16x8(pack8(f[kk]));
  }
}

template <int NTH>
DI void stage_kv(int tid, const u16* kb, const u16* vb, size_t stride, int r0, int rlo, int rhi, const float* __restrict__ kgain, u16* Ks, u16* Vts) {
  const int dp = tid & 7;
#pragma unroll
  for (int j = 0; j < 512 / NTH; ++j) {
    const int key = (tid >> 3) + (NTH / 8) * j; const int r = r0 + key;
    uint4 kv = make_uint4(0, 0, 0, 0), vv = make_uint4(0, 0, 0, 0);
    if (r >= rlo && r < rhi) { kv = *(const uint4*)(kb + (size_t)r * stride + dp * 8); vv = *(const uint4*)(vb + (size_t)r * stride + dp * 8); }
    if (kgain) {
      float f[8]; unpack8(kv, f);
      float ss = 0.f;
#pragma unroll
      for (int e = 0; e < 8; ++e) ss += f[e] * f[e];
      ss += __shfl_xor(ss, 1); ss += __shfl_xor(ss, 2); ss += __shfl_xor(ss, 4);
      const float rs = rsqrtf(ss * (1.f / 64.f) + EPSF);
#pragma unroll
      for (int e = 0; e < 8; ++e) f[e] *= rs * kgain[dp * 8 + e];
      kv = pack8(f);
    }
    *(uint4*)(Ks + key * 72 + dp * 8) = kv;
    u16* vd = Vts + (dp * 8) * 72 + key;
    vd[0 * 72] = (u16)(vv.x & 0xffffu); vd[1 * 72] = (u16)(vv.x >> 16);
    vd[2 * 72] = (u16)(vv.y & 0xffffu); vd[3 * 72] = (u16)(vv.y >> 16);
    vd[4 * 72] = (u16)(vv.z & 0xffffu); vd[5 * 72] = (u16)(vv.z >> 16);
    vd[6 * 72] = (u16)(vv.w & 0xffffu); vd[7 * 72] = (u16)(vv.w >> 16);
  }
}

template <class MF>
DI void score_stage(const bf16x8 (&qf)[4], const u16* Ks, int lane, MF maskf, f32x16 (&s)[2], float& mx) {
  const int lr = lane & 31, hh = lane >> 5;
#pragma unroll
  for (int sub = 0; sub < 2; ++sub) {
    s[sub] = zero16();
#pragma unroll
    for (int kk = 0; kk < 4; ++kk) {
      bf16x8 kf = *(const bf16x8*)(Ks + (sub * 32 + lr) * 72 + kk * 16 + hh * 8);
      s[sub] = MFMA32(kf, qf[kk], s[sub]);
    }
  }
  mx = -INFINITY;
#pragma unroll
  for (int sub = 0; sub < 2; ++sub)
#pragma unroll
    for (int i = 0; i < 16; ++i) {
      const int ko = sub * 32 + (i & 3) + 8 * (i >> 2) + 4 * hh;
      const float v = maskf(s[sub][i], ko);
      s[sub][i] = v; mx = fmaxf(mx, v);
    }
  mx = fmaxf(mx, __shfl_xor(mx, 32));
}

DI void pv_stage(const f32x16 (&s)[2], const u16* Vts, f32x16 (&o)[2], int lane) {
  const int lr = lane & 31, hh = lane >> 5;
#pragma unroll
  for (int sub = 0; sub < 2; ++sub)
#pragma unroll
    for (int st = 0; st < 2; ++st) {
      uint4 pk;
      pk.x = pack2(s[sub][8 * st + 0], s[sub][8 * st + 1]); pk.y = pack2(s[sub][8 * st + 2], s[sub][8 * st + 3]);
      pk.z = pack2(s[sub][8 * st + 4], s[sub][8 * st + 5]); pk.w = pack2(s[sub][8 * st + 6], s[sub][8 * st + 7]);
      const bf16x8 pf = as_bf16x8(pk);
#pragma unroll
      for (int dt = 0; dt < 2; ++dt) {
        const u16* vp = Vts + (dt * 32 + lr) * 72 + sub * 32 + 16 * st + 4 * hh;
        const uint2 lo = *(const uint2*)vp, hi = *(const uint2*)(vp + 8);
        const bf16x8 vf = as_bf16x8(make_uint4(lo.x, lo.y, hi.x, hi.y));
        o[dt] = MFMA32(vf, pf, o[dt]);
      }
    }
}

template <class MF>
DI void flash_stage(const bf16x8 (&qf)[4], const u16* Ks, const u16* Vts, f32x16 (&o)[2], float& m, float& l, int lane, MF maskf) {
  f32x16 s[2]; float mx;
  score_stage(qf, Ks, lane, maskf, s, mx);
  const float mn = fmaxf(m, mx);
  const float alpha = fexp2(m - mn);
  m = mn;
  float ls = 0.f;
#pragma unroll
  for (int sub = 0; sub < 2; ++sub)
#pragma unroll
    for (int i = 0; i < 16; ++i) { const float pv = fexp2(s[sub][i] - mn); s[sub][i] = pv; ls += pv; }
  l = l * alpha + ls;
#pragma unroll
  for (int dt = 0; dt < 2; ++dt)
#pragma unroll
    for (int i = 0; i < 16; ++i) o[dt][i] *= alpha;
  pv_stage(s, Vts, o, lane);
}

DI void dilated_item(const Params& p, int li, int pairitem, char* smem) {
  const int tfull = tidx();
  const int half = tfull >> 8, tid = tfull & 255;
  const int item = pairitem * 2 + half;
  u16* Ks = (u16*)(smem + half * 18432); u16* Vts = Ks + 64 * 72;
  const int lane = tid & 63, w = tid >> 6, lr = lane & 31, hh = lane >> 5;
  const int idx16 = item & 15; const int br = (item >> 4) % 3; const int hb = (item / 48) & 7; const int b = item / 384;
  const int d = br == 0 ? 1 : (br == 1 ? 4 : 16);
  const int tiles = 16 / d;
  const int resid = idx16 / tiles, tile = idx16 % tiles;
  const int u0 = tile * 128;
  const int uq = u0 + 32 * w + lr; const int tq = uq * d + resid;
  const u16* prow = p.proj + (size_t)(b * S_ + tq) * LD_EVEN;
  bf16x8 qf[4];
  load_q(prow + 2048 + hb * 64, p.hy_qg + li * 64, hh, qf);
  const float slope2 = fexp2(-(float)(hb + 1)) * LOG2E * (float)d;
  const u16* kb = p.proj + (size_t)(b * S_ + resid) * LD_EVEN + 2560 + hb * 64;
  const u16* vb = kb + 512;
  const size_t stride = (size_t)d * LD_EVEN;
  f32x16 o[2]; o[0] = zero16(); o[1] = zero16();
  float m = -1e30f, l = 0.f;
  const int uw = u0 + 32 * w;
  for (int st = 0; st < 4; ++st) {
    const int ub = u0 - 128 + 64 * st;
    __syncthreads();
    stage_kv<256>(tid, kb, vb, stride, ub, 0, 1 << 30, p.hy_kg + li * 64, Ks, Vts);
    __syncthreads();
    if (ub + 63 >= 0 && ub <= uw + 31 && ub + 63 >= uw - 128) {
      flash_stage(qf, Ks, Vts, o, m, l, lane, [&](float sv, int ko) -> float {
        const int kp = ub + ko; const int dist = uq - kp;
        return (dist >= 0 && dist <= 128 && kp >= 0) ? sv - slope2 * (float)dist : -INFINITY; });
    }
  }
  const float lt = l + __shfl_xor(l, 32);
  const float inv = 1.f / lt;
  const size_t trow = (size_t)br * T_ + (size_t)b * S_ + tq;
  if (hh == 0) p.lse[trow * 8 + hb] = (m + log2f(lt)) * LN2;
  u16* orow = p.obr + trow * 512 + hb * 64;
#pragma unroll
  for (int dt = 0; dt < 2; ++dt)
#pragma unroll
    for (int q4 = 0; q4 < 4; ++q4) {
      uint2 ov; ov.x = pack2(o[dt][4 * q4] * inv, o[dt][4 * q4 + 1] * inv); ov.y = pack2(o[dt][4 * q4 + 2] * inv, o[dt][4 * q4 + 3] * inv);
      *(uint2*)(orow + dt * 32 + 8 * q4 + 4 * hh) = ov;
    }
  __syncthreads();
}

DI void post_even_phase(const Params& p, int li) {
  const int tid = tidx();
  const int rsel = tid >> 7, c8 = tid & 127;
  for (int it = blockIdx.x; it < T_ / 4; it += gridDim.x) {
    const int t = it * 4 + rsel;
    const int c = c8 * 8;
    float val[8];
    if (c8 < 64) {
      uint4 raw = *(const uint4*)(p.hbuf + (size_t)t * 1024 + c);
      float o[8]; unpack8(raw, o);
      float ss = 0.f;
#pragma unroll
      for (int j = 0; j < 8; ++j) ss += o[j] * o[j];
      ss += __shfl_xor(ss, 1); ss += __shfl_xor(ss, 2); ss += __shfl_xor(ss, 4); ss += __shfl_xor(ss, 8);
      const float rs = rsqrtf(ss * (1.f / 128.f) + EPSF);
      uint4 graw = *(const uint4*)(p.proj + (size_t)t * LD_EVEN + 1536 + c);
      float gt[8]; unpack8(graw, gt);
#pragma unroll
      for (int j = 0; j < 8; ++j) val[j] = o[j] * rs * p.hy_og[li * 512 + c + j] * fsilu(gt[j]);
    } else {
      const int cb = c - 512, hb = cb >> 6;
      float l0 = p.lse[((size_t)0 * T_ + t) * 8 + hb], l1 = p.lse[((size_t)1 * T_ + t) * 8 + hb], l2 = p.lse[((size_t)2 * T_ + t) * 8 + hb];
      const float mx = fmaxf(l0, fmaxf(l1, l2));
      float w0 = __expf(l0 - mx), w1 = __expf(l1 - mx), w2 = __expf(l2 - mx);
      const float inv = 1.f / (w0 + w1 + w2);
      w0 *= inv; w1 *= inv; w2 *= inv;
      float a[8], bq[8], cq[8];
      unpack8(*(const uint4*)(p.obr + ((size_t)0 * T_ + t) * 512 + cb), a);
      unpack8(*(const uint4*)(p.obr + ((size_t)1 * T_ + t) * 512 + cb), bq);
      unpack8(*(const uint4*)(p.obr + ((size_t)2 * T_ + t) * 512 + cb), cq);
#pragma unroll
      for (int j = 0; j < 8; ++j) val[j] = w0 * a[j] + w1 * bq[j] + w2 * cq[j];
    }
    *(uint4*)(p.hbuf + (size_t)t * 1024 + c) = pack8(val);
  }
}

DI void compress_item(const Params& p, int li, int pairitem, char* smem) {
  const int tfull = tidx();
  const int half = tfull >> 8, tid = tfull & 255;
  const int item = pairitem * 2 + half;
  u16* hs = (u16*)(smem + half * 17408);
  float* outs = (float*)(smem + half * 17408 + 32 * 136 * 2);
  const int lane = tid & 63, w = tid >> 6, lr = lane & 31, hh = lane >> 5;
  const int nt = item & 3, g = (item >> 2) & 3, b = (item >> 4) & 15, kv = item >> 8;
  const int n = nt * 32 + lr; const int nc = n > 126 ? 126 : n;
  const int col = 1024 + kv * 256 + g * 64;
  const u16* arow = p.proj + (size_t)(b * S_ + 16 * nc) * LD_ODD + col;
  const u16* w1t = p.wt_c1 + (size_t)(li * 2 + kv) * 128 * 2048 + (size_t)(32 * w + lr) * 2048;
  f32x16 acc = zero16();
#pragma unroll 4
  for (int ks = 0; ks < 128; ++ks) {
    const int lidx = ks >> 2, dd = (ks & 3) * 16 + hh * 8;
    const bf16x8 a = as_bf16x8(*(const uint4*)(arow + (size_t)lidx * LD_ODD + dd));
    const bf16x8 bb = as_bf16x8(*(const uint4*)(w1t + ks * 16 + hh * 8));
    acc = MFMA32(a, bb, acc);
  }
  const float cb = p.c1[(li * 2 + kv) * 128 + 32 * w + lr];
  __syncthreads();
#pragma unroll
  for (int i = 0; i < 16; ++i) {
    const int r = (i & 3) + 8 * (i >> 2) + 4 * hh;
    hs[r * 136 + 32 * w + lr] = f2bf(fsilu(acc[i] + cb));
  }
  __syncthreads();
  if (w < 2) {
    const u16* w2t = p.wt_c2 + (size_t)(li * 2 + kv) * 64 * 128 + (size_t)(w * 32 + lr) * 128;
    f32x16 a2 = zero16();
#pragma unroll
    for (int kk = 0; kk < 8; ++kk) {
      const bf16x8 a = *(const bf16x8*)(hs + lr * 136 + kk * 16 + hh * 8);
      const bf16x8 bb = as_bf16x8(*(const uint4*)(w2t + kk * 16 + hh * 8));
      a2 = MFMA32(a, bb, a2);
    }
#pragma unroll
    for (int i = 0; i < 16; ++i) {
      const int r = (i & 3) + 8 * (i >> 2) + 4 * hh;
      outs[r * 65 + w * 32 + lr] = a2[i];
    }
  }
  __syncthreads();
  {
    const int r = tid >> 3, c8 = tid & 7;
    float v[8]; float ss = 0.f;
#pragma unroll
    for (int j = 0; j < 8; ++j) { v[j] = outs[r * 65 + c8 * 8 + j]; ss += v[j] * v[j]; }
    ss += __shfl_xor(ss, 1); ss += __shfl_xor(ss, 2); ss += __shfl_xor(ss, 4);
    if (kv == 0) {
      const float rs = rsqrtf(ss * (1.f / 64.f) + EPSF);
#pragma unroll
      for (int j = 0; j < 8; ++j) v[j] *= rs * p.nsa_kg[(li * 3 + 0) * 64 + c8 * 8 + j];
    }
    const int nn = nt * 32 + r;
    if (nn >= 127) {
#pragma unroll
      for (int j = 0; j < 8; ++j) v[j] = 0.f;
    }
    u16* dst = (kv == 0 ? p.kcmp : p.vcmp) + ((size_t)(b * 4 + g) * 128 + nn) * 64 + c8 * 8;
    *(uint4*)dst = pack8(v);
  }
  __syncthreads();
}

DI void nsa_item(const Params& p, int li, int item, char* smem) {
  u16* Ks = (u16*)smem; u16* Vts = Ks + 64 * 72;
  float* impA = (float*)(smem + 18432);
  float* impB = impA + 8192;
  float* imp = impB + 8192;
  unsigned* selm = (unsigned*)(imp + 64 * 33);
  const int tid = tidx(), lane = tid & 63, wv = tid >> 6, lr = lane & 31, hh = lane >> 5;
  const int w = wv & 3, half = wv >> 2;
  const int tt = item & 31, g = (item >> 5) & 3, b = item >> 7;
  const int t0 = tt * 64; const int cur = t0 >> 6;
  const int hd = g * 4 + w;
  const int tokl = 32 * half + lr;
  const int tq = t0 + tokl;
  const u16* pb = p.proj + (size_t)b * S_ * LD_ODD;
  const u16* prow = pb + (size_t)tq * LD_ODD;
  bf16x8 qf[4];
  load_q(prow + g * 256 + w * 64, p.nsa_qg + li * 64, hh, qf);
  const float slope2 = fexp2(-0.5f * (float)(hd + 1)) * LOG2E;
  const float g0 = fsigmoid(bf2f(prow[2560 + 0 + g * 4 + w]));
  const float g1 = fsigmoid(bf2f(prow[2560 + 16 + g * 4 + w]));
  const float g2 = fsigmoid(bf2f(prow[2560 + 32 + g * 4 + w]));
  f32x16 ot[2]; ot[0] = zero16(); ot[1] = zero16();
  {
    const u16* kb = p.kcmp + (size_t)(b * 4 + g) * 128 * 64;
    const u16* vb = p.vcmp + (size_t)(b * 4 + g) * 128 * 64;
    float m = -1e30f, l = 0.f;
#pragma unroll
    for (int st = 0; st < 2; ++st) {
      if (1024 * st > t0) continue;
      __syncthreads();
      stage_kv<512>(tid, kb, vb, 64, 64 * st, 0, 128, nullptr, Ks, Vts);
      __syncthreads();
      f32x16 s[2]; float mx;
      score_stage(qf, Ks, lane, [&](float sv, int ko) -> float {
        const int n = 64 * st + ko; const int dist = tq - (16 * n + 31);
        return (dist >= 0 && n < 127) ? sv - slope2 * (float)dist : -INFINITY; }, s, mx);
      const float mn = fmaxf(m, mx);
      float ls = 0.f;
#pragma unroll
      for (int sub = 0; sub < 2; ++sub)
#pragma unroll
        for (int i = 0; i < 16; ++i) ls += fexp2(s[sub][i] - mn);
      l = l * fexp2(m - mn) + ls;
      m = mn;
    }
    const float lt = l + __shfl_xor(l, 32);
    const float inv = lt > 0.f ? 1.f / lt : 0.f;
    f32x16 o[2]; o[0] = zero16(); o[1] = zero16();
#pragma unroll
    for (int st = 0; st < 2; ++st) {
      if (1024 * st > t0) {
#pragma unroll
        for (int G = 0; G < 16; ++G) {
          if ((G & 1) == hh) { impA[(w * 64 + tokl) * 32 + 16 * st + G] = 0.f; impB[(w * 64 + tokl) * 32 + 16 * st + G] = 0.f; }
        }
        continue;
      }
      __syncthreads();
      stage_kv<512>(tid, kb, vb, 64, 64 * st, 0, 128, nullptr, Ks, Vts);
      __syncthreads();
      f32x16 s[2]; float mx;
      score_stage(qf, Ks, lane, [&](float sv, int ko) -> float {
        const int n = 64 * st + ko; const int dist = tq - (16 * n + 31);
        return (dist >= 0 && n < 127) ? sv - slope2 * (float)dist : -INFINITY; }, s, mx);
#pragma unroll
      for (int sub = 0; sub < 2; ++sub)
#pragma unroll
        for (int i = 0; i < 16; ++i) s[sub][i] = fexp2(s[sub][i] - m) * inv;
#pragma unroll
      for (int sub = 0; sub < 2; ++sub)
#pragma unroll
        for (int q4 = 0; q4 < 4; ++q4) {
          const int G = 16 * st + 8 * sub + 2 * q4 + hh;
          impA[(w * 64 + tokl) * 32 + G] = (s[sub][4 * q4] + s[sub][4 * q4 + 1]) + (s[sub][4 * q4 + 2] + s[sub][4 * q4 + 3]);
          impB[(w * 64 + tokl) * 32 + G] = s[sub][4 * q4 + 3];
        }
      pv_stage(s, Vts, o, lane);
    }
#pragma unroll
    for (int dt = 0; dt < 2; ++dt)
#pragma unroll
      for (int i = 0; i < 16; ++i) ot[dt][i] += g0 * o[dt][i];
  }
  __syncthreads();
  for (int idx = tid; idx < 2048; idx += NT) {
    const int tok = idx >> 5, mm = idx & 31;
    float a = 0.f;
#pragma unroll
    for (int ww = 0; ww < 4; ++ww) a += impA[(ww * 64 + tok) * 32 + mm] + (mm > 0 ? impB[(ww * 64 + tok) * 32 + mm - 1] : 0.f);
    imp[tok * 33 + mm] = a;
  }
  __syncthreads();
  if (tid < 64) {
    unsigned sel = 1u | (1u << cur) | (cur > 0 ? (1u << (cur - 1)) : 0u);
    int cnt = __popc(sel);
    const float* im = imp + tid * 33;
    for (int r = cnt; r < 8; ++r) {
      int best = -1; float bv = 0.f;
      for (int mm = 0; mm <= cur; ++mm) {
        if ((sel >> mm) & 1u) continue;
        const float v = im[mm];
        if (best < 0 || v > bv) { best = mm; bv = v; }
      }
      if (best < 0) break;
      sel |= 1u << best;
    }
    selm[tid] = sel;
  }
  __syncthreads();
  const unsigned myMask = selm[tokl];
  unsigned uni = 0u;
#pragma unroll 8
  for (int i = 0; i < 64; ++i) uni |= selm[i];
  {
    f32x16 o[2]; o[0] = zero16(); o[1] = zero16();
    float m = -1e30f, l = 0.f;
    const u16* kb = pb + 1536 + g * 64; const u16* vb = pb + 1792 + g * 64;
    for (int mb = 0; mb <= cur; ++mb) {
      if (!((uni >> mb) & 1u)) continue;
      __syncthreads();
      stage_kv<512>(tid, kb, vb, LD_ODD, 64 * mb, 0, S_, p.nsa_kg + (li * 3 + 1) * 64, Ks, Vts);
      __syncthreads();
      const bool selb = (myMask >> mb) & 1u;
      flash_stage(qf, Ks, Vts, o, m, l, lane, [&](float s, int ko) -> float {
        const int dist = tq - (64 * mb + ko);
        return (selb && dist >= 0) ? s - slope2 * (float)dist : -INFINITY; });
    }
    const float lt = l + __shfl_xor(l, 32);
    const float sc = g1 / lt;
#pragma unroll
    for (int dt = 0; dt < 2; ++dt)
#pragma unroll
      for (int i = 0; i < 16; ++i) ot[dt][i] += sc * o[dt][i];
  }
  {
    f32x16 o[2]; o[0] = zero16(); o[1] = zero16();
    float m = -1e30f, l = 0.f;
    const u16* kb = pb + 2048 + g * 64; const u16* vb = pb + 2304 + g * 64;
    const int mlo = (t0 - 511) < 0 ? 0 : ((t0 - 511) >> 6);
    for (int mb = mlo; mb <= cur; ++mb) {
      __syncthreads();
      stage_kv<512>(tid, kb, vb, LD_ODD, 64 * mb, 0, S_, p.nsa_kg + (li * 3 + 2) * 64, Ks, Vts);
      __syncthreads();
      flash_stage(qf, Ks, Vts, o, m, l, lane, [&](float s, int ko) -> float {
        const int dist = tq - (64 * mb + ko);
        return (dist >= 0 && dist <= 511) ? s - slope2 * (float)dist : -INFINITY; });
    }
    const float lt = l + __shfl_xor(l, 32);
    const float sc = g2 / lt;
#pragma unroll
    for (int dt = 0; dt < 2; ++dt)
#pragma unroll
      for (int i = 0; i < 16; ++i) ot[dt][i] += sc * o[dt][i];
  }
  u16* orow = p.hbuf + (size_t)(b * S_ + tq) * 1024 + g * 256 + w * 64;
#pragma unroll
  for (int dt = 0; dt < 2; ++dt)
#pragma unroll
    for (int q4 = 0; q4 < 4; ++q4) {
      uint2 ov; ov.x = pack2(ot[dt][4 * q4], ot[dt][4 * q4 + 1]); ov.y = pack2(ot[dt][4 * q4 + 2], ot[dt][4 * q4 + 3]);
      *(uint2*)(orow + dt * 32 + 8 * q4 + 4 * hh) = ov;
    }
  __syncthreads();
}

DI void run_phase(const Params& p, int ph, char* smem) {
  if (ph == 0) { prep_phase(p, smem); return; }
  const int l = (ph - 1) >> 3, s = (ph - 1) & 7, li = l >> 1;
  const bool even = (l & 1) == 0;
  const float* xin = (l == 0) ? p.x : p.out;
  switch (s) {
    case 0: rmsnorm_phase(xin, p.attn_norm + l * 1024, p.hbuf); break;
    case 1:
      if (even) gemm_phase<0>(p.hbuf, p.wt_hy_in + (size_t)li * 3584 * 1024, 1024, 14, p.proj, LD_EVEN, nullptr, nullptr, smem);
      else gemm_phase<0>(p.hbuf, p.wt_nsa_in + (size_t)li * 2816 * 1024, 1024, 11, p.proj, LD_ODD, nullptr, nullptr, smem);
      break;
    case 2:
      if (even) {
        for (int item = blockIdx.x; item < 256 + 3072; item += gridDim.x) {
          if (item < 256) hgrn_item(p, li, item, smem); else dilated_item(p, li, item - 256, smem);
        }
      } else {
        for (int item = blockIdx.x; item < 256; item += gridDim.x) compress_item(p, li, item, smem);
      }
      break;
    case 3:
      if (even) post_even_phase(p, li);
      else { for (int item = blockIdx.x; item < 2048; item += gridDim.x) nsa_item(p, li, item, smem); }
      break;
    case 4:
      gemm_phase<1>(p.hbuf, (even ? p.wt_hy_out : p.wt_nsa_out) + (size_t)li * 1048576, 1024, 4, nullptr, 0, xin, p.out, smem);
      break;
    case 5: rmsnorm_phase(p.out, p.ffn_norm + l * 1024, p.hbuf); break;
    case 6: gemm_phase<2>(p.hbuf, p.wt_gu + (size_t)l * 5632 * 1024, 1024, 22, p.proj, DFF, nullptr, nullptr, smem); break;
    case 7: gemm_phase<1>(p.proj, p.wt_dn + (size_t)l * 1024 * 2816, 2816, 4, nullptr, 0, p.out, p.out, smem); break;
  }
}

__global__ void __launch_bounds__(512) mk_forward(Params p) {
  __shared__ __attribute__((aligned(16))) char smem[131072];
  cg::grid_group grid = cg::this_grid();
  for (int ph = p.phase_lo; ph < p.phase_hi; ++ph) {
    run_phase(p, ph, smem);
    if (ph + 1 < p.phase_hi) grid.sync();
  }
}

extern "C" void kernel_launch(void* const* d_in, const int* in_sizes, int n_in, void* d_out, int out_size,
                              void* d_ws, size_t ws_size, hipStream_t stream) {
  static int grid_blocks = 0;
  if (!grid_blocks) {
    int dev = 0, cus = 0, per_cu = 0;
    hipGetDevice(&dev);
    hipDeviceGetAttribute(&cus, hipDeviceAttributeMultiprocessorCount, dev);
    hipOccupancyMaxActiveBlocksPerMultiprocessor(&per_cu, mk_forward, 512, 0);
    if (per_cu > 1) per_cu = 1;
    if (per_cu < 1) per_cu = 1;
    grid_blocks = cus * per_cu;
  }
  Params p;
  memset(&p, 0, sizeof(p));
  p.x = (const float*)d_in[0]; p.attn_norm = (const float*)d_in[1]; p.ffn_norm = (const float*)d_in[2];
  p.hy_w_in = (const float*)d_in[3]; p.hy_lb = (const float*)d_in[4]; p.hy_og = (const float*)d_in[5];
  p.hy_qg = (const float*)d_in[6]; p.hy_kg = (const float*)d_in[7]; p.hy_w_out = (const float*)d_in[8];
  p.nsa_w_in = (const float*)d_in[9]; p.nsa_qg = (const float*)d_in[10]; p.nsa_kg = (const float*)d_in[11];
  p.cmp_pe = (const float*)d_in[12]; p.cmp_w1 = (const float*)d_in[13]; p.cmp_w2 = (const float*)d_in[14];
  p.nsa_w_out = (const float*)d_in[15]; p.ffn_g = (const float*)d_in[16]; p.ffn_u = (const float*)d_in[17]; p.ffn_d = (const float*)d_in[18];
  p.out = (float*)d_out;
  char* ws = (char*)d_ws; size_t off = 0;
  auto take = [&](size_t bytes) { char* r = ws + off; off += (bytes + 255) & ~(size_t)255; return r; };
  p.wt_hy_in = (u16*)take((size_t)2 * 3584 * 1024 * 2);
  p.wt_hy_out = (u16*)take((size_t)2 * 1048576 * 2);
  p.wt_nsa_in = (u16*)take((size_t)2 * 2816 * 1024 * 2);
  p.wt_nsa_out = (u16*)take((size_t)2 * 1048576 * 2);
  p.wt_gu = (u16*)take((size_t)4 * 5632 * 1024 * 2);
  p.wt_dn = (u16*)take((size_t)4 * 1024 * 2816 * 2);
  p.wt_c1 = (u16*)take((size_t)4 * 128 * 2048 * 2);
  p.wt_c2 = (u16*)take((size_t)4 * 64 * 128 * 2);
  p.c1 = (float*)take(4 * 128 * 4);
  p.lb = (float*)take(2 * 512 * 4);
  p.lse = (float*)take((size_t)3 * T_ * 8 * 4);
  p.proj = (u16*)take((size_t)T_ * 3584 * 2);
  p.hbuf = (u16*)take((size_t)T_ * 1024 * 2);
  p.obr = (u16*)take((size_t)3 * T_ * 512 * 2);
  p.kcmp = (u16*)take((size_t)16 * 4 * 128 * 64 * 2);
  p.vcmp = (u16*)take((size_t)16 * 4 * 128 * 64 * 2);
  if (off > ws_size) { fprintf(stderr, "workspace too small: need %zu have %zu\n", off, ws_size); return; }
  const int NPH = 33;
#if MK_MULTI
  for (int ph = 0; ph < NPH; ++ph) {
    p.phase_lo = ph; p.phase_hi = ph + 1;
    hipLaunchKernelGGL(mk_forward, dim3(grid_blocks), dim3(512), 0, stream, p);
  }
#else
  p.phase_lo = 0; p.phase_hi = NPH;
  void* args[] = {&p};
  hipError_t e = hipLaunchCooperativeKernel((void*)mk_forward, dim3(grid_blocks), dim3(512), args, 0, stream);
  if (e != hipSuccess) fprintf(stderr, "cooperative launch failed: %s (grid %d)\n", hipGetErrorString(e), grid_blocks);
#endif
}
```

```cpp
#include <hip/hip_runtime.h>
#include <hip/hip_cooperative_groups.h>
#include <cstdio>
#include <cstdint>
#include <cstring>
namespace cg = cooperative_groups;

typedef unsigned short u16;
using bf16x8 = __attribute__((ext_vector_type(8))) short;
using f32x16 = __attribute__((ext_vector_type(16))) float;
using u32x4v = __attribute__((ext_vector_type(4))) unsigned;
#define DI __device__ __forceinline__
#define MFMA32(a, b, c) __builtin_amdgcn_mfma_f32_32x32x16_bf16((a), (b), (c), 0, 0, 0)

#ifndef MK_MULTI
#define MK_MULTI 0
#endif

constexpr int T_ = 32768, S_ = 2048;
constexpr float EPSF = 1e-6f;
constexpr float LOG2E = 1.4426950408889634f, LN2 = 0.6931471805599453f;
constexpr int LD_EVEN = 3584, LD_ODD = 2816, DFF = 2816;
constexpr int NT = 512;
#define LAS __attribute__((address_space(3)))
using f32x4v = __attribute__((ext_vector_type(4))) float;

struct Params {
  const float* x; const float* attn_norm; const float* ffn_norm;
  const float* hy_w_in; const float* hy_lb; const float* hy_og; const float* hy_qg; const float* hy_kg; const float* hy_w_out;
  const float* nsa_w_in; const float* nsa_qg; const float* nsa_kg; const float* cmp_pe; const float* cmp_w1; const float* cmp_w2; const float* nsa_w_out;
  const float* ffn_g; const float* ffn_u; const float* ffn_d;
  float* out;
  u16* wt_hy_in; u16* wt_hy_out; u16* wt_nsa_in; u16* wt_nsa_out; u16* wt_gu; u16* wt_dn; u16* wt_c1; u16* wt_c2;
  float* c1; float* lb; float* lse;
  u16* proj; u16* hbuf; u16* obr; u16* kcmp; u16* vcmp;
  unsigned* bar;
  int phase_lo; int phase_hi;
};

DI int tidx() { int t = __builtin_amdgcn_workitem_id_x(); asm volatile("" : "+v"(t)); return t; }
DI float bf2f(u16 h) { return __uint_as_float(((unsigned)h) << 16); }
typedef __bf16 bf16x2_t __attribute__((ext_vector_type(2)));
typedef float f32x2_t __attribute__((ext_vector_type(2)));
DI unsigned pack2(float a, float b) { f32x2_t v = {a, b}; bf16x2_t r = __builtin_convertvector(v, bf16x2_t); return __builtin_bit_cast(unsigned, r); }
DI u16 f2bf(float x) { return (u16)(pack2(x, 0.f) & 0xffffu); }
DI float fsigmoid(float x) { return 1.f / (1.f + __expf(-x)); }
DI float fsilu(float x) { return x / (1.f + __expf(-x)); }
DI float fexp2(float x) { return __builtin_amdgcn_exp2f(x); }
DI void unpack8(uint4 v, float (&f)[8]) {
  f[0] = __uint_as_float(v.x << 16); f[1] = __uint_as_float(v.x & 0xffff0000u);
  f[2] = __uint_as_float(v.y << 16); f[3] = __uint_as_float(v.y & 0xffff0000u);
  f[4] = __uint_as_float(v.z << 16); f[5] = __uint_as_float(v.z & 0xffff0000u);
  f[6] = __uint_as_float(v.w << 16); f[7] = __uint_as_float(v.w & 0xffff0000u);
}
DI uint4 pack8(const float (&f)[8]) {
  uint4 o; o.x = pack2(f[0], f[1]); o.y = pack2(f[2], f[3]); o.z = pack2(f[4], f[5]); o.w = pack2(f[6], f[7]); return o;
}
DI bf16x8 as_bf16x8(uint4 v) { u32x4v t; t[0] = v.x; t[1] = v.y; t[2] = v.z; t[3] = v.w; return __builtin_bit_cast(bf16x8, t); }
DI f32x16 zero16() { f32x16 z;
#pragma unroll
  for (int i = 0; i < 16; ++i) z[i] = 0.f; return z; }


#define XB_TMO      128
#define XB_XCNT(j)  (256  + 64 * (j))
#define XB_XSUB(j)  (1280 + 64 * (j))
#define XB_XGEN(j)  (2304 + 64 * (j))
#define XB_TOP      3328
#define XB_TOPGEN   3392
#define XCD_BAR_WORDS 3456
#define XB_SPIN_CAP (1u << 18)
DI unsigned xb_ld(unsigned* p) { return __hip_atomic_load(p, __ATOMIC_RELAXED, __HIP_MEMORY_SCOPE_AGENT); }
DI unsigned xb_add(unsigned* p, unsigned v) { return __hip_atomic_fetch_add(p, v, __ATOMIC_RELAXED, __HIP_MEMORY_SCOPE_AGENT); }
DI unsigned xb_xcc_id() { return (unsigned)__builtin_amdgcn_s_getreg((3 << 11) | 20) & 0xFu; }
#define XB_SPIN(cond, bar) do { unsigned _sp = 0; while (cond) { __builtin_amdgcn_s_sleep(1); \
    if ((++_sp & 255u) == 0u) { if (xb_ld(&(bar)[XB_TMO])) break; if (_sp > XB_SPIN_CAP) { atomicAdd(&(bar)[XB_TMO], 1u); break; } } } } while (0)
struct XcdBarrier { unsigned* bar; unsigned x; volatile LAS unsigned* st; };
DI XcdBarrier xcd_barrier_post(unsigned* bar, volatile LAS unsigned* st) {
  XcdBarrier b; b.bar = bar; b.x = xb_xcc_id(); b.st = st;
  if (__builtin_amdgcn_workitem_id_x() == 0) (void)xb_add(&bar[XB_XCNT(b.x)], 1u);
  return b;
}
DI void xcd_barrier_complete(unsigned* bar, unsigned x, unsigned& nloc, unsigned& nx) {
  const unsigned G = gridDim.x * gridDim.y * gridDim.z;
  unsigned sum, cnt, mine, sp = 0u;
  for (;;) {
    sum = 0u; cnt = 0u; mine = 0u;
#pragma unroll
    for (unsigned j = 0; j < 16; ++j) { const unsigned c = xb_ld(&bar[XB_XCNT(j)]); sum += c; cnt += (c > 0u) ? 1u : 0u; mine = (j == x) ? c : mine; }
    if (sum == G) break;
    __builtin_amdgcn_s_sleep(1);
    if ((++sp & 255u) == 0u) { if (xb_ld(&bar[XB_TMO])) break; if (sp > XB_SPIN_CAP) { atomicAdd(&bar[XB_TMO], 1u); break; } }
  }
  nloc = mine > 0u ? mine : 1u; nx = cnt > 0u ? cnt : 1u;
}
DI void xcd_barrier(const XcdBarrier& b) {
  asm volatile("s_waitcnt vmcnt(0)" ::: "memory");
  __syncthreads();
  if (__builtin_amdgcn_workitem_id_x() == 0) {
    unsigned* bar = b.bar;
    __builtin_amdgcn_s_waitcnt(0);
    unsigned nloc = b.st[0], nx = b.st[1];
    if (nloc == 0u) { xcd_barrier_complete(bar, b.x, nloc, nx); b.st[0] = nloc; b.st[1] = nx; }
    const unsigned old = xb_add(&bar[XB_XSUB(b.x)], 1u);
    const unsigned gen = old / nloc;
    if (old + 1u == (gen + 1u) * nloc) {
      __builtin_amdgcn_fence(__ATOMIC_RELEASE, "agent");
      asm volatile("s_waitcnt vmcnt(0)" ::: "memory");
      const unsigned og = xb_add(&bar[XB_TOP], 1u);
      const unsigned tg = og / nx;
      if (og + 1u == (tg + 1u) * nx) xb_add(&bar[XB_TOPGEN], 1u);
      else XB_SPIN(xb_ld(&bar[XB_TOPGEN]) == tg, bar);
      __builtin_amdgcn_fence(__ATOMIC_ACQUIRE, "agent");
      xb_add(&bar[XB_XGEN(b.x)], 1u);
      asm volatile("s_waitcnt vmcnt(0)" ::: "memory");
    } else {
      XB_SPIN(xb_ld(&bar[XB_XGEN(b.x)]) == gen, bar);
      __builtin_amdgcn_fence(__ATOMIC_ACQUIRE, "agent");
      asm volatile("s_waitcnt vmcnt(0)" ::: "memory");
    }
  }
  __syncthreads();
}

DI void prep_tile(const float* __restrict__ src, u16* __restrict__ dst, int K, int N, int mode, int tk, int tn, float* sm) {
  const int tid = tidx();
  __syncthreads();
  {
    const int c = tid & 63; const int n = tn * 64 + c;
#pragma unroll 4
    for (int r = tid >> 6; r < 64; r += 8)
      sm[r * 65 + c] = (n < N) ? src[(size_t)(tk * 64 + r) * N + n] : 0.f;
  }
  __syncthreads();
  {
    const int pi = tid;
    const int nl = pi >> 3, kp = pi & 7;
    const int n = tn * 64 + nl;
    int nd = n;
    if (mode == 1) nd = (n >> 4) * 32 + (n & 15);
    else if (mode == 2) nd = (n >> 4) * 32 + 16 + (n & 15);
    float v[8];
#pragma unroll
    for (int j = 0; j < 8; ++j) v[j] = sm[(kp * 8 + j) * 65 + nl];
    *(uint4*)(dst + (size_t)nd * K + tk * 64 + kp * 8) = pack8(v);
  }
}

DI void prep_phase(const Params& p, char* smem) {
  float* sm = (float*)smem;
  constexpr int G0 = 1792, G1 = 2304, G2 = 3712, G3 = 4224, G4 = 7040, G5 = 9856, G6 = 12672, G7 = 12928, G8 = 12936;
  for (int tile = blockIdx.x; tile < G8; tile += gridDim.x) {
    const float* src; u16* dst; int K, N, Np, mode = 0, lt;
    if (tile < G0) { int i = tile / 896; lt = tile % 896; src = p.hy_w_in + (size_t)i * 1024 * 3584; dst = p.wt_hy_in + (size_t)i * 3584 * 1024; K = 1024; N = 3584; Np = 3584; }
    else if (tile < G1) { int t = tile - G0; int i = t / 256; lt = t % 256; src = p.hy_w_out + (size_t)i * 1048576; dst = p.wt_hy_out + (size_t)i * 1048576; K = 1024; N = 1024; Np = 1024; }
    else if (tile < G2) { int t = tile - G1; int i = t / 704; lt = t % 704; src = p.nsa_w_in + (size_t)i * 1024 * 2608; dst = p.wt_nsa_in + (size_t)i * 2816 * 1024; K = 1024; N = 2608; Np = 2816; }
    else if (tile < G3) { int t = tile - G2; int i = t / 256; lt = t % 256; src = p.nsa_w_out + (size_t)i * 1048576; dst = p.wt_nsa_out + (size_t)i * 1048576; K = 1024; N = 1024; Np = 1024; }
    else if (tile < G4) { int t = tile - G3; int i = t / 704; lt = t % 704; src = p.ffn_g + (size_t)i * 1024 * 2816; dst = p.wt_gu + (size_t)i * 5632 * 1024; K = 1024; N = 2816; Np = 2816; mode = 1; }
    else if (tile < G5) { int t = tile - G4; int i = t / 704; lt = t % 704; src = p.ffn_u + (size_t)i * 1024 * 2816; dst = p.wt_gu + (size_t)i * 5632 * 1024; K = 1024; N = 2816; Np = 2816; mode = 2; }
    else if (tile < G6) { int t = tile - G5; int i = t / 704; lt = t % 704; src = p.ffn_d + (size_t)i * 2816 * 1024; dst = p.wt_dn + (size_t)i * 1024 * 2816; K = 2816; N = 1024; Np = 1024; }
    else if (tile < G7) { int t = tile - G6; int i = t / 64; lt = t % 64; src = p.cmp_w1 + (size_t)i * 2048 * 128; dst = p.wt_c1 + (size_t)i * 128 * 2048; K = 2048; N = 128; Np = 128; }
    else { int t = tile - G7; int i = t / 2; lt = t % 2; src = p.cmp_w2 + (size_t)i * 128 * 64; dst = p.wt_c2 + (size_t)i * 64 * 128; K = 128; N = 64; Np = 64; }
    const int ntn = Np / 64;
    prep_tile(src, dst, K, N, mode, lt / ntn, lt % ntn, sm);
  }
  __syncthreads();
  if (blockIdx.x < 4) {
    const int mi = blockIdx.x;
    const float* pe = p.cmp_pe + (size_t)mi * 2048;
    const float* w1 = p.cmp_w1 + (size_t)mi * 2048 * 128;
    const int tq_ = tidx();
    const int o = tq_ & 127, half = tq_ >> 7;
    float a0 = 0.f, a1 = 0.f, a2 = 0.f, a3 = 0.f;
    for (int k = half * 512; k < half * 512 + 512; k += 4) {
      a0 += pe[k] * w1[(size_t)k * 128 + o]; a1 += pe[k + 1] * w1[(size_t)(k + 1) * 128 + o];
      a2 += pe[k + 2] * w1[(size_t)(k + 2) * 128 + o]; a3 += pe[k + 3] * w1[(size_t)(k + 3) * 128 + o];
    }
    sm[tq_] = (a0 + a1) + (a2 + a3);
    __syncthreads();
    if (tq_ < 128) p.c1[mi * 128 + tq_] = (sm[tq_] + sm[tq_ + 128]) + (sm[tq_ + 256] + sm[tq_ + 384]);
    __syncthreads();
  }
  if (blockIdx.x == 4 || (gridDim.x <= 4 && blockIdx.x == 0)) {
    for (int c = tidx(); c < 512; c += NT) {
      float l0 = p.hy_lb[c], l1 = p.hy_lb[512 + c];
      float mx = fmaxf(l0, l1); float e0 = __expf(l0 - mx), e1 = __expf(l1 - mx); float inv = 1.f / (e0 + e1);
      float p0 = e0 * inv, p1 = e1 * inv;
      p.lb[c] = p0 - p0; p.lb[512 + c] = (p0 + p1) - p0;
    }
  }
}

DI void rmsnorm_phase(const float* x, const float* __restrict__ g, u16* h) {
  const int t_ = tidx();
  const int wave = t_ >> 6, lane = t_ & 63;
  for (int row = blockIdx.x * 8 + wave; row < T_; row += gridDim.x * 8) {
    const float4* xr = (const float4*)(x + (size_t)row * 1024);
    float4 v[4]; float ss = 0.f;
#pragma unroll
    for (int j = 0; j < 4; ++j) { v[j] = xr[lane + 64 * j]; ss += v[j].x * v[j].x + v[j].y * v[j].y + v[j].z * v[j].z + v[j].w * v[j].w; }
#pragma unroll
    for (int off = 32; off >= 1; off >>= 1) ss += __shfl_xor(ss, off);
    const float rs = rsqrtf(ss * (1.f / 1024.f) + EPSF);
#pragma unroll
    for (int j = 0; j < 4; ++j) {
      float4 gg = ((const float4*)g)[lane + 64 * j];
      uint2 o; o.x = pack2(v[j].x * rs * gg.x, v[j].y * rs * gg.y); o.y = pack2(v[j].z * rs * gg.z, v[j].w * rs * gg.w);
      *(uint2*)(h + (size_t)row * 1024 + (lane + 64 * j) * 4) = o;
    }
  }
}

DI int lds_byte(int r, int c) { const int st = (r >> 4) * 2 + (c >> 5), rr = r & 15, cc = c & 31, ob = rr * 64 + cc * 2; return st * 1024 + (ob ^ (((ob >> 9) & 1) << 5)); }
DI void stage_rc(int b, int& R, int& C) { const int st = b / 1024, sb = b % 1024, swz = sb ^ (((sb >> 9) & 1) << 5); R = (st >> 1) * 16 + swz / 64; C = (st & 1) * 32 + (swz % 64) / 2; }

template <int EPI>
DI void gemm_phase(const u16* A, const u16* Bt, const int K, const int nN, u16* outb, const int ldc, const float* res, float* outf, char* smem) {
  constexpr int HTB = 16384;
  const int tid = tidx();
  const int wid = tid >> 6, lane = tid & 63, wr = wid >> 2, wc = wid & 3, fr = lane & 15, fq = lane >> 4;
  const int nM = 128, nwg = nM * nN, nt = K / 64;
  int sR0, sC0, sR1, sC1; stage_rc(tid * 16, sR0, sC0); stage_rc(tid * 16 + 8192, sR1, sC1);
  const unsigned vo0 = (unsigned)((sR0 * K + sC0) * 2), vo1 = (unsigned)((sR1 * K + sC1) * 2);
#define SA_(b, h) (smem + ((b) * 2 + (h)) * HTB)
#define SB_(b, h) (smem + (4 + (b) * 2 + (h)) * HTB)
#define STAGE(P, BASE, br, kt) do { const char* _g = (const char*)((BASE) + (size_t)(br) * K + (size_t)(kt) * 64); \
    unsigned _o0 = vo0, _o1 = vo1; asm volatile("" : "+v"(_o0), "+v"(_o1)); \
    __builtin_amdgcn_global_load_lds((const unsigned*)(_g + _o0), (LAS unsigned*)((P) + tid * 16), 16, 0, 0); \
    __builtin_amdgcn_global_load_lds((const unsigned*)(_g + _o1), (LAS unsigned*)((P) + tid * 16 + 8192), 16, 0, 0); } while (0)
#define LDA(dst, b, h) _Pragma("unroll") for (int m = 0; m < 4; ++m) _Pragma("unroll") for (int k = 0; k < 2; ++k) \
    dst[m][k] = *(const bf16x8*)(SA_(b, h) + lds_byte(wr * 64 + m * 16 + fr, k * 32 + fq * 8))
#define LDB(dst, b, h) _Pragma("unroll") for (int n = 0; n < 2; ++n) _Pragma("unroll") for (int k = 0; k < 2; ++k) \
    dst[n][k] = *(const bf16x8*)(SB_(b, h) + lds_byte(wc * 32 + n * 16 + fr, k * 32 + fq * 8))
#define MMA(ai, bj, At_, Bx_) do { __builtin_amdgcn_s_setprio(1); \
    _Pragma("unroll") for (int m = 0; m < 4; ++m) _Pragma("unroll") for (int n = 0; n < 2; ++n) _Pragma("unroll") for (int k = 0; k < 2; ++k) \
      acc[ai][bj][m][n] = __builtin_amdgcn_mfma_f32_16x16x32_bf16(Bx_[n][k], At_[m][k], acc[ai][bj][m][n], 0, 0, 0); \
    __builtin_amdgcn_s_setprio(0); } while (0)
#define WAIT_V(n) asm volatile("s_waitcnt vmcnt(" #n ")" ::: "memory")
#define WAIT_L(n) asm volatile("s_waitcnt lgkmcnt(" #n ")" ::: "memory")
#define BAR __builtin_amdgcn_s_barrier()
#define SCHED __builtin_amdgcn_sched_barrier(0)
  for (int it = 0;; ++it) {
    const long L = (long)it * gridDim.x + blockIdx.x;
    if (L >= nwg) break;
    int wgid = (int)L;
    { const int q = nwg / 8, r = nwg % 8, xcd = wgid % 8, off = wgid / 8; wgid = (xcd < r ? xcd * (q + 1) : r * (q + 1) + (xcd - r) * q) + off; }
    const int nig = 8 * nN, gid = wgid / nig, fm = gid * 8, gsz = (nM - fm) < 8 ? (nM - fm) : 8;
    const int pm = fm + ((wgid % nig) % gsz), pn = (wgid % nig) / gsz;
    const int brow = pm * 256, bcol = pn * 256;
    f32x4v acc[2][2][4][2];
#pragma unroll
    for (int a = 0; a < 2; ++a)
#pragma unroll
      for (int b = 0; b < 2; ++b)
#pragma unroll
        for (int m = 0; m < 4; ++m)
#pragma unroll
          for (int n = 0; n < 2; ++n) acc[a][b][m][n] = (f32x4v){0.f, 0.f, 0.f, 0.f};
    bf16x8 At[4][2], B0[2][2], B1[2][2];
    __syncthreads();
    STAGE(SB_(0, 0), Bt, bcol, 0); STAGE(SA_(0, 0), A, brow, 0);
    STAGE(SB_(0, 1), Bt, bcol + 128, 0); STAGE(SA_(0, 1), A, brow + 128, 0);
    if (wr == 1) BAR;
    WAIT_V(4); BAR;
    STAGE(SB_(1, 0), Bt, bcol, 1); STAGE(SA_(1, 0), A, brow, 1); STAGE(SB_(1, 1), Bt, bcol + 128, 1);
    WAIT_V(6); BAR;
    for (int t = 0; t < nt - 2; t += 2) {
      LDB(B0, 0, 0); SCHED; LDA(At, 0, 0); STAGE(SA_(1, 1), A, brow + 128, t + 1);
      WAIT_L(8); BAR; WAIT_L(0); MMA(0, 0, At, B0); BAR; SCHED;
      LDB(B1, 0, 1); STAGE(SB_(0, 0), Bt, bcol, t + 2);
      BAR; WAIT_L(0); MMA(0, 1, At, B1); BAR;
      LDA(At, 0, 1); STAGE(SA_(0, 0), A, brow, t + 2);
      BAR; WAIT_L(0); MMA(1, 0, At, B0); BAR; SCHED;
      STAGE(SB_(0, 1), Bt, bcol + 128, t + 2);
      WAIT_V(6); BAR; MMA(1, 1, At, B1); BAR;
      LDB(B0, 1, 0); SCHED; LDA(At, 1, 0); STAGE(SA_(0, 1), A, brow + 128, t + 2);
      WAIT_L(8); BAR; WAIT_L(0); MMA(0, 0, At, B0); BAR; SCHED;
      LDB(B1, 1, 1); STAGE(SB_(1, 0), Bt, bcol, t + 3);
      BAR; WAIT_L(0); MMA(0, 1, At, B1); BAR;
      LDA(At, 1, 1); STAGE(SA_(1, 0), A, brow, t + 3);
      BAR; WAIT_L(0); MMA(1, 0, At, B0); BAR; SCHED;
      STAGE(SB_(1, 1), Bt, bcol + 128, t + 3);
      WAIT_V(6); BAR; MMA(1, 1, At, B1); BAR;
    }
    { LDB(B0, 0, 0); LDA(At, 0, 0); STAGE(SA_(1, 1), A, brow + 128, nt - 1);
      BAR; WAIT_L(0); MMA(0, 0, At, B0); BAR;
      LDB(B1, 0, 1); BAR; WAIT_L(0); MMA(0, 1, At, B1); BAR;
      LDA(At, 0, 1); WAIT_V(4); BAR; WAIT_L(0); MMA(1, 0, At, B0); MMA(1, 1, At, B1); BAR; }
    { LDB(B0, 1, 0); LDA(At, 1, 0); WAIT_V(2); BAR; WAIT_L(0); MMA(0, 0, At, B0); BAR;
      LDB(B1, 1, 1); WAIT_V(0); BAR; WAIT_L(0); MMA(0, 1, At, B1); BAR;
      LDA(At, 1, 1); BAR; WAIT_L(0); MMA(1, 0, At, B0); MMA(1, 1, At, B1); BAR; }
    if (wr == 0) BAR;
    int tid2 = tid; asm volatile("" : "+v"(tid2));
    const int fr2 = tid2 & 15, fq2 = (tid2 >> 4) & 3, wc2 = (tid2 >> 6) & 3, wr2 = tid2 >> 8;
#pragma unroll
    for (int ai = 0; ai < 2; ++ai)
#pragma unroll
      for (int m = 0; m < 4; ++m) {
        const size_t row = (size_t)(brow + ai * 128 + wr2 * 64 + m * 16 + fr2);
#pragma unroll
        for (int bj = 0; bj < 2; ++bj) {
          const int cb = bcol + bj * 128 + wc2 * 32 + fq2 * 4;
          if (EPI == 0) {
#pragma unroll
            for (int n = 0; n < 2; ++n) {
              uint2 o; o.x = pack2(acc[ai][bj][m][n][0], acc[ai][bj][m][n][1]); o.y = pack2(acc[ai][bj][m][n][2], acc[ai][bj][m][n][3]);
              *(uint2*)(outb + row * ldc + cb + n * 16) = o;
            }
          } else if (EPI == 1) {
#pragma unroll
            for (int n = 0; n < 2; ++n) {
              const size_t idx = row * 1024 + cb + n * 16;
              const f32x4v r4 = *(const f32x4v*)(res + idx);
              *(f32x4v*)(outf + idx) = r4 + acc[ai][bj][m][n];
            }
          } else {
            const f32x4v gv = acc[ai][bj][m][0], uv = acc[ai][bj][m][1];
            uint2 o; o.x = pack2(fsilu(gv[0]) * uv[0], fsilu(gv[1]) * uv[1]); o.y = pack2(fsilu(gv[2]) * uv[2], fsilu(gv[3]) * uv[3]);
            *(uint2*)(outb + row * DFF + ((bcol + bj * 128 + wc2 * 32) >> 1) + fq2 * 4) = o;
          }
        }
      }
  }
  __syncthreads();
#undef SA_
#undef SB_
#undef STAGE
#undef LDA
#undef LDB
#undef MMA
}

DI void hgrn_item(const Params& p, int li, int item, char* smem) {
  float* qs = (float*)smem;
  float* fs = qs + 2 * 16 * 128;
  float* vsm = fs + 2 * 16 * 128;
  float* opart = vsm + 2 * 16 * 32;
  const int tid = tidx(), lane = tid & 63, w = tid >> 6;
  const int vs = item & 3, h = (item >> 2) & 3, b = item >> 4;
  const int kq = lane >> 5, vc = lane & 31;
  const int k0 = 16 * w + 8 * kq;
  const int role = tid >> 8, t2 = tid & 255;
  const int tok = t2 >> 4, piece = t2 & 15;
  const u16* base = p.proj + (size_t)b * S_ * LD_EVEN;
  float lbv[8];
#pragma unroll
  for (int j = 0; j < 8; ++j) lbv[j] = p.lb[li * 512 + h * 128 + piece * 8 + j];
  float st[8];
#pragma unroll
  for (int j = 0; j < 8; ++j) st[j] = 0.f;
  const int colqf = role * 512 + h * 128 + piece * 8;
  const int colv = 1024 + h * 128 + vs * 32 + (tid & 3) * 8;
  uint4 rq, rv = make_uint4(0, 0, 0, 0);
  rq = *(const uint4*)(base + (size_t)tok * LD_EVEN + colqf);
  if (tid < 64) rv = *(const uint4*)(base + (size_t)(tid >> 2) * LD_EVEN + colv);
  __syncthreads();
  for (int c = 0; c < 128; ++c) {
    const int buf = c & 1;
    {
      float q8[8];
      unpack8(rq, q8);
      if (role == 0) {
#pragma unroll
        for (int j = 0; j < 8; ++j) q8[j] = fsilu(q8[j]);
      } else {
#pragma unroll
        for (int j = 0; j < 8; ++j) q8[j] = lbv[j] + (1.f - lbv[j]) * fsigmoid(q8[j]);
      }
      float4* qd = (float4*)((role == 0 ? qs : fs) + (buf * 16 + tok) * 128 + piece * 8);
      qd[0] = make_float4(q8[0], q8[1], q8[2], q8[3]); qd[1] = make_float4(q8[4], q8[5], q8[6], q8[7]);
      if (tid < 64) {
        float v8[8]; unpack8(rv, v8);
        float4* vd = (float4*)(vsm + (buf * 16 + (tid >> 2)) * 32 + (tid & 3) * 8);
        vd[0] = make_float4(v8[0], v8[1], v8[2], v8[3]); vd[1] = make_float4(v8[4], v8[5], v8[6], v8[7]);
      }
    }
    __syncthreads();
    if (c + 1 < 128) {
      rq = *(const uint4*)(base + (size_t)((c + 1) * 16 + tok) * LD_EVEN + colqf);
      if (tid < 64) rv = *(const uint4*)(base + (size_t)((c + 1) * 16 + (tid >> 2)) * LD_EVEN + colv);
    }
#pragma unroll 4
    for (int t = 0; t < 16; ++t) {
      const float4* q4 = (const float4*)(qs + (buf * 16 + t) * 128 + k0);
      const float4* f4 = (const float4*)(fs + (buf * 16 + t) * 128 + k0);
      const float4 qa = q4[0], qb = q4[1], fa = f4[0], fb = f4[1];
      const float v = vsm[(buf * 16 + t) * 32 + vc];
      st[0] = fa.x * (st[0] - v) + v; st[1] = fa.y * (st[1] - v) + v; st[2] = fa.z * (st[2] - v) + v; st[3] = fa.w * (st[3] - v) + v;
      st[4] = fb.x * (st[4] - v) + v; st[5] = fb.y * (st[5] - v) + v; st[6] = fb.z * (st[6] - v) + v; st[7] = fb.w * (st[7] - v) + v;
      float o = qa.x * st[0];
      o += qa.y * st[1]; o += qa.z * st[2]; o += qa.w * st[3]; o += qb.x * st[4]; o += qb.y * st[5]; o += qb.z * st[6]; o += qb.w * st[7];
      opart[(t * 16 + w * 2 + kq) * 32 + vc] = o;
    }
    __syncthreads();
    {
      const int t = tid >> 5, v2 = tid & 31;
      float sacc = 0.f;
#pragma unroll
      for (int jj = 0; jj < 16; ++jj) sacc += opart[(t * 16 + jj) * 32 + v2];
      p.hbuf[(size_t)(b * S_ + c * 16 + t) * 1024 + h * 128 + vs * 32 + v2] = f2bf(sacc);
    }
  }
  __syncthreads();
}

DI void load_q(const u16* qrow, const float* __restrict__ gain, int hh, bf16x8 (&qf)[4]) {
  float f[4][8]; float ss = 0.f;
#pragma unroll
  for (int kk = 0; kk < 4; ++kk) {
    uint4 raw = *(const uint4*)(qrow + kk * 16 + hh * 8);
    unpack8(raw, f[kk]);
#pragma unroll
    for (int j = 0; j < 8; ++j) ss += f[kk][j] * f[kk][j];
  }
  ss += __shfl_xor(ss, 32);
  const float rs = rsqrtf(ss * (1.f / 64.f) + EPSF) * (0.125f * LOG2E);
#pragma unroll
  for (int kk = 0; kk < 4; ++kk) {
#pragma unroll
    for (int j = 0; j < 8; ++j) f[kk][j] *= rs * gain[kk * 16 + hh * 8 + j];
    qf[kk] = as_bf16x8(pack8(f[kk]));
  }
}

template <int NTH>
DI void stage_kv(int tid, const u16* kb, const u16* vb, size_t stride, int r0, int rlo, int rhi, const float* __restrict__ kgain, u16* Ks, u16* Vts) {
  const int dp = tid & 7;
#pragma unroll
  for (int j = 0; j < 512 / NTH; ++j) {
    const int key = (tid >> 3) + (NTH / 8) * j; const int r = r0 + key;
    uint4 kv = make_uint4(0, 0, 0, 0), vv = make_uint4(0, 0, 0, 0);
    if (r >= rlo && r < rhi) { kv = *(const uint4*)(kb + (size_t)r * stride + dp * 8); vv = *(const uint4*)(vb + (size_t)r * stride + dp * 8); }
    if (kgain) {
      float f[8]; unpack8(kv, f);
      float ss = 0.f;
#pragma unroll
      for (int e = 0; e < 8; ++e) ss += f[e] * f[e];
      ss += __shfl_xor(ss, 1); ss += __shfl_xor(ss, 2); ss += __shfl_xor(ss, 4);
      const float rs = rsqrtf(ss * (1.f / 64.f) + EPSF);
#pragma unroll
      for (int e = 0; e < 8; ++e) f[e] *= rs * kgain[dp * 8 + e];
      kv = pack8(f);
    }
    *(uint4*)(Ks + key * 72 + dp * 8) = kv;
    u16* vd = Vts + (dp * 8) * 72 + key;
    vd[0 * 72] = (u16)(vv.x & 0xffffu); vd[1 * 72] = (u16)(vv.x >> 16);
    vd[2 * 72] = (u16)(vv.y & 0xffffu); vd[3 * 72] = (u16)(vv.y >> 16);
    vd[4 * 72] = (u16)(vv.z & 0xffffu); vd[5 * 72] = (u16)(vv.z >> 16);
    vd[6 * 72] = (u16)(vv.w & 0xffffu); vd[7 * 72] = (u16)(vv.w >> 16);
  }
}

template <class MF>
DI void score_stage(const bf16x8 (&qf)[4], const u16* Ks, int lane, MF maskf, f32x16 (&s)[2], float& mx) {
  const int lr = lane & 31, hh = lane >> 5;
#pragma unroll
  for (int sub = 0; sub < 2; ++sub) {
    s[sub] = zero16();
#pragma unroll
    for (int kk = 0; kk < 4; ++kk) {
      bf16x8 kf = *(const bf16x8*)(Ks + (sub * 32 + lr) * 72 + kk * 16 + hh * 8);
      s[sub] = MFMA32(kf, qf[kk], s[sub]);
    }
  }
  mx = -INFINITY;
#pragma unroll
  for (int sub = 0; sub < 2; ++sub)
#pragma unroll
    for (int i = 0; i < 16; ++i) {
      const int ko = sub * 32 + (i & 3) + 8 * (i >> 2) + 4 * hh;
      const float v = maskf(s[sub][i], ko);
      s[sub][i] = v; mx = fmaxf(mx, v);
    }
  mx = fmaxf(mx, __shfl_xor(mx, 32));
}

DI void pv_stage(const f32x16 (&s)[2], const u16* Vts, f32x16 (&o)[2], int lane) {
  const int lr = lane & 31, hh = lane >> 5;
#pragma unroll
  for (int sub = 0; sub < 2; ++sub)
#pragma unroll
    for (int st = 0; st < 2; ++st) {
      uint4 pk;
      pk.x = pack2(s[sub][8 * st + 0], s[sub][8 * st + 1]); pk.y = pack2(s[sub][8 * st + 2], s[sub][8 * st + 3]);
      pk.z = pack2(s[sub][8 * st + 4], s[sub][8 * st + 5]); pk.w = pack2(s[sub][8 * st + 6], s[sub][8 * st + 7]);
      const bf16x8 pf = as_bf16x8(pk);
#pragma unroll
      for (int dt = 0; dt < 2; ++dt) {
        const u16* vp = Vts + (dt * 32 + lr) * 72 + sub * 32 + 16 * st + 4 * hh;
        const uint2 lo = *(const uint2*)vp, hi = *(const uint2*)(vp + 8);
        const bf16x8 vf = as_bf16x8(make_uint4(lo.x, lo.y, hi.x, hi.y));
        o[dt] = MFMA32(vf, pf, o[dt]);
      }
    }
}

template <class MF>
DI void flash_stage(const bf16x8 (&qf)[4], const u16* Ks, const u16* Vts, f32x16 (&o)[2], float& m, float& l, int lane, MF maskf) {
  f32x16 s[2]; float mx;
  score_stage(qf, Ks, lane, maskf, s, mx);
  const float mn = fmaxf(m, mx);
  const float alpha = fexp2(m - mn);
  m = mn;
  float ls = 0.f;
#pragma unroll
  for (int sub = 0; sub < 2; ++sub)
#pragma unroll
    for (int i = 0; i < 16; ++i) { const float pv = fexp2(s[sub][i] - mn); s[sub][i] = pv; ls += pv; }
  l = l * alpha + ls;
#pragma unroll
  for (int dt = 0; dt < 2; ++dt)
#pragma unroll
    for (int i = 0; i < 16; ++i) o[dt][i] *= alpha;
  pv_stage(s, Vts, o, lane);
}

DI void dilated_item(const Params& p, int li, int pairitem, char* smem) {
  const int tfull = tidx();
  const int half = tfull >> 8, tid = tfull & 255;
  const int item = pairitem * 2 + half;
  u16* Ks = (u16*)(smem + half * 18432); u16* Vts = Ks + 64 * 72;
  const int lane = tid & 63, w = tid >> 6, lr = lane & 31, hh = lane >> 5;
  const int idx16 = item & 15; const int br = (item >> 4) % 3; const int hb = (item / 48) & 7; const int b = item / 384;
  const int d = br == 0 ? 1 : (br == 1 ? 4 : 16);
  const int tiles = 16 / d;
  const int resid = idx16 / tiles, tile = idx16 % tiles;
  const int u0 = tile * 128;
  const int uq = u0 + 32 * w + lr; const int tq = uq * d + resid;
  const u16* prow = p.proj + (size_t)(b * S_ + tq) * LD_EVEN;
  bf16x8 qf[4];
  load_q(prow + 2048 + hb * 64, p.hy_qg + li * 64, hh, qf);
  const float slope2 = fexp2(-(float)(hb + 1)) * LOG2E * (float)d;
  const u16* kb = p.proj + (size_t)(b * S_ + resid) * LD_EVEN + 2560 + hb * 64;
  const u16* vb = kb + 512;
  const size_t stride = (size_t)d * LD_EVEN;
  f32x16 o[2]; o[0] = zero16(); o[1] = zero16();
  float m = -1e30f, l = 0.f;
  const int uw = u0 + 32 * w;
  for (int st = 0; st < 4; ++st) {
    const int ub = u0 - 128 + 64 * st;
    __syncthreads();
    stage_kv<256>(tid, kb, vb, stride, ub, 0, 1 << 30, p.hy_kg + li * 64, Ks, Vts);
    __syncthreads();
    if (ub + 63 >= 0 && ub <= uw + 31 && ub + 63 >= uw - 128) {
      flash_stage(qf, Ks, Vts, o, m, l, lane, [&](float sv, int ko) -> float {
        const int kp = ub + ko; const int dist = uq - kp;
        return (dist >= 0 && dist <= 128 && kp >= 0) ? sv - slope2 * (float)dist : -INFINITY; });
    }
  }
  const float lt = l + __shfl_xor(l, 32);
  const float inv = 1.f / lt;
  const size_t trow = (size_t)br * T_ + (size_t)b * S_ + tq;
  if (hh == 0) p.lse[trow * 8 + hb] = (m + log2f(lt)) * LN2;
  u16* orow = p.obr + trow * 512 + hb * 64;
#pragma unroll
  for (int dt = 0; dt < 2; ++dt)
#pragma unroll
    for (int q4 = 0; q4 < 4; ++q4) {
      uint2 ov; ov.x = pack2(o[dt][4 * q4] * inv, o[dt][4 * q4 + 1] * inv); ov.y = pack2(o[dt][4 * q4 + 2] * inv, o[dt][4 * q4 + 3] * inv);
      *(uint2*)(orow + dt * 32 + 8 * q4 + 4 * hh) = ov;
    }
  __syncthreads();
}

DI void post_even_phase(const Params& p, int li) {
  const int tid = tidx();
  const int rsel = tid >> 7, c8 = tid & 127;
  for (int it = blockIdx.x; it < T_ / 4; it += gridDim.x) {
    const int t = it * 4 + rsel;
    const int c = c8 * 8;
    float val[8];
    if (c8 < 64) {
      uint4 raw = *(const uint4*)(p.hbuf + (size_t)t * 1024 + c);
      float o[8]; unpack8(raw, o);
      float ss = 0.f;
#pragma unroll
      for (int j = 0; j < 8; ++j) ss += o[j] * o[j];
      ss += __shfl_xor(ss, 1); ss += __shfl_xor(ss, 2); ss += __shfl_xor(ss, 4); ss += __shfl_xor(ss, 8);
      const float rs = rsqrtf(ss * (1.f / 128.f) + EPSF);
      uint4 graw = *(const uint4*)(p.proj + (size_t)t * LD_EVEN + 1536 + c);
      float gt[8]; unpack8(graw, gt);
#pragma unroll
      for (int j = 0; j < 8; ++j) val[j] = o[j] * rs * p.hy_og[li * 512 + c + j] * fsilu(gt[j]);
    } else {
      const int cb = c - 512, hb = cb >> 6;
      float l0 = p.lse[((size_t)0 * T_ + t) * 8 + hb], l1 = p.lse[((size_t)1 * T_ + t) * 8 + hb], l2 = p.lse[((size_t)2 * T_ + t) * 8 + hb];
      const float mx = fmaxf(l0, fmaxf(l1, l2));
      float w0 = __expf(l0 - mx), w1 = __expf(l1 - mx), w2 = __expf(l2 - mx);
      const float inv = 1.f / (w0 + w1 + w2);
      w0 *= inv; w1 *= inv; w2 *= inv;
      float a[8], bq[8], cq[8];
      unpack8(*(const uint4*)(p.obr + ((size_t)0 * T_ + t) * 512 + cb), a);
      unpack8(*(const uint4*)(p.obr + ((size_t)1 * T_ + t) * 512 + cb), bq);
      unpack8(*(const uint4*)(p.obr + ((size_t)2 * T_ + t) * 512 + cb), cq);
#pragma unroll
      for (int j = 0; j < 8; ++j) val[j] = w0 * a[j] + w1 * bq[j] + w2 * cq[j];
    }
    *(uint4*)(p.hbuf + (size_t)t * 1024 + c) = pack8(val);
  }
}

DI void compress_item(const Params& p, int li, int pairitem, char* smem) {
  const int tfull = tidx();
  const int half = tfull >> 8, tid = tfull & 255;
  const int item = pairitem * 2 + half;
  u16* hs = (u16*)(smem + half * 17408);
  float* outs = (float*)(smem + half * 17408 + 32 * 136 * 2);
  const int lane = tid & 63, w = tid >> 6, lr = lane & 31, hh = lane >> 5;
  const int nt = item & 3, g = (item >> 2) & 3, b = (item >> 4) & 15, kv = item >> 8;
  const int n = nt * 32 + lr; const int nc = n > 126 ? 126 : n;
  const int col = 1024 + kv * 256 + g * 64;
  const u16* arow = p.proj + (size_t)(b * S_ + 16 * nc) * LD_ODD + col;
  const u16* w1t = p.wt_c1 + (size_t)(li * 2 + kv) * 128 * 2048 + (size_t)(32 * w + lr) * 2048;
  f32x16 acc = zero16();
#pragma unroll 4
  for (int ks = 0; ks < 128; ++ks) {
    const int lidx = ks >> 2, dd = (ks & 3) * 16 + hh * 8;
    const bf16x8 a = as_bf16x8(*(const uint4*)(arow + (size_t)lidx * LD_ODD + dd));
    const bf16x8 bb = as_bf16x8(*(const uint4*)(w1t + ks * 16 + hh * 8));
    acc = MFMA32(a, bb, acc);
  }
  const float cb = p.c1[(li * 2 + kv) * 128 + 32 * w + lr];
  __syncthreads();
#pragma unroll
  for (int i = 0; i < 16; ++i) {
    const int r = (i & 3) + 8 * (i >> 2) + 4 * hh;
    hs[r * 136 + 32 * w + lr] = f2bf(fsilu(acc[i] + cb));
  }
  __syncthreads();
  if (w < 2) {
    const u16* w2t = p.wt_c2 + (size_t)(li * 2 + kv) * 64 * 128 + (size_t)(w * 32 + lr) * 128;
    f32x16 a2 = zero16();
#pragma unroll
    for (int kk = 0; kk < 8; ++kk) {
      const bf16x8 a = *(const bf16x8*)(hs + lr * 136 + kk * 16 + hh * 8);
      const bf16x8 bb = as_bf16x8(*(const uint4*)(w2t + kk * 16 + hh * 8));
      a2 = MFMA32(a, bb, a2);
    }
#pragma unroll
    for (int i = 0; i < 16; ++i) {
      const int r = (i & 3) + 8 * (i >> 2) + 4 * hh;
      outs[r * 65 + w * 32 + lr] = a2[i];
    }
  }
  __syncthreads();
  {
    const int r = tid >> 3, c8 = tid & 7;
    float v[8]; float ss = 0.f;
#pragma unroll
    for (int j = 0; j < 8; ++j) { v[j] = outs[r * 65 + c8 * 8 + j]; ss += v[j] * v[j]; }
    ss += __shfl_xor(ss, 1); ss += __shfl_xor(ss, 2); ss += __shfl_xor(ss, 4);
    if (kv == 0) {
      const float rs = rsqrtf(ss * (1.f / 64.f) + EPSF);
#pragma unroll
      for (int j = 0; j < 8; ++j) v[j] *= rs * p.nsa_kg[(li * 3 + 0) * 64 + c8 * 8 + j];
    }
    const int nn = nt * 32 + r;
    if (nn >= 127) {
#pragma unroll
      for (int j = 0; j < 8; ++j) v[j] = 0.f;
    }
    u16* dst = (kv == 0 ? p.kcmp : p.vcmp) + ((size_t)(b * 4 + g) * 128 + nn) * 64 + c8 * 8;
    *(uint4*)dst = pack8(v);
  }
  __syncthreads();
}

DI void nsa_item(const Params& p, int li, int item, char* smem) {
  u16* Ks = (u16*)smem; u16* Vts = Ks + 64 * 72;
  float* impA = (float*)(smem + 18432);
  float* impB = impA + 8192;
  float* imp = impB + 8192;
  unsigned* selm = (unsigned*)(imp + 64 * 33);
  const int tid = tidx(), lane = tid & 63, wv = tid >> 6, lr = lane & 31, hh = lane >> 5;
  const int w = wv & 3, half = wv >> 2;
  const int tt = item & 31, g = (item >> 5) & 3, b = item >> 7;
  const int t0 = tt * 64; const int cur = t0 >> 6;
  const int hd = g * 4 + w;
  const int tokl = 32 * half + lr;
  const int tq = t0 + tokl;
  const u16* pb = p.proj + (size_t)b * S_ * LD_ODD;
  const u16* prow = pb + (size_t)tq * LD_ODD;
  bf16x8 qf[4];
  load_q(prow + g * 256 + w * 64, p.nsa_qg + li * 64, hh, qf);
  const float slope2 = fexp2(-0.5f * (float)(hd + 1)) * LOG2E;
  const float g0 = fsigmoid(bf2f(prow[2560 + 0 + g * 4 + w]));
  const float g1 = fsigmoid(bf2f(prow[2560 + 16 + g * 4 + w]));
  const float g2 = fsigmoid(bf2f(prow[2560 + 32 + g * 4 + w]));
  f32x16 ot[2]; ot[0] = zero16(); ot[1] = zero16();
  {
    const u16* kb = p.kcmp + (size_t)(b * 4 + g) * 128 * 64;
    const u16* vb = p.vcmp + (size_t)(b * 4 + g) * 128 * 64;
    float m = -1e30f, l = 0.f;
#pragma unroll
    for (int st = 0; st < 2; ++st) {
      if (1024 * st > t0) continue;
      __syncthreads();
      stage_kv<512>(tid, kb, vb, 64, 64 * st, 0, 128, nullptr, Ks, Vts);
      __syncthreads();
      f32x16 s[2]; float mx;
      score_stage(qf, Ks, lane, [&](float sv, int ko) -> float {
        const int n = 64 * st + ko; const int dist = tq - (16 * n + 31);
        return (dist >= 0 && n < 127) ? sv - slope2 * (float)dist : -INFINITY; }, s, mx);
      const float mn = fmaxf(m, mx);
      float ls = 0.f;
#pragma unroll
      for (int sub = 0; sub < 2; ++sub)
#pragma unroll
        for (int i = 0; i < 16; ++i) ls += fexp2(s[sub][i] - mn);
      l = l * fexp2(m - mn) + ls;
      m = mn;
    }
    const float lt = l + __shfl_xor(l, 32);
    const float inv = lt > 0.f ? 1.f / lt : 0.f;
    f32x16 o[2]; o[0] = zero16(); o[1] = zero16();
#pragma unroll
    for (int st = 0; st < 2; ++st) {
      if (1024 * st > t0) {
#pragma unroll
        for (int G = 0; G < 16; ++G) {
          if ((G & 1) == hh) { impA[(w * 64 + tokl) * 32 + 16 * st + G] = 0.f; impB[(w * 64 + tokl) * 32 + 16 * st + G] = 0.f; }
        }
        continue;
      }
      __syncthreads();
      stage_kv<512>(tid, kb, vb, 64, 64 * st, 0, 128, nullptr, Ks, Vts);
      __syncthreads();
      f32x16 s[2]; float mx;
      score_stage(qf, Ks, lane, [&](float sv, int ko) -> float {
        const int n = 64 * st + ko; const int dist = tq - (16 * n + 31);
        return (dist >= 0 && n < 127) ? sv - slope2 * (float)dist : -INFINITY; }, s, mx);
#pragma unroll
      for (int sub = 0; sub < 2; ++sub)
#pragma unroll
        for (int i = 0; i < 16; ++i) s[sub][i] = fexp2(s[sub][i] - m) * inv;
#pragma unroll
      for (int sub = 0; sub < 2; ++sub)
#pragma unroll
        for (int q4 = 0; q4 < 4; ++q4) {
          const int G = 16 * st + 8 * sub + 2 * q4 + hh;
          impA[(w * 64 + tokl) * 32 + G] = (s[sub][4 * q4] + s[sub][4 * q4 + 1]) + (s[sub][4 * q4 + 2] + s[sub][4 * q4 + 3]);
          impB[(w * 64 + tokl) * 32 + G] = s[sub][4 * q4 + 3];
        }
      pv_stage(s, Vts, o, lane);
    }
#pragma unroll
    for (int dt = 0; dt < 2; ++dt)
#pragma unroll
      for (int i = 0; i < 16; ++i) ot[dt][i] += g0 * o[dt][i];
  }
  __syncthreads();
  for (int idx = tid; idx < 2048; idx += NT) {
    const int tok = idx >> 5, mm = idx & 31;
    float a = 0.f;
#pragma unroll
    for (int ww = 0; ww < 4; ++ww) a += impA[(ww * 64 + tok) * 32 + mm] + (mm > 0 ? impB[(ww * 64 + tok) * 32 + mm - 1] : 0.f);
    imp[tok * 33 + mm] = a;
  }
  __syncthreads();
  if (tid < 64) {
    unsigned sel = 1u | (1u << cur) | (cur > 0 ? (1u << (cur - 1)) : 0u);
    int cnt = __popc(sel);
    const float* im = imp + tid * 33;
    for (int r = cnt; r < 8; ++r) {
      int best = -1; float bv = 0.f;
      for (int mm = 0; mm <= cur; ++mm) {
        if ((sel >> mm) & 1u) continue;
        const float v = im[mm];
        if (best < 0 || v > bv) { best = mm; bv = v; }
      }
      if (best < 0) break;
      sel |= 1u << best;
    }
    selm[tid] = sel;
  }
  __syncthreads();
  const unsigned myMask = selm[tokl];
  unsigned uni = 0u;
#pragma unroll 8
  for (int i = 0; i < 64; ++i) uni |= selm[i];
  {
    f32x16 o[2]; o[0] = zero16(); o[1] = zero16();
    float m = -1e30f, l = 0.f;
    const u16* kb = pb + 1536 + g * 64; const u16* vb = pb + 1792 + g * 64;
    for (int mb = 0; mb <= cur; ++mb) {
      if (!((uni >> mb) & 1u)) continue;
      __syncthreads();
      stage_kv<512>(tid, kb, vb, LD_ODD, 64 * mb, 0, S_, p.nsa_kg + (li * 3 + 1) * 64, Ks, Vts);
      __syncthreads();
      const bool selb = (myMask >> mb) & 1u;
      flash_stage(qf, Ks, Vts, o, m, l, lane, [&](float s, int ko) -> float {
        const int dist = tq - (64 * mb + ko);
        return (selb && dist >= 0) ? s - slope2 * (float)dist : -INFINITY; });
    }
    const float lt = l + __shfl_xor(l, 32);
    const float sc = g1 / lt;
#pragma unroll
    for (int dt = 0; dt < 2; ++dt)
#pragma unroll
      for (int i = 0; i < 16; ++i) ot[dt][i] += sc * o[dt][i];
  }
  {
    f32x16 o[2]; o[0] = zero16(); o[1] = zero16();
    float m = -1e30f, l = 0.f;
    const u16* kb = pb + 2048 + g * 64; const u16* vb = pb + 2304 + g * 64;
    const int mlo = (t0 - 511) < 0 ? 0 : ((t0 - 511) >> 6);
    for (int mb = mlo; mb <= cur; ++mb) {
      __syncthreads();
      stage_kv<512>(tid, kb, vb, LD_ODD, 64 * mb, 0, S_, p.nsa_kg + (li * 3 + 2) * 64, Ks, Vts);
      __syncthreads();
      flash_stage(qf, Ks, Vts, o, m, l, lane, [&](float s, int ko) -> float {
        const int dist = tq - (64 * mb + ko);
        return (dist >= 0 && dist <= 511) ? s - slope2 * (float)dist : -INFINITY; });
    }
    const float lt = l + __shfl_xor(l, 32);
    const float sc = g2 / lt;
#pragma unroll
    for (int dt = 0; dt < 2; ++dt)
#pragma unroll
      for (int i = 0; i < 16; ++i) ot[dt][i] += sc * o[dt][i];
  }
  u16* orow = p.hbuf + (size_t)(b * S_ + tq) * 1024 + g * 256 + w * 64;
#pragma unroll
  for (int dt = 0; dt < 2; ++dt)
#pragma unroll
    for (int q4 = 0; q4 < 4; ++q4) {
      uint2 ov; ov.x = pack2(ot[dt][4 * q4], ot[dt][4 * q4 + 1]); ov.y = pack2(ot[dt][4 * q4 + 2], ot[dt][4 * q4 + 3]);
      *(uint2*)(orow + dt * 32 + 8 * q4 + 4 * hh) = ov;
    }
  __syncthreads();
}

DI void run_phase(const Params& p, int ph, char* smem) {
  if (ph == 0) { prep_phase(p, smem); return; }
  const int l = (ph - 1) >> 3, s = (ph - 1) & 7, li = l >> 1;
  const bool even = (l & 1) == 0;
  const float* xin = (l == 0) ? p.x : p.out;
  switch (s) {
    case 0: rmsnorm_phase(xin, p.attn_norm + l * 1024, p.hbuf); break;
    case 1:
      if (even) gemm_phase<0>(p.hbuf, p.wt_hy_in + (size_t)li * 3584 * 1024, 1024, 14, p.proj, LD_EVEN, nullptr, nullptr, smem);
      else gemm_phase<0>(p.hbuf, p.wt_nsa_in + (size_t)li * 2816 * 1024, 1024, 11, p.proj, LD_ODD, nullptr, nullptr, smem);
      break;
    case 2:
      if (even) {
        for (int item = blockIdx.x; item < 256 + 3072; item += gridDim.x) {
          if (item < 256) hgrn_item(p, li, item, smem); else dilated_item(p, li, item - 256, smem);
        }
      } else {
        for (int item = blockIdx.x; item < 256; item += gridDim.x) compress_item(p, li, item, smem);
      }
      break;
    case 3:
      if (even) post_even_phase(p, li);
      else { for (int item = blockIdx.x; item < 2048; item += gridDim.x) nsa_item(p, li, item, smem); }
      break;
    case 4:
      gemm_phase<1>(p.hbuf, (even ? p.wt_hy_out : p.wt_nsa_out) + (size_t)li * 1048576, 1024, 4, nullptr, 0, xin, p.out, smem);
      break;
    case 5: rmsnorm_phase(p.out, p.ffn_norm + l * 1024, p.hbuf); break;
    case 6: gemm_phase<2>(p.hbuf, p.wt_gu + (size_t)l * 5632 * 1024, 1024, 22, p.proj, DFF, nullptr, nullptr, smem); break;
    case 7: gemm_phase<1>(p.proj, p.wt_dn + (size_t)l * 1024 * 2816, 2816, 4, nullptr, 0, p.out, p.out, smem); break;
  }
}

__global__ void __launch_bounds__(512) mk_forward(Params p) {
  __shared__ __attribute__((aligned(16))) char smem[131072];
  __shared__ uint4 xb_words;
  cg::grid_group grid = cg::this_grid();
  if (__builtin_amdgcn_workitem_id_x() == 0) xb_words = make_uint4(0u, 0u, 0u, 0u);
  __syncthreads();
  const XcdBarrier xb = xcd_barrier_post(p.bar, (volatile LAS unsigned*)&xb_words);
  for (int ph = p.phase_lo; ph < p.phase_hi; ++ph) {
    run_phase(p, ph, smem);
    if (ph + 1 < p.phase_hi) {
      if (ph == p.phase_lo) grid.sync();
      else xcd_barrier(xb);
    }
  }
}

extern "C" void kernel_launch(void* const* d_in, const int* in_sizes, int n_in, void* d_out, int out_size,
                              void* d_ws, size_t ws_size, hipStream_t stream) {
  static int grid_blocks = 0;
  if (!grid_blocks) {
    int dev = 0, cus = 0, per_cu = 0;
    hipGetDevice(&dev);
    hipDeviceGetAttribute(&cus, hipDeviceAttributeMultiprocessorCount, dev);
    hipOccupancyMaxActiveBlocksPerMultiprocessor(&per_cu, mk_forward, 512, 0);
    if (per_cu > 1) per_cu = 1;
    if (per_cu < 1) per_cu = 1;
    grid_blocks = cus * per_cu;
  }
  Params p;
  memset(&p, 0, sizeof(p));
  p.x = (const float*)d_in[0]; p.attn_norm = (const float*)d_in[1]; p.ffn_norm = (const float*)d_in[2];
  p.hy_w_in = (const float*)d_in[3]; p.hy_lb = (const float*)d_in[4]; p.hy_og = (const float*)d_in[5];
  p.hy_qg = (const float*)d_in[6]; p.hy_kg = (const float*)d_in[7]; p.hy_w_out = (const float*)d_in[8];
  p.nsa_w_in = (const float*)d_in[9]; p.nsa_qg = (const float*)d_in[10]; p.nsa_kg = (const float*)d_in[11];
  p.cmp_pe = (const float*)d_in[12]; p.cmp_w1 = (const float*)d_in[13]; p.cmp_w2 = (const float*)d_in[14];
  p.nsa_w_out = (const float*)d_in[15]; p.ffn_g = (const float*)d_in[16]; p.ffn_u = (const float*)d_in[17]; p.ffn_d = (const float*)d_in[18];
  p.out = (float*)d_out;
  char* ws = (char*)d_ws; size_t off = 0;
  auto take = [&](size_t bytes) { char* r = ws + off; off += (bytes + 255) & ~(size_t)255; return r; };
  p.wt_hy_in = (u16*)take((size_t)2 * 3584 * 1024 * 2);
  p.wt_hy_out = (u16*)take((size_t)2 * 1048576 * 2);
  p.wt_nsa_in = (u16*)take((size_t)2 * 2816 * 1024 * 2);
  p.wt_nsa_out = (u16*)take((size_t)2 * 1048576 * 2);
  p.wt_gu = (u16*)take((size_t)4 * 5632 * 1024 * 2);
  p.wt_dn = (u16*)take((size_t)4 * 1024 * 2816 * 2);
  p.wt_c1 = (u16*)take((size_t)4 * 128 * 2048 * 2);
  p.wt_c2 = (u16*)take((size_t)4 * 64 * 128 * 2);
  p.c1 = (float*)take(4 * 128 * 4);
  p.lb = (float*)take(2 * 512 * 4);
  p.lse = (float*)take((size_t)3 * T_ * 8 * 4);
  p.proj = (u16*)take((size_t)T_ * 3584 * 2);
  p.hbuf = (u16*)take((size_t)T_ * 1024 * 2);
  p.obr = (u16*)take((size_t)3 * T_ * 512 * 2);
  p.kcmp = (u16*)take((size_t)16 * 4 * 128 * 64 * 2);
  p.vcmp = (u16*)take((size_t)16 * 4 * 128 * 64 * 2);
  p.bar = (unsigned*)take(XCD_BAR_WORDS * 4);
  if (off > ws_size) { fprintf(stderr, "workspace too small: need %zu have %zu\n", off, ws_size); return; }
  const int NPH = 33;
  hipMemsetAsync(p.bar, 0, XCD_BAR_WORDS * 4, stream);
#if MK_MULTI
  for (int ph = 0; ph < NPH; ++ph) {
    p.phase_lo = ph; p.phase_hi = ph + 1;
    hipLaunchKernelGGL(mk_forward, dim3(grid_blocks), dim3(512), 0, stream, p);
  }
#else
  p.phase_lo = 0; p.phase_hi = NPH;
  void* args[] = {&p};
  hipError_t e = hipLaunchCooperativeKernel((void*)mk_forward, dim3(grid_blocks), dim3(512), args, 0, stream);
  if (e != hipSuccess) fprintf(stderr, "cooperative launch failed: %s (grid %d)\n", hipGetErrorString(e), grid_blocks);
#endif
}
```

```cpp
#include <hip/hip_runtime.h>
#include <hip/hip_cooperative_groups.h>
#include <cstdio>
#include <cstdint>
#include <cstring>
namespace cg = cooperative_groups;

typedef unsigned short u16;
using bf16x8 = __attribute__((ext_vector_type(8))) short;
using f32x16 = __attribute__((ext_vector_type(16))) float;
using u32x4v = __attribute__((ext_vector_type(4))) unsigned;
#define DI __device__ __forceinline__
#define MFMA32(a, b, c) __builtin_amdgcn_mfma_f32_32x32x16_bf16((a), (b), (c), 0, 0, 0)

#ifndef MK_MULTI
#define MK_MULTI 0
#endif

constexpr int T_ = 32768, S_ = 2048;
constexpr float EPSF = 1e-6f;
constexpr float LOG2E = 1.4426950408889634f, LN2 = 0.6931471805599453f;
constexpr int LD_EVEN = 3584, LD_ODD = 2816, DFF = 2816;
constexpr int NT = 512;
#define LAS __attribute__((address_space(3)))
using f32x4v = __attribute__((ext_vector_type(4))) float;

struct Params {
  const float* x; const float* attn_norm; const float* ffn_norm;
  const float* hy_w_in; const float* hy_lb; const float* hy_og; const float* hy_qg; const float* hy_kg; const float* hy_w_out;
  const float* nsa_w_in; const float* nsa_qg; const float* nsa_kg; const float* cmp_pe; const float* cmp_w1; const float* cmp_w2; const float* nsa_w_out;
  const float* ffn_g; const float* ffn_u; const float* ffn_d;
  float* out;
  u16* wt_hy_in; u16* wt_hy_out; u16* wt_nsa_in; u16* wt_nsa_out; u16* wt_gu; u16* wt_dn; u16* wt_c1; u16* wt_c2;
  float* c1; float* lb; float* lse;
  u16* proj; u16* hbuf; u16* obr; u16* kcmp; u16* vcmp;
  unsigned* bar;
  int phase_lo; int phase_hi;
};

DI int tidx() { int t = __builtin_amdgcn_workitem_id_x(); asm volatile("" : "+v"(t)); return t; }
DI float bf2f(u16 h) { return __uint_as_float(((unsigned)h) << 16); }
typedef __bf16 bf16x2_t __attribute__((ext_vector_type(2)));
typedef float f32x2_t __attribute__((ext_vector_type(2)));
DI unsigned pack2(float a, float b) { f32x2_t v = {a, b}; bf16x2_t r = __builtin_convertvector(v, bf16x2_t); return __builtin_bit_cast(unsigned, r); }
DI u16 f2bf(float x) { return (u16)(pack2(x, 0.f) & 0xffffu); }
DI float fsigmoid(float x) { return 1.f / (1.f + __expf(-x)); }
DI float fsilu(float x) { return x / (1.f + __expf(-x)); }
DI float fexp2(float x) { return __builtin_amdgcn_exp2f(x); }
DI void unpack8(uint4 v, float (&f)[8]) {
  f[0] = __uint_as_float(v.x << 16); f[1] = __uint_as_float(v.x & 0xffff0000u);
  f[2] = __uint_as_float(v.y << 16); f[3] = __uint_as_float(v.y & 0xffff0000u);
  f[4] = __uint_as_float(v.z << 16); f[5] = __uint_as_float(v.z & 0xffff0000u);
  f[6] = __uint_as_float(v.w << 16); f[7] = __uint_as_float(v.w & 0xffff0000u);
}
DI uint4 pack8(const float (&f)[8]) {
  uint4 o; o.x = pack2(f[0], f[1]); o.y = pack2(f[2], f[3]); o.z = pack2(f[4], f[5]); o.w = pack2(f[6], f[7]); return o;
}
DI bf16x8 as_bf16x8(uint4 v) { u32x4v t; t[0] = v.x; t[1] = v.y; t[2] = v.z; t[3] = v.w; return __builtin_bit_cast(bf16x8, t); }
DI f32x16 zero16() { f32x16 z;
#pragma unroll
  for (int i = 0; i < 16; ++i) z[i] = 0.f; return z; }


#define XB_TMO      128
#define XB_XCNT(j)  (256  + 64 * (j))
#define XB_XSUB(j)  (1280 + 64 * (j))
#define XB_XGEN(j)  (2304 + 64 * (j))
#define XB_TOP      3328
#define XB_TOPGEN   3392
#define XCD_BAR_WORDS 3456
#define XB_SPIN_CAP (1u << 18)
DI unsigned xb_ld(unsigned* p) { return __hip_atomic_load(p, __ATOMIC_RELAXED, __HIP_MEMORY_SCOPE_AGENT); }
DI unsigned xb_add(unsigned* p, unsigned v) { return __hip_atomic_fetch_add(p, v, __ATOMIC_RELAXED, __HIP_MEMORY_SCOPE_AGENT); }
DI unsigned xb_xcc_id() { return (unsigned)__builtin_amdgcn_s_getreg((3 << 11) | 20) & 0xFu; }
#define XB_SPIN(cond, bar) do { unsigned _sp = 0; while (cond) { __builtin_amdgcn_s_sleep(1); \
    if ((++_sp & 255u) == 0u) { if (xb_ld(&(bar)[XB_TMO])) break; if (_sp > XB_SPIN_CAP) { atomicAdd(&(bar)[XB_TMO], 1u); break; } } } } while (0)
struct XcdBarrier { unsigned* bar; unsigned x; volatile LAS unsigned* st; };
DI XcdBarrier xcd_barrier_post(unsigned* bar, volatile LAS unsigned* st) {
  XcdBarrier b; b.bar = bar; b.x = xb_xcc_id(); b.st = st;
  if (__builtin_amdgcn_workitem_id_x() == 0) (void)xb_add(&bar[XB_XCNT(b.x)], 1u);
  return b;
}
DI void xcd_barrier_complete(unsigned* bar, unsigned x, unsigned& nloc, unsigned& nx) {
  const unsigned G = gridDim.x * gridDim.y * gridDim.z;
  unsigned sum, cnt, mine, sp = 0u;
  for (;;) {
    sum = 0u; cnt = 0u; mine = 0u;
#pragma unroll
    for (unsigned j = 0; j < 16; ++j) { const unsigned c = xb_ld(&bar[XB_XCNT(j)]); sum += c; cnt += (c > 0u) ? 1u : 0u; mine = (j == x) ? c : mine; }
    if (sum == G) break;
    __builtin_amdgcn_s_sleep(1);
    if ((++sp & 255u) == 0u) { if (xb_ld(&bar[XB_TMO])) break; if (sp > XB_SPIN_CAP) { atomicAdd(&bar[XB_TMO], 1u); break; } }
  }
  nloc = mine > 0u ? mine : 1u; nx = cnt > 0u ? cnt : 1u;
}
DI void xcd_barrier(const XcdBarrier& b) {
  asm volatile("s_waitcnt vmcnt(0)" ::: "memory");
  __syncthreads();
  if (__builtin_amdgcn_workitem_id_x() == 0) {
    unsigned* bar = b.bar;
    __builtin_amdgcn_s_waitcnt(0);
    unsigned nloc = b.st[0], nx = b.st[1];
    if (nloc == 0u) { xcd_barrier_complete(bar, b.x, nloc, nx); b.st[0] = nloc; b.st[1] = nx; }
    const unsigned old = xb_add(&bar[XB_XSUB(b.x)], 1u);
    const unsigned gen = old / nloc;
    if (old + 1u == (gen + 1u) * nloc) {
      __builtin_amdgcn_fence(__ATOMIC_RELEASE, "agent");
      asm volatile("s_waitcnt vmcnt(0)" ::: "memory");
      const unsigned og = xb_add(&bar[XB_TOP], 1u);
      const unsigned tg = og / nx;
      if (og + 1u == (tg + 1u) * nx) xb_add(&bar[XB_TOPGEN], 1u);
      else XB_SPIN(xb_ld(&bar[XB_TOPGEN]) == tg, bar);
      __builtin_amdgcn_fence(__ATOMIC_ACQUIRE, "agent");
      xb_add(&bar[XB_XGEN(b.x)], 1u);
      asm volatile("s_waitcnt vmcnt(0)" ::: "memory");
    } else {
      XB_SPIN(xb_ld(&bar[XB_XGEN(b.x)]) == gen, bar);
      __builtin_amdgcn_fence(__ATOMIC_ACQUIRE, "agent");
      asm volatile("s_waitcnt vmcnt(0)" ::: "memory");
    }
  }
  __syncthreads();
}

DI void prep_tile(const float* __restrict__ src, u16* __restrict__ dst, int K, int N, int mode, int tk, int tn, float* sm) {
  const int tid = tidx();
  __syncthreads();
  {
    const int c = tid & 63; const int n = tn * 64 + c;
#pragma unroll 4
    for (int r = tid >> 6; r < 64; r += 8)
      sm[r * 65 + c] = (n < N) ? src[(size_t)(tk * 64 + r) * N + n] : 0.f;
  }
  __syncthreads();
  {
    const int pi = tid;
    const int nl = pi >> 3, kp = pi & 7;
    const int n = tn * 64 + nl;
    int nd = n;
    if (mode == 1) nd = (n >> 4) * 32 + (n & 15);
    else if (mode == 2) nd = (n >> 4) * 32 + 16 + (n & 15);
    float v[8];
#pragma unroll
    for (int j = 0; j < 8; ++j) v[j] = sm[(kp * 8 + j) * 65 + nl];
    *(uint4*)(dst + (size_t)nd * K + tk * 64 + kp * 8) = pack8(v);
  }
}

DI void prep_phase(const Params& p, char* smem) {
  float* sm = (float*)smem;
  constexpr int G0 = 1792, G1 = 2304, G2 = 3712, G3 = 4224, G4 = 7040, G5 = 9856, G6 = 12672, G7 = 12928, G8 = 12936;
  for (int tile = blockIdx.x; tile < G8; tile += gridDim.x) {
    const float* src; u16* dst; int K, N, Np, mode = 0, lt;
    if (tile < G0) { int i = tile / 896; lt = tile % 896; src = p.hy_w_in + (size_t)i * 1024 * 3584; dst = p.wt_hy_in + (size_t)i * 3584 * 1024; K = 1024; N = 3584; Np = 3584; }
    else if (tile < G1) { int t = tile - G0; int i = t / 256; lt = t % 256; src = p.hy_w_out + (size_t)i * 1048576; dst = p.wt_hy_out + (size_t)i * 1048576; K = 1024; N = 1024; Np = 1024; }
    else if (tile < G2) { int t = tile - G1; int i = t / 704; lt = t % 704; src = p.nsa_w_in + (size_t)i * 1024 * 2608; dst = p.wt_nsa_in + (size_t)i * 2816 * 1024; K = 1024; N = 2608; Np = 2816; }
    else if (tile < G3) { int t = tile - G2; int i = t / 256; lt = t % 256; src = p.nsa_w_out + (size_t)i * 1048576; dst = p.wt_nsa_out + (size_t)i * 1048576; K = 1024; N = 1024; Np = 1024; }
    else if (tile < G4) { int t = tile - G3; int i = t / 704; lt = t % 704; src = p.ffn_g + (size_t)i * 1024 * 2816; dst = p.wt_gu + (size_t)i * 5632 * 1024; K = 1024; N = 2816; Np = 2816; mode = 1; }
    else if (tile < G5) { int t = tile - G4; int i = t / 704; lt = t % 704; src = p.ffn_u + (size_t)i * 1024 * 2816; dst = p.wt_gu + (size_t)i * 5632 * 1024; K = 1024; N = 2816; Np = 2816; mode = 2; }
    else if (tile < G6) { int t = tile - G5; int i = t / 704; lt = t % 704; src = p.ffn_d + (size_t)i * 2816 * 1024; dst = p.wt_dn + (size_t)i * 1024 * 2816; K = 2816; N = 1024; Np = 1024; }
    else if (tile < G7) { int t = tile - G6; int i = t / 64; lt = t % 64; src = p.cmp_w1 + (size_t)i * 2048 * 128; dst = p.wt_c1 + (size_t)i * 128 * 2048; K = 2048; N = 128; Np = 128; }
    else { int t = tile - G7; int i = t / 2; lt = t % 2; src = p.cmp_w2 + (size_t)i * 128 * 64; dst = p.wt_c2 + (size_t)i * 64 * 128; K = 128; N = 64; Np = 64; }
    const int ntn = Np / 64;
    prep_tile(src, dst, K, N, mode, lt / ntn, lt % ntn, sm);
  }
  __syncthreads();
  if (blockIdx.x < 4) {
    const int mi = blockIdx.x;
    const float* pe = p.cmp_pe + (size_t)mi * 2048;
    const float* w1 = p.cmp_w1 + (size_t)mi * 2048 * 128;
    const int tq_ = tidx();
    const int o = tq_ & 127, half = tq_ >> 7;
    float a0 = 0.f, a1 = 0.f, a2 = 0.f, a3 = 0.f;
    for (int k = half * 512; k < half * 512 + 512; k += 4) {
      a0 += pe[k] * w1[(size_t)k * 128 + o]; a1 += pe[k + 1] * w1[(size_t)(k + 1) * 128 + o];
      a2 += pe[k + 2] * w1[(size_t)(k + 2) * 128 + o]; a3 += pe[k + 3] * w1[(size_t)(k + 3) * 128 + o];
    }
    sm[tq_] = (a0 + a1) + (a2 + a3);
    __syncthreads();
    if (tq_ < 128) p.c1[mi * 128 + tq_] = (sm[tq_] + sm[tq_ + 128]) + (sm[tq_ + 256] + sm[tq_ + 384]);
    __syncthreads();
  }
  if (blockIdx.x == 4 || (gridDim.x <= 4 && blockIdx.x == 0)) {
    for (int c = tidx(); c < 512; c += NT) {
      float l0 = p.hy_lb[c], l1 = p.hy_lb[512 + c];
      float mx = fmaxf(l0, l1); float e0 = __expf(l0 - mx), e1 = __expf(l1 - mx); float inv = 1.f / (e0 + e1);
      float p0 = e0 * inv, p1 = e1 * inv;
      p.lb[c] = p0 - p0; p.lb[512 + c] = (p0 + p1) - p0;
    }
  }
}

DI void rmsnorm_phase(const float* x, const float* __restrict__ g, u16* h) {
  const int t_ = tidx();
  const int wave = t_ >> 6, lane = t_ & 63;
  for (int row = blockIdx.x * 8 + wave; row < T_; row += gridDim.x * 8) {
    const float4* xr = (const float4*)(x + (size_t)row * 1024);
    float4 v[4]; float ss = 0.f;
#pragma unroll
    for (int j = 0; j < 4; ++j) { v[j] = xr[lane + 64 * j]; ss += v[j].x * v[j].x + v[j].y * v[j].y + v[j].z * v[j].z + v[j].w * v[j].w; }
#pragma unroll
    for (int off = 32; off >= 1; off >>= 1) ss += __shfl_xor(ss, off);
    const float rs = rsqrtf(ss * (1.f / 1024.f) + EPSF);
#pragma unroll
    for (int j = 0; j < 4; ++j) {
      float4 gg = ((const float4*)g)[lane + 64 * j];
      uint2 o; o.x = pack2(v[j].x * rs * gg.x, v[j].y * rs * gg.y); o.y = pack2(v[j].z * rs * gg.z, v[j].w * rs * gg.w);
      *(uint2*)(h + (size_t)row * 1024 + (lane + 64 * j) * 4) = o;
    }
  }
}

DI int lds_byte(int r, int c) { const int st = (r >> 4) * 2 + (c >> 5), rr = r & 15, cc = c & 31, ob = rr * 64 + cc * 2; return st * 1024 + (ob ^ (((ob >> 9) & 1) << 5)); }
DI void stage_rc(int b, int& R, int& C) { const int st = b / 1024, sb = b % 1024, swz = sb ^ (((sb >> 9) & 1) << 5); R = (st >> 1) * 16 + swz / 64; C = (st & 1) * 32 + (swz % 64) / 2; }

template <int EPI>
DI void gemm_phase(const u16* A, const u16* Bt, const int K, const int nN, u16* outb, const int ldc, const float* res, float* outf, char* smem) {
  constexpr int HTB = 16384;
  const int tid = tidx();
  const int wid = tid >> 6, lane = tid & 63, wr = wid >> 2, wc = wid & 3, fr = lane & 15, fq = lane >> 4;
  const int nM = 128, nwg = nM * nN, nt = K / 64;
  int sR0, sC0, sR1, sC1; stage_rc(tid * 16, sR0, sC0); stage_rc(tid * 16 + 8192, sR1, sC1);
  const unsigned vo0 = (unsigned)((sR0 * K + sC0) * 2), vo1 = (unsigned)((sR1 * K + sC1) * 2);
#define SA_(b, h) (smem + ((b) * 2 + (h)) * HTB)
#define SB_(b, h) (smem + (4 + (b) * 2 + (h)) * HTB)
#define STAGE(P, BASE, br, kt) do { const char* _g = (const char*)((BASE) + (size_t)(br) * K + (size_t)(kt) * 64); \
    unsigned _o0 = vo0, _o1 = vo1; asm volatile("" : "+v"(_o0), "+v"(_o1)); \
    __builtin_amdgcn_global_load_lds((const unsigned*)(_g + _o0), (LAS unsigned*)((P) + tid * 16), 16, 0, 0); \
    __builtin_amdgcn_global_load_lds((const unsigned*)(_g + _o1), (LAS unsigned*)((P) + tid * 16 + 8192), 16, 0, 0); } while (0)
#define LDA(dst, b, h) _Pragma("unroll") for (int m = 0; m < 4; ++m) _Pragma("unroll") for (int k = 0; k < 2; ++k) \
    dst[m][k] = *(const bf16x8*)(SA_(b, h) + lds_byte(wr * 64 + m * 16 + fr, k * 32 + fq * 8))
#define LDB(dst, b, h) _Pragma("unroll") for (int n = 0; n < 2; ++n) _Pragma("unroll") for (int k = 0; k < 2; ++k) \
    dst[n][k] = *(const bf16x8*)(SB_(b, h) + lds_byte(wc * 32 + n * 16 + fr, k * 32 + fq * 8))
#define MMA(ai, bj, At_, Bx_) do { __builtin_amdgcn_s_setprio(1); \
    _Pragma("unroll") for (int m = 0; m < 4; ++m) _Pragma("unroll") for (int n = 0; n < 2; ++n) _Pragma("unroll") for (int k = 0; k < 2; ++k) \
      acc[ai][bj][m][n] = __builtin_amdgcn_mfma_f32_16x16x32_bf16(Bx_[n][k], At_[m][k], acc[ai][bj][m][n], 0, 0, 0); \
    __builtin_amdgcn_s_setprio(0); } while (0)
#define WAIT_V(n) asm volatile("s_waitcnt vmcnt(" #n ")" ::: "memory")
#define WAIT_L(n) asm volatile("s_waitcnt lgkmcnt(" #n ")" ::: "memory")
#define BAR __builtin_amdgcn_s_barrier()
#define SCHED __builtin_amdgcn_sched_barrier(0)
  for (int it = 0;; ++it) {
    const long L = (long)it * gridDim.x + blockIdx.x;
    if (L >= nwg) break;
    int wgid = (int)L;
    { const int q = nwg / 8, r = nwg % 8, xcd = wgid % 8, off = wgid / 8; wgid = (xcd < r ? xcd * (q + 1) : r * (q + 1) + (xcd - r) * q) + off; }
    const int nig = 8 * nN, gid = wgid / nig, fm = gid * 8, gsz = (nM - fm) < 8 ? (nM - fm) : 8;
    const int pm = fm + ((wgid % nig) % gsz), pn = (wgid % nig) / gsz;
    const int brow = pm * 256, bcol = pn * 256;
    f32x4v acc[2][2][4][2];
#pragma unroll
    for (int a = 0; a < 2; ++a)
#pragma unroll
      for (int b = 0; b < 2; ++b)
#pragma unroll
        for (int m = 0; m < 4; ++m)
#pragma unroll
          for (int n = 0; n < 2; ++n) acc[a][b][m][n] = (f32x4v){0.f, 0.f, 0.f, 0.f};
    bf16x8 At[4][2], B0[2][2], B1[2][2];
    __syncthreads();
    STAGE(SB_(0, 0), Bt, bcol, 0); STAGE(SA_(0, 0), A, brow, 0);
    STAGE(SB_(0, 1), Bt, bcol + 128, 0); STAGE(SA_(0, 1), A, brow + 128, 0);
    if (wr == 1) BAR;
    WAIT_V(4); BAR;
    STAGE(SB_(1, 0), Bt, bcol, 1); STAGE(SA_(1, 0), A, brow, 1); STAGE(SB_(1, 1), Bt, bcol + 128, 1);
    WAIT_V(6); BAR;
    for (int t = 0; t < nt - 2; t += 2) {
      LDB(B0, 0, 0); SCHED; LDA(At, 0, 0); STAGE(SA_(1, 1), A, brow + 128, t + 1);
      WAIT_L(8); BAR; WAIT_L(0); MMA(0, 0, At, B0); BAR; SCHED;
      LDB(B1, 0, 1); STAGE(SB_(0, 0), Bt, bcol, t + 2);
      BAR; WAIT_L(0); MMA(0, 1, At, B1); BAR;
      LDA(At, 0, 1); STAGE(SA_(0, 0), A, brow, t + 2);
      BAR; WAIT_L(0); MMA(1, 0, At, B0); BAR; SCHED;
      STAGE(SB_(0, 1), Bt, bcol + 128, t + 2);
      WAIT_V(6); BAR; MMA(1, 1, At, B1); BAR;
      LDB(B0, 1, 0); SCHED; LDA(At, 1, 0); STAGE(SA_(0, 1), A, brow + 128, t + 2);
      WAIT_L(8); BAR; WAIT_L(0); MMA(0, 0, At, B0); BAR; SCHED;
      LDB(B1, 1, 1); STAGE(SB_(1, 0), Bt, bcol, t + 3);
      BAR; WAIT_L(0); MMA(0, 1, At, B1); BAR;
      LDA(At, 1, 1); STAGE(SA_(1, 0), A, brow, t + 3);
      BAR; WAIT_L(0); MMA(1, 0, At, B0); BAR; SCHED;
      STAGE(SB_(1, 1), Bt, bcol + 128, t + 3);
      WAIT_V(6); BAR; MMA(1, 1, At, B1); BAR;
    }
    { LDB(B0, 0, 0); LDA(At, 0, 0); STAGE(SA_(1, 1), A, brow + 128, nt - 1);
      BAR; WAIT_L(0); MMA(0, 0, At, B0); BAR;
      LDB(B1, 0, 1); BAR; WAIT_L(0); MMA(0, 1, At, B1); BAR;
      LDA(At, 0, 1); WAIT_V(4); BAR; WAIT_L(0); MMA(1, 0, At, B0); MMA(1, 1, At, B1); BAR; }
    { LDB(B0, 1, 0); LDA(At, 1, 0); WAIT_V(2); BAR; WAIT_L(0); MMA(0, 0, At, B0); BAR;
      LDB(B1, 1, 1); WAIT_V(0); BAR; WAIT_L(0); MMA(0, 1, At, B1); BAR;
      LDA(At, 1, 1); BAR; WAIT_L(0); MMA(1, 0, At, B0); MMA(1, 1, At, B1); BAR; }
    if (wr == 0) BAR;
    int tid2 = tid; asm volatile("" : "+v"(tid2));
    const int fr2 = tid2 & 15, fq2 = (tid2 >> 4) & 3, wc2 = (tid2 >> 6) & 3, wr2 = tid2 >> 8;
#pragma unroll
    for (int ai = 0; ai < 2; ++ai)
#pragma unroll
      for (int m = 0; m < 4; ++m) {
        const size_t row = (size_t)(brow + ai * 128 + wr2 * 64 + m * 16 + fr2);
#pragma unroll
        for (int bj = 0; bj < 2; ++bj) {
          const int cb = bcol + bj * 128 + wc2 * 32 + fq2 * 4;
          if (EPI == 0) {
#pragma unroll
            for (int n = 0; n < 2; ++n) {
              uint2 o; o.x = pack2(acc[ai][bj][m][n][0], acc[ai][bj][m][n][1]); o.y = pack2(acc[ai][bj][m][n][2], acc[ai][bj][m][n][3]);
              *(uint2*)(outb + row * ldc + cb + n * 16) = o;
            }
          } else if (EPI == 1) {
#pragma unroll
            for (int n = 0; n < 2; ++n) {
              const size_t idx = row * 1024 + cb + n * 16;
              const f32x4v r4 = *(const f32x4v*)(res + idx);
              *(f32x4v*)(outf + idx) = r4 + acc[ai][bj][m][n];
            }
          } else {
            const f32x4v gv = acc[ai][bj][m][0], uv = acc[ai][bj][m][1];
            uint2 o; o.x = pack2(fsilu(gv[0]) * uv[0], fsilu(gv[1]) * uv[1]); o.y = pack2(fsilu(gv[2]) * uv[2], fsilu(gv[3]) * uv[3]);
            *(uint2*)(outb + row * DFF + ((bcol + bj * 128 + wc2 * 32) >> 1) + fq2 * 4) = o;
          }
        }
      }
  }
  __syncthreads();
#undef SA_
#undef SB_
#undef STAGE
#undef LDA
#undef LDB
#undef MMA
}

#define MFMA16(a, b, c) __builtin_amdgcn_mfma_f32_16x16x32_bf16((a), (b), (c), 0, 0, 0)
DI void hgrn_item(const Params& p, int li, int item, char* smem) {
  u16* Qt = (u16*)smem;
  u16* Kt = Qt + 16 * 136;
  u16* Kh = Kt + 16 * 136;
  u16* Vt = Kh + 128 * 24;
  float* Pc = (float*)(Vt + 32 * 24);
  float* Opart = Pc + 128;
  const int tid = tidx(), lane = tid & 63, w = tid >> 6, fr = lane & 15, fq = lane >> 4;
  const int kk = w >> 1, vt = w & 1;
  const int vs = item & 3, h = (item >> 2) & 3, b = item >> 4;
  const int tg = tid & 3, kch = tid >> 2;
  const int sv = tid >> 5, vv = tid & 31;
  const float lbv = p.lb[li * 512 + h * 128 + kch];
  const u16* base = p.proj + (size_t)b * S_ * LD_EVEN;
  const u16* pq = base + (size_t)(4 * tg) * LD_EVEN + h * 128 + kch;
  const u16* pv = base + (size_t)sv * LD_EVEN + 1024 + h * 128 + vs * 32 + vv;
  unsigned rq0 = pq[0], rq1 = pq[LD_EVEN], rq2 = pq[2 * LD_EVEN], rq3 = pq[3 * LD_EVEN];
  unsigned rf0 = pq[512], rf1 = pq[LD_EVEN + 512], rf2 = pq[2 * LD_EVEN + 512], rf3 = pq[3 * LD_EVEN + 512];
  unsigned rvv = pv[0];
  f32x4v S0 = {0.f, 0.f, 0.f, 0.f}, S1 = {0.f, 0.f, 0.f, 0.f};
  const f32x4v z4 = {0.f, 0.f, 0.f, 0.f};
  __syncthreads();
#pragma unroll 1
  for (int c = 0; c < 128; ++c) {
    {
      float qv[4], kv[4], cs[4];
      const unsigned rq[4] = {rq0, rq1, rq2, rq3}, rf[4] = {rf0, rf1, rf2, rf3};
      float cp = 1.f;
#pragma unroll
      for (int i = 0; i < 4; ++i) {
        const float f = lbv + (1.f - lbv) * fsigmoid(__uint_as_float(rf[i] << 16));
        cp *= f; cs[i] = cp; kv[i] = 1.f - f; qv[i] = fsilu(__uint_as_float(rq[i] << 16));
      }
      const int bl = lane & ~3;
      const float t0 = __shfl(cp, bl), t1 = __shfl(cp, bl + 1), t2 = __shfl(cp, bl + 2), t3 = __shfl(cp, bl + 3);
      const float pre = (tg > 0 ? t0 : 1.f) * (tg > 1 ? t1 : 1.f) * (tg > 2 ? t2 : 1.f);
      const float PC = (t0 * t1) * (t2 * t3);
      float kh[4];
#pragma unroll
      for (int i = 0; i < 4; ++i) {
        const float P = fmaxf(pre * cs[i], 1e-30f);
        const float rP = __builtin_amdgcn_rcpf(P);
        const int t = 4 * tg + i;
        Qt[t * 136 + kch] = f2bf(qv[i] * P);
        const float kr = kv[i] * rP;
        Kt[t * 136 + kch] = f2bf(kr);
        kh[i] = kr * PC;
      }
      uint2 k2; k2.x = pack2(kh[0], kh[1]); k2.y = pack2(kh[2], kh[3]);
      *(uint2*)(Kh + kch * 24 + 4 * tg) = k2;
      if (tg == 0) Pc[kch] = PC;
      Vt[vv * 24 + sv] = (u16)rvv;
    }
    __syncthreads();
    if (c + 1 < 128) {
      const u16* pq2 = pq + (size_t)(c + 1) * 16 * LD_EVEN;
      rq0 = pq2[0]; rq1 = pq2[LD_EVEN]; rq2 = pq2[2 * LD_EVEN]; rq3 = pq2[3 * LD_EVEN];
      rf0 = pq2[512]; rf1 = pq2[LD_EVEN + 512]; rf2 = pq2[2 * LD_EVEN + 512]; rf3 = pq2[3 * LD_EVEN + 512];
      rvv = pv[(size_t)(c + 1) * 16 * LD_EVEN];
    }
    {
      const uint2 v2 = *(const uint2*)(Vt + (16 * vt + fr) * 24 + 4 * fq);
      const bf16x8 vb = as_bf16x8(make_uint4(v2.x, v2.y, 0u, 0u));
      const u16* qrow = Qt + fr * 136 + 32 * kk + 4 * fq;
      const uint2 qa = *(const uint2*)qrow, qb = *(const uint2*)(qrow + 16);
      const bf16x8 qfrag = as_bf16x8(make_uint4(qa.x, qa.y, qb.x, qb.y));
      const bf16x8 sfrag = as_bf16x8(make_uint4(pack2(S0[0], S0[1]), pack2(S0[2], S0[3]), pack2(S1[0], S1[1]), pack2(S1[2], S1[3])));
      f32x4v acc = MFMA16(qfrag, sfrag, z4);
      if (kk == 0) {
        f32x4v sa = z4;
#pragma unroll
        for (int ks = 0; ks < 4; ++ks) {
          const bf16x8 kf = *(const bf16x8*)(Kt + fr * 136 + 32 * ks + 8 * fq);
          const bf16x8 qf2 = *(const bf16x8*)(Qt + fr * 136 + 32 * ks + 8 * fq);
          sa = MFMA16(kf, qf2, sa);
        }
#pragma unroll
        for (int j = 0; j < 4; ++j) sa[j] = (4 * fq + j <= fr) ? sa[j] : 0.f;
        const bf16x8 afrag = as_bf16x8(make_uint4(pack2(sa[0], sa[1]), pack2(sa[2], sa[3]), 0u, 0u));
        acc = MFMA16(afrag, vb, acc);
      }
#pragma unroll
      for (int j = 0; j < 4; ++j) Opart[(w * 16 + 4 * fq + j) * 16 + fr] = acc[j];
      const float* pc0 = Pc + 32 * kk + 4 * fq;
#pragma unroll
      for (int j = 0; j < 4; ++j) { S0[j] *= pc0[j]; S1[j] *= pc0[16 + j]; }
      const uint2 h0 = *(const uint2*)(Kh + (32 * kk + fr) * 24 + 4 * fq);
      const uint2 h1v = *(const uint2*)(Kh + (32 * kk + 16 + fr) * 24 + 4 * fq);
      S0 = MFMA16(as_bf16x8(make_uint4(h0.x, h0.y, 0u, 0u)), vb, S0);
      S1 = MFMA16(as_bf16x8(make_uint4(h1v.x, h1v.y, 0u, 0u)), vb, S1);
    }
    __syncthreads();
    {
      const int t = tid >> 5, v = tid & 31, vtt = v >> 4, vl = v & 15;
      float o = 0.f;
#pragma unroll
      for (int q = 0; q < 4; ++q) o += Opart[((2 * q + vtt) * 16 + t) * 16 + vl];
      p.hbuf[(size_t)(b * S_ + c * 16 + t) * 1024 + h * 128 + vs * 32 + v] = f2bf(o);
    }
  }
  __syncthreads();
}

DI void load_q(const u16* qrow, const float* __restrict__ gain, int hh, bf16x8 (&qf)[4]) {
  float f[4][8]; float ss = 0.f;
#pragma unroll
  for (int kk = 0; kk < 4; ++kk) {
    uint4 raw = *(const uint4*)(qrow + kk * 16 + hh * 8);
    unpack8(raw, f[kk]);
#pragma unroll
    for (int j = 0; j < 8; ++j) ss += f[kk][j] * f[kk][j];
  }
  ss += __shfl_xor(ss, 32);
  const float rs = rsqrtf(ss * (1.f / 64.f) + EPSF) * (0.125f * LOG2E);
#pragma unroll
  for (int kk = 0; kk < 4; ++kk) {
#pragma unroll
    for (int j = 0; j < 8; ++j) f[kk][j] *= rs * gain[kk * 16 + hh * 8 + j];
    qf[kk] = as_bf16x8(pack8(f[kk]));
  }
}

template <int NTH> struct KVRegs { u32x4v k[512 / NTH]; u32x4v v[512 / NTH]; };
template <int NTH>
DI void kv_load(int tid, const u16* kb, const u16* vb, size_t stride, int r0, int rlo, int rhi, KVRegs<NTH>& rg) {
  const int dp = tid & 7;
#pragma unroll
  for (int j = 0; j < 512 / NTH; ++j) {
    const int r = r0 + (tid >> 3) + (NTH / 8) * j;
    u32x4v kv = {0u, 0u, 0u, 0u}, vv = {0u, 0u, 0u, 0u};
    if (r >= rlo && r < rhi) { kv = *(const u32x4v*)(kb + (size_t)r * stride + dp * 8); vv = *(const u32x4v*)(vb + (size_t)r * stride + dp * 8); }
    rg.k[j] = kv; rg.v[j] = vv;
  }
}
template <int NTH>
DI void kv_store(int tid, const KVRegs<NTH>& rg, const float* __restrict__ kgain, u16* Ks, u16* Vts) {
  const int dp = tid & 7;
#pragma unroll
  for (int j = 0; j < 512 / NTH; ++j) {
    const int key = (tid >> 3) + (NTH / 8) * j;
    uint4 kv = make_uint4(rg.k[j][0], rg.k[j][1], rg.k[j][2], rg.k[j][3]);
    const u32x4v vv = rg.v[j];
    if (kgain) {
      float f[8]; unpack8(kv, f);
      float ss = 0.f;
#pragma unroll
      for (int e = 0; e < 8; ++e) ss += f[e] * f[e];
      ss += __shfl_xor(ss, 1); ss += __shfl_xor(ss, 2); ss += __shfl_xor(ss, 4);
      const float rs = rsqrtf(ss * (1.f / 64.f) + EPSF);
#pragma unroll
      for (int e = 0; e < 8; ++e) f[e] *= rs * kgain[dp * 8 + e];
      kv = pack8(f);
    }
    *(uint4*)(Ks + key * 72 + dp * 8) = kv;
    u16* vd = Vts + (dp * 8) * 72 + key;
    vd[0 * 72] = (u16)(vv[0] & 0xffffu); vd[1 * 72] = (u16)(vv[0] >> 16);
    vd[2 * 72] = (u16)(vv[1] & 0xffffu); vd[3 * 72] = (u16)(vv[1] >> 16);
    vd[4 * 72] = (u16)(vv[2] & 0xffffu); vd[5 * 72] = (u16)(vv[2] >> 16);
    vd[6 * 72] = (u16)(vv[3] & 0xffffu); vd[7 * 72] = (u16)(vv[3] >> 16);
  }
}

DI void score_stage(const bf16x8 (&qf)[4], const u16* Ks, int lane, float sk, float sb, int lower, int lim, f32x16 (&s)[2], float& mx) {
  const int lr = lane & 31, hh = lane >> 5;
#pragma unroll
  for (int sub = 0; sub < 2; ++sub) {
#pragma unroll
    for (int i = 0; i < 16; ++i) s[sub][i] = fmaf(sk, (float)(sub * 32 + (i & 3) + 8 * (i >> 2)), sb);
#pragma unroll
    for (int kk = 0; kk < 4; ++kk) {
      bf16x8 kf = *(const bf16x8*)(Ks + (sub * 32 + lr) * 72 + kk * 16 + hh * 8);
      s[sub] = MFMA32(kf, qf[kk], s[sub]);
    }
  }
  if (lim < lower) { lower = 64; lim = 64; }
  const bool full = (lower <= 0) && (lim >= 63);
  if (!__all(full)) {
    const int lo2 = lower - 4 * hh; const unsigned rng = (unsigned)(lim - lower);
#pragma unroll
    for (int sub = 0; sub < 2; ++sub)
#pragma unroll
      for (int i = 0; i < 16; ++i) {
        const int kc = sub * 32 + (i & 3) + 8 * (i >> 2);
        s[sub][i] = ((unsigned)(kc - lo2) <= rng) ? s[sub][i] : -INFINITY;
      }
  }
  mx = -INFINITY;
#pragma unroll
  for (int sub = 0; sub < 2; ++sub)
#pragma unroll
    for (int i = 0; i < 16; ++i) mx = fmaxf(mx, s[sub][i]);
  mx = fmaxf(mx, __shfl_xor(mx, 32));
}

DI void pv_stage(const f32x16 (&s)[2], const u16* Vts, f32x16 (&o)[2], int lane) {
  const int lr = lane & 31, hh = lane >> 5;
#pragma unroll
  for (int sub = 0; sub < 2; ++sub)
#pragma unroll
    for (int st = 0; st < 2; ++st) {
      uint4 pk;
      pk.x = pack2(s[sub][8 * st + 0], s[sub][8 * st + 1]); pk.y = pack2(s[sub][8 * st + 2], s[sub][8 * st + 3]);
      pk.z = pack2(s[sub][8 * st + 4], s[sub][8 * st + 5]); pk.w = pack2(s[sub][8 * st + 6], s[sub][8 * st + 7]);
      const bf16x8 pf = as_bf16x8(pk);
#pragma unroll
      for (int dt = 0; dt < 2; ++dt) {
        const u16* vp = Vts + (dt * 32 + lr) * 72 + sub * 32 + 16 * st + 4 * hh;
        const uint2 lo = *(const uint2*)vp, hi = *(const uint2*)(vp + 8);
        const bf16x8 vf = as_bf16x8(make_uint4(lo.x, lo.y, hi.x, hi.y));
        o[dt] = MFMA32(vf, pf, o[dt]);
      }
    }
}

DI void flash_stage(const bf16x8 (&qf)[4], const u16* Ks, const u16* Vts, f32x16 (&o)[2], float& m, float& l, int lane,
                    float sk, float sb, int lower, int lim) {
  f32x16 s[2]; float mx;
  score_stage(qf, Ks, lane, sk, sb, lower, lim, s, mx);
  const float mn = fmaxf(m, mx);
  const float alpha = fexp2(m - mn);
  const bool same = (mn == m);
  m = mn;
  float ls = 0.f;
#pragma unroll
  for (int sub = 0; sub < 2; ++sub)
#pragma unroll
    for (int i = 0; i < 16; ++i) { const float pv = fexp2(s[sub][i] - mn); s[sub][i] = pv; ls += pv; }
  l = l * alpha + ls;
  if (!__all(same)) {
#pragma unroll
    for (int dt = 0; dt < 2; ++dt)
#pragma unroll
      for (int i = 0; i < 16; ++i) o[dt][i] *= alpha;
  }
  pv_stage(s, Vts, o, lane);
}

DI void dilated_item(const Params& p, int li, int pairitem, char* smem) {
  const int tfull = tidx();
  const int half = tfull >> 8, tid = tfull & 255;
  const int item = pairitem * 2 + half;
  u16* Ks = (u16*)(smem + half * 18432); u16* Vts = Ks + 64 * 72;
  const int lane = tid & 63, w = tid >> 6, lr = lane & 31, hh = lane >> 5;
  const int idx16 = item & 15; const int br = (item >> 4) % 3; const int hb = (item / 48) & 7; const int b = item / 384;
  const int d = br == 0 ? 1 : (br == 1 ? 4 : 16);
  const int tiles = 16 / d;
  const int resid = idx16 / tiles, tile = idx16 % tiles;
  const int u0 = tile * 128;
  const int uq = u0 + 32 * w + lr; const int tq = uq * d + resid;
  const u16* prow = p.proj + (size_t)(b * S_ + tq) * LD_EVEN;
  bf16x8 qf[4];
  load_q(prow + 2048 + hb * 64, p.hy_qg + li * 64, hh, qf);
  const float slope2 = fexp2(-(float)(hb + 1)) * LOG2E;
  const float sk = slope2 * (float)d;
  const u16* kb = p.proj + (size_t)(b * S_ + resid) * LD_EVEN + 2560 + hb * 64;
  const u16* vb = kb + 512;
  const size_t stride = (size_t)d * LD_EVEN;
  const float* kg = p.hy_kg + li * 64;
  f32x16 o[2]; o[0] = zero16(); o[1] = zero16();
  float m = -1e30f, l = 0.f;
  const int uw = u0 + 32 * w;
  KVRegs<256> rg;
  kv_load<256>(tid, kb, vb, stride, u0 - 128, 0, 1 << 30, rg);
#pragma unroll 1
  for (int st = 0; st < 4; ++st) {
    const int ub = u0 - 128 + 64 * st;
    __syncthreads();
    kv_store<256>(tid, rg, kg, Ks, Vts);
    __syncthreads();
    if (st + 1 < 4) kv_load<256>(tid, kb, vb, stride, ub + 64, 0, 1 << 30, rg);
    if (ub + 63 >= 0 && ub <= uw + 31 && ub + 63 >= uw - 128) {
      const int lim = uq - ub;
      const int lower = max(lim - 128, -ub);
      const float sb = slope2 * (float)(ub * d + resid) + sk * (float)(4 * hh);
      flash_stage(qf, Ks, Vts, o, m, l, lane, sk, sb, lower, lim);
    }
  }
  const float lt = l + __shfl_xor(l, 32);
  const float inv = 1.f / lt;
  const size_t trow = (size_t)br * T_ + (size_t)b * S_ + tq;
  if (hh == 0) p.lse[trow * 8 + hb] = (m + log2f(lt)) * LN2;
  u16* orow = p.obr + trow * 512 + hb * 64;
#pragma unroll
  for (int dt = 0; dt < 2; ++dt)
#pragma unroll
    for (int q4 = 0; q4 < 4; ++q4) {
      uint2 ov; ov.x = pack2(o[dt][4 * q4] * inv, o[dt][4 * q4 + 1] * inv); ov.y = pack2(o[dt][4 * q4 + 2] * inv, o[dt][4 * q4 + 3] * inv);
      *(uint2*)(orow + dt * 32 + 8 * q4 + 4 * hh) = ov;
    }
  __syncthreads();
}

DI void post_even_phase(const Params& p, int li) {
  const int tid = tidx();
  const int rsel = tid >> 7, c8 = tid & 127;
  for (int it = blockIdx.x; it < T_ / 4; it += gridDim.x) {
    const int t = it * 4 + rsel;
    const int c = c8 * 8;
    float val[8];
    if (c8 < 64) {
      uint4 raw = *(const uint4*)(p.hbuf + (size_t)t * 1024 + c);
      float o[8]; unpack8(raw, o);
      float ss = 0.f;
#pragma unroll
      for (int j = 0; j < 8; ++j) ss += o[j] * o[j];
      ss += __shfl_xor(ss, 1); ss += __shfl_xor(ss, 2); ss += __shfl_xor(ss, 4); ss += __shfl_xor(ss, 8);
      const float rs = rsqrtf(ss * (1.f / 128.f) + EPSF);
      uint4 graw = *(const uint4*)(p.proj + (size_t)t * LD_EVEN + 1536 + c);
      float gt[8]; unpack8(graw, gt);
#pragma unroll
      for (int j = 0; j < 8; ++j) val[j] = o[j] * rs * p.hy_og[li * 512 + c + j] * fsilu(gt[j]);
    } else {
      const int cb = c - 512, hb = cb >> 6;
      float l0 = p.lse[((size_t)0 * T_ + t) * 8 + hb], l1 = p.lse[((size_t)1 * T_ + t) * 8 + hb], l2 = p.lse[((size_t)2 * T_ + t) * 8 + hb];
      const float mx = fmaxf(l0, fmaxf(l1, l2));
      float w0 = __expf(l0 - mx), w1 = __expf(l1 - mx), w2 = __expf(l2 - mx);
      const float inv = 1.f / (w0 + w1 + w2);
      w0 *= inv; w1 *= inv; w2 *= inv;
      float a[8], bq[8], cq[8];
      unpack8(*(const uint4*)(p.obr + ((size_t)0 * T_ + t) * 512 + cb), a);
      unpack8(*(const uint4*)(p.obr + ((size_t)1 * T_ + t) * 512 + cb), bq);
      unpack8(*(const uint4*)(p.obr + ((size_t)2 * T_ + t) * 512 + cb), cq);
#pragma unroll
      for (int j = 0; j < 8; ++j) val[j] = w0 * a[j] + w1 * bq[j] + w2 * cq[j];
    }
    *(uint4*)(p.hbuf + (size_t)t * 1024 + c) = pack8(val);
  }
}

DI void compress_item(const Params& p, int li, int pairitem, char* smem) {
  const int tfull = tidx();
  const int half = tfull >> 8, tid = tfull & 255;
  const int item = pairitem * 2 + half;
  u16* hs = (u16*)(smem + half * 17408);
  float* outs = (float*)(smem + half * 17408 + 32 * 136 * 2);
  const int lane = tid & 63, w = tid >> 6, lr = lane & 31, hh = lane >> 5;
  const int nt = item & 3, g = (item >> 2) & 3, b = (item >> 4) & 15, kv = item >> 8;
  const int n = nt * 32 + lr; const int nc = n > 126 ? 126 : n;
  const int col = 1024 + kv * 256 + g * 64;
  const u16* arow = p.proj + (size_t)(b * S_ + 16 * nc) * LD_ODD + col;
  const u16* w1t = p.wt_c1 + (size_t)(li * 2 + kv) * 128 * 2048 + (size_t)(32 * w + lr) * 2048;
  f32x16 acc = zero16();
#pragma unroll 4
  for (int ks = 0; ks < 128; ++ks) {
    const int lidx = ks >> 2, dd = (ks & 3) * 16 + hh * 8;
    const bf16x8 a = as_bf16x8(*(const uint4*)(arow + (size_t)lidx * LD_ODD + dd));
    const bf16x8 bb = as_bf16x8(*(const uint4*)(w1t + ks * 16 + hh * 8));
    acc = MFMA32(a, bb, acc);
  }
  const float cb = p.c1[(li * 2 + kv) * 128 + 32 * w + lr];
  __syncthreads();
#pragma unroll
  for (int i = 0; i < 16; ++i) {
    const int r = (i & 3) + 8 * (i >> 2) + 4 * hh;
    hs[r * 136 + 32 * w + lr] = f2bf(fsilu(acc[i] + cb));
  }
  __syncthreads();
  if (w < 2) {
    const u16* w2t = p.wt_c2 + (size_t)(li * 2 + kv) * 64 * 128 + (size_t)(w * 32 + lr) * 128;
    f32x16 a2 = zero16();
#pragma unroll
    for (int kk = 0; kk < 8; ++kk) {
      const bf16x8 a = *(const bf16x8*)(hs + lr * 136 + kk * 16 + hh * 8);
      const bf16x8 bb = as_bf16x8(*(const uint4*)(w2t + kk * 16 + hh * 8));
      a2 = MFMA32(a, bb, a2);
    }
#pragma unroll
    for (int i = 0; i < 16; ++i) {
      const int r = (i & 3) + 8 * (i >> 2) + 4 * hh;
      outs[r * 65 + w * 32 + lr] = a2[i];
    }
  }
  __syncthreads();
  {
    const int r = tid >> 3, c8 = tid & 7;
    float v[8]; float ss = 0.f;
#pragma unroll
    for (int j = 0; j < 8; ++j) { v[j] = outs[r * 65 + c8 * 8 + j]; ss += v[j] * v[j]; }
    ss += __shfl_xor(ss, 1); ss += __shfl_xor(ss, 2); ss += __shfl_xor(ss, 4);
    if (kv == 0) {
      const float rs = rsqrtf(ss * (1.f / 64.f) + EPSF);
#pragma unroll
      for (int j = 0; j < 8; ++j) v[j] *= rs * p.nsa_kg[(li * 3 + 0) * 64 + c8 * 8 + j];
    }
    const int nn = nt * 32 + r;
    if (nn >= 127) {
#pragma unroll
      for (int j = 0; j < 8; ++j) v[j] = 0.f;
    }
    u16* dst = (kv == 0 ? p.kcmp : p.vcmp) + ((size_t)(b * 4 + g) * 128 + nn) * 64 + c8 * 8;
    *(uint4*)dst = pack8(v);
  }
  __syncthreads();
}

DI void nsa_item(const Params& p, int li, int item, char* smem) {
  u16* Ks = (u16*)smem; u16* Vts = Ks + 64 * 72;
  float* impA = (float*)(smem + 18432);
  float* impB = impA + 8192;
  float* imp = impB + 8192;
  unsigned* selm = (unsigned*)(imp + 64 * 33);
  const int tid = tidx(), lane = tid & 63, wv = tid >> 6, lr = lane & 31, hh = lane >> 5;
  const int w = wv & 3, half = wv >> 2;
  const int tt = item & 31, g = (item >> 5) & 3, b = item >> 7;
  const int t0 = tt * 64; const int cur = t0 >> 6;
  const int hd = g * 4 + w;
  const int tokl = 32 * half + lr;
  const int tq = t0 + tokl;
  const u16* pb = p.proj + (size_t)b * S_ * LD_ODD;
  const u16* prow = pb + (size_t)tq * LD_ODD;
  bf16x8 qf[4];
  load_q(prow + g * 256 + w * 64, p.nsa_qg + li * 64, hh, qf);
  const float slope2 = fexp2(-0.5f * (float)(hd + 1)) * LOG2E;
  const float g0 = fsigmoid(bf2f(prow[2560 + 0 + g * 4 + w]));
  const float g1 = fsigmoid(bf2f(prow[2560 + 16 + g * 4 + w]));
  const float g2 = fsigmoid(bf2f(prow[2560 + 32 + g * 4 + w]));
  f32x16 ot[2]; ot[0] = zero16(); ot[1] = zero16();
  {
    const u16* kb = p.kcmp + (size_t)(b * 4 + g) * 128 * 64;
    const u16* vb = p.vcmp + (size_t)(b * 4 + g) * 128 * 64;
    const float sk = 16.f * slope2;
    const int limc = (tq - 31) >> 4;
    float m = -1e30f, l = 0.f;
    KVRegs<512> rg;
#pragma unroll
    for (int st = 0; st < 2; ++st) {
      if (1024 * st > t0) continue;
      kv_load<512>(tid, kb, vb, 64, 64 * st, 0, 128, rg);
      __syncthreads();
      kv_store<512>(tid, rg, nullptr, Ks, Vts);
      __syncthreads();
      f32x16 s[2]; float mx;
      const float sb = slope2 * (float)(1024 * st + 31) + sk * (float)(4 * hh);
      score_stage(qf, Ks, lane, sk, sb, 0, min(limc, 126) - 64 * st, s, mx);
      const float mn = fmaxf(m, mx);
      float ls = 0.f;
#pragma unroll
      for (int sub = 0; sub < 2; ++sub)
#pragma unroll
        for (int i = 0; i < 16; ++i) ls += fexp2(s[sub][i] - mn);
      l = l * fexp2(m - mn) + ls;
      m = mn;
    }
    const float lt = l + __shfl_xor(l, 32);
    const float inv = lt > 0.f ? 1.f / lt : 0.f;
    f32x16 o[2]; o[0] = zero16(); o[1] = zero16();
#pragma unroll
    for (int st = 0; st < 2; ++st) {
      if (1024 * st > t0) {
#pragma unroll
        for (int G = 0; G < 16; ++G) {
          if ((G & 1) == hh) { impA[(w * 64 + tokl) * 32 + 16 * st + G] = 0.f; impB[(w * 64 + tokl) * 32 + 16 * st + G] = 0.f; }
        }
        continue;
      }
      kv_load<512>(tid, kb, vb, 64, 64 * st, 0, 128, rg);
      __syncthreads();
      kv_store<512>(tid, rg, nullptr, Ks, Vts);
      __syncthreads();
      f32x16 s[2]; float mx;
      const float sb = slope2 * (float)(1024 * st + 31) + sk * (float)(4 * hh);
      score_stage(qf, Ks, lane, sk, sb, 0, min(limc, 126) - 64 * st, s, mx);
#pragma unroll
      for (int sub = 0; sub < 2; ++sub)
#pragma unroll
        for (int i = 0; i < 16; ++i) s[sub][i] = fexp2(s[sub][i] - m) * inv;
#pragma unroll
      for (int sub = 0; sub < 2; ++sub)
#pragma unroll
        for (int q4 = 0; q4 < 4; ++q4) {
          const int G = 16 * st + 8 * sub + 2 * q4 + hh;
          impA[(w * 64 + tokl) * 32 + G] = (s[sub][4 * q4] + s[sub][4 * q4 + 1]) + (s[sub][4 * q4 + 2] + s[sub][4 * q4 + 3]);
          impB[(w * 64 + tokl) * 32 + G] = s[sub][4 * q4 + 3];
        }
      pv_stage(s, Vts, o, lane);
    }
#pragma unroll
    for (int dt = 0; dt < 2; ++dt)
#pragma unroll
      for (int i = 0; i < 16; ++i) ot[dt][i] += g0 * o[dt][i];
  }
  __syncthreads();
  for (int idx = tid; idx < 2048; idx += NT) {
    const int tok = idx >> 5, mm = idx & 31;
    float a = 0.f;
#pragma unroll
    for (int ww = 0; ww < 4; ++ww) a += impA[(ww * 64 + tok) * 32 + mm] + (mm > 0 ? impB[(ww * 64 + tok) * 32 + mm - 1] : 0.f);
    imp[tok * 33 + mm] = a;
  }
  __syncthreads();
  if (tid < 64) {
    unsigned sel = 1u | (1u << cur) | (cur > 0 ? (1u << (cur - 1)) : 0u);
    int cnt = __popc(sel);
    const float* im = imp + tid * 33;
    for (int r = cnt; r < 8; ++r) {
      int best = -1; float bv = 0.f;
      for (int mm = 0; mm <= cur; ++mm) {
        if ((sel >> mm) & 1u) continue;
        const float v = im[mm];
        if (best < 0 || v > bv) { best = mm; bv = v; }
      }
      if (best < 0) break;
      sel |= 1u << best;
    }
    selm[tid] = sel;
  }
  __syncthreads();
  const unsigned myMask = selm[tokl];
  unsigned uni = 0u;
#pragma unroll 8
  for (int i = 0; i < 64; ++i) uni |= selm[i];
  {
    f32x16 o[2]; o[0] = zero16(); o[1] = zero16();
    float m = -1e30f, l = 0.f;
    const u16* kb = pb + 1536 + g * 64; const u16* vb = pb + 1792 + g * 64;
    const float* kg = p.nsa_kg + (li * 3 + 1) * 64;
    KVRegs<512> rg;
    unsigned rem = uni;
    int mb = __builtin_ctz(rem);
    kv_load<512>(tid, kb, vb, LD_ODD, 64 * mb, 0, S_, rg);
#pragma unroll 1
    while (true) {
      rem &= rem - 1u;
      __syncthreads();
      kv_store<512>(tid, rg, kg, Ks, Vts);
      __syncthreads();
      const int mbn = rem ? __builtin_ctz(rem) : -1;
      if (mbn >= 0) kv_load<512>(tid, kb, vb, LD_ODD, 64 * mbn, 0, S_, rg);
      const bool selb = (myMask >> mb) & 1u;
      const float sb = slope2 * (float)(64 * mb) + slope2 * (float)(4 * hh);
      flash_stage(qf, Ks, Vts, o, m, l, lane, slope2, sb, 0, selb ? (tq - 64 * mb) : -1);
      if (mbn < 0) break;
      mb = mbn;
    }
    const float lt = l + __shfl_xor(l, 32);
    const float sc = g1 / lt;
#pragma unroll
    for (int dt = 0; dt < 2; ++dt)
#pragma unroll
      for (int i = 0; i < 16; ++i) ot[dt][i] += sc * o[dt][i];
  }
  {
    f32x16 o[2]; o[0] = zero16(); o[1] = zero16();
    float m = -1e30f, l = 0.f;
    const u16* kb = pb + 2048 + g * 64; const u16* vb = pb + 2304 + g * 64;
    const float* kg = p.nsa_kg + (li * 3 + 2) * 64;
    const int mlo = (t0 - 511) < 0 ? 0 : ((t0 - 511) >> 6);
    KVRegs<512> rg;
    kv_load<512>(tid, kb, vb, LD_ODD, 64 * mlo, 0, S_, rg);
#pragma unroll 1
    for (int mb = mlo; mb <= cur; ++mb) {
      __syncthreads();
      kv_store<512>(tid, rg, kg, Ks, Vts);
      __syncthreads();
      if (mb + 1 <= cur) kv_load<512>(tid, kb, vb, LD_ODD, 64 * (mb + 1), 0, S_, rg);
      const int lim = tq - 64 * mb;
      const float sb = slope2 * (float)(64 * mb) + slope2 * (float)(4 * hh);
      flash_stage(qf, Ks, Vts, o, m, l, lane, slope2, sb, lim - 511, lim);
    }
    const float lt = l + __shfl_xor(l, 32);
    const float sc = g2 / lt;
#pragma unroll
    for (int dt = 0; dt < 2; ++dt)
#pragma unroll
      for (int i = 0; i < 16; ++i) ot[dt][i] += sc * o[dt][i];
  }
  u16* orow = p.hbuf + (size_t)(b * S_ + tq) * 1024 + g * 256 + w * 64;
#pragma unroll
  for (int dt = 0; dt < 2; ++dt)
#pragma unroll
    for (int q4 = 0; q4 < 4; ++q4) {
      uint2 ov; ov.x = pack2(ot[dt][4 * q4], ot[dt][4 * q4 + 1]); ov.y = pack2(ot[dt][4 * q4 + 2], ot[dt][4 * q4 + 3]);
      *(uint2*)(orow + dt * 32 + 8 * q4 + 4 * hh) = ov;
    }
  __syncthreads();
}

DI void run_phase(const Params& p, int ph, char* smem) {
  if (ph == 0) { prep_phase(p, smem); return; }
  const int l = (ph - 1) >> 3, s = (ph - 1) & 7, li = l >> 1;
  const bool even = (l & 1) == 0;
  const float* xin = (l == 0) ? p.x : p.out;
  switch (s) {
    case 0: rmsnorm_phase(xin, p.attn_norm + l * 1024, p.hbuf); break;
    case 1:
      if (even) gemm_phase<0>(p.hbuf, p.wt_hy_in + (size_t)li * 3584 * 1024, 1024, 14, p.proj, LD_EVEN, nullptr, nullptr, smem);
      else gemm_phase<0>(p.hbuf, p.wt_nsa_in + (size_t)li * 2816 * 1024, 1024, 11, p.proj, LD_ODD, nullptr, nullptr, smem);
      break;
    case 2:
      if (even) {
        for (int item = blockIdx.x; item < 256 + 3072; item += gridDim.x) {
          if (item < 256) hgrn_item(p, li, item, smem); else dilated_item(p, li, item - 256, smem);
        }
      } else {
        for (int item = blockIdx.x; item < 256; item += gridDim.x) compress_item(p, li, item, smem);
      }
      break;
    case 3:
      if (even) post_even_phase(p, li);
      else {
        for (int item = blockIdx.x; item < 2048; item += gridDim.x) {
          const int r = item / gridDim.x, i = item % gridDim.x;
          int it2 = item;
          if (gridDim.x == 256) {
            const int c = (i + 4 * (r >> 1)) & 31;
            const int tt = (r & 1) ? 31 - c : c;
            it2 = ((i >> 5) + 8 * r) * 32 + tt;
          }
          nsa_item(p, li, it2, smem);
        }
      }
      break;
    case 4:
      gemm_phase<1>(p.hbuf, (even ? p.wt_hy_out : p.wt_nsa_out) + (size_t)li * 1048576, 1024, 4, nullptr, 0, xin, p.out, smem);
      break;
    case 5: rmsnorm_phase(p.out, p.ffn_norm + l * 1024, p.hbuf); break;
    case 6: gemm_phase<2>(p.hbuf, p.wt_gu + (size_t)l * 5632 * 1024, 1024, 22, p.proj, DFF, nullptr, nullptr, smem); break;
    case 7: gemm_phase<1>(p.proj, p.wt_dn + (size_t)l * 1024 * 2816, 2816, 4, nullptr, 0, p.out, p.out, smem); break;
  }
}

__global__ void __launch_bounds__(512) mk_forward(Params p) {
  __shared__ __attribute__((aligned(16))) char smem[131072];
  __shared__ uint4 xb_words;
  cg::grid_group grid = cg::this_grid();
  if (__builtin_amdgcn_workitem_id_x() == 0) xb_words = make_uint4(0u, 0u, 0u, 0u);
  __syncthreads();
  const XcdBarrier xb = xcd_barrier_post(p.bar, (volatile LAS unsigned*)&xb_words);
  for (int ph = p.phase_lo; ph < p.phase_hi; ++ph) {
    run_phase(p, ph, smem);
    if (ph + 1 < p.phase_hi) {
      if (ph == p.phase_lo) grid.sync();
      else xcd_barrier(xb);
    }
  }
}

extern "C" void kernel_launch(void* const* d_in, const int* in_sizes, int n_in, void* d_out, int out_size,
                              void* d_ws, size_t ws_size, hipStream_t stream) {
  static int grid_blocks = 0;
  if (!grid_blocks) {
    int dev = 0, cus = 0, per_cu = 0;
    hipGetDevice(&dev);
    hipDeviceGetAttribute(&cus, hipDeviceAttributeMultiprocessorCount, dev);
    hipOccupancyMaxActiveBlocksPerMultiprocessor(&per_cu, mk_forward, 512, 0);
    if (per_cu > 1) per_cu = 1;
    if (per_cu < 1) per_cu = 1;
    grid_blocks = cus * per_cu;
  }
  Params p;
  memset(&p, 0, sizeof(p));
  p.x = (const float*)d_in[0]; p.attn_norm = (const float*)d_in[1]; p.ffn_norm = (const float*)d_in[2];
  p.hy_w_in = (const float*)d_in[3]; p.hy_lb = (const float*)d_in[4]; p.hy_og = (const float*)d_in[5];
  p.hy_qg = (const float*)d_in[6]; p.hy_kg = (const float*)d_in[7]; p.hy_w_out = (const float*)d_in[8];
  p.nsa_w_in = (const float*)d_in[9]; p.nsa_qg = (const float*)d_in[10]; p.nsa_kg = (const float*)d_in[11];
  p.cmp_pe = (const float*)d_in[12]; p.cmp_w1 = (const float*)d_in[13]; p.cmp_w2 = (const float*)d_in[14];
  p.nsa_w_out = (const float*)d_in[15]; p.ffn_g = (const float*)d_in[16]; p.ffn_u = (const float*)d_in[17]; p.ffn_d = (const float*)d_in[18];
  p.out = (float*)d_out;
  char* ws = (char*)d_ws; size_t off = 0;
  auto take = [&](size_t bytes) { char* r = ws + off; off += (bytes + 255) & ~(size_t)255; return r; };
  p.wt_hy_in = (u16*)take((size_t)2 * 3584 * 1024 * 2);
  p.wt_hy_out = (u16*)take((size_t)2 * 1048576 * 2);
  p.wt_nsa_in = (u16*)take((size_t)2 * 2816 * 1024 * 2);
  p.wt_nsa_out = (u16*)take((size_t)2 * 1048576 * 2);
  p.wt_gu = (u16*)take((size_t)4 * 5632 * 1024 * 2);
  p.wt_dn = (u16*)take((size_t)4 * 1024 * 2816 * 2);
  p.wt_c1 = (u16*)take((size_t)4 * 128 * 2048 * 2);
  p.wt_c2 = (u16*)take((size_t)4 * 64 * 128 * 2);
  p.c1 = (float*)take(4 * 128 * 4);
  p.lb = (float*)take(2 * 512 * 4);
  p.lse = (float*)take((size_t)3 * T_ * 8 * 4);
  p.proj = (u16*)take((size_t)T_ * 3584 * 2);
  p.hbuf = (u16*)take((size_t)T_ * 1024 * 2);
  p.obr = (u16*)take((size_t)3 * T_ * 512 * 2);
  p.kcmp = (u16*)take((size_t)16 * 4 * 128 * 64 * 2);
  p.vcmp = (u16*)take((size_t)16 * 4 * 128 * 64 * 2);
  p.bar = (unsigned*)take(XCD_BAR_WORDS * 4);
  if (off > ws_size) { fprintf(stderr, "workspace too small: need %zu have %zu\n", off, ws_size); return; }
  const int NPH = 33;
  hipMemsetAsync(p.bar, 0, XCD_BAR_WORDS * 4, stream);
#if MK_MULTI
  for (int ph = 0; ph < NPH; ++ph) {
    p.phase_lo = ph; p.phase_hi = ph + 1;
    hipLaunchKernelGGL(mk_forward, dim3(grid_blocks), dim3(512), 0, stream, p);
  }
#else
  p.phase_lo = 0; p.phase_hi = NPH;
  void* args[] = {&p};
  hipError_t e = hipLaunchCooperativeKernel((void*)mk_forward, dim3(grid_blocks), dim3(512), args, 0, stream);
  if (e != hipSuccess) fprintf(stderr, "cooperative launch failed: %s (grid %d)\n", hipGetErrorString(e), grid_blocks);
#endif
}
```

```cpp
#include <hip/hip_runtime.h>
#include <hip/hip_cooperative_groups.h>
#include <cstdio>
#include <cstdint>
#include <cstring>
namespace cg = cooperative_groups;

typedef unsigned short u16;
using bf16x8 = __attribute__((ext_vector_type(8))) short;
using f32x16 = __attribute__((ext_vector_type(16))) float;
using u32x4v = __attribute__((ext_vector_type(4))) unsigned;
#define DI __device__ __forceinline__
#define MFMA32(a, b, c) __builtin_amdgcn_mfma_f32_32x32x16_bf16((a), (b), (c), 0, 0, 0)

#ifndef MK_MULTI
#define MK_MULTI 0
#endif

constexpr int T_ = 32768, S_ = 2048;
constexpr float EPSF = 1e-6f;
constexpr float LOG2E = 1.4426950408889634f, LN2 = 0.6931471805599453f;
constexpr int LD_EVEN = 3584, LD_ODD = 2816, DFF = 2816;
constexpr int NT = 512;
#define LAS __attribute__((address_space(3)))
using f32x4v = __attribute__((ext_vector_type(4))) float;

struct Params {
  const float* x; const float* attn_norm; const float* ffn_norm;
  const float* hy_w_in; const float* hy_lb; const float* hy_og; const float* hy_qg; const float* hy_kg; const float* hy_w_out;
  const float* nsa_w_in; const float* nsa_qg; const float* nsa_kg; const float* cmp_pe; const float* cmp_w1; const float* cmp_w2; const float* nsa_w_out;
  const float* ffn_g; const float* ffn_u; const float* ffn_d;
  float* out;
  u16* wt_hy_in; u16* wt_hy_out; u16* wt_nsa_in; u16* wt_nsa_out; u16* wt_gu; u16* wt_dn; u16* wt_c1; u16* wt_c2;
  float* c1; float* lb; float* lse;
  u16* proj; u16* hbuf; u16* obr; u16* kcmp; u16* vcmp;
  unsigned* bar;
  int phase_lo; int phase_hi;
};

DI int tidx() { int t = __builtin_amdgcn_workitem_id_x(); asm volatile("" : "+v"(t)); return t; }
DI float bf2f(u16 h) { return __uint_as_float(((unsigned)h) << 16); }
typedef __bf16 bf16x2_t __attribute__((ext_vector_type(2)));
typedef float f32x2_t __attribute__((ext_vector_type(2)));
DI unsigned pack2(float a, float b) { f32x2_t v = {a, b}; bf16x2_t r = __builtin_convertvector(v, bf16x2_t); return __builtin_bit_cast(unsigned, r); }
DI u16 f2bf(float x) { return (u16)(pack2(x, 0.f) & 0xffffu); }
DI float fsigmoid(float x) { return 1.f / (1.f + __expf(-x)); }
DI float fsilu(float x) { return x / (1.f + __expf(-x)); }
DI float fexp2(float x) { return __builtin_amdgcn_exp2f(x); }
DI void unpack8(uint4 v, float (&f)[8]) {
  f[0] = __uint_as_float(v.x << 16); f[1] = __uint_as_float(v.x & 0xffff0000u);
  f[2] = __uint_as_float(v.y << 16); f[3] = __uint_as_float(v.y & 0xffff0000u);
  f[4] = __uint_as_float(v.z << 16); f[5] = __uint_as_float(v.z & 0xffff0000u);
  f[6] = __uint_as_float(v.w << 16); f[7] = __uint_as_float(v.w & 0xffff0000u);
}
DI uint4 pack8(const float (&f)[8]) {
  uint4 o; o.x = pack2(f[0], f[1]); o.y = pack2(f[2], f[3]); o.z = pack2(f[4], f[5]); o.w = pack2(f[6], f[7]); return o;
}
DI bf16x8 as_bf16x8(uint4 v) { u32x4v t; t[0] = v.x; t[1] = v.y; t[2] = v.z; t[3] = v.w; return __builtin_bit_cast(bf16x8, t); }
DI f32x16 zero16() { f32x16 z;
#pragma unroll
  for (int i = 0; i < 16; ++i) z[i] = 0.f; return z; }


#define XB_TMO      128
#define XB_XCNT(j)  (256  + 64 * (j))
#define XB_XSUB(j)  (1280 + 64 * (j))
#define XB_XGEN(j)  (2304 + 64 * (j))
#define XB_TOP      3328
#define XB_TOPGEN   3392
#define XCD_BAR_WORDS 3456
#define XB_SPIN_CAP (1u << 18)
DI unsigned xb_ld(unsigned* p) { return __hip_atomic_load(p, __ATOMIC_RELAXED, __HIP_MEMORY_SCOPE_AGENT); }
DI unsigned xb_add(unsigned* p, unsigned v) { return __hip_atomic_fetch_add(p, v, __ATOMIC_RELAXED, __HIP_MEMORY_SCOPE_AGENT); }
DI unsigned xb_xcc_id() { return (unsigned)__builtin_amdgcn_s_getreg((3 << 11) | 20) & 0xFu; }
#define XB_SPIN(cond, bar) do { unsigned _sp = 0; while (cond) { __builtin_amdgcn_s_sleep(1); \
    if ((++_sp & 255u) == 0u) { if (xb_ld(&(bar)[XB_TMO])) break; if (_sp > XB_SPIN_CAP) { atomicAdd(&(bar)[XB_TMO], 1u); break; } } } } while (0)
struct XcdBarrier { unsigned* bar; unsigned x; volatile LAS unsigned* st; };
DI XcdBarrier xcd_barrier_post(unsigned* bar, volatile LAS unsigned* st) {
  XcdBarrier b; b.bar = bar; b.x = xb_xcc_id(); b.st = st;
  if (__builtin_amdgcn_workitem_id_x() == 0) (void)xb_add(&bar[XB_XCNT(b.x)], 1u);
  return b;
}
DI void xcd_barrier_complete(unsigned* bar, unsigned x, unsigned& nloc, unsigned& nx) {
  const unsigned G = gridDim.x * gridDim.y * gridDim.z;
  unsigned sum, cnt, mine, sp = 0u;
  for (;;) {
    sum = 0u; cnt = 0u; mine = 0u;
#pragma unroll
    for (unsigned j = 0; j < 16; ++j) { const unsigned c = xb_ld(&bar[XB_XCNT(j)]); sum += c; cnt += (c > 0u) ? 1u : 0u; mine = (j == x) ? c : mine; }
    if (sum == G) break;
    __builtin_amdgcn_s_sleep(1);
    if ((++sp & 255u) == 0u) { if (xb_ld(&bar[XB_TMO])) break; if (sp > XB_SPIN_CAP) { atomicAdd(&bar[XB_TMO], 1u); break; } }
  }
  nloc = mine > 0u ? mine : 1u; nx = cnt > 0u ? cnt : 1u;
}
DI void xcd_barrier(const XcdBarrier& b) {
  asm volatile("s_waitcnt vmcnt(0)" ::: "memory");
  __syncthreads();
  if (__builtin_amdgcn_workitem_id_x() == 0) {
    unsigned* bar = b.bar;
    __builtin_amdgcn_s_waitcnt(0);
    unsigned nloc = b.st[0], nx = b.st[1];
    if (nloc == 0u) { xcd_barrier_complete(bar, b.x, nloc, nx); b.st[0] = nloc; b.st[1] = nx; }
    const unsigned old = xb_add(&bar[XB_XSUB(b.x)], 1u);
    const unsigned gen = old / nloc;
    if (old + 1u == (gen + 1u) * nloc) {
      __builtin_amdgcn_fence(__ATOMIC_RELEASE, "agent");
      asm volatile("s_waitcnt vmcnt(0)" ::: "memory");
      const unsigned og = xb_add(&bar[XB_TOP], 1u);
      const unsigned tg = og / nx;
      if (og + 1u == (tg + 1u) * nx) xb_add(&bar[XB_TOPGEN], 1u);
      else XB_SPIN(xb_ld(&bar[XB_TOPGEN]) == tg, bar);
      __builtin_amdgcn_fence(__ATOMIC_ACQUIRE, "agent");
      xb_add(&bar[XB_XGEN(b.x)], 1u);
      asm volatile("s_waitcnt vmcnt(0)" ::: "memory");
    } else {
      XB_SPIN(xb_ld(&bar[XB_XGEN(b.x)]) == gen, bar);
      __builtin_amdgcn_fence(__ATOMIC_ACQUIRE, "agent");
      asm volatile("s_waitcnt vmcnt(0)" ::: "memory");
    }
  }
  __syncthreads();
}

DI void prep_tile(const float* __restrict__ src, u16* __restrict__ dst, int K, int N, int mode, int tk, int tn, float* sm) {
  const int tid = tidx();
  __syncthreads();
  {
    const int c = tid & 63; const int n = tn * 64 + c;
#pragma unroll 4
    for (int r = tid >> 6; r < 64; r += 8)
      sm[r * 65 + c] = (n < N) ? src[(size_t)(tk * 64 + r) * N + n] : 0.f;
  }
  __syncthreads();
  {
    const int pi = tid;
    const int nl = pi >> 3, kp = pi & 7;
    const int n = tn * 64 + nl;
    int nd = n;
    if (mode == 1) nd = (n >> 4) * 32 + (n & 15);
    else if (mode == 2) nd = (n >> 4) * 32 + 16 + (n & 15);
    float v[8];
#pragma unroll
    for (int j = 0; j < 8; ++j) v[j] = sm[(kp * 8 + j) * 65 + nl];
    *(uint4*)(dst + (size_t)nd * K + tk * 64 + kp * 8) = pack8(v);
  }
}

DI void prep_phase(const Params& p, char* smem) {
  float* sm = (float*)smem;
  constexpr int G0 = 1792, G1 = 2304, G2 = 3712, G3 = 4224, G4 = 7040, G5 = 9856, G6 = 12672, G7 = 12928, G8 = 12936;
  for (int tile = blockIdx.x; tile < G8; tile += gridDim.x) {
    const float* src; u16* dst; int K, N, Np, mode = 0, lt;
    if (tile < G0) { int i = tile / 896; lt = tile % 896; src = p.hy_w_in + (size_t)i * 1024 * 3584; dst = p.wt_hy_in + (size_t)i * 3584 * 1024; K = 1024; N = 3584; Np = 3584; }
    else if (tile < G1) { int t = tile - G0; int i = t / 256; lt = t % 256; src = p.hy_w_out + (size_t)i * 1048576; dst = p.wt_hy_out + (size_t)i * 1048576; K = 1024; N = 1024; Np = 1024; }
    else if (tile < G2) { int t = tile - G1; int i = t / 704; lt = t % 704; src = p.nsa_w_in + (size_t)i * 1024 * 2608; dst = p.wt_nsa_in + (size_t)i * 2816 * 1024; K = 1024; N = 2608; Np = 2816; }
    else if (tile < G3) { int t = tile - G2; int i = t / 256; lt = t % 256; src = p.nsa_w_out + (size_t)i * 1048576; dst = p.wt_nsa_out + (size_t)i * 1048576; K = 1024; N = 1024; Np = 1024; }
    else if (tile < G4) { int t = tile - G3; int i = t / 704; lt = t % 704; src = p.ffn_g + (size_t)i * 1024 * 2816; dst = p.wt_gu + (size_t)i * 5632 * 1024; K = 1024; N = 2816; Np = 2816; mode = 1; }
    else if (tile < G5) { int t = tile - G4; int i = t / 704; lt = t % 704; src = p.ffn_u + (size_t)i * 1024 * 2816; dst = p.wt_gu + (size_t)i * 5632 * 1024; K = 1024; N = 2816; Np = 2816; mode = 2; }
    else if (tile < G6) { int t = tile - G5; int i = t / 704; lt = t % 704; src = p.ffn_d + (size_t)i * 2816 * 1024; dst = p.wt_dn + (size_t)i * 1024 * 2816; K = 2816; N = 1024; Np = 1024; }
    else if (tile < G7) { int t = tile - G6; int i = t / 64; lt = t % 64; src = p.cmp_w1 + (size_t)i * 2048 * 128; dst = p.wt_c1 + (size_t)i * 128 * 2048; K = 2048; N = 128; Np = 128; }
    else { int t = tile - G7; int i = t / 2; lt = t % 2; src = p.cmp_w2 + (size_t)i * 128 * 64; dst = p.wt_c2 + (size_t)i * 64 * 128; K = 128; N = 64; Np = 64; }
    const int ntn = Np / 64;
    prep_tile(src, dst, K, N, mode, lt / ntn, lt % ntn, sm);
  }
  __syncthreads();
  if (blockIdx.x < 4) {
    const int mi = blockIdx.x;
    const float* pe = p.cmp_pe + (size_t)mi * 2048;
    const float* w1 = p.cmp_w1 + (size_t)mi * 2048 * 128;
    const int tq_ = tidx();
    const int o = tq_ & 127, half = tq_ >> 7;
    float a0 = 0.f, a1 = 0.f, a2 = 0.f, a3 = 0.f;
    for (int k = half * 512; k < half * 512 + 512; k += 4) {
      a0 += pe[k] * w1[(size_t)k * 128 + o]; a1 += pe[k + 1] * w1[(size_t)(k + 1) * 128 + o];
      a2 += pe[k + 2] * w1[(size_t)(k + 2) * 128 + o]; a3 += pe[k + 3] * w1[(size_t)(k + 3) * 128 + o];
    }
    sm[tq_] = (a0 + a1) + (a2 + a3);
    __syncthreads();
    if (tq_ < 128) p.c1[mi * 128 + tq_] = (sm[tq_] + sm[tq_ + 128]) + (sm[tq_ + 256] + sm[tq_ + 384]);
    __syncthreads();
  }
  if (blockIdx.x == 4 || (gridDim.x <= 4 && blockIdx.x == 0)) {
    for (int c = tidx(); c < 512; c += NT) {
      float l0 = p.hy_lb[c], l1 = p.hy_lb[512 + c];
      float mx = fmaxf(l0, l1); float e0 = __expf(l0 - mx), e1 = __expf(l1 - mx); float inv = 1.f / (e0 + e1);
      float p0 = e0 * inv, p1 = e1 * inv;
      p.lb[c] = p0 - p0; p.lb[512 + c] = (p0 + p1) - p0;
    }
  }
}

DI void rmsnorm_phase(const float* x, const float* __restrict__ g, u16* h) {
  const int t_ = tidx();
  const int wave = t_ >> 6, lane = t_ & 63;
  for (int row = blockIdx.x * 8 + wave; row < T_; row += gridDim.x * 8) {
    const float4* xr = (const float4*)(x + (size_t)row * 1024);
    float4 v[4]; float ss = 0.f;
#pragma unroll
    for (int j = 0; j < 4; ++j) { v[j] = xr[lane + 64 * j]; ss += v[j].x * v[j].x + v[j].y * v[j].y + v[j].z * v[j].z + v[j].w * v[j].w; }
#pragma unroll
    for (int off = 32; off >= 1; off >>= 1) ss += __shfl_xor(ss, off);
    const float rs = rsqrtf(ss * (1.f / 1024.f) + EPSF);
#pragma unroll
    for (int j = 0; j < 4; ++j) {
      float4 gg = ((const float4*)g)[lane + 64 * j];
      uint2 o; o.x = pack2(v[j].x * rs * gg.x, v[j].y * rs * gg.y); o.y = pack2(v[j].z * rs * gg.z, v[j].w * rs * gg.w);
      *(uint2*)(h + (size_t)row * 1024 + (lane + 64 * j) * 4) = o;
    }
  }
}

DI int lds_byte(int r, int c) { const int st = (r >> 4) * 2 + (c >> 5), rr = r & 15, cc = c & 31, ob = rr * 64 + cc * 2; return st * 1024 + (ob ^ (((ob >> 9) & 1) << 5)); }
DI void stage_rc(int b, int& R, int& C) { const int st = b / 1024, sb = b % 1024, swz = sb ^ (((sb >> 9) & 1) << 5); R = (st >> 1) * 16 + swz / 64; C = (st & 1) * 32 + (swz % 64) / 2; }

template <int EPI>
DI void gemm_phase(const u16* A, const u16* Bt, const int K, const int nN, u16* outb, const int ldc, const float* res, float* outf, char* smem) {
  constexpr int HTB = 16384;
  const int tid = tidx();
  const int wid = tid >> 6, lane = tid & 63, wr = wid >> 2, wc = wid & 3, fr = lane & 15, fq = lane >> 4;
  const int nM = 128, nwg = nM * nN, nt = K / 64;
  int sR0, sC0, sR1, sC1; stage_rc(tid * 16, sR0, sC0); stage_rc(tid * 16 + 8192, sR1, sC1);
  const unsigned vo0 = (unsigned)((sR0 * K + sC0) * 2), vo1 = (unsigned)((sR1 * K + sC1) * 2);
#define SA_(b, h) (smem + ((b) * 2 + (h)) * HTB)
#define SB_(b, h) (smem + (4 + (b) * 2 + (h)) * HTB)
#define STAGE(P, BASE, br, kt) do { const char* _g = (const char*)((BASE) + (size_t)(br) * K + (size_t)(kt) * 64); \
    unsigned _o0 = vo0, _o1 = vo1; asm volatile("" : "+v"(_o0), "+v"(_o1)); \
    __builtin_amdgcn_global_load_lds((const unsigned*)(_g + _o0), (LAS unsigned*)((P) + tid * 16), 16, 0, 0); \
    __builtin_amdgcn_global_load_lds((const unsigned*)(_g + _o1), (LAS unsigned*)((P) + tid * 16 + 8192), 16, 0, 0); } while (0)
#define LDA(dst, b, h) _Pragma("unroll") for (int m = 0; m < 4; ++m) _Pragma("unroll") for (int k = 0; k < 2; ++k) \
    dst[m][k] = *(const bf16x8*)(SA_(b, h) + lds_byte(wr * 64 + m * 16 + fr, k * 32 + fq * 8))
#define LDB(dst, b, h) _Pragma("unroll") for (int n = 0; n < 2; ++n) _Pragma("unroll") for (int k = 0; k < 2; ++k) \
    dst[n][k] = *(const bf16x8*)(SB_(b, h) + lds_byte(wc * 32 + n * 16 + fr, k * 32 + fq * 8))
#define MMA(ai, bj, At_, Bx_) do { __builtin_amdgcn_s_setprio(1); \
    _Pragma("unroll") for (int m = 0; m < 4; ++m) _Pragma("unroll") for (int n = 0; n < 2; ++n) _Pragma("unroll") for (int k = 0; k < 2; ++k) \
      acc[ai][bj][m][n] = __builtin_amdgcn_mfma_f32_16x16x32_bf16(Bx_[n][k], At_[m][k], acc[ai][bj][m][n], 0, 0, 0); \
    __builtin_amdgcn_s_setprio(0); } while (0)
#define WAIT_V(n) asm volatile("s_waitcnt vmcnt(" #n ")" ::: "memory")
#define WAIT_L(n) asm volatile("s_waitcnt lgkmcnt(" #n ")" ::: "memory")
#define BAR __builtin_amdgcn_s_barrier()
#define SCHED __builtin_amdgcn_sched_barrier(0)
  auto tile_of = [&](long Lq, int& brow_, int& bcol_, int& pn_) {
    int wgid = (int)Lq;
    { const int q = nwg / 8, r = nwg % 8, xcd = wgid % 8, off = wgid / 8; wgid = (xcd < r ? xcd * (q + 1) : r * (q + 1) + (xcd - r) * q) + off; }
    const int nig = 8 * nN, gid = wgid / nig, fm = gid * 8, gsz = (nM - fm) < 8 ? (nM - fm) : 8;
    const int pm = fm + ((wgid % nig) % gsz);
    pn_ = (wgid % nig) / gsz; brow_ = pm * 256; bcol_ = pn_ * 256;
  };
#define STAGE7(br_, bc_) do { STAGE(SB_(0, 0), Bt, bc_, 0); STAGE(SA_(0, 0), A, br_, 0); STAGE(SB_(0, 1), Bt, (bc_) + 128, 0); STAGE(SA_(0, 1), A, (br_) + 128, 0); \
    STAGE(SB_(1, 0), Bt, bc_, 1); STAGE(SA_(1, 0), A, br_, 1); STAGE(SB_(1, 1), Bt, (bc_) + 128, 1); } while (0)
  long L = blockIdx.x;
  bool have = L < nwg;
  int brow = 0, bcol = 0, pn = 0;
  __syncthreads();
  if (have) { tile_of(L, brow, bcol, pn); STAGE7(brow, bcol); }
  while (have) {
    f32x4v acc[2][2][4][2];
#pragma unroll
    for (int a = 0; a < 2; ++a)
#pragma unroll
      for (int b = 0; b < 2; ++b)
#pragma unroll
        for (int m = 0; m < 4; ++m)
#pragma unroll
          for (int n = 0; n < 2; ++n) acc[a][b][m][n] = (f32x4v){0.f, 0.f, 0.f, 0.f};
    bf16x8 At[4][2], B0[2][2], B1[2][2];
    if (wr == 1) BAR;
    WAIT_V(0); BAR;
    BAR;
    for (int t = 0; t < nt - 2; t += 2) {
      LDB(B0, 0, 0); SCHED; LDA(At, 0, 0); STAGE(SA_(1, 1), A, brow + 128, t + 1);
      WAIT_L(8); BAR; WAIT_L(0); MMA(0, 0, At, B0); BAR; SCHED;
      LDB(B1, 0, 1); STAGE(SB_(0, 0), Bt, bcol, t + 2);
      BAR; WAIT_L(0); MMA(0, 1, At, B1); BAR;
      LDA(At, 0, 1); STAGE(SA_(0, 0), A, brow, t + 2);
      BAR; WAIT_L(0); MMA(1, 0, At, B0); BAR; SCHED;
      STAGE(SB_(0, 1), Bt, bcol + 128, t + 2);
      WAIT_V(6); BAR; MMA(1, 1, At, B1); BAR;
      LDB(B0, 1, 0); SCHED; LDA(At, 1, 0); STAGE(SA_(0, 1), A, brow + 128, t + 2);
      WAIT_L(8); BAR; WAIT_L(0); MMA(0, 0, At, B0); BAR; SCHED;
      LDB(B1, 1, 1); STAGE(SB_(1, 0), Bt, bcol, t + 3);
      BAR; WAIT_L(0); MMA(0, 1, At, B1); BAR;
      LDA(At, 1, 1); STAGE(SA_(1, 0), A, brow, t + 3);
      BAR; WAIT_L(0); MMA(1, 0, At, B0); BAR; SCHED;
      STAGE(SB_(1, 1), Bt, bcol + 128, t + 3);
      WAIT_V(6); BAR; MMA(1, 1, At, B1); BAR;
    }
    { LDB(B0, 0, 0); LDA(At, 0, 0); STAGE(SA_(1, 1), A, brow + 128, nt - 1);
      BAR; WAIT_L(0); MMA(0, 0, At, B0); BAR;
      LDB(B1, 0, 1); BAR; WAIT_L(0); MMA(0, 1, At, B1); BAR;
      LDA(At, 0, 1); WAIT_V(4); BAR; WAIT_L(0); MMA(1, 0, At, B0); MMA(1, 1, At, B1); BAR; }
    { LDB(B0, 1, 0); LDA(At, 1, 0); WAIT_V(2); BAR; WAIT_L(0); MMA(0, 0, At, B0); BAR;
      LDB(B1, 1, 1); WAIT_V(0); BAR; WAIT_L(0); MMA(0, 1, At, B1); BAR;
      LDA(At, 1, 1); BAR; WAIT_L(0); MMA(1, 0, At, B0); MMA(1, 1, At, B1); BAR; }
    if (wr == 0) BAR;
    const long Ln = L + gridDim.x;
    const bool haven = Ln < nwg;
    int browN = 0, bcolN = 0, pnN = 0;
    if (haven) { tile_of(Ln, browN, bcolN, pnN); STAGE7(browN, bcolN); }
    int tid2 = tid; asm volatile("" : "+v"(tid2));
    const int fr2 = tid2 & 15, fq2 = (tid2 >> 4) & 3, wc2 = (tid2 >> 6) & 3, wr2 = tid2 >> 8;
#pragma unroll
    for (int ai = 0; ai < 2; ++ai)
#pragma unroll
      for (int m = 0; m < 4; ++m) {
        const size_t row = (size_t)(brow + ai * 128 + wr2 * 64 + m * 16 + fr2);
#pragma unroll
        for (int bj = 0; bj < 2; ++bj) {
          const int cb = bcol + bj * 128 + wc2 * 32 + fq2 * 4;
          if (EPI == 0) {
#pragma unroll
            for (int n = 0; n < 2; ++n) {
              uint2 o; o.x = pack2(acc[ai][bj][m][n][0], acc[ai][bj][m][n][1]); o.y = pack2(acc[ai][bj][m][n][2], acc[ai][bj][m][n][3]);
              *(uint2*)(outb + row * ldc + cb + n * 16) = o;
            }
          } else if (EPI == 1) {
#pragma unroll
            for (int n = 0; n < 2; ++n) {
              const size_t idx = row * 1024 + cb + n * 16;
              const f32x4v r4 = *(const f32x4v*)(res + idx);
              *(f32x4v*)(outf + idx) = r4 + acc[ai][bj][m][n];
            }
          } else {
            const f32x4v gv = acc[ai][bj][m][0], uv = acc[ai][bj][m][1];
            uint2 o; o.x = pack2(fsilu(gv[0]) * uv[0], fsilu(gv[1]) * uv[1]); o.y = pack2(fsilu(gv[2]) * uv[2], fsilu(gv[3]) * uv[3]);
            *(uint2*)(outb + row * DFF + ((bcol + bj * 128 + wc2 * 32) >> 1) + fq2 * 4) = o;
          }
        }
      }
    L = Ln; have = haven; brow = browN; bcol = bcolN; pn = pnN;
  }
  __syncthreads();
#undef STAGE7
#undef SA_
#undef SB_
#undef STAGE
#undef LDA
#undef LDB
#undef MMA
}

#define MFMA16(a, b, c) __builtin_amdgcn_mfma_f32_16x16x32_bf16((a), (b), (c), 0, 0, 0)
DI void hgrn_item(const Params& p, int li, int item, char* smem) {
  u16* Qt = (u16*)smem;
  u16* Kt = Qt + 16 * 136;
  u16* Kh = Kt + 16 * 136;
  u16* Vt = Kh + 128 * 24;
  float* Pc = (float*)(Vt + 32 * 24);
  float* Opart = Pc + 128;
  const int tid = tidx(), lane = tid & 63, w = tid >> 6, fr = lane & 15, fq = lane >> 4;
  const int kk = w >> 1, vt = w & 1;
  const int vs = item & 3, h = (item >> 2) & 3, b = item >> 4;
  const int tg = tid & 3, kch = tid >> 2;
  const int sv = tid >> 5, vv = tid & 31;
  const float lbv = p.lb[li * 512 + h * 128 + kch];
  const u16* base = p.proj + (size_t)b * S_ * LD_EVEN;
  const u16* pq = base + (size_t)(4 * tg) * LD_EVEN + h * 128 + kch;
  const u16* pv = base + (size_t)sv * LD_EVEN + 1024 + h * 128 + vs * 32 + vv;
  unsigned rq0 = pq[0], rq1 = pq[LD_EVEN], rq2 = pq[2 * LD_EVEN], rq3 = pq[3 * LD_EVEN];
  unsigned rf0 = pq[512], rf1 = pq[LD_EVEN + 512], rf2 = pq[2 * LD_EVEN + 512], rf3 = pq[3 * LD_EVEN + 512];
  unsigned rvv = pv[0];
  f32x4v S0 = {0.f, 0.f, 0.f, 0.f}, S1 = {0.f, 0.f, 0.f, 0.f};
  const f32x4v z4 = {0.f, 0.f, 0.f, 0.f};
  __syncthreads();
#pragma unroll 1
  for (int c = 0; c < 128; ++c) {
    {
      float qv[4], kv[4], cs[4];
      const unsigned rq[4] = {rq0, rq1, rq2, rq3}, rf[4] = {rf0, rf1, rf2, rf3};
      float cp = 1.f;
#pragma unroll
      for (int i = 0; i < 4; ++i) {
        const float f = lbv + (1.f - lbv) * fsigmoid(__uint_as_float(rf[i] << 16));
        cp *= f; cs[i] = cp; kv[i] = 1.f - f; qv[i] = fsilu(__uint_as_float(rq[i] << 16));
      }
      const int bl = lane & ~3;
      const float t0 = __shfl(cp, bl), t1 = __shfl(cp, bl + 1), t2 = __shfl(cp, bl + 2), t3 = __shfl(cp, bl + 3);
      const float pre = (tg > 0 ? t0 : 1.f) * (tg > 1 ? t1 : 1.f) * (tg > 2 ? t2 : 1.f);
      const float PC = (t0 * t1) * (t2 * t3);
      float kh[4];
#pragma unroll
      for (int i = 0; i < 4; ++i) {
        const float P = fmaxf(pre * cs[i], 1e-30f);
        const float rP = __builtin_amdgcn_rcpf(P);
        const int t = 4 * tg + i;
        Qt[t * 136 + kch] = f2bf(qv[i] * P);
        const float kr = kv[i] * rP;
        Kt[t * 136 + kch] = f2bf(kr);
        kh[i] = kr * PC;
      }
      uint2 k2; k2.x = pack2(kh[0], kh[1]); k2.y = pack2(kh[2], kh[3]);
      *(uint2*)(Kh + kch * 24 + 4 * tg) = k2;
      if (tg == 0) Pc[kch] = PC;
      Vt[vv * 24 + sv] = (u16)rvv;
    }
    __syncthreads();
    if (c + 1 < 128) {
      const u16* pq2 = pq + (size_t)(c + 1) * 16 * LD_EVEN;
      rq0 = pq2[0]; rq1 = pq2[LD_EVEN]; rq2 = pq2[2 * LD_EVEN]; rq3 = pq2[3 * LD_EVEN];
      rf0 = pq2[512]; rf1 = pq2[LD_EVEN + 512]; rf2 = pq2[2 * LD_EVEN + 512]; rf3 = pq2[3 * LD_EVEN + 512];
      rvv = pv[(size_t)(c + 1) * 16 * LD_EVEN];
    }
    {
      const uint2 v2 = *(const uint2*)(Vt + (16 * vt + fr) * 24 + 4 * fq);
      const bf16x8 vb = as_bf16x8(make_uint4(v2.x, v2.y, 0u, 0u));
      const u16* qrow = Qt + fr * 136 + 32 * kk + 4 * fq;
      const uint2 qa = *(const uint2*)qrow, qb = *(const uint2*)(qrow + 16);
      const bf16x8 qfrag = as_bf16x8(make_uint4(qa.x, qa.y, qb.x, qb.y));
      const bf16x8 sfrag = as_bf16x8(make_uint4(pack2(S0[0], S0[1]), pack2(S0[2], S0[3]), pack2(S1[0], S1[1]), pack2(S1[2], S1[3])));
      f32x4v acc = MFMA16(qfrag, sfrag, z4);
      if (kk == 0) {
        f32x4v sa = z4;
#pragma unroll
        for (int ks = 0; ks < 4; ++ks) {
          const bf16x8 kf = *(const bf16x8*)(Kt + fr * 136 + 32 * ks + 8 * fq);
          const bf16x8 qf2 = *(const bf16x8*)(Qt + fr * 136 + 32 * ks + 8 * fq);
          sa = MFMA16(kf, qf2, sa);
        }
#pragma unroll
        for (int j = 0; j < 4; ++j) sa[j] = (4 * fq + j <= fr) ? sa[j] : 0.f;
        const bf16x8 afrag = as_bf16x8(make_uint4(pack2(sa[0], sa[1]), pack2(sa[2], sa[3]), 0u, 0u));
        acc = MFMA16(afrag, vb, acc);
      }
#pragma unroll
      for (int j = 0; j < 4; ++j) Opart[(w * 16 + 4 * fq + j) * 16 + fr] = acc[j];
      const float* pc0 = Pc + 32 * kk + 4 * fq;
#pragma unroll
      for (int j = 0; j < 4; ++j) { S0[j] *= pc0[j]; S1[j] *= pc0[16 + j]; }
      const uint2 h0 = *(const uint2*)(Kh + (32 * kk + fr) * 24 + 4 * fq);
      const uint2 h1v = *(const uint2*)(Kh + (32 * kk + 16 + fr) * 24 + 4 * fq);
      S0 = MFMA16(as_bf16x8(make_uint4(h0.x, h0.y, 0u, 0u)), vb, S0);
      S1 = MFMA16(as_bf16x8(make_uint4(h1v.x, h1v.y, 0u, 0u)), vb, S1);
    }
    __syncthreads();
    {
      const int t = tid >> 5, v = tid & 31, vtt = v >> 4, vl = v & 15;
      float o = 0.f;
#pragma unroll
      for (int q = 0; q < 4; ++q) o += Opart[((2 * q + vtt) * 16 + t) * 16 + vl];
      p.hbuf[(size_t)(b * S_ + c * 16 + t) * 1024 + h * 128 + vs * 32 + v] = f2bf(o);
    }
  }
  __syncthreads();
}

DI void load_q(const u16* qrow, const float* __restrict__ gain, int hh, bf16x8 (&qf)[4]) {
  float f[4][8]; float ss = 0.f;
#pragma unroll
  for (int kk = 0; kk < 4; ++kk) {
    uint4 raw = *(const uint4*)(qrow + kk * 16 + hh * 8);
    unpack8(raw, f[kk]);
#pragma unroll
    for (int j = 0; j < 8; ++j) ss += f[kk][j] * f[kk][j];
  }
  ss += __shfl_xor(ss, 32);
  const float rs = rsqrtf(ss * (1.f / 64.f) + EPSF) * (0.125f * LOG2E);
#pragma unroll
  for (int kk = 0; kk < 4; ++kk) {
#pragma unroll
    for (int j = 0; j < 8; ++j) f[kk][j] *= rs * gain[kk * 16 + hh * 8 + j];
    qf[kk] = as_bf16x8(pack8(f[kk]));
  }
}

constexpr int VS = 68;
constexpr int KVBUF = 18432;
template <int NTH> struct KVRegs { u32x4v r[NTH == 256 ? 4 : 2]; };
DI void kv_ld2(const u16* src, size_t stride, int ra, int rb, int rlo, int rhi, int dp, u32x4v& x0, u32x4v& x1) {
  const u32x4v z = {0u, 0u, 0u, 0u};
  x0 = z; x1 = z;
  if (ra >= rlo && ra < rhi) x0 = *(const u32x4v*)(src + (size_t)ra * stride + dp * 8);
  if (rb >= rlo && rb < rhi) x1 = *(const u32x4v*)(src + (size_t)rb * stride + dp * 8);
}
template <int NTH>
DI void kv_load(int tid, const u16* kb, const u16* vb, size_t stride, int r0, int rlo, int rhi, KVRegs<NTH>& rg) {
  const int dp = tid & 7, kq = (tid & 255) >> 3;
  if (NTH == 256) {
    kv_ld2(kb, stride, r0 + kq, r0 + kq + 32, rlo, rhi, dp, rg.r[0], rg.r[1]);
    kv_ld2(vb, stride, r0 + 2 * kq, r0 + 2 * kq + 1, rlo, rhi, dp, rg.r[2], rg.r[3]);
  } else {
    if (tid < 256) kv_ld2(kb, stride, r0 + kq, r0 + kq + 32, rlo, rhi, dp, rg.r[0], rg.r[1]);
    else kv_ld2(vb, stride, r0 + 2 * kq, r0 + 2 * kq + 1, rlo, rhi, dp, rg.r[0], rg.r[1]);
  }
}
DI void k_store1(u32x4v x, int key, int dp, const float* __restrict__ kgain, u16* Ks) {
  uint4 kv = make_uint4(x[0], x[1], x[2], x[3]);
  if (kgain) {
    float f[8]; unpack8(kv, f);
    float ss = 0.f;
#pragma unroll
    for (int e = 0; e < 8; ++e) ss += f[e] * f[e];
    ss += __shfl_xor(ss, 1); ss += __shfl_xor(ss, 2); ss += __shfl_xor(ss, 4);
    const float rs = rsqrtf(ss * (1.f / 64.f) + EPSF);
#pragma unroll
    for (int e = 0; e < 8; ++e) f[e] *= rs * kgain[dp * 8 + e];
    kv = pack8(f);
  }
  *(uint4*)(Ks + key * 72 + dp * 8) = kv;
}
DI void v_store2(u32x4v v0, u32x4v v1, int kp, int dp, u16* Vts) {
  unsigned* vd = (unsigned*)(Vts + (dp * 8) * VS + 2 * kp);
#pragma unroll
  for (int d = 0; d < 4; ++d) {
    vd[(2 * d) * (VS / 2)] = (v0[d] & 0xffffu) | (v1[d] << 16);
    vd[(2 * d + 1) * (VS / 2)] = (v0[d] >> 16) | (v1[d] & 0xffff0000u);
  }
}
template <int NTH>
DI void kv_store(int tid, const KVRegs<NTH>& rg, const float* __restrict__ kgain, u16* Ks, u16* Vts) {
  const int dp = tid & 7, kq = (tid & 255) >> 3;
  if (NTH == 256) {
    k_store1(rg.r[0], kq, dp, kgain, Ks); k_store1(rg.r[1], kq + 32, dp, kgain, Ks);
    v_store2(rg.r[2], rg.r[3], kq, dp, Vts);
  } else {
    if (tid < 256) { k_store1(rg.r[0], kq, dp, kgain, Ks); k_store1(rg.r[1], kq + 32, dp, kgain, Ks); }
    else v_store2(rg.r[0], rg.r[1], kq, dp, Vts);
  }
}

DI void score_stage(const bf16x8 (&qf)[4], const u16* Ks, int lane, float sk, float sb, int lower, int lim, f32x16 (&s)[2], float& mx) {
  const int lr = lane & 31, hh = lane >> 5;
#pragma unroll
  for (int sub = 0; sub < 2; ++sub) {
#pragma unroll
    for (int i = 0; i < 16; ++i) s[sub][i] = fmaf(sk, (float)(sub * 32 + (i & 3) + 8 * (i >> 2)), sb);
#pragma unroll
    for (int kk = 0; kk < 4; ++kk) {
      bf16x8 kf = *(const bf16x8*)(Ks + (sub * 32 + lr) * 72 + kk * 16 + hh * 8);
      s[sub] = MFMA32(kf, qf[kk], s[sub]);
    }
  }
  if (lim < lower) { lower = 64; lim = 64; }
  const bool full = (lower <= 0) && (lim >= 63);
  if (!__all(full)) {
    const int lo2 = lower - 4 * hh; const unsigned rng = (unsigned)(lim - lower);
#pragma unroll
    for (int sub = 0; sub < 2; ++sub)
#pragma unroll
      for (int i = 0; i < 16; ++i) {
        const int kc = sub * 32 + (i & 3) + 8 * (i >> 2);
        s[sub][i] = ((unsigned)(kc - lo2) <= rng) ? s[sub][i] : -INFINITY;
      }
  }
  mx = -INFINITY;
#pragma unroll
  for (int sub = 0; sub < 2; ++sub)
#pragma unroll
    for (int i = 0; i < 16; ++i) mx = fmaxf(mx, s[sub][i]);
  mx = fmaxf(mx, __shfl_xor(mx, 32));
}

DI void pv_stage(const f32x16 (&s)[2], const u16* Vts, f32x16 (&o)[2], int lane) {
  const int lr = lane & 31, hh = lane >> 5;
#pragma unroll
  for (int sub = 0; sub < 2; ++sub)
#pragma unroll
    for (int st = 0; st < 2; ++st) {
      uint4 pk;
      pk.x = pack2(s[sub][8 * st + 0], s[sub][8 * st + 1]); pk.y = pack2(s[sub][8 * st + 2], s[sub][8 * st + 3]);
      pk.z = pack2(s[sub][8 * st + 4], s[sub][8 * st + 5]); pk.w = pack2(s[sub][8 * st + 6], s[sub][8 * st + 7]);
      const bf16x8 pf = as_bf16x8(pk);
#pragma unroll
      for (int dt = 0; dt < 2; ++dt) {
        const u16* vp = Vts + (dt * 32 + lr) * VS + sub * 32 + 16 * st + 4 * hh;
        const uint2 lo = *(const uint2*)vp, hi = *(const uint2*)(vp + 8);
        const bf16x8 vf = as_bf16x8(make_uint4(lo.x, lo.y, hi.x, hi.y));
        o[dt] = MFMA32(vf, pf, o[dt]);
      }
    }
}

DI void flash_stage(const bf16x8 (&qf)[4], const u16* Ks, const u16* Vts, f32x16 (&o)[2], float& m, float& l, int lane,
                    float sk, float sb, int lower, int lim) {
  f32x16 s[2]; float mx;
  score_stage(qf, Ks, lane, sk, sb, lower, lim, s, mx);
  const float mn = fmaxf(m, mx);
  const float alpha = fexp2(m - mn);
  const bool same = (mn == m);
  m = mn;
  float ls = 0.f;
#pragma unroll
  for (int sub = 0; sub < 2; ++sub)
#pragma unroll
    for (int i = 0; i < 16; ++i) { const float pv = fexp2(s[sub][i] - mn); s[sub][i] = pv; ls += pv; }
  l = l * alpha + ls;
  if (!__all(same)) {
#pragma unroll
    for (int dt = 0; dt < 2; ++dt)
#pragma unroll
      for (int i = 0; i < 16; ++i) o[dt][i] *= alpha;
  }
  pv_stage(s, Vts, o, lane);
}

DI void dilated_item(const Params& p, int li, int pairitem, char* smem) {
  const int tfull = tidx();
  const int half = tfull >> 8, tid = tfull & 255;
  const int item = pairitem * 2 + half;
  char* kvb = smem + half * (2 * KVBUF);
  const int lane = tid & 63, w = tid >> 6, lr = lane & 31, hh = lane >> 5;
  const int idx16 = item & 15; const int br = (item >> 4) % 3; const int hb = (item / 48) & 7; const int b = item / 384;
  const int d = br == 0 ? 1 : (br == 1 ? 4 : 16);
  const int tile = idx16 / d, resid = idx16 % d;
  const int st0 = (d >= 2 && tile == 0) ? 2 : 0;
  const int u0 = tile * 128;
  const int uq = u0 + 32 * w + lr; const int tq = uq * d + resid;
  const u16* prow = p.proj + (size_t)(b * S_ + tq) * LD_EVEN;
  bf16x8 qf[4];
  load_q(prow + 2048 + hb * 64, p.hy_qg + li * 64, hh, qf);
  const float slope2 = fexp2(-(float)(hb + 1)) * LOG2E;
  const float sk = slope2 * (float)d;
  const u16* kb = p.proj + (size_t)(b * S_ + resid) * LD_EVEN + 2560 + hb * 64;
  const u16* vb = kb + 512;
  const size_t stride = (size_t)d * LD_EVEN;
  const float* kg = p.hy_kg + li * 64;
  f32x16 o[2]; o[0] = zero16(); o[1] = zero16();
  float m = -1e30f, l = 0.f;
  const int uw = u0 + 32 * w;
  KVRegs<256> rg;
  kv_load<256>(tid, kb, vb, stride, u0 - 128 + 64 * st0, 0, 1 << 30, rg);
  __syncthreads();
  kv_store<256>(tid, rg, kg, (u16*)(kvb + (st0 & 1) * KVBUF), (u16*)(kvb + (st0 & 1) * KVBUF) + 64 * 72);
  kv_load<256>(tid, kb, vb, stride, u0 - 64 + 64 * st0, 0, 1 << 30, rg);
  __syncthreads();
#pragma unroll 1
  for (int st = st0; st < 4; ++st) {
    const int ub = u0 - 128 + 64 * st;
    u16* Ks = (u16*)(kvb + (st & 1) * KVBUF); u16* Vts = Ks + 64 * 72;
    if (st + 1 < 4) { u16* Kn = (u16*)(kvb + ((st + 1) & 1) * KVBUF); kv_store<256>(tid, rg, kg, Kn, Kn + 64 * 72); }
    if (st + 2 < 4) kv_load<256>(tid, kb, vb, stride, ub + 128, 0, 1 << 30, rg);
    if (ub + 63 >= 0 && ub <= uw + 31 && ub + 63 >= uw - 128) {
      const int lim = uq - ub;
      const int lower = max(lim - 128, -ub);
      const float sb = slope2 * (float)(ub * d + resid) + sk * (float)(4 * hh);
      flash_stage(qf, Ks, Vts, o, m, l, lane, sk, sb, lower, lim);
    }
    __syncthreads();
  }
  const float lt = l + __shfl_xor(l, 32);
  const float inv = 1.f / lt;
  const size_t trow = (size_t)br * T_ + (size_t)b * S_ + tq;
  if (hh == 0) p.lse[trow * 8 + hb] = (m + log2f(lt)) * LN2;
  u16* orow = p.obr + trow * 512 + hb * 64;
#pragma unroll
  for (int dt = 0; dt < 2; ++dt)
#pragma unroll
    for (int q4 = 0; q4 < 4; ++q4) {
      uint2 ov; ov.x = pack2(o[dt][4 * q4] * inv, o[dt][4 * q4 + 1] * inv); ov.y = pack2(o[dt][4 * q4 + 2] * inv, o[dt][4 * q4 + 3] * inv);
      *(uint2*)(orow + dt * 32 + 8 * q4 + 4 * hh) = ov;
    }
}

DI void post_even_phase(const Params& p, int li) {
  const int tid = tidx();
  const int rsel = tid >> 7, c8 = tid & 127;
  for (int it = blockIdx.x; it < T_ / 4; it += gridDim.x) {
    const int t = it * 4 + rsel;
    const int c = c8 * 8;
    float val[8];
    if (c8 < 64) {
      uint4 raw = *(const uint4*)(p.hbuf + (size_t)t * 1024 + c);
      float o[8]; unpack8(raw, o);
      float ss = 0.f;
#pragma unroll
      for (int j = 0; j < 8; ++j) ss += o[j] * o[j];
      ss += __shfl_xor(ss, 1); ss += __shfl_xor(ss, 2); ss += __shfl_xor(ss, 4); ss += __shfl_xor(ss, 8);
      const float rs = rsqrtf(ss * (1.f / 128.f) + EPSF);
      uint4 graw = *(const uint4*)(p.proj + (size_t)t * LD_EVEN + 1536 + c);
      float gt[8]; unpack8(graw, gt);
#pragma unroll
      for (int j = 0; j < 8; ++j) val[j] = o[j] * rs * p.hy_og[li * 512 + c + j] * fsilu(gt[j]);
    } else {
      const int cb = c - 512, hb = cb >> 6;
      float l0 = p.lse[((size_t)0 * T_ + t) * 8 + hb], l1 = p.lse[((size_t)1 * T_ + t) * 8 + hb], l2 = p.lse[((size_t)2 * T_ + t) * 8 + hb];
      const float mx = fmaxf(l0, fmaxf(l1, l2));
      float w0 = __expf(l0 - mx), w1 = __expf(l1 - mx), w2 = __expf(l2 - mx);
      const float inv = 1.f / (w0 + w1 + w2);
      w0 *= inv; w1 *= inv; w2 *= inv;
      float a[8], bq[8], cq[8];
      unpack8(*(const uint4*)(p.obr + ((size_t)0 * T_ + t) * 512 + cb), a);
      unpack8(*(const uint4*)(p.obr + ((size_t)1 * T_ + t) * 512 + cb), bq);
      unpack8(*(const uint4*)(p.obr + ((size_t)2 * T_ + t) * 512 + cb), cq);
#pragma unroll
      for (int j = 0; j < 8; ++j) val[j] = w0 * a[j] + w1 * bq[j] + w2 * cq[j];
    }
    *(uint4*)(p.hbuf + (size_t)t * 1024 + c) = pack8(val);
  }
}

DI void compress_item(const Params& p, int li, int pairitem, char* smem) {
  const int tfull = tidx();
  const int half = tfull >> 8, tid = tfull & 255;
  const int item = pairitem * 2 + half;
  u16* hs = (u16*)(smem + half * 17408);
  float* outs = (float*)(smem + half * 17408 + 32 * 136 * 2);
  const int lane = tid & 63, w = tid >> 6, lr = lane & 31, hh = lane >> 5;
  const int nt = item & 3, g = (item >> 2) & 3, b = (item >> 4) & 15, kv = item >> 8;
  const int n = nt * 32 + lr; const int nc = n > 126 ? 126 : n;
  const int col = 1024 + kv * 256 + g * 64;
  const u16* arow = p.proj + (size_t)(b * S_ + 16 * nc) * LD_ODD + col;
  const u16* w1t = p.wt_c1 + (size_t)(li * 2 + kv) * 128 * 2048 + (size_t)(32 * w + lr) * 2048;
  f32x16 acc = zero16();
#pragma unroll 4
  for (int ks = 0; ks < 128; ++ks) {
    const int lidx = ks >> 2, dd = (ks & 3) * 16 + hh * 8;
    const bf16x8 a = as_bf16x8(*(const uint4*)(arow + (size_t)lidx * LD_ODD + dd));
    const bf16x8 bb = as_bf16x8(*(const uint4*)(w1t + ks * 16 + hh * 8));
    acc = MFMA32(a, bb, acc);
  }
  const float cb = p.c1[(li * 2 + kv) * 128 + 32 * w + lr];
  __syncthreads();
#pragma unroll
  for (int i = 0; i < 16; ++i) {
    const int r = (i & 3) + 8 * (i >> 2) + 4 * hh;
    hs[r * 136 + 32 * w + lr] = f2bf(fsilu(acc[i] + cb));
  }
  __syncthreads();
  if (w < 2) {
    const u16* w2t = p.wt_c2 + (size_t)(li * 2 + kv) * 64 * 128 + (size_t)(w * 32 + lr) * 128;
    f32x16 a2 = zero16();
#pragma unroll
    for (int kk = 0; kk < 8; ++kk) {
      const bf16x8 a = *(const bf16x8*)(hs + lr * 136 + kk * 16 + hh * 8);
      const bf16x8 bb = as_bf16x8(*(const uint4*)(w2t + kk * 16 + hh * 8));
      a2 = MFMA32(a, bb, a2);
    }
#pragma unroll
    for (int i = 0; i < 16; ++i) {
      const int r = (i & 3) + 8 * (i >> 2) + 4 * hh;
      outs[r * 65 + w * 32 + lr] = a2[i];
    }
  }
  __syncthreads();
  {
    const int r = tid >> 3, c8 = tid & 7;
    float v[8]; float ss = 0.f;
#pragma unroll
    for (int j = 0; j < 8; ++j) { v[j] = outs[r * 65 + c8 * 8 + j]; ss += v[j] * v[j]; }
    ss += __shfl_xor(ss, 1); ss += __shfl_xor(ss, 2); ss += __shfl_xor(ss, 4);
    if (kv == 0) {
      const float rs = rsqrtf(ss * (1.f / 64.f) + EPSF);
#pragma unroll
      for (int j = 0; j < 8; ++j) v[j] *= rs * p.nsa_kg[(li * 3 + 0) * 64 + c8 * 8 + j];
    }
    const int nn = nt * 32 + r;
    if (nn >= 127) {
#pragma unroll
      for (int j = 0; j < 8; ++j) v[j] = 0.f;
    }
    u16* dst = (kv == 0 ? p.kcmp : p.vcmp) + ((size_t)(b * 4 + g) * 128 + nn) * 64 + c8 * 8;
    *(uint4*)dst = pack8(v);
  }
  __syncthreads();
}

DI void nsa_item(const Params& p, int li, int item, char* smem) {
  float* impA = (float*)(smem + 2 * KVBUF);
  float* impB = impA + 8192;
  float* imp = impB + 8192;
  unsigned* selm = (unsigned*)(imp + 64 * 33);
  const int tid = tidx(), lane = tid & 63, wv = tid >> 6, lr = lane & 31, hh = lane >> 5;
  const int w = wv & 3, half = wv >> 2;
  const int tt = item & 31, g = (item >> 5) & 3, b = item >> 7;
  const int t0 = tt * 64; const int cur = t0 >> 6;
  const int hd = g * 4 + w;
  const int tokl = 32 * half + lr;
  const int tq = t0 + tokl;
  const u16* pb = p.proj + (size_t)b * S_ * LD_ODD;
  const u16* prow = pb + (size_t)tq * LD_ODD;
  bf16x8 qf[4];
  load_q(prow + g * 256 + w * 64, p.nsa_qg + li * 64, hh, qf);
  const float slope2 = fexp2(-0.5f * (float)(hd + 1)) * LOG2E;
  const float g0 = fsigmoid(bf2f(prow[2560 + 0 + g * 4 + w]));
  const float g1 = fsigmoid(bf2f(prow[2560 + 16 + g * 4 + w]));
  const float g2 = fsigmoid(bf2f(prow[2560 + 32 + g * 4 + w]));
  f32x16 ot[2]; ot[0] = zero16(); ot[1] = zero16();
  {
    const u16* kb = p.kcmp + (size_t)(b * 4 + g) * 128 * 64;
    const u16* vb = p.vcmp + (size_t)(b * 4 + g) * 128 * 64;
    const float sk = 16.f * slope2;
    const int limc = min((tq - 31) >> 4, 126);
    const int nst = (1024 > t0) ? 1 : 2;
    {
      KVRegs<512> rg0;
      kv_load<512>(tid, kb, vb, 64, 0, 0, 128, rg0);
      __syncthreads();
      kv_store<512>(tid, rg0, nullptr, (u16*)smem, (u16*)smem + 64 * 72);
      if (nst > 1) {
        kv_load<512>(tid, kb, vb, 64, 64, 0, 128, rg0);
        kv_store<512>(tid, rg0, nullptr, (u16*)(smem + KVBUF), (u16*)(smem + KVBUF) + 64 * 72);
      }
    }
    __syncthreads();
    float m = -1e30f, l = 0.f;
#pragma unroll
    for (int st = 0; st < 2; ++st) {
      if (st >= nst) continue;
      const u16* Ks = (const u16*)(smem + st * KVBUF);
      f32x16 s[2]; float mx;
      const float sb = slope2 * (float)(1024 * st + 31) + sk * (float)(4 * hh);
      score_stage(qf, Ks, lane, sk, sb, 0, limc - 64 * st, s, mx);
      const float mn = fmaxf(m, mx);
      float ls = 0.f;
#pragma unroll
      for (int sub = 0; sub < 2; ++sub)
#pragma unroll
        for (int i = 0; i < 16; ++i) ls += fexp2(s[sub][i] - mn);
      l = l * fexp2(m - mn) + ls;
      m = mn;
    }
    const float lt = l + __shfl_xor(l, 32);
    const float inv = lt > 0.f ? 1.f / lt : 0.f;
    f32x16 o[2]; o[0] = zero16(); o[1] = zero16();
#pragma unroll
    for (int st = 0; st < 2; ++st) {
      if (st >= nst) {
#pragma unroll
        for (int G = 0; G < 16; ++G) {
          if ((G & 1) == hh) { impA[(w * 64 + tokl) * 32 + 16 * st + G] = 0.f; impB[(w * 64 + tokl) * 32 + 16 * st + G] = 0.f; }
        }
        continue;
      }
      const u16* Ks = (const u16*)(smem + st * KVBUF); const u16* Vts = Ks + 64 * 72;
      f32x16 s[2]; float mx;
      const float sb = slope2 * (float)(1024 * st + 31) + sk * (float)(4 * hh);
      score_stage(qf, Ks, lane, sk, sb, 0, limc - 64 * st, s, mx);
#pragma unroll
      for (int sub = 0; sub < 2; ++sub)
#pragma unroll
        for (int i = 0; i < 16; ++i) s[sub][i] = fexp2(s[sub][i] - m) * inv;
#pragma unroll
      for (int sub = 0; sub < 2; ++sub)
#pragma unroll
        for (int q4 = 0; q4 < 4; ++q4) {
          const int G = 16 * st + 8 * sub + 2 * q4 + hh;
          impA[(w * 64 + tokl) * 32 + G] = (s[sub][4 * q4] + s[sub][4 * q4 + 1]) + (s[sub][4 * q4 + 2] + s[sub][4 * q4 + 3]);
          impB[(w * 64 + tokl) * 32 + G] = s[sub][4 * q4 + 3];
        }
      pv_stage(s, Vts, o, lane);
    }
#pragma unroll
    for (int dt = 0; dt < 2; ++dt)
#pragma unroll
      for (int i = 0; i < 16; ++i) ot[dt][i] += g0 * o[dt][i];
  }
  const u16* kbs = pb + 1536 + g * 64; const u16* vbs = pb + 1792 + g * 64;
  KVRegs<512> rg;
  kv_load<512>(tid, kbs, vbs, LD_ODD, 0, 0, S_, rg);
  __syncthreads();
  for (int idx = tid; idx < 2048; idx += NT) {
    const int tok = idx >> 5, mm = idx & 31;
    float a = 0.f;
#pragma unroll
    for (int ww = 0; ww < 4; ++ww) a += impA[(ww * 64 + tok) * 32 + mm] + (mm > 0 ? impB[(ww * 64 + tok) * 32 + mm - 1] : 0.f);
    imp[tok * 33 + mm] = a;
  }
  __syncthreads();
  float* ots = impA + tid;
#pragma unroll
  for (int dt = 0; dt < 2; ++dt)
#pragma unroll
    for (int i = 0; i < 16; ++i) ots[(dt * 16 + i) * NT] = ot[dt][i];
  {
    const int tok = tid >> 3, sub8 = tid & 7;
    unsigned sel = 1u | (1u << cur) | (cur > 0 ? (1u << (cur - 1)) : 0u);
    const int cnt = __popc(sel);
    float cv[4];
#pragma unroll
    for (int e = 0; e < 4; ++e) cv[e] = imp[tok * 33 + sub8 * 4 + e];
    for (int r = cnt; r < 8; ++r) {
      float bv = -1.f; int bi = 64;
#pragma unroll
      for (int e = 0; e < 4; ++e) {
        const int mm = sub8 * 4 + e;
        const bool ok = (mm <= cur) && !((sel >> mm) & 1u);
        if (ok && cv[e] > bv) { bv = cv[e]; bi = mm; }
      }
#pragma unroll
      for (int off = 1; off < 8; off <<= 1) {
        const float ov = __shfl_xor(bv, off); const int oi = __shfl_xor(bi, off);
        if (ov > bv || (ov == bv && oi < bi)) { bv = ov; bi = oi; }
      }
      if (bi < 64) sel |= 1u << bi;
    }
    if (sub8 == 0) selm[tok] = sel;
  }
  __syncthreads();
  const unsigned myMask = selm[tokl];
  unsigned uni = 0u;
#pragma unroll 8
  for (int i = 0; i < 64; ++i) uni |= selm[i];
  {
    f32x16 o[2]; o[0] = zero16(); o[1] = zero16();
    float m = -1e30f, l = 0.f;
    const float* kg = p.nsa_kg + (li * 3 + 1) * 64;
    unsigned rem = uni & (uni - 1u);
    int mb = 0;
    int mbn = rem ? __builtin_ctz(rem) : -1;
    kv_store<512>(tid, rg, kg, (u16*)smem, (u16*)smem + 64 * 72);
    if (mbn >= 0) kv_load<512>(tid, kbs, vbs, LD_ODD, 64 * mbn, 0, S_, rg);
    __syncthreads();
    int par = 0;
#pragma unroll 1
    while (true) {
      u16* Ks = (u16*)(smem + par * KVBUF); u16* Vts = Ks + 64 * 72;
      int mbn2 = -1;
      if (mbn >= 0) {
        u16* Kn = (u16*)(smem + (par ^ 1) * KVBUF);
        kv_store<512>(tid, rg, kg, Kn, Kn + 64 * 72);
        rem &= rem - 1u;
        mbn2 = rem ? __builtin_ctz(rem) : -1;
        if (mbn2 >= 0) kv_load<512>(tid, kbs, vbs, LD_ODD, 64 * mbn2, 0, S_, rg);
      }
      const bool selb = (myMask >> mb) & 1u;
      const float sb = slope2 * (float)(64 * mb) + slope2 * (float)(4 * hh);
      if (__any(selb)) flash_stage(qf, Ks, Vts, o, m, l, lane, slope2, sb, 0, selb ? (tq - 64 * mb) : -1);
      __syncthreads();
      if (mbn < 0) break;
      mb = mbn; mbn = mbn2; par ^= 1;
    }
    const float lt = l + __shfl_xor(l, 32);
    const float sc = g1 / lt;
#pragma unroll
    for (int dt = 0; dt < 2; ++dt)
#pragma unroll
      for (int i = 0; i < 16; ++i) ots[(dt * 16 + i) * NT] += sc * o[dt][i];
  }
  {
    f32x16 o[2]; o[0] = zero16(); o[1] = zero16();
    float m = -1e30f, l = 0.f;
    const u16* kb = pb + 2048 + g * 64; const u16* vb = pb + 2304 + g * 64;
    const float* kg = p.nsa_kg + (li * 3 + 2) * 64;
    const int mlo = (t0 - 511) < 0 ? 0 : ((t0 - 511) >> 6);
    kv_load<512>(tid, kb, vb, LD_ODD, 64 * mlo, 0, S_, rg);
    kv_store<512>(tid, rg, kg, (u16*)smem, (u16*)smem + 64 * 72);
    if (mlo + 1 <= cur) kv_load<512>(tid, kb, vb, LD_ODD, 64 * (mlo + 1), 0, S_, rg);
    __syncthreads();
#pragma unroll 1
    for (int mb = mlo; mb <= cur; ++mb) {
      const int par = (mb - mlo) & 1;
      u16* Ks = (u16*)(smem + par * KVBUF); u16* Vts = Ks + 64 * 72;
      if (mb + 1 <= cur) { u16* Kn = (u16*)(smem + (par ^ 1) * KVBUF); kv_store<512>(tid, rg, kg, Kn, Kn + 64 * 72); }
      if (mb + 2 <= cur) kv_load<512>(tid, kb, vb, LD_ODD, 64 * (mb + 2), 0, S_, rg);
      const int lim = tq - 64 * mb;
      const float sb = slope2 * (float)(64 * mb) + slope2 * (float)(4 * hh);
      flash_stage(qf, Ks, Vts, o, m, l, lane, slope2, sb, lim - 511, lim);
      __syncthreads();
    }
    const float lt = l + __shfl_xor(l, 32);
    const float sc = g2 / lt;
    u16* orow = p.hbuf + (size_t)(b * S_ + tq) * 1024 + g * 256 + w * 64;
#pragma unroll
    for (int dt = 0; dt < 2; ++dt)
#pragma unroll
      for (int q4 = 0; q4 < 4; ++q4) {
        const float a0 = ots[(dt * 16 + 4 * q4 + 0) * NT] + sc * o[dt][4 * q4 + 0], a1 = ots[(dt * 16 + 4 * q4 + 1) * NT] + sc * o[dt][4 * q4 + 1];
        const float a2 = ots[(dt * 16 + 4 * q4 + 2) * NT] + sc * o[dt][4 * q4 + 2], a3 = ots[(dt * 16 + 4 * q4 + 3) * NT] + sc * o[dt][4 * q4 + 3];
        uint2 ov; ov.x = pack2(a0, a1); ov.y = pack2(a2, a3);
        *(uint2*)(orow + dt * 32 + 8 * q4 + 4 * hh) = ov;
      }
  }
  __syncthreads();
}

DI void run_phase(const Params& p, int ph, char* smem) {
  if (ph == 0) { prep_phase(p, smem); return; }
  const int l = (ph - 1) >> 3, s = (ph - 1) & 7, li = l >> 1;
  const bool even = (l & 1) == 0;
  const float* xin = (l == 0) ? p.x : p.out;
  switch (s) {
    case 0: rmsnorm_phase(xin, p.attn_norm + l * 1024, p.hbuf); break;
    case 1:
      if (even) gemm_phase<0>(p.hbuf, p.wt_hy_in + (size_t)li * 3584 * 1024, 1024, 14, p.proj, LD_EVEN, nullptr, nullptr, smem);
      else gemm_phase<0>(p.hbuf, p.wt_nsa_in + (size_t)li * 2816 * 1024, 1024, 11, p.proj, LD_ODD, nullptr, nullptr, smem);
      break;
    case 2:
      if (even) {
        for (int item = blockIdx.x; item < 256 + 3072; item += gridDim.x) {
          if (item < 256) hgrn_item(p, li, item, smem); else dilated_item(p, li, item - 256, smem);
        }
      } else {
        for (int item = blockIdx.x; item < 256; item += gridDim.x) compress_item(p, li, item, smem);
      }
      break;
    case 3:
      if (even) post_even_phase(p, li);
      else {
        for (int item = blockIdx.x; item < 2048; item += gridDim.x) {
          const int r = item / gridDim.x, i = item % gridDim.x;
          int it2 = item;
          if (gridDim.x == 256) {
            const int c = (i + 4 * (r >> 1)) & 31;
            const int tt = (r & 1) ? 31 - c : c;
            it2 = ((i >> 5) + 8 * r) * 32 + tt;
          }
          nsa_item(p, li, it2, smem);
        }
      }
      break;
    case 4:
      gemm_phase<1>(p.hbuf, (even ? p.wt_hy_out : p.wt_nsa_out) + (size_t)li * 1048576, 1024, 4, nullptr, 0, xin, p.out, smem);
      break;
    case 5: rmsnorm_phase(p.out, p.ffn_norm + l * 1024, p.hbuf); break;
    case 6: gemm_phase<2>(p.hbuf, p.wt_gu + (size_t)l * 5632 * 1024, 1024, 22, p.proj, DFF, nullptr, nullptr, smem); break;
    case 7: gemm_phase<1>(p.proj, p.wt_dn + (size_t)l * 1024 * 2816, 2816, 4, nullptr, 0, p.out, p.out, smem); break;
  }
}

__global__ void __launch_bounds__(512) mk_forward(Params p) {
  __shared__ __attribute__((aligned(16))) char smem[131072];
  __shared__ uint4 xb_words;
  cg::grid_group grid = cg::this_grid();
  if (__builtin_amdgcn_workitem_id_x() == 0) xb_words = make_uint4(0u, 0u, 0u, 0u);
  __syncthreads();
  const XcdBarrier xb = xcd_barrier_post(p.bar, (volatile LAS unsigned*)&xb_words);
  for (int ph = p.phase_lo; ph < p.phase_hi; ++ph) {
    run_phase(p, ph, smem);
    if (ph + 1 < p.phase_hi) {
      if (ph == p.phase_lo) grid.sync();
      else xcd_barrier(xb);
    }
  }
}

extern "C" void kernel_launch(void* const* d_in, const int* in_sizes, int n_in, void* d_out, int out_size,
                              void* d_ws, size_t ws_size, hipStream_t stream) {
  static int grid_blocks = 0;
  if (!grid_blocks) {
    int dev = 0, cus = 0, per_cu = 0;
    hipGetDevice(&dev);
    hipDeviceGetAttribute(&cus, hipDeviceAttributeMultiprocessorCount, dev);
    hipOccupancyMaxActiveBlocksPerMultiprocessor(&per_cu, mk_forward, 512, 0);
    if (per_cu > 1) per_cu = 1;
    if (per_cu < 1) per_cu = 1;
    grid_blocks = cus * per_cu;
  }
  Params p;
  memset(&p, 0, sizeof(p));
  p.x = (const float*)d_in[0]; p.attn_norm = (const float*)d_in[1]; p.ffn_norm = (const float*)d_in[2];
  p.hy_w_in = (const float*)d_in[3]; p.hy_lb = (const float*)d_in[4]; p.hy_og = (const float*)d_in[5];
  p.hy_qg = (const float*)d_in[6]; p.hy_kg = (const float*)d_in[7]; p.hy_w_out = (const float*)d_in[8];
  p.nsa_w_in = (const float*)d_in[9]; p.nsa_qg = (const float*)d_in[10]; p.nsa_kg = (const float*)d_in[11];
  p.cmp_pe = (const float*)d_in[12]; p.cmp_w1 = (const float*)d_in[13]; p.cmp_w2 = (const float*)d_in[14];
  p.nsa_w_out = (const float*)d_in[15]; p.ffn_g = (const float*)d_in[16]; p.ffn_u = (const float*)d_in[17]; p.ffn_d = (const float*)d_in[18];
  p.out = (float*)d_out;
  char* ws = (char*)d_ws; size_t off = 0;
  auto take = [&](size_t bytes) { char* r = ws + off; off += (bytes + 255) & ~(size_t)255; return r; };
  p.wt_hy_in = (u16*)take((size_t)2 * 3584 * 1024 * 2);
  p.wt_hy_out = (u16*)take((size_t)2 * 1048576 * 2);
  p.wt_nsa_in = (u16*)take((size_t)2 * 2816 * 1024 * 2);
  p.wt_nsa_out = (u16*)take((size_t)2 * 1048576 * 2);
  p.wt_gu = (u16*)take((size_t)4 * 5632 * 1024 * 2);
  p.wt_dn = (u16*)take((size_t)4 * 1024 * 2816 * 2);
  p.wt_c1 = (u16*)take((size_t)4 * 128 * 2048 * 2);
  p.wt_c2 = (u16*)take((size_t)4 * 64 * 128 * 2);
  p.c1 = (float*)take(4 * 128 * 4);
  p.lb = (float*)take(2 * 512 * 4);
  p.lse = (float*)take((size_t)3 * T_ * 8 * 4);
  p.proj = (u16*)take((size_t)T_ * 3584 * 2);
  p.hbuf = (u16*)take((size_t)T_ * 1024 * 2);
  p.obr = (u16*)take((size_t)3 * T_ * 512 * 2);
  p.kcmp = (u16*)take((size_t)16 * 4 * 128 * 64 * 2);
  p.vcmp = (u16*)take((size_t)16 * 4 * 128 * 64 * 2);
  p.bar = (unsigned*)take(XCD_BAR_WORDS * 4);
  if (off > ws_size) { fprintf(stderr, "workspace too small: need %zu have %zu\n", off, ws_size); return; }
  const int NPH = 33;
  hipMemsetAsync(p.bar, 0, XCD_BAR_WORDS * 4, stream);
#if MK_MULTI
  for (int ph = 0; ph < NPH; ++ph) {
    p.phase_lo = ph; p.phase_hi = ph + 1;
    hipLaunchKernelGGL(mk_forward, dim3(grid_blocks), dim3(512), 0, stream, p);
  }
#else
  p.phase_lo = 0; p.phase_hi = NPH;
  void* args[] = {&p};
  hipError_t e = hipLaunchCooperativeKernel((void*)mk_forward, dim3(grid_blocks), dim3(512), args, 0, stream);
  if (e != hipSuccess) fprintf(stderr, "cooperative launch failed: %s (grid %d)\n", hipGetErrorString(e), grid_blocks);
#endif
}
```

```cpp
#include <hip/hip_runtime.h>
#include <hip/hip_cooperative_groups.h>
#include <cstdio>
#include <cstdint>
#include <cstring>
namespace cg = cooperative_groups;

typedef unsigned short u16;
using bf16x8 = __attribute__((ext_vector_type(8))) short;
using f32x16 = __attribute__((ext_vector_type(16))) float;
using u32x4v = __attribute__((ext_vector_type(4))) unsigned;
#define DI __device__ __forceinline__
#define MFMA32(a, b, c) __builtin_amdgcn_mfma_f32_32x32x16_bf16((a), (b), (c), 0, 0, 0)

#ifndef MK_MULTI
#define MK_MULTI 0
#endif

constexpr int T_ = 32768, S_ = 2048;
constexpr float EPSF = 1e-6f;
constexpr float LOG2E = 1.4426950408889634f, LN2 = 0.6931471805599453f;
constexpr int LD_EVEN = 3584, LD_ODD = 2816, DFF = 2816;
constexpr int NT = 512;
#define LAS __attribute__((address_space(3)))
using f32x4v = __attribute__((ext_vector_type(4))) float;

struct Params {
  const float* x; const float* attn_norm; const float* ffn_norm;
  const float* hy_w_in; const float* hy_lb; const float* hy_og; const float* hy_qg; const float* hy_kg; const float* hy_w_out;
  const float* nsa_w_in; const float* nsa_qg; const float* nsa_kg; const float* cmp_pe; const float* cmp_w1; const float* cmp_w2; const float* nsa_w_out;
  const float* ffn_g; const float* ffn_u; const float* ffn_d;
  float* out;
  u16* wt_hy_in; u16* wt_hy_out; u16* wt_nsa_in; u16* wt_nsa_out; u16* wt_gu; u16* wt_dn; u16* wt_c1; u16* wt_c2;
  float* c1; float* lb; float* lse;
  u16* proj; u16* hbuf; u16* obr; u16* kcmp; u16* vcmp;
  unsigned* bar;
  int phase_lo; int phase_hi;
};

DI int tidx() { int t = __builtin_amdgcn_workitem_id_x(); asm volatile("" : "+v"(t)); return t; }
DI float bf2f(u16 h) { return __uint_as_float(((unsigned)h) << 16); }
typedef __bf16 bf16x2_t __attribute__((ext_vector_type(2)));
typedef float f32x2_t __attribute__((ext_vector_type(2)));
DI unsigned pack2(float a, float b) { f32x2_t v = {a, b}; bf16x2_t r = __builtin_convertvector(v, bf16x2_t); return __builtin_bit_cast(unsigned, r); }
DI u16 f2bf(float x) { return (u16)(pack2(x, 0.f) & 0xffffu); }
DI float fsigmoid(float x) { return 1.f / (1.f + __expf(-x)); }
DI float fsilu(float x) { return x / (1.f + __expf(-x)); }
DI float fexp2(float x) { return __builtin_amdgcn_exp2f(x); }
DI void unpack8(uint4 v, float (&f)[8]) {
  f[0] = __uint_as_float(v.x << 16); f[1] = __uint_as_float(v.x & 0xffff0000u);
  f[2] = __uint_as_float(v.y << 16); f[3] = __uint_as_float(v.y & 0xffff0000u);
  f[4] = __uint_as_float(v.z << 16); f[5] = __uint_as_float(v.z & 0xffff0000u);
  f[6] = __uint_as_float(v.w << 16); f[7] = __uint_as_float(v.w & 0xffff0000u);
}
DI uint4 pack8(const float (&f)[8]) {
  uint4 o; o.x = pack2(f[0], f[1]); o.y = pack2(f[2], f[3]); o.z = pack2(f[4], f[5]); o.w = pack2(f[6], f[7]); return o;
}
DI bf16x8 as_bf16x8(uint4 v) { u32x4v t; t[0] = v.x; t[1] = v.y; t[2] = v.z; t[3] = v.w; return __builtin_bit_cast(bf16x8, t); }
DI f32x16 zero16() { f32x16 z;
#pragma unroll
  for (int i = 0; i < 16; ++i) z[i] = 0.f; return z; }


#define XB_TMO      128
#define XB_XCNT(j)  (256  + 64 * (j))
#define XB_XSUB(j)  (1280 + 64 * (j))
#define XB_XGEN(j)  (2304 + 64 * (j))
#define XB_TOP      3328
#define XB_TOPGEN   3392
#define XCD_BAR_WORDS 3456
#define XB_SPIN_CAP (1u << 18)
DI unsigned xb_ld(unsigned* p) { return __hip_atomic_load(p, __ATOMIC_RELAXED, __HIP_MEMORY_SCOPE_AGENT); }
DI unsigned xb_add(unsigned* p, unsigned v) { return __hip_atomic_fetch_add(p, v, __ATOMIC_RELAXED, __HIP_MEMORY_SCOPE_AGENT); }
DI unsigned xb_xcc_id() { return (unsigned)__builtin_amdgcn_s_getreg((3 << 11) | 20) & 0xFu; }
#define XB_SPIN(cond, bar) do { unsigned _sp = 0; while (cond) { __builtin_amdgcn_s_sleep(1); \
    if ((++_sp & 255u) == 0u) { if (xb_ld(&(bar)[XB_TMO])) break; if (_sp > XB_SPIN_CAP) { atomicAdd(&(bar)[XB_TMO], 1u); break; } } } } while (0)
struct XcdBarrier { unsigned* bar; unsigned x; volatile LAS unsigned* st; };
DI XcdBarrier xcd_barrier_post(unsigned* bar, volatile LAS unsigned* st) {
  XcdBarrier b; b.bar = bar; b.x = xb_xcc_id(); b.st = st;
  if (__builtin_amdgcn_workitem_id_x() == 0) (void)xb_add(&bar[XB_XCNT(b.x)], 1u);
  return b;
}
DI void xcd_barrier_complete(unsigned* bar, unsigned x, unsigned& nloc, unsigned& nx) {
  const unsigned G = gridDim.x * gridDim.y * gridDim.z;
  unsigned sum, cnt, mine, sp = 0u;
  for (;;) {
    sum = 0u; cnt = 0u; mine = 0u;
#pragma unroll
    for (unsigned j = 0; j < 16; ++j) { const unsigned c = xb_ld(&bar[XB_XCNT(j)]); sum += c; cnt += (c > 0u) ? 1u : 0u; mine = (j == x) ? c : mine; }
    if (sum == G) break;
    __builtin_amdgcn_s_sleep(1);
    if ((++sp & 255u) == 0u) { if (xb_ld(&bar[XB_TMO])) break; if (sp > XB_SPIN_CAP) { atomicAdd(&bar[XB_TMO], 1u); break; } }
  }
  nloc = mine > 0u ? mine : 1u; nx = cnt > 0u ? cnt : 1u;
}
DI void xcd_barrier(const XcdBarrier& b) {
  asm volatile("s_waitcnt vmcnt(0)" ::: "memory");
  __syncthreads();
  if (__builtin_amdgcn_workitem_id_x() == 0) {
    unsigned* bar = b.bar;
    __builtin_amdgcn_s_waitcnt(0);
    unsigned nloc = b.st[0], nx = b.st[1];
    if (nloc == 0u) { xcd_barrier_complete(bar, b.x, nloc, nx); b.st[0] = nloc; b.st[1] = nx; }
    const unsigned old = xb_add(&bar[XB_XSUB(b.x)], 1u);
    const unsigned gen = old / nloc;
    if (old + 1u == (gen + 1u) * nloc) {
      __builtin_amdgcn_fence(__ATOMIC_RELEASE, "agent");
      asm volatile("s_waitcnt vmcnt(0)" ::: "memory");
      const unsigned og = xb_add(&bar[XB_TOP], 1u);
      const unsigned tg = og / nx;
      if (og + 1u == (tg + 1u) * nx) xb_add(&bar[XB_TOPGEN], 1u);
      else XB_SPIN(xb_ld(&bar[XB_TOPGEN]) == tg, bar);
      __builtin_amdgcn_fence(__ATOMIC_ACQUIRE, "agent");
      xb_add(&bar[XB_XGEN(b.x)], 1u);
      asm volatile("s_waitcnt vmcnt(0)" ::: "memory");
    } else {
      XB_SPIN(xb_ld(&bar[XB_XGEN(b.x)]) == gen, bar);
      __builtin_amdgcn_fence(__ATOMIC_ACQUIRE, "agent");
      asm volatile("s_waitcnt vmcnt(0)" ::: "memory");
    }
  }
  __syncthreads();
}

struct PrepDesc { const float* src; u16* dst; int K, N, mode, tk, tn; };
DI PrepDesc prep_desc(const Params& p, int tile) {
  constexpr int G0 = 1792, G1 = 2304, G2 = 3712, G3 = 4224, G4 = 7040, G5 = 9856, G6 = 12672, G7 = 12928;
  PrepDesc d; int Np, lt; d.mode = 0;
  if (tile < G0) { int i = tile / 896; lt = tile % 896; d.src = p.hy_w_in + (size_t)i * 1024 * 3584; d.dst = p.wt_hy_in + (size_t)i * 3584 * 1024; d.K = 1024; d.N = 3584; Np = 3584; }
  else if (tile < G1) { int t = tile - G0; int i = t / 256; lt = t % 256; d.src = p.hy_w_out + (size_t)i * 1048576; d.dst = p.wt_hy_out + (size_t)i * 1048576; d.K = 1024; d.N = 1024; Np = 1024; }
  else if (tile < G2) { int t = tile - G1; int i = t / 704; lt = t % 704; d.src = p.nsa_w_in + (size_t)i * 1024 * 2608; d.dst = p.wt_nsa_in + (size_t)i * 2816 * 1024; d.K = 1024; d.N = 2608; Np = 2816; }
  else if (tile < G3) { int t = tile - G2; int i = t / 256; lt = t % 256; d.src = p.nsa_w_out + (size_t)i * 1048576; d.dst = p.wt_nsa_out + (size_t)i * 1048576; d.K = 1024; d.N = 1024; Np = 1024; }
  else if (tile < G4) { int t = tile - G3; int i = t / 704; lt = t % 704; d.src = p.ffn_g + (size_t)i * 1024 * 2816; d.dst = p.wt_gu + (size_t)i * 5632 * 1024; d.K = 1024; d.N = 2816; Np = 2816; d.mode = 1; }
  else if (tile < G5) { int t = tile - G4; int i = t / 704; lt = t % 704; d.src = p.ffn_u + (size_t)i * 1024 * 2816; d.dst = p.wt_gu + (size_t)i * 5632 * 1024; d.K = 1024; d.N = 2816; Np = 2816; d.mode = 2; }
  else if (tile < G6) { int t = tile - G5; int i = t / 704; lt = t % 704; d.src = p.ffn_d + (size_t)i * 2816 * 1024; d.dst = p.wt_dn + (size_t)i * 1024 * 2816; d.K = 2816; d.N = 1024; Np = 1024; }
  else if (tile < G7) { int t = tile - G6; int i = t / 64; lt = t % 64; d.src = p.cmp_w1 + (size_t)i * 2048 * 128; d.dst = p.wt_c1 + (size_t)i * 128 * 2048; d.K = 2048; d.N = 128; Np = 128; }
  else { int t = tile - G7; int i = t / 2; lt = t % 2; d.src = p.cmp_w2 + (size_t)i * 128 * 64; d.dst = p.wt_c2 + (size_t)i * 64 * 128; d.K = 128; d.N = 64; Np = 64; }
  const int ntn = Np / 64;
  d.tk = lt / ntn; d.tn = lt % ntn;
  return d;
}
DI void prep_load(const PrepDesc& d, int tid, float (&rv)[8]) {
  const int c = tid & 63; const int n = d.tn * 64 + c;
#pragma unroll
  for (int j = 0; j < 8; ++j) {
    const int r = (tid >> 6) + 8 * j;
    rv[j] = (n < d.N) ? d.src[(size_t)(d.tk * 64 + r) * d.N + n] : 0.f;
  }
}

DI void prep_phase(const Params& p, char* smem) {
  float* sm = (float*)smem;
  constexpr int G8 = 12936;
  const int tid = tidx();
  float rv[8];
  int tile = blockIdx.x;
  asm volatile("" : "+s"(tile));
  if (tile < G8) { const PrepDesc d0 = prep_desc(p, tile); prep_load(d0, tid, rv); }
  for (; tile < G8; tile += gridDim.x) {
    const PrepDesc d = prep_desc(p, tile);
    __syncthreads();
#pragma unroll
    for (int j = 0; j < 8; ++j) sm[((tid >> 6) + 8 * j) * 65 + (tid & 63)] = rv[j];
    __syncthreads();
    if (tile + (int)gridDim.x < G8) { const PrepDesc dn = prep_desc(p, tile + gridDim.x); prep_load(dn, tid, rv); }
    const int nl = tid >> 3, kp = tid & 7;
    const int n = d.tn * 64 + nl;
    int nd = n;
    if (d.mode == 1) nd = (n >> 4) * 32 + (n & 15);
    else if (d.mode == 2) nd = (n >> 4) * 32 + 16 + (n & 15);
    float v[8];
#pragma unroll
    for (int j = 0; j < 8; ++j) v[j] = sm[(kp * 8 + j) * 65 + nl];
    *(uint4*)(d.dst + (size_t)nd * d.K + d.tk * 64 + kp * 8) = pack8(v);
  }
  __syncthreads();
  if (blockIdx.x < 4) {
    const int mi = blockIdx.x;
    const float* pe = p.cmp_pe + (size_t)mi * 2048;
    const float* w1 = p.cmp_w1 + (size_t)mi * 2048 * 128;
    const int tq_ = tidx();
    const int o = tq_ & 127, half = tq_ >> 7;
    float a0 = 0.f, a1 = 0.f, a2 = 0.f, a3 = 0.f;
    for (int k = half * 512; k < half * 512 + 512; k += 4) {
      a0 += pe[k] * w1[(size_t)k * 128 + o]; a1 += pe[k + 1] * w1[(size_t)(k + 1) * 128 + o];
      a2 += pe[k + 2] * w1[(size_t)(k + 2) * 128 + o]; a3 += pe[k + 3] * w1[(size_t)(k + 3) * 128 + o];
    }
    sm[tq_] = (a0 + a1) + (a2 + a3);
    __syncthreads();
    if (tq_ < 128) p.c1[mi * 128 + tq_] = (sm[tq_] + sm[tq_ + 128]) + (sm[tq_ + 256] + sm[tq_ + 384]);
    __syncthreads();
  }
  if (blockIdx.x == 4 || (gridDim.x <= 4 && blockIdx.x == 0)) {
    for (int c = tidx(); c < 512; c += NT) {
      float l0 = p.hy_lb[c], l1 = p.hy_lb[512 + c];
      float mx = fmaxf(l0, l1); float e0 = __expf(l0 - mx), e1 = __expf(l1 - mx); float inv = 1.f / (e0 + e1);
      float p0 = e0 * inv, p1 = e1 * inv;
      p.lb[c] = p0 - p0; p.lb[512 + c] = (p0 + p1) - p0;
    }
  }
}

DI void rmsnorm_phase(const float* x, const float* __restrict__ g, u16* h) {
  const int t_ = tidx();
  const int wave = t_ >> 6, lane = t_ & 63;
  for (int row = blockIdx.x * 8 + wave; row < T_; row += gridDim.x * 8) {
    const float4* xr = (const float4*)(x + (size_t)row * 1024);
    float4 v[4]; float ss = 0.f;
#pragma unroll
    for (int j = 0; j < 4; ++j) { v[j] = xr[lane + 64 * j]; ss += v[j].x * v[j].x + v[j].y * v[j].y + v[j].z * v[j].z + v[j].w * v[j].w; }
#pragma unroll
    for (int off = 32; off >= 1; off >>= 1) ss += __shfl_xor(ss, off);
    const float rs = rsqrtf(ss * (1.f / 1024.f) + EPSF);
#pragma unroll
    for (int j = 0; j < 4; ++j) {
      float4 gg = ((const float4*)g)[lane + 64 * j];
      uint2 o; o.x = pack2(v[j].x * rs * gg.x, v[j].y * rs * gg.y); o.y = pack2(v[j].z * rs * gg.z, v[j].w * rs * gg.w);
      *(uint2*)(h + (size_t)row * 1024 + (lane + 64 * j) * 4) = o;
    }
  }
}

DI int lds_byte(int r, int c) { const int st = (r >> 4) * 2 + (c >> 5), rr = r & 15, cc = c & 31, ob = rr * 64 + cc * 2; return st * 1024 + (ob ^ (((ob >> 9) & 1) << 5)); }
DI void stage_rc(int b, int& R, int& C) { const int st = b / 1024, sb = b % 1024, swz = sb ^ (((sb >> 9) & 1) << 5); R = (st >> 1) * 16 + swz / 64; C = (st & 1) * 32 + (swz % 64) / 2; }

template <int EPI>
DI void gemm_phase(const u16* A, const u16* Bt, const int K, const int nN, u16* outb, const int ldc, const float* res, float* outf, char* smem) {
  constexpr int HTB = 16384;
  const int tid = tidx();
  const int wid = tid >> 6, lane = tid & 63, wr = wid >> 2, wc = wid & 3, fr = lane & 15, fq = lane >> 4;
  const int nM = 128, nwg = nM * nN, nt = K / 64;
  int sR0, sC0, sR1, sC1; stage_rc(tid * 16, sR0, sC0); stage_rc(tid * 16 + 8192, sR1, sC1);
  const unsigned vo0 = (unsigned)((sR0 * K + sC0) * 2), vo1 = (unsigned)((sR1 * K + sC1) * 2);
#define SA_(b, h) (smem + ((b) * 2 + (h)) * HTB)
#define SB_(b, h) (smem + (4 + (b) * 2 + (h)) * HTB)
#define STAGE(P, BASE, br, kt) do { const char* _g = (const char*)((BASE) + (size_t)(br) * K + (size_t)(kt) * 64); \
    unsigned _o0 = vo0, _o1 = vo1; asm volatile("" : "+v"(_o0), "+v"(_o1)); \
    __builtin_amdgcn_global_load_lds((const unsigned*)(_g + _o0), (LAS unsigned*)((P) + tid * 16), 16, 0, 0); \
    __builtin_amdgcn_global_load_lds((const unsigned*)(_g + _o1), (LAS unsigned*)((P) + tid * 16 + 8192), 16, 0, 0); } while (0)
#define LDA(dst, b, h) _Pragma("unroll") for (int m = 0; m < 4; ++m) _Pragma("unroll") for (int k = 0; k < 2; ++k) \
    dst[m][k] = *(const bf16x8*)(SA_(b, h) + lds_byte(wr * 64 + m * 16 + fr, k * 32 + fq * 8))
#define LDB(dst, b, h) _Pragma("unroll") for (int n = 0; n < 2; ++n) _Pragma("unroll") for (int k = 0; k < 2; ++k) \
    dst[n][k] = *(const bf16x8*)(SB_(b, h) + lds_byte(wc * 32 + n * 16 + fr, k * 32 + fq * 8))
#define MMA(ai, bj, At_, Bx_) do { __builtin_amdgcn_s_setprio(1); \
    _Pragma("unroll") for (int m = 0; m < 4; ++m) _Pragma("unroll") for (int n = 0; n < 2; ++n) _Pragma("unroll") for (int k = 0; k < 2; ++k) \
      acc[ai][bj][m][n] = __builtin_amdgcn_mfma_f32_16x16x32_bf16(Bx_[n][k], At_[m][k], acc[ai][bj][m][n], 0, 0, 0); \
    __builtin_amdgcn_s_setprio(0); } while (0)
#define WAIT_V(n) asm volatile("s_waitcnt vmcnt(" #n ")" ::: "memory")
#define WAIT_L(n) asm volatile("s_waitcnt lgkmcnt(" #n ")" ::: "memory")
#define BAR __builtin_amdgcn_s_barrier()
#define SCHED __builtin_amdgcn_sched_barrier(0)
  auto tile_of = [&](long Lq, int& brow_, int& bcol_, int& pn_) {
    int wgid = (int)Lq;
    { const int q = nwg / 8, r = nwg % 8, xcd = wgid % 8, off = wgid / 8; wgid = (xcd < r ? xcd * (q + 1) : r * (q + 1) + (xcd - r) * q) + off; }
    const int nig = 8 * nN, gid = wgid / nig, fm = gid * 8, gsz = (nM - fm) < 8 ? (nM - fm) : 8;
    const int pm = fm + ((wgid % nig) % gsz);
    pn_ = (wgid % nig) / gsz; brow_ = pm * 256; bcol_ = pn_ * 256;
  };
#define STAGE7(br_, bc_) do { STAGE(SB_(0, 0), Bt, bc_, 0); STAGE(SA_(0, 0), A, br_, 0); STAGE(SB_(0, 1), Bt, (bc_) + 128, 0); STAGE(SA_(0, 1), A, (br_) + 128, 0); \
    STAGE(SB_(1, 0), Bt, bc_, 1); STAGE(SA_(1, 0), A, br_, 1); STAGE(SB_(1, 1), Bt, (bc_) + 128, 1); } while (0)
  long L = blockIdx.x;
  bool have = L < nwg;
  int brow = 0, bcol = 0, pn = 0;
  __syncthreads();
  if (have) { tile_of(L, brow, bcol, pn); STAGE7(brow, bcol); }
  while (have) {
    f32x4v acc[2][2][4][2];
#pragma unroll
    for (int a = 0; a < 2; ++a)
#pragma unroll
      for (int b = 0; b < 2; ++b)
#pragma unroll
        for (int m = 0; m < 4; ++m)
#pragma unroll
          for (int n = 0; n < 2; ++n) acc[a][b][m][n] = (f32x4v){0.f, 0.f, 0.f, 0.f};
    bf16x8 At[4][2], B0[2][2], B1[2][2];
    if (wr == 1) BAR;
    WAIT_V(0); BAR;
    BAR;
    for (int t = 0; t < nt - 2; t += 2) {
      LDB(B0, 0, 0); SCHED; LDA(At, 0, 0); STAGE(SA_(1, 1), A, brow + 128, t + 1);
      WAIT_L(8); BAR; WAIT_L(0); MMA(0, 0, At, B0); BAR; SCHED;
      LDB(B1, 0, 1); STAGE(SB_(0, 0), Bt, bcol, t + 2);
      BAR; WAIT_L(0); MMA(0, 1, At, B1); BAR;
      LDA(At, 0, 1); STAGE(SA_(0, 0), A, brow, t + 2);
      BAR; WAIT_L(0); MMA(1, 0, At, B0); BAR; SCHED;
      STAGE(SB_(0, 1), Bt, bcol + 128, t + 2);
      WAIT_V(6); BAR; MMA(1, 1, At, B1); BAR;
      LDB(B0, 1, 0); SCHED; LDA(At, 1, 0); STAGE(SA_(0, 1), A, brow + 128, t + 2);
      WAIT_L(8); BAR; WAIT_L(0); MMA(0, 0, At, B0); BAR; SCHED;
      LDB(B1, 1, 1); STAGE(SB_(1, 0), Bt, bcol, t + 3);
      BAR; WAIT_L(0); MMA(0, 1, At, B1); BAR;
      LDA(At, 1, 1); STAGE(SA_(1, 0), A, brow, t + 3);
      BAR; WAIT_L(0); MMA(1, 0, At, B0); BAR; SCHED;
      STAGE(SB_(1, 1), Bt, bcol + 128, t + 3);
      WAIT_V(6); BAR; MMA(1, 1, At, B1); BAR;
    }
    { LDB(B0, 0, 0); LDA(At, 0, 0); STAGE(SA_(1, 1), A, brow + 128, nt - 1);
      BAR; WAIT_L(0); MMA(0, 0, At, B0); BAR;
      LDB(B1, 0, 1); BAR; WAIT_L(0); MMA(0, 1, At, B1); BAR;
      LDA(At, 0, 1); WAIT_V(4); BAR; WAIT_L(0); MMA(1, 0, At, B0); MMA(1, 1, At, B1); BAR; }
    { LDB(B0, 1, 0); LDA(At, 1, 0); WAIT_V(2); BAR; WAIT_L(0); MMA(0, 0, At, B0); BAR;
      LDB(B1, 1, 1); WAIT_V(0); BAR; WAIT_L(0); MMA(0, 1, At, B1); BAR;
      LDA(At, 1, 1); BAR; WAIT_L(0); MMA(1, 0, At, B0); MMA(1, 1, At, B1); BAR; }
    if (wr == 0) BAR;
    const long Ln = L + gridDim.x;
    const bool haven = Ln < nwg;
    int browN = 0, bcolN = 0, pnN = 0;
    if (haven) { tile_of(Ln, browN, bcolN, pnN); STAGE7(browN, bcolN); }
    int tid2 = tid; asm volatile("" : "+v"(tid2));
    const int fr2 = tid2 & 15, fq2 = (tid2 >> 4) & 3, wc2 = (tid2 >> 6) & 3, wr2 = tid2 >> 8;
#pragma unroll
    for (int ai = 0; ai < 2; ++ai)
#pragma unroll
      for (int m = 0; m < 4; ++m) {
        const size_t row = (size_t)(brow + ai * 128 + wr2 * 64 + m * 16 + fr2);
#pragma unroll
        for (int bj = 0; bj < 2; ++bj) {
          const int cb = bcol + bj * 128 + wc2 * 32 + fq2 * 4;
          if (EPI == 0) {
#pragma unroll
            for (int n = 0; n < 2; ++n) {
              uint2 o; o.x = pack2(acc[ai][bj][m][n][0], acc[ai][bj][m][n][1]); o.y = pack2(acc[ai][bj][m][n][2], acc[ai][bj][m][n][3]);
              *(uint2*)(outb + row * ldc + cb + n * 16) = o;
            }
          } else if (EPI == 1) {
#pragma unroll
            for (int n = 0; n < 2; ++n) {
              const size_t idx = row * 1024 + cb + n * 16;
              const f32x4v r4 = *(const f32x4v*)(res + idx);
              *(f32x4v*)(outf + idx) = r4 + acc[ai][bj][m][n];
            }
          } else {
            const f32x4v gv = acc[ai][bj][m][0], uv = acc[ai][bj][m][1];
            uint2 o; o.x = pack2(fsilu(gv[0]) * uv[0], fsilu(gv[1]) * uv[1]); o.y = pack2(fsilu(gv[2]) * uv[2], fsilu(gv[3]) * uv[3]);
            *(uint2*)(outb + row * DFF + ((bcol + bj * 128 + wc2 * 32) >> 1) + fq2 * 4) = o;
          }
        }
      }
    L = Ln; have = haven; brow = browN; bcol = bcolN; pn = pnN;
  }
  __syncthreads();
#undef STAGE7
#undef SA_
#undef SB_
#undef STAGE
#undef LDA
#undef LDB
#undef MMA
}

#define MFMA16(a, b, c) __builtin_amdgcn_mfma_f32_16x16x32_bf16((a), (b), (c), 0, 0, 0)
DI void hgrn_item(const Params& p, int li, int item, char* smem) {
  const int tid = tidx(), lane = tid & 63, w = tid >> 6, fr = lane & 15, fq = lane >> 4;
  const int kk = w >> 1, vt = w & 1;
  const int vs = item & 3, h = (item >> 2) & 3, b = item >> 4;
  const int tg = tid & 3, kch = tid >> 2;
  const int sv = tid >> 5, vv = tid & 31;
  const float lbv = p.lb[li * 512 + h * 128 + kch];
  const u16* base = p.proj + (size_t)b * S_ * LD_EVEN;
  const u16* pq = base + (size_t)(4 * tg) * LD_EVEN + h * 128 + kch;
  const u16* pv = base + (size_t)sv * LD_EVEN + 1024 + h * 128 + vs * 32 + vv;
  struct HRegs { unsigned q0, q1, q2, q3, f0, f1, f2, f3, v; };
  auto hload = [&](int c, HRegs& r) {
    const u16* pq2 = pq + (size_t)c * 16 * LD_EVEN;
    r.q0 = pq2[0]; r.q1 = pq2[LD_EVEN]; r.q2 = pq2[2 * LD_EVEN]; r.q3 = pq2[3 * LD_EVEN];
    r.f0 = pq2[512]; r.f1 = pq2[LD_EVEN + 512]; r.f2 = pq2[2 * LD_EVEN + 512]; r.f3 = pq2[3 * LD_EVEN + 512];
    r.v = pv[(size_t)c * 16 * LD_EVEN];
  };
  HRegs ra, rb;
  hload(0, ra); hload(1, rb);
  f32x4v S0 = {0.f, 0.f, 0.f, 0.f}, S1 = {0.f, 0.f, 0.f, 0.f};
  const f32x4v z4 = {0.f, 0.f, 0.f, 0.f};
  __syncthreads();
  constexpr int HBUF = 16896;
  auto prep = [&](const HRegs& rr, int par) {
    u16* Qt_ = (u16*)(smem + par * HBUF); u16* Kt_ = Qt_ + 16 * 136; u16* Kh_ = Kt_ + 16 * 136; u16* Vt_ = Kh_ + 128 * 24; float* Pc_ = (float*)(Vt_ + 32 * 24);
    float qv[4], kv[4], cs[4];
    const unsigned rq[4] = {rr.q0, rr.q1, rr.q2, rr.q3}, rf[4] = {rr.f0, rr.f1, rr.f2, rr.f3};
    float cp = 1.f;
#pragma unroll
    for (int i = 0; i < 4; ++i) {
      const float f = lbv + (1.f - lbv) * fsigmoid(__uint_as_float(rf[i] << 16));
      cp *= f; cs[i] = cp; kv[i] = 1.f - f; qv[i] = fsilu(__uint_as_float(rq[i] << 16));
    }
    const int bl = lane & ~3;
    const float t0 = __shfl(cp, bl), t1 = __shfl(cp, bl + 1), t2 = __shfl(cp, bl + 2), t3 = __shfl(cp, bl + 3);
    const float pre = (tg > 0 ? t0 : 1.f) * (tg > 1 ? t1 : 1.f) * (tg > 2 ? t2 : 1.f);
    const float PC = (t0 * t1) * (t2 * t3);
    float kh[4];
#pragma unroll
    for (int i = 0; i < 4; ++i) {
      const float P = fmaxf(pre * cs[i], 1e-30f);
      const float rP = __builtin_amdgcn_rcpf(P);
      const int t = 4 * tg + i;
      Qt_[t * 136 + kch] = f2bf(qv[i] * P);
      const float kr = kv[i] * rP;
      Kt_[t * 136 + kch] = f2bf(kr);
      kh[i] = kr * PC;
    }
    uint2 k2; k2.x = pack2(kh[0], kh[1]); k2.y = pack2(kh[2], kh[3]);
    *(uint2*)(Kh_ + kch * 24 + 4 * tg) = k2;
    if (tg == 0) Pc_[kch] = PC;
    Vt_[vv * 24 + sv] = (u16)rr.v;
  };
  auto mfma = [&](int par) {
    const u16* Qt_ = (const u16*)(smem + par * HBUF); const u16* Kt_ = Qt_ + 16 * 136; const u16* Kh_ = Kt_ + 16 * 136; const u16* Vt_ = Kh_ + 128 * 24;
    const float* Pc_ = (const float*)(Vt_ + 32 * 24);
    float* Op_ = (float*)(smem + 2 * HBUF) + par * 2048;
    const uint2 v2 = *(const uint2*)(Vt_ + (16 * vt + fr) * 24 + 4 * fq);
    const bf16x8 vb = as_bf16x8(make_uint4(v2.x, v2.y, 0u, 0u));
    const u16* qrow = Qt_ + fr * 136 + 32 * kk + 4 * fq;
    const uint2 qa = *(const uint2*)qrow, qb = *(const uint2*)(qrow + 16);
    const bf16x8 qfrag = as_bf16x8(make_uint4(qa.x, qa.y, qb.x, qb.y));
    const bf16x8 sfrag = as_bf16x8(make_uint4(pack2(S0[0], S0[1]), pack2(S0[2], S0[3]), pack2(S1[0], S1[1]), pack2(S1[2], S1[3])));
    f32x4v acc = MFMA16(qfrag, sfrag, z4);
    if (kk == 0) {
      f32x4v sa = z4;
#pragma unroll
      for (int ks = 0; ks < 4; ++ks) {
        const bf16x8 kf = *(const bf16x8*)(Kt_ + fr * 136 + 32 * ks + 8 * fq);
        const bf16x8 qf2 = *(const bf16x8*)(Qt_ + fr * 136 + 32 * ks + 8 * fq);
        sa = MFMA16(kf, qf2, sa);
      }
#pragma unroll
      for (int j = 0; j < 4; ++j) sa[j] = (4 * fq + j <= fr) ? sa[j] : 0.f;
      const bf16x8 afrag = as_bf16x8(make_uint4(pack2(sa[0], sa[1]), pack2(sa[2], sa[3]), 0u, 0u));
      acc = MFMA16(afrag, vb, acc);
    }
#pragma unroll
    for (int j = 0; j < 4; ++j) Op_[(w * 16 + 4 * fq + j) * 16 + fr] = acc[j];
    const float* pc0 = Pc_ + 32 * kk + 4 * fq;
#pragma unroll
    for (int j = 0; j < 4; ++j) { S0[j] *= pc0[j]; S1[j] *= pc0[16 + j]; }
    const uint2 h0 = *(const uint2*)(Kh_ + (32 * kk + fr) * 24 + 4 * fq);
    const uint2 h1v = *(const uint2*)(Kh_ + (32 * kk + 16 + fr) * 24 + 4 * fq);
    S0 = MFMA16(as_bf16x8(make_uint4(h0.x, h0.y, 0u, 0u)), vb, S0);
    S1 = MFMA16(as_bf16x8(make_uint4(h1v.x, h1v.y, 0u, 0u)), vb, S1);
  };
  auto reduce = [&](int c, int par) {
    const float* Op_ = (const float*)(smem + 2 * HBUF) + par * 2048;
    const int t = tid >> 5, v = tid & 31, vtt = v >> 4, vl = v & 15;
    float o = 0.f;
#pragma unroll
    for (int q = 0; q < 4; ++q) o += Op_[((2 * q + vtt) * 16 + t) * 16 + vl];
    p.hbuf[(size_t)(b * S_ + c * 16 + t) * 1024 + h * 128 + vs * 32 + v] = f2bf(o);
  };
  prep(ra, 0); hload(2, ra);
  __syncthreads();
#pragma unroll 1
  for (int c = 0; c < 128; c += 2) {
    mfma(0);
    prep(rb, 1); if (c + 3 < 128) hload(c + 3, rb);
    __syncthreads();
    reduce(c, 0);
    mfma(1);
    if (c + 2 < 128) { prep(ra, 0); if (c + 4 < 128) hload(c + 4, ra); }
    __syncthreads();
    reduce(c + 1, 1);
  }
  __syncthreads();
}

DI void load_q(const u16* qrow, const float* __restrict__ gain, int hh, bf16x8 (&qf)[4]) {
  float f[4][8]; float ss = 0.f;
#pragma unroll
  for (int kk = 0; kk < 4; ++kk) {
    uint4 raw = *(const uint4*)(qrow + kk * 16 + hh * 8);
    unpack8(raw, f[kk]);
#pragma unroll
    for (int j = 0; j < 8; ++j) ss += f[kk][j] * f[kk][j];
  }
  ss += __shfl_xor(ss, 32);
  const float rs = rsqrtf(ss * (1.f / 64.f) + EPSF) * (0.125f * LOG2E);
#pragma unroll
  for (int kk = 0; kk < 4; ++kk) {
#pragma unroll
    for (int j = 0; j < 8; ++j) f[kk][j] *= rs * gain[kk * 16 + hh * 8 + j];
    qf[kk] = as_bf16x8(pack8(f[kk]));
  }
}

constexpr int VS = 68;
constexpr int KVBUF = 18432;
template <int NTH> struct KVRegs { u32x4v r[NTH == 256 ? 4 : 2]; };
DI void kv_ld2(const u16* src, size_t stride, int ra, int rb, int rlo, int rhi, int dp, u32x4v& x0, u32x4v& x1) {
  const u32x4v z = {0u, 0u, 0u, 0u};
  x0 = z; x1 = z;
  if (ra >= rlo && ra < rhi) x0 = *(const u32x4v*)(src + (size_t)ra * stride + dp * 8);
  if (rb >= rlo && rb < rhi) x1 = *(const u32x4v*)(src + (size_t)rb * stride + dp * 8);
}
template <int NTH>
DI void kv_load(int tid, const u16* kb, const u16* vb, size_t stride, int r0, int rlo, int rhi, KVRegs<NTH>& rg) {
  const int dp = tid & 7, kq = (tid & 255) >> 3;
  if (NTH == 256) {
    kv_ld2(kb, stride, r0 + kq, r0 + kq + 32, rlo, rhi, dp, rg.r[0], rg.r[1]);
    kv_ld2(vb, stride, r0 + 2 * kq, r0 + 2 * kq + 1, rlo, rhi, dp, rg.r[2], rg.r[3]);
  } else {
    if (tid < 256) kv_ld2(kb, stride, r0 + kq, r0 + kq + 32, rlo, rhi, dp, rg.r[0], rg.r[1]);
    else kv_ld2(vb, stride, r0 + 2 * kq, r0 + 2 * kq + 1, rlo, rhi, dp, rg.r[0], rg.r[1]);
  }
}
DI void k_store1(u32x4v x, int key, int dp, const float* __restrict__ kgain, u16* Ks) {
  uint4 kv = make_uint4(x[0], x[1], x[2], x[3]);
  if (kgain) {
    float f[8]; unpack8(kv, f);
    float ss = 0.f;
#pragma unroll
    for (int e = 0; e < 8; ++e) ss += f[e] * f[e];
    ss += __shfl_xor(ss, 1); ss += __shfl_xor(ss, 2); ss += __shfl_xor(ss, 4);
    const float rs = rsqrtf(ss * (1.f / 64.f) + EPSF);
#pragma unroll
    for (int e = 0; e < 8; ++e) f[e] *= rs * kgain[dp * 8 + e];
    kv = pack8(f);
  }
  *(uint4*)(Ks + key * 72 + dp * 8) = kv;
}
DI void v_store2(u32x4v v0, u32x4v v1, int kp, int dp, u16* Vts) {
  unsigned* vd = (unsigned*)(Vts + (dp * 8) * VS + 2 * kp);
#pragma unroll
  for (int d = 0; d < 4; ++d) {
    vd[(2 * d) * (VS / 2)] = (v0[d] & 0xffffu) | (v1[d] << 16);
    vd[(2 * d + 1) * (VS / 2)] = (v0[d] >> 16) | (v1[d] & 0xffff0000u);
  }
}
template <int NTH>
DI void kv_store(int tid, const KVRegs<NTH>& rg, const float* __restrict__ kgain, u16* Ks, u16* Vts) {
  const int dp = tid & 7, kq = (tid & 255) >> 3;
  if (NTH == 256) {
    k_store1(rg.r[0], kq, dp, kgain, Ks); k_store1(rg.r[1], kq + 32, dp, kgain, Ks);
    v_store2(rg.r[2], rg.r[3], kq, dp, Vts);
  } else {
    if (tid < 256) { k_store1(rg.r[0], kq, dp, kgain, Ks); k_store1(rg.r[1], kq + 32, dp, kgain, Ks); }
    else v_store2(rg.r[0], rg.r[1], kq, dp, Vts);
  }
}

DI void score_stage(const bf16x8 (&qf)[4], const u16* Ks, int lane, float sk, float sb, int lower, int lim, f32x16 (&s)[2], float& mx) {
  const int lr = lane & 31, hh = lane >> 5;
#pragma unroll
  for (int sub = 0; sub < 2; ++sub) {
#pragma unroll
    for (int i = 0; i < 16; ++i) s[sub][i] = fmaf(sk, (float)(sub * 32 + (i & 3) + 8 * (i >> 2)), sb);
#pragma unroll
    for (int kk = 0; kk < 4; ++kk) {
      bf16x8 kf = *(const bf16x8*)(Ks + (sub * 32 + lr) * 72 + kk * 16 + hh * 8);
      s[sub] = MFMA32(kf, qf[kk], s[sub]);
    }
  }
  if (lim < lower) { lower = 64; lim = 64; }
  const bool full = (lower <= 0) && (lim >= 63);
  if (!__all(full)) {
    const int lo2 = lower - 4 * hh; const unsigned rng = (unsigned)(lim - lower);
#pragma unroll
    for (int sub = 0; sub < 2; ++sub)
#pragma unroll
      for (int i = 0; i < 16; ++i) {
        const int kc = sub * 32 + (i & 3) + 8 * (i >> 2);
        s[sub][i] = ((unsigned)(kc - lo2) <= rng) ? s[sub][i] : -INFINITY;
      }
  }
  mx = -INFINITY;
#pragma unroll
  for (int sub = 0; sub < 2; ++sub)
#pragma unroll
    for (int i = 0; i < 16; ++i) mx = fmaxf(mx, s[sub][i]);
  mx = fmaxf(mx, __shfl_xor(mx, 32));
}

DI void pv_stage(const f32x16 (&s)[2], const u16* Vts, f32x16 (&o)[2], int lane) {
  const int lr = lane & 31, hh = lane >> 5;
#pragma unroll
  for (int sub = 0; sub < 2; ++sub)
#pragma unroll
    for (int st = 0; st < 2; ++st) {
      uint4 pk;
      pk.x = pack2(s[sub][8 * st + 0], s[sub][8 * st + 1]); pk.y = pack2(s[sub][8 * st + 2], s[sub][8 * st + 3]);
      pk.z = pack2(s[sub][8 * st + 4], s[sub][8 * st + 5]); pk.w = pack2(s[sub][8 * st + 6], s[sub][8 * st + 7]);
      const bf16x8 pf = as_bf16x8(pk);
#pragma unroll
      for (int dt = 0; dt < 2; ++dt) {
        const u16* vp = Vts + (dt * 32 + lr) * VS + sub * 32 + 16 * st + 4 * hh;
        const uint2 lo = *(const uint2*)vp, hi = *(const uint2*)(vp + 8);
        const bf16x8 vf = as_bf16x8(make_uint4(lo.x, lo.y, hi.x, hi.y));
        o[dt] = MFMA32(vf, pf, o[dt]);
      }
    }
}

DI void flash_stage(const bf16x8 (&qf)[4], const u16* Ks, const u16* Vts, f32x16 (&o)[2], float& m, float& l, int lane,
                    float sk, float sb, int lower, int lim) {
  f32x16 s[2]; float mx;
  score_stage(qf, Ks, lane, sk, sb, lower, lim, s, mx);
  const float mn = fmaxf(m, mx);
  const float alpha = fexp2(m - mn);
  const bool same = (mn == m);
  m = mn;
  float ls = 0.f;
#pragma unroll
  for (int sub = 0; sub < 2; ++sub)
#pragma unroll
    for (int i = 0; i < 16; ++i) { const float pv = fexp2(s[sub][i] - mn); s[sub][i] = pv; ls += pv; }
  l = l * alpha + ls;
  if (!__all(same)) {
#pragma unroll
    for (int dt = 0; dt < 2; ++dt)
#pragma unroll
      for (int i = 0; i < 16; ++i) o[dt][i] *= alpha;
  }
  pv_stage(s, Vts, o, lane);
}

DI void dilated_item(const Params& p, int li, int pairitem, char* smem) {
  const int tfull = tidx();
  const int half = tfull >> 8, tid = tfull & 255;
  const int item = pairitem * 2 + half;
  char* kvb = smem + half * (2 * KVBUF);
  const int lane = tid & 63, w = tid >> 6, lr = lane & 31, hh = lane >> 5;
  const int idx16 = item & 15; const int br = (item >> 4) % 3; const int hb = (item / 48) & 7; const int b = item / 384;
  const int d = br == 0 ? 1 : (br == 1 ? 4 : 16);
  const int tile = idx16 / d, resid = idx16 % d;
  const int st0 = (d >= 2 && tile == 0) ? 2 : 0;
  const int u0 = tile * 128;
  const int uq = u0 + 32 * w + lr; const int tq = uq * d + resid;
  const u16* prow = p.proj + (size_t)(b * S_ + tq) * LD_EVEN;
  bf16x8 qf[4];
  load_q(prow + 2048 + hb * 64, p.hy_qg + li * 64, hh, qf);
  const float slope2 = fexp2(-(float)(hb + 1)) * LOG2E;
  const float sk = slope2 * (float)d;
  const u16* kb = p.proj + (size_t)(b * S_ + resid) * LD_EVEN + 2560 + hb * 64;
  const u16* vb = kb + 512;
  const size_t stride = (size_t)d * LD_EVEN;
  const float* kg = p.hy_kg + li * 64;
  f32x16 o[2]; o[0] = zero16(); o[1] = zero16();
  float m = -1e30f, l = 0.f;
  const int uw = u0 + 32 * w;
  KVRegs<256> rg;
  kv_load<256>(tid, kb, vb, stride, u0 - 128 + 64 * st0, 0, 1 << 30, rg);
  __syncthreads();
  kv_store<256>(tid, rg, kg, (u16*)(kvb + (st0 & 1) * KVBUF), (u16*)(kvb + (st0 & 1) * KVBUF) + 64 * 72);
  kv_load<256>(tid, kb, vb, stride, u0 - 64 + 64 * st0, 0, 1 << 30, rg);
  __syncthreads();
#pragma unroll 1
  for (int st = st0; st < 4; ++st) {
    const int ub = u0 - 128 + 64 * st;
    u16* Ks = (u16*)(kvb + (st & 1) * KVBUF); u16* Vts = Ks + 64 * 72;
    if (st + 1 < 4) { u16* Kn = (u16*)(kvb + ((st + 1) & 1) * KVBUF); kv_store<256>(tid, rg, kg, Kn, Kn + 64 * 72); }
    if (st + 2 < 4) kv_load<256>(tid, kb, vb, stride, ub + 128, 0, 1 << 30, rg);
    if (ub + 63 >= 0 && ub <= uw + 31 && ub + 63 >= uw - 128) {
      const int lim = uq - ub;
      const int lower = max(lim - 128, -ub);
      const float sb = slope2 * (float)(ub * d + resid) + sk * (float)(4 * hh);
      flash_stage(qf, Ks, Vts, o, m, l, lane, sk, sb, lower, lim);
    }
    __syncthreads();
  }
  const float lt = l + __shfl_xor(l, 32);
  const float inv = 1.f / lt;
  const size_t trow = (size_t)br * T_ + (size_t)b * S_ + tq;
  if (hh == 0) p.lse[trow * 8 + hb] = (m + log2f(lt)) * LN2;
  u16* orow = p.obr + trow * 512 + hb * 64;
#pragma unroll
  for (int dt = 0; dt < 2; ++dt)
#pragma unroll
    for (int q4 = 0; q4 < 4; ++q4) {
      uint2 ov; ov.x = pack2(o[dt][4 * q4] * inv, o[dt][4 * q4 + 1] * inv); ov.y = pack2(o[dt][4 * q4 + 2] * inv, o[dt][4 * q4 + 3] * inv);
      *(uint2*)(orow + dt * 32 + 8 * q4 + 4 * hh) = ov;
    }
}

DI void post_even_phase(const Params& p, int li) {
  const int tid = tidx();
  const int rsel = tid >> 7, c8 = tid & 127;
  for (int it = blockIdx.x; it < T_ / 4; it += gridDim.x) {
    const int t = it * 4 + rsel;
    const int c = c8 * 8;
    float val[8];
    if (c8 < 64) {
      uint4 raw = *(const uint4*)(p.hbuf + (size_t)t * 1024 + c);
      float o[8]; unpack8(raw, o);
      float ss = 0.f;
#pragma unroll
      for (int j = 0; j < 8; ++j) ss += o[j] * o[j];
      ss += __shfl_xor(ss, 1); ss += __shfl_xor(ss, 2); ss += __shfl_xor(ss, 4); ss += __shfl_xor(ss, 8);
      const float rs = rsqrtf(ss * (1.f / 128.f) + EPSF);
      uint4 graw = *(const uint4*)(p.proj + (size_t)t * LD_EVEN + 1536 + c);
      float gt[8]; unpack8(graw, gt);
#pragma unroll
      for (int j = 0; j < 8; ++j) val[j] = o[j] * rs * p.hy_og[li * 512 + c + j] * fsilu(gt[j]);
    } else {
      const int cb = c - 512, hb = cb >> 6;
      float l0 = p.lse[((size_t)0 * T_ + t) * 8 + hb], l1 = p.lse[((size_t)1 * T_ + t) * 8 + hb], l2 = p.lse[((size_t)2 * T_ + t) * 8 + hb];
      const float mx = fmaxf(l0, fmaxf(l1, l2));
      float w0 = __expf(l0 - mx), w1 = __expf(l1 - mx), w2 = __expf(l2 - mx);
      const float inv = 1.f / (w0 + w1 + w2);
      w0 *= inv; w1 *= inv; w2 *= inv;
      float a[8], bq[8], cq[8];
      unpack8(*(const uint4*)(p.obr + ((size_t)0 * T_ + t) * 512 + cb), a);
      unpack8(*(const uint4*)(p.obr + ((size_t)1 * T_ + t) * 512 + cb), bq);
      unpack8(*(const uint4*)(p.obr + ((size_t)2 * T_ + t) * 512 + cb), cq);
#pragma unroll
      for (int j = 0; j < 8; ++j) val[j] = w0 * a[j] + w1 * bq[j] + w2 * cq[j];
    }
    *(uint4*)(p.hbuf + (size_t)t * 1024 + c) = pack8(val);
  }
}

DI void compress_item(const Params& p, int li, int pairitem, char* smem) {
  const int tfull = tidx();
  const int half = tfull >> 8, tid = tfull & 255;
  const int item = pairitem * 2 + half;
  u16* hs = (u16*)(smem + half * 17408);
  float* outs = (float*)(smem + half * 17408 + 32 * 136 * 2);
  const int lane = tid & 63, w = tid >> 6, lr = lane & 31, hh = lane >> 5;
  const int nt = item & 3, g = (item >> 2) & 3, b = (item >> 4) & 15, kv = item >> 8;
  const int n = nt * 32 + lr; const int nc = n > 126 ? 126 : n;
  const int col = 1024 + kv * 256 + g * 64;
  const u16* arow = p.proj + (size_t)(b * S_ + 16 * nc) * LD_ODD + col;
  const u16* w1t = p.wt_c1 + (size_t)(li * 2 + kv) * 128 * 2048 + (size_t)(32 * w + lr) * 2048;
  f32x16 acc = zero16();
#pragma unroll 16
  for (int ks = 0; ks < 128; ++ks) {
    const int lidx = ks >> 2, dd = (ks & 3) * 16 + hh * 8;
    const bf16x8 a = as_bf16x8(*(const uint4*)(arow + (size_t)lidx * LD_ODD + dd));
    const bf16x8 bb = as_bf16x8(*(const uint4*)(w1t + ks * 16 + hh * 8));
    acc = MFMA32(a, bb, acc);
  }
  const float cb = p.c1[(li * 2 + kv) * 128 + 32 * w + lr];
  __syncthreads();
#pragma unroll
  for (int i = 0; i < 16; ++i) {
    const int r = (i & 3) + 8 * (i >> 2) + 4 * hh;
    hs[r * 136 + 32 * w + lr] = f2bf(fsilu(acc[i] + cb));
  }
  __syncthreads();
  if (w < 2) {
    const u16* w2t = p.wt_c2 + (size_t)(li * 2 + kv) * 64 * 128 + (size_t)(w * 32 + lr) * 128;
    f32x16 a2 = zero16();
#pragma unroll
    for (int kk = 0; kk < 8; ++kk) {
      const bf16x8 a = *(const bf16x8*)(hs + lr * 136 + kk * 16 + hh * 8);
      const bf16x8 bb = as_bf16x8(*(const uint4*)(w2t + kk * 16 + hh * 8));
      a2 = MFMA32(a, bb, a2);
    }
#pragma unroll
    for (int i = 0; i < 16; ++i) {
      const int r = (i & 3) + 8 * (i >> 2) + 4 * hh;
      outs[r * 65 + w * 32 + lr] = a2[i];
    }
  }
  __syncthreads();
  {
    const int r = tid >> 3, c8 = tid & 7;
    float v[8]; float ss = 0.f;
#pragma unroll
    for (int j = 0; j < 8; ++j) { v[j] = outs[r * 65 + c8 * 8 + j]; ss += v[j] * v[j]; }
    ss += __shfl_xor(ss, 1); ss += __shfl_xor(ss, 2); ss += __shfl_xor(ss, 4);
    if (kv == 0) {
      const float rs = rsqrtf(ss * (1.f / 64.f) + EPSF);
#pragma unroll
      for (int j = 0; j < 8; ++j) v[j] *= rs * p.nsa_kg[(li * 3 + 0) * 64 + c8 * 8 + j];
    }
    const int nn = nt * 32 + r;
    if (nn >= 127) {
#pragma unroll
      for (int j = 0; j < 8; ++j) v[j] = 0.f;
    }
    u16* dst = (kv == 0 ? p.kcmp : p.vcmp) + ((size_t)(b * 4 + g) * 128 + nn) * 64 + c8 * 8;
    *(uint4*)dst = pack8(v);
  }
  __syncthreads();
}

DI void nsa_knorm_phase(const Params& p, int li) {
  const int tid = tidx();
  for (int u = blockIdx.x * NT + tid; u < T_ * 64; u += gridDim.x * NT) {
    const int piece = u & 7, head = (u >> 3) & 3, br = (u >> 5) & 1, row = u >> 6;
    u16* ptr = p.proj + (size_t)row * LD_ODD + 1536 + br * 512 + head * 64 + piece * 8;
    float f[8]; unpack8(*(const uint4*)ptr, f);
    float ss = 0.f;
#pragma unroll
    for (int e = 0; e < 8; ++e) ss += f[e] * f[e];
    ss += __shfl_xor(ss, 1); ss += __shfl_xor(ss, 2); ss += __shfl_xor(ss, 4);
    const float rs = rsqrtf(ss * (1.f / 64.f) + EPSF);
    const float* kg = p.nsa_kg + (li * 3 + 1 + br) * 64 + piece * 8;
#pragma unroll
    for (int e = 0; e < 8; ++e) f[e] *= rs * kg[e];
    *(uint4*)ptr = pack8(f);
  }
}

DI void nsa_item(const Params& p, int li, int item, char* smem) {
  float* impA = (float*)(smem + 2 * KVBUF);
  float* impB = impA + 8192;
  float* imp = impB + 8192;
  unsigned* selm = (unsigned*)(imp + 64 * 33);
  const int tid = tidx(), lane = tid & 63, wv = tid >> 6, lr = lane & 31, hh = lane >> 5;
  const int w = wv & 3, half = wv >> 2;
  const int tt = item & 31, g = (item >> 5) & 3, b = item >> 7;
  const int t0 = tt * 64; const int cur = t0 >> 6;
  const int hd = g * 4 + w;
  const int tokl = 32 * half + lr;
  const int tq = t0 + tokl;
  const u16* pb = p.proj + (size_t)b * S_ * LD_ODD;
  const u16* prow = pb + (size_t)tq * LD_ODD;
  bf16x8 qf[4];
  load_q(prow + g * 256 + w * 64, p.nsa_qg + li * 64, hh, qf);
  const float slope2 = fexp2(-0.5f * (float)(hd + 1)) * LOG2E;
  const float g0 = fsigmoid(bf2f(prow[2560 + 0 + g * 4 + w]));
  const float g1 = fsigmoid(bf2f(prow[2560 + 16 + g * 4 + w]));
  const float g2 = fsigmoid(bf2f(prow[2560 + 32 + g * 4 + w]));
  f32x16 ot[2]; ot[0] = zero16(); ot[1] = zero16();
  {
    const u16* kb = p.kcmp + (size_t)(b * 4 + g) * 128 * 64;
    const u16* vb = p.vcmp + (size_t)(b * 4 + g) * 128 * 64;
    const float sk = 16.f * slope2;
    const int limc = min((tq - 31) >> 4, 126);
    const int nst = (1024 > t0) ? 1 : 2;
    {
      KVRegs<512> rg0;
      kv_load<512>(tid, kb, vb, 64, 0, 0, 128, rg0);
      __syncthreads();
      kv_store<512>(tid, rg0, nullptr, (u16*)smem, (u16*)smem + 64 * 72);
      if (nst > 1) {
        kv_load<512>(tid, kb, vb, 64, 64, 0, 128, rg0);
        kv_store<512>(tid, rg0, nullptr, (u16*)(smem + KVBUF), (u16*)(smem + KVBUF) + 64 * 72);
      }
    }
    __syncthreads();
    float m = -1e30f, l = 0.f;
#pragma unroll
    for (int st = 0; st < 2; ++st) {
      if (st >= nst) continue;
      const u16* Ks = (const u16*)(smem + st * KVBUF);
      f32x16 s[2]; float mx;
      const float sb = slope2 * (float)(1024 * st + 31) + sk * (float)(4 * hh);
      score_stage(qf, Ks, lane, sk, sb, 0, limc - 64 * st, s, mx);
      const float mn = fmaxf(m, mx);
      float ls = 0.f;
#pragma unroll
      for (int sub = 0; sub < 2; ++sub)
#pragma unroll
        for (int i = 0; i < 16; ++i) ls += fexp2(s[sub][i] - mn);
      l = l * fexp2(m - mn) + ls;
      m = mn;
    }
    const float lt = l + __shfl_xor(l, 32);
    const float inv = lt > 0.f ? 1.f / lt : 0.f;
    f32x16 o[2]; o[0] = zero16(); o[1] = zero16();
#pragma unroll
    for (int st = 0; st < 2; ++st) {
      if (st >= nst) {
#pragma unroll
        for (int G = 0; G < 16; ++G) {
          if ((G & 1) == hh) { impA[(w * 64 + tokl) * 32 + 16 * st + G] = 0.f; impB[(w * 64 + tokl) * 32 + 16 * st + G] = 0.f; }
        }
        continue;
      }
      const u16* Ks = (const u16*)(smem + st * KVBUF); const u16* Vts = Ks + 64 * 72;
      f32x16 s[2]; float mx;
      const float sb = slope2 * (float)(1024 * st + 31) + sk * (float)(4 * hh);
      score_stage(qf, Ks, lane, sk, sb, 0, limc - 64 * st, s, mx);
#pragma unroll
      for (int sub = 0; sub < 2; ++sub)
#pragma unroll
        for (int i = 0; i < 16; ++i) s[sub][i] = fexp2(s[sub][i] - m) * inv;
#pragma unroll
      for (int sub = 0; sub < 2; ++sub)
#pragma unroll
        for (int q4 = 0; q4 < 4; ++q4) {
          const int G = 16 * st + 8 * sub + 2 * q4 + hh;
          impA[(w * 64 + tokl) * 32 + G] = (s[sub][4 * q4] + s[sub][4 * q4 + 1]) + (s[sub][4 * q4 + 2] + s[sub][4 * q4 + 3]);
          impB[(w * 64 + tokl) * 32 + G] = s[sub][4 * q4 + 3];
        }
      pv_stage(s, Vts, o, lane);
    }
#pragma unroll
    for (int dt = 0; dt < 2; ++dt)
#pragma unroll
      for (int i = 0; i < 16; ++i) ot[dt][i] += g0 * o[dt][i];
  }
  const u16* kbs = pb + 1536 + g * 64; const u16* vbs = pb + 1792 + g * 64;
  KVRegs<512> rg;
  kv_load<512>(tid, kbs, vbs, LD_ODD, 0, 0, S_, rg);
  __syncthreads();
  for (int idx = tid; idx < 2048; idx += NT) {
    const int tok = idx >> 5, mm = idx & 31;
    float a = 0.f;
#pragma unroll
    for (int ww = 0; ww < 4; ++ww) a += impA[(ww * 64 + tok) * 32 + mm] + (mm > 0 ? impB[(ww * 64 + tok) * 32 + mm - 1] : 0.f);
    imp[tok * 33 + mm] = a;
  }
  __syncthreads();
  float* ots = impA + tid;
#pragma unroll
  for (int dt = 0; dt < 2; ++dt)
#pragma unroll
    for (int i = 0; i < 16; ++i) ots[(dt * 16 + i) * NT] = ot[dt][i];
  {
    const int tok = tid >> 3, sub8 = tid & 7;
    unsigned sel = 1u | (1u << cur) | (cur > 0 ? (1u << (cur - 1)) : 0u);
    const int cnt = __popc(sel);
    float cv[4];
#pragma unroll
    for (int e = 0; e < 4; ++e) cv[e] = imp[tok * 33 + sub8 * 4 + e];
    for (int r = cnt; r < 8; ++r) {
      float bv = -1.f; int bi = 64;
#pragma unroll
      for (int e = 0; e < 4; ++e) {
        const int mm = sub8 * 4 + e;
        const bool ok = (mm <= cur) && !((sel >> mm) & 1u);
        if (ok && cv[e] > bv) { bv = cv[e]; bi = mm; }
      }
#pragma unroll
      for (int off = 1; off < 8; off <<= 1) {
        const float ov = __shfl_xor(bv, off); const int oi = __shfl_xor(bi, off);
        if (ov > bv || (ov == bv && oi < bi)) { bv = ov; bi = oi; }
      }
      if (bi < 64) sel |= 1u << bi;
    }
    if (sub8 == 0) selm[tok] = sel;
  }
  __syncthreads();
  const unsigned myMask = selm[tokl];
  unsigned uni = 0u;
#pragma unroll 8
  for (int i = 0; i < 64; ++i) uni |= selm[i];
  {
    f32x16 o[2]; o[0] = zero16(); o[1] = zero16();
    float m = -1e30f, l = 0.f;
    const float* kg = nullptr;
    unsigned rem = uni & (uni - 1u);
    int mb = 0;
    int mbn = rem ? __builtin_ctz(rem) : -1;
    kv_store<512>(tid, rg, kg, (u16*)smem, (u16*)smem + 64 * 72);
    if (mbn >= 0) kv_load<512>(tid, kbs, vbs, LD_ODD, 64 * mbn, 0, S_, rg);
    __syncthreads();
    int par = 0;
#pragma unroll 1
    while (true) {
      u16* Ks = (u16*)(smem + par * KVBUF); u16* Vts = Ks + 64 * 72;
      int mbn2 = -1;
      if (mbn >= 0) {
        u16* Kn = (u16*)(smem + (par ^ 1) * KVBUF);
        kv_store<512>(tid, rg, kg, Kn, Kn + 64 * 72);
        rem &= rem - 1u;
        mbn2 = rem ? __builtin_ctz(rem) : -1;
        if (mbn2 >= 0) kv_load<512>(tid, kbs, vbs, LD_ODD, 64 * mbn2, 0, S_, rg);
      }
      const bool selb = (myMask >> mb) & 1u;
      const float sb = slope2 * (float)(64 * mb) + slope2 * (float)(4 * hh);
      if (__any(selb)) flash_stage(qf, Ks, Vts, o, m, l, lane, slope2, sb, 0, selb ? (tq - 64 * mb) : -1);
      __syncthreads();
      if (mbn < 0) break;
      mb = mbn; mbn = mbn2; par ^= 1;
    }
    const float lt = l + __shfl_xor(l, 32);
    const float sc = g1 / lt;
#pragma unroll
    for (int dt = 0; dt < 2; ++dt)
#pragma unroll
      for (int i = 0; i < 16; ++i) ots[(dt * 16 + i) * NT] += sc * o[dt][i];
  }
  {
    f32x16 o[2]; o[0] = zero16(); o[1] = zero16();
    float m = -1e30f, l = 0.f;
    const u16* kb = pb + 2048 + g * 64; const u16* vb = pb + 2304 + g * 64;
    const float* kg = nullptr;
    const int mlo = (t0 - 511) < 0 ? 0 : ((t0 - 511) >> 6);
    kv_load<512>(tid, kb, vb, LD_ODD, 64 * mlo, 0, S_, rg);
    kv_store<512>(tid, rg, kg, (u16*)smem, (u16*)smem + 64 * 72);
    if (mlo + 1 <= cur) kv_load<512>(tid, kb, vb, LD_ODD, 64 * (mlo + 1), 0, S_, rg);
    __syncthreads();
#pragma unroll 1
    for (int mb = mlo; mb <= cur; ++mb) {
      const int par = (mb - mlo) & 1;
      u16* Ks = (u16*)(smem + par * KVBUF); u16* Vts = Ks + 64 * 72;
      if (mb + 1 <= cur) { u16* Kn = (u16*)(smem + (par ^ 1) * KVBUF); kv_store<512>(tid, rg, kg, Kn, Kn + 64 * 72); }
      if (mb + 2 <= cur) kv_load<512>(tid, kb, vb, LD_ODD, 64 * (mb + 2), 0, S_, rg);
      const int lim = tq - 64 * mb;
      const float sb = slope2 * (float)(64 * mb) + slope2 * (float)(4 * hh);
      flash_stage(qf, Ks, Vts, o, m, l, lane, slope2, sb, lim - 511, lim);
      __syncthreads();
    }
    const float lt = l + __shfl_xor(l, 32);
    const float sc = g2 / lt;
    u16* orow = p.hbuf + (size_t)(b * S_ + tq) * 1024 + g * 256 + w * 64;
#pragma unroll
    for (int dt = 0; dt < 2; ++dt)
#pragma unroll
      for (int q4 = 0; q4 < 4; ++q4) {
        const float a0 = ots[(dt * 16 + 4 * q4 + 0) * NT] + sc * o[dt][4 * q4 + 0], a1 = ots[(dt * 16 + 4 * q4 + 1) * NT] + sc * o[dt][4 * q4 + 1];
        const float a2 = ots[(dt * 16 + 4 * q4 + 2) * NT] + sc * o[dt][4 * q4 + 2], a3 = ots[(dt * 16 + 4 * q4 + 3) * NT] + sc * o[dt][4 * q4 + 3];
        uint2 ov; ov.x = pack2(a0, a1); ov.y = pack2(a2, a3);
        *(uint2*)(orow + dt * 32 + 8 * q4 + 4 * hh) = ov;
      }
  }
  __syncthreads();
}

DI void run_phase(const Params& p, int ph, char* smem) {
  if (ph == 0) { prep_phase(p, smem); return; }
  const int l = (ph - 1) >> 3, s = (ph - 1) & 7, li = l >> 1;
  const bool even = (l & 1) == 0;
  const float* xin = (l == 0) ? p.x : p.out;
  switch (s) {
    case 0: rmsnorm_phase(xin, p.attn_norm + l * 1024, p.hbuf); break;
    case 1:
      if (even) gemm_phase<0>(p.hbuf, p.wt_hy_in + (size_t)li * 3584 * 1024, 1024, 14, p.proj, LD_EVEN, nullptr, nullptr, smem);
      else gemm_phase<0>(p.hbuf, p.wt_nsa_in + (size_t)li * 2816 * 1024, 1024, 11, p.proj, LD_ODD, nullptr, nullptr, smem);
      break;
    case 2:
      if (even) {
        for (int item = blockIdx.x; item < 256 + 3072; item += gridDim.x) {
          if (item < 256) hgrn_item(p, li, item, smem); else dilated_item(p, li, item - 256, smem);
        }
      } else {
        for (int item = blockIdx.x; item < 256; item += gridDim.x) compress_item(p, li, item, smem);
        nsa_knorm_phase(p, li);
      }
      break;
    case 3:
      if (even) post_even_phase(p, li);
      else {
        for (int item = blockIdx.x; item < 2048; item += gridDim.x) {
          const int r = item / gridDim.x, i = item % gridDim.x;
          int it2 = item;
          if (gridDim.x == 256) {
            const int c = (i + 4 * (r >> 1)) & 31;
            const int tt = (r & 1) ? 31 - c : c;
            it2 = ((i >> 5) + 8 * r) * 32 + tt;
          }
          nsa_item(p, li, it2, smem);
        }
      }
      break;
    case 4:
      gemm_phase<1>(p.hbuf, (even ? p.wt_hy_out : p.wt_nsa_out) + (size_t)li * 1048576, 1024, 4, nullptr, 0, xin, p.out, smem);
      break;
    case 5: rmsnorm_phase(p.out, p.ffn_norm + l * 1024, p.hbuf); break;
    case 6: gemm_phase<2>(p.hbuf, p.wt_gu + (size_t)l * 5632 * 1024, 1024, 22, p.proj, DFF, nullptr, nullptr, smem); break;
    case 7: gemm_phase<1>(p.proj, p.wt_dn + (size_t)l * 1024 * 2816, 2816, 4, nullptr, 0, p.out, p.out, smem); break;
  }
}

__global__ void __launch_bounds__(512) mk_forward(Params p) {
  __shared__ __attribute__((aligned(16))) char smem[131072];
  __shared__ uint4 xb_words;
  cg::grid_group grid = cg::this_grid();
  if (__builtin_amdgcn_workitem_id_x() == 0) xb_words = make_uint4(0u, 0u, 0u, 0u);
  __syncthreads();
  const XcdBarrier xb = xcd_barrier_post(p.bar, (volatile LAS unsigned*)&xb_words);
  for (int ph = p.phase_lo; ph < p.phase_hi; ++ph) {
    run_phase(p, ph, smem);
    if (ph + 1 < p.phase_hi) {
      if (p.phase_hi < 0) grid.sync();
      xcd_barrier(xb);
    }
  }
}

extern "C" void kernel_launch(void* const* d_in, const int* in_sizes, int n_in, void* d_out, int out_size,
                              void* d_ws, size_t ws_size, hipStream_t stream) {
  static int grid_blocks = 0;
  if (!grid_blocks) {
    int dev = 0, cus = 0, per_cu = 0;
    hipGetDevice(&dev);
    hipDeviceGetAttribute(&cus, hipDeviceAttributeMultiprocessorCount, dev);
    hipOccupancyMaxActiveBlocksPerMultiprocessor(&per_cu, mk_forward, 512, 0);
    if (per_cu > 1) per_cu = 1;
    if (per_cu < 1) per_cu = 1;
    grid_blocks = cus * per_cu;
  }
  Params p;
  memset(&p, 0, sizeof(p));
  p.x = (const float*)d_in[0]; p.attn_norm = (const float*)d_in[1]; p.ffn_norm = (const float*)d_in[2];
  p.hy_w_in = (const float*)d_in[3]; p.hy_lb = (const float*)d_in[4]; p.hy_og = (const float*)d_in[5];
  p.hy_qg = (const float*)d_in[6]; p.hy_kg = (const float*)d_in[7]; p.hy_w_out = (const float*)d_in[8];
  p.nsa_w_in = (const float*)d_in[9]; p.nsa_qg = (const float*)d_in[10]; p.nsa_kg = (const float*)d_in[11];
  p.cmp_pe = (const float*)d_in[12]; p.cmp_w1 = (const float*)d_in[13]; p.cmp_w2 = (const float*)d_in[14];
  p.nsa_w_out = (const float*)d_in[15]; p.ffn_g = (const float*)d_in[16]; p.ffn_u = (const float*)d_in[17]; p.ffn_d = (const float*)d_in[18];
  p.out = (float*)d_out;
  char* ws = (char*)d_ws; size_t off = 0;
  auto take = [&](size_t bytes) { char* r = ws + off; off += (bytes + 255) & ~(size_t)255; return r; };
  p.wt_hy_in = (u16*)take((size_t)2 * 3584 * 1024 * 2);
  p.wt_hy_out = (u16*)take((size_t)2 * 1048576 * 2);
  p.wt_nsa_in = (u16*)take((size_t)2 * 2816 * 1024 * 2);
  p.wt_nsa_out = (u16*)take((size_t)2 * 1048576 * 2);
  p.wt_gu = (u16*)take((size_t)4 * 5632 * 1024 * 2);
  p.wt_dn = (u16*)take((size_t)4 * 1024 * 2816 * 2);
  p.wt_c1 = (u16*)take((size_t)4 * 128 * 2048 * 2);
  p.wt_c2 = (u16*)take((size_t)4 * 64 * 128 * 2);
  p.c1 = (float*)take(4 * 128 * 4);
  p.lb = (float*)take(2 * 512 * 4);
  p.lse = (float*)take((size_t)3 * T_ * 8 * 4);
  p.proj = (u16*)take((size_t)T_ * 3584 * 2);
  p.hbuf = (u16*)take((size_t)T_ * 1024 * 2);
  p.obr = (u16*)take((size_t)3 * T_ * 512 * 2);
  p.kcmp = (u16*)take((size_t)16 * 4 * 128 * 64 * 2);
  p.vcmp = (u16*)take((size_t)16 * 4 * 128 * 64 * 2);
  p.bar = (unsigned*)take(XCD_BAR_WORDS * 4);
  if (off > ws_size) { fprintf(stderr, "workspace too small: need %zu have %zu\n", off, ws_size); return; }
  const int NPH = 33;
  hipMemsetAsync(p.bar, 0, XCD_BAR_WORDS * 4, stream);
#if MK_MULTI
  for (int ph = 0; ph < NPH; ++ph) {
    p.phase_lo = ph; p.phase_hi = ph + 1;
    hipLaunchKernelGGL(mk_forward, dim3(grid_blocks), dim3(512), 0, stream, p);
  }
#else
  p.phase_lo = 0; p.phase_hi = NPH;
  void* args[] = {&p};
  hipError_t e = hipLaunchCooperativeKernel((void*)mk_forward, dim3(grid_blocks), dim3(512), args, 0, stream);
  if (e != hipSuccess) fprintf(stderr, "cooperative launch failed: %s (grid %d)\n", hipGetErrorString(e), grid_blocks);
#endif
}
```

```cpp
#include <hip/hip_runtime.h>
#include <hip/hip_cooperative_groups.h>
#include <cstdio>
#include <cstdint>
#include <cstring>
namespace cg = cooperative_groups;

typedef unsigned short u16;
using bf16x8 = __attribute__((ext_vector_type(8))) short;
using f32x16 = __attribute__((ext_vector_type(16))) float;
using u32x4v = __attribute__((ext_vector_type(4))) unsigned;
#define DI __device__ __forceinline__
#define MFMA32(a, b, c) __builtin_amdgcn_mfma_f32_32x32x16_bf16((a), (b), (c), 0, 0, 0)

#ifndef MK_MULTI
#define MK_MULTI 0
#endif

constexpr int T_ = 32768, S_ = 2048;
constexpr float EPSF = 1e-6f;
constexpr float LOG2E = 1.4426950408889634f, LN2 = 0.6931471805599453f;
constexpr int LD_EVEN = 3584, LD_ODD = 2816, DFF = 2816;
constexpr int NT = 512;
#define LAS __attribute__((address_space(3)))
using f32x4v = __attribute__((ext_vector_type(4))) float;

struct Params {
  const float* x; const float* attn_norm; const float* ffn_norm;
  const float* hy_w_in; const float* hy_lb; const float* hy_og; const float* hy_qg; const float* hy_kg; const float* hy_w_out;
  const float* nsa_w_in; const float* nsa_qg; const float* nsa_kg; const float* cmp_pe; const float* cmp_w1; const float* cmp_w2; const float* nsa_w_out;
  const float* ffn_g; const float* ffn_u; const float* ffn_d;
  float* out;
  u16* wt_hy_in; u16* wt_hy_out; u16* wt_nsa_in; u16* wt_nsa_out; u16* wt_gu; u16* wt_dn; u16* wt_c1; u16* wt_c2;
  float* c1; float* lb; float* lse;
  u16* proj; u16* hbuf; u16* obr; u16* kcmp; u16* vcmp;
  unsigned* bar;
  int phase_lo; int phase_hi;
};

DI int tidx() { int t = __builtin_amdgcn_workitem_id_x(); asm volatile("" : "+v"(t)); return t; }
DI float bf2f(u16 h) { return __uint_as_float(((unsigned)h) << 16); }
typedef __bf16 bf16x2_t __attribute__((ext_vector_type(2)));
typedef float f32x2_t __attribute__((ext_vector_type(2)));
DI unsigned pack2(float a, float b) { f32x2_t v = {a, b}; bf16x2_t r = __builtin_convertvector(v, bf16x2_t); return __builtin_bit_cast(unsigned, r); }
DI u16 f2bf(float x) { return (u16)(pack2(x, 0.f) & 0xffffu); }
DI float fsigmoid(float x) { return 1.f / (1.f + __expf(-x)); }
DI float fsilu(float x) { return x / (1.f + __expf(-x)); }
DI float fexp2(float x) { return __builtin_amdgcn_exp2f(x); }
DI void unpack8(uint4 v, float (&f)[8]) {
  f[0] = __uint_as_float(v.x << 16); f[1] = __uint_as_float(v.x & 0xffff0000u);
  f[2] = __uint_as_float(v.y << 16); f[3] = __uint_as_float(v.y & 0xffff0000u);
  f[4] = __uint_as_float(v.z << 16); f[5] = __uint_as_float(v.z & 0xffff0000u);
  f[6] = __uint_as_float(v.w << 16); f[7] = __uint_as_float(v.w & 0xffff0000u);
}
DI uint4 pack8(const float (&f)[8]) {
  uint4 o; o.x = pack2(f[0], f[1]); o.y = pack2(f[2], f[3]); o.z = pack2(f[4], f[5]); o.w = pack2(f[6], f[7]); return o;
}
DI bf16x8 as_bf16x8(uint4 v) { u32x4v t; t[0] = v.x; t[1] = v.y; t[2] = v.z; t[3] = v.w; return __builtin_bit_cast(bf16x8, t); }
DI f32x16 zero16() { f32x16 z;
#pragma unroll
  for (int i = 0; i < 16; ++i) z[i] = 0.f; return z; }


#define XB_TMO      128
#define XB_XCNT(j)  (256  + 64 * (j))
#define XB_XSUB(j)  (1280 + 64 * (j))
#define XB_XGEN(j)  (2304 + 64 * (j))
#define XB_TOP      3328
#define XB_TOPGEN   3392
#define XCD_BAR_WORDS 3456
#define XB_SPIN_CAP (1u << 18)
DI unsigned xb_ld(unsigned* p) { return __hip_atomic_load(p, __ATOMIC_RELAXED, __HIP_MEMORY_SCOPE_AGENT); }
DI unsigned xb_add(unsigned* p, unsigned v) { return __hip_atomic_fetch_add(p, v, __ATOMIC_RELAXED, __HIP_MEMORY_SCOPE_AGENT); }
DI unsigned xb_xcc_id() { return (unsigned)__builtin_amdgcn_s_getreg((3 << 11) | 20) & 0xFu; }
#define XB_SPIN(cond, bar) do { unsigned _sp = 0; while (cond) { __builtin_amdgcn_s_sleep(1); \
    if ((++_sp & 255u) == 0u) { if (xb_ld(&(bar)[XB_TMO])) break; if (_sp > XB_SPIN_CAP) { atomicAdd(&(bar)[XB_TMO], 1u); break; } } } } while (0)
struct XcdBarrier { unsigned* bar; unsigned x; volatile LAS unsigned* st; };
DI XcdBarrier xcd_barrier_post(unsigned* bar, volatile LAS unsigned* st) {
  XcdBarrier b; b.bar = bar; b.x = xb_xcc_id(); b.st = st;
  if (__builtin_amdgcn_workitem_id_x() == 0) (void)xb_add(&bar[XB_XCNT(b.x)], 1u);
  return b;
}
DI void xcd_barrier_complete(unsigned* bar, unsigned x, unsigned& nloc, unsigned& nx) {
  const unsigned G = gridDim.x * gridDim.y * gridDim.z;
  unsigned sum, cnt, mine, sp = 0u;
  for (;;) {
    sum = 0u; cnt = 0u; mine = 0u;
#pragma unroll
    for (unsigned j = 0; j < 16; ++j) { const unsigned c = xb_ld(&bar[XB_XCNT(j)]); sum += c; cnt += (c > 0u) ? 1u : 0u; mine = (j == x) ? c : mine; }
    if (sum == G) break;
    __builtin_amdgcn_s_sleep(1);
    if ((++sp & 255u) == 0u) { if (xb_ld(&bar[XB_TMO])) break; if (sp > XB_SPIN_CAP) { atomicAdd(&bar[XB_TMO], 1u); break; } }
  }
  nloc = mine > 0u ? mine : 1u; nx = cnt > 0u ? cnt : 1u;
}
DI void xcd_barrier(const XcdBarrier& b) {
  asm volatile("s_waitcnt vmcnt(0)" ::: "memory");
  __syncthreads();
  if (__builtin_amdgcn_workitem_id_x() == 0) {
    unsigned* bar = b.bar;
    __builtin_amdgcn_s_waitcnt(0);
    unsigned nloc = b.st[0], nx = b.st[1];
    if (nloc == 0u) { xcd_barrier_complete(bar, b.x, nloc, nx); b.st[0] = nloc; b.st[1] = nx; }
    const unsigned old = xb_add(&bar[XB_XSUB(b.x)], 1u);
    const unsigned gen = old / nloc;
    if (old + 1u == (gen + 1u) * nloc) {
      __builtin_amdgcn_fence(__ATOMIC_RELEASE, "agent");
      asm volatile("s_waitcnt vmcnt(0)" ::: "memory");
      const unsigned og = xb_add(&bar[XB_TOP], 1u);
      const unsigned tg = og / nx;
      if (og + 1u == (tg + 1u) * nx) xb_add(&bar[XB_TOPGEN], 1u);
      else XB_SPIN(xb_ld(&bar[XB_TOPGEN]) == tg, bar);
      __builtin_amdgcn_fence(__ATOMIC_ACQUIRE, "agent");
      xb_add(&bar[XB_XGEN(b.x)], 1u);
      asm volatile("s_waitcnt vmcnt(0)" ::: "memory");
    } else {
      XB_SPIN(xb_ld(&bar[XB_XGEN(b.x)]) == gen, bar);
      __builtin_amdgcn_fence(__ATOMIC_ACQUIRE, "agent");
      asm volatile("s_waitcnt vmcnt(0)" ::: "memory");
    }
  }
  __syncthreads();
}

struct PrepDesc { const float* src; u16* dst; int K, N, mode, tk, tn; };
DI PrepDesc prep_desc(const Params& p, int tile) {
  constexpr int G0 = 1792, G1 = 2304, G2 = 3712, G3 = 4224, G4 = 7040, G5 = 9856, G6 = 12672, G7 = 12928;
  PrepDesc d; int Np, lt; d.mode = 0;
  if (tile < G0) { int i = tile / 896; lt = tile % 896; d.src = p.hy_w_in + (size_t)i * 1024 * 3584; d.dst = p.wt_hy_in + (size_t)i * 3584 * 1024; d.K = 1024; d.N = 3584; Np = 3584; }
  else if (tile < G1) { int t = tile - G0; int i = t / 256; lt = t % 256; d.src = p.hy_w_out + (size_t)i * 1048576; d.dst = p.wt_hy_out + (size_t)i * 1048576; d.K = 1024; d.N = 1024; Np = 1024; }
  else if (tile < G2) { int t = tile - G1; int i = t / 704; lt = t % 704; d.src = p.nsa_w_in + (size_t)i * 1024 * 2608; d.dst = p.wt_nsa_in + (size_t)i * 2816 * 1024; d.K = 1024; d.N = 2608; Np = 2816; }
  else if (tile < G3) { int t = tile - G2; int i = t / 256; lt = t % 256; d.src = p.nsa_w_out + (size_t)i * 1048576; d.dst = p.wt_nsa_out + (size_t)i * 1048576; d.K = 1024; d.N = 1024; Np = 1024; }
  else if (tile < G4) { int t = tile - G3; int i = t / 704; lt = t % 704; d.src = p.ffn_g + (size_t)i * 1024 * 2816; d.dst = p.wt_gu + (size_t)i * 5632 * 1024; d.K = 1024; d.N = 2816; Np = 2816; d.mode = 1; }
  else if (tile < G5) { int t = tile - G4; int i = t / 704; lt = t % 704; d.src = p.ffn_u + (size_t)i * 1024 * 2816; d.dst = p.wt_gu + (size_t)i * 5632 * 1024; d.K = 1024; d.N = 2816; Np = 2816; d.mode = 2; }
  else if (tile < G6) { int t = tile - G5; int i = t / 704; lt = t % 704; d.src = p.ffn_d + (size_t)i * 2816 * 1024; d.dst = p.wt_dn + (size_t)i * 1024 * 2816; d.K = 2816; d.N = 1024; Np = 1024; }
  else if (tile < G7) { int t = tile - G6; int i = t / 64; lt = t % 64; d.src = p.cmp_w1 + (size_t)i * 2048 * 128; d.dst = p.wt_c1 + (size_t)i * 128 * 2048; d.K = 2048; d.N = 128; Np = 128; }
  else { int t = tile - G7; int i = t / 2; lt = t % 2; d.src = p.cmp_w2 + (size_t)i * 128 * 64; d.dst = p.wt_c2 + (size_t)i * 64 * 128; d.K = 128; d.N = 64; Np = 64; }
  const int ntn = Np / 64;
  d.tk = lt / ntn; d.tn = lt % ntn;
  return d;
}
DI void prep_load(const PrepDesc& d, int tid, float (&rv)[8]) {
  const int c = tid & 63; const int n = d.tn * 64 + c;
#pragma unroll
  for (int j = 0; j < 8; ++j) {
    const int r = (tid >> 6) + 8 * j;
    rv[j] = (n < d.N) ? d.src[(size_t)(d.tk * 64 + r) * d.N + n] : 0.f;
  }
}

DI void prep_phase(const Params& p, char* smem) {
  float* sm = (float*)smem;
  constexpr int G8 = 12936;
  const int tid = tidx();
  float rv[8];
  int tile = blockIdx.x;
  asm volatile("" : "+s"(tile));
  if (tile < G8) { const PrepDesc d0 = prep_desc(p, tile); prep_load(d0, tid, rv); }
  for (; tile < G8; tile += gridDim.x) {
    const PrepDesc d = prep_desc(p, tile);
    __syncthreads();
#pragma unroll
    for (int j = 0; j < 8; ++j) sm[((tid >> 6) + 8 * j) * 65 + (tid & 63)] = rv[j];
    __syncthreads();
    if (tile + (int)gridDim.x < G8) { const PrepDesc dn = prep_desc(p, tile + gridDim.x); prep_load(dn, tid, rv); }
    const int nl = tid >> 3, kp = tid & 7;
    const int n = d.tn * 64 + nl;
    int nd = n;
    if (d.mode == 1) nd = (n >> 4) * 32 + (n & 15);
    else if (d.mode == 2) nd = (n >> 4) * 32 + 16 + (n & 15);
    float v[8];
#pragma unroll
    for (int j = 0; j < 8; ++j) v[j] = sm[(kp * 8 + j) * 65 + nl];
    *(uint4*)(d.dst + (size_t)nd * d.K + d.tk * 64 + kp * 8) = pack8(v);
  }
  __syncthreads();
  if (blockIdx.x < 4) {
    const int mi = blockIdx.x;
    const float* pe = p.cmp_pe + (size_t)mi * 2048;
    const float* w1 = p.cmp_w1 + (size_t)mi * 2048 * 128;
    const int tq_ = tidx();
    const int o = tq_ & 127, half = tq_ >> 7;
    float a0 = 0.f, a1 = 0.f, a2 = 0.f, a3 = 0.f;
    for (int k = half * 512; k < half * 512 + 512; k += 4) {
      a0 += pe[k] * w1[(size_t)k * 128 + o]; a1 += pe[k + 1] * w1[(size_t)(k + 1) * 128 + o];
      a2 += pe[k + 2] * w1[(size_t)(k + 2) * 128 + o]; a3 += pe[k + 3] * w1[(size_t)(k + 3) * 128 + o];
    }
    sm[tq_] = (a0 + a1) + (a2 + a3);
    __syncthreads();
    if (tq_ < 128) p.c1[mi * 128 + tq_] = (sm[tq_] + sm[tq_ + 128]) + (sm[tq_ + 256] + sm[tq_ + 384]);
    __syncthreads();
  }
  if (blockIdx.x == 4 || (gridDim.x <= 4 && blockIdx.x == 0)) {
    for (int c = tidx(); c < 512; c += NT) {
      float l0 = p.hy_lb[c], l1 = p.hy_lb[512 + c];
      float mx = fmaxf(l0, l1); float e0 = __expf(l0 - mx), e1 = __expf(l1 - mx); float inv = 1.f / (e0 + e1);
      float p0 = e0 * inv, p1 = e1 * inv;
      p.lb[c] = p0 - p0; p.lb[512 + c] = (p0 + p1) - p0;
    }
  }
}

DI void rmsnorm_phase(const float* x, const float* __restrict__ g, u16* h) {
  const int t_ = tidx();
  const int wave = t_ >> 6, lane = t_ & 63;
  const int stride = gridDim.x * 8;
  int row = blockIdx.x * 8 + wave;
  float4 v[4], nv[4];
  float4 gg[4];
#pragma unroll
  for (int j = 0; j < 4; ++j) gg[j] = ((const float4*)g)[lane + 64 * j];
  if (row < T_) {
    const float4* xr = (const float4*)(x + (size_t)row * 1024);
#pragma unroll
    for (int j = 0; j < 4; ++j) v[j] = xr[lane + 64 * j];
  }
  while (row < T_) {
    const int nrow = row + stride;
    if (nrow < T_) {
      const float4* xr = (const float4*)(x + (size_t)nrow * 1024);
#pragma unroll
      for (int j = 0; j < 4; ++j) nv[j] = xr[lane + 64 * j];
    }
    float ss = 0.f;
#pragma unroll
    for (int j = 0; j < 4; ++j) ss += v[j].x * v[j].x + v[j].y * v[j].y + v[j].z * v[j].z + v[j].w * v[j].w;
#pragma unroll
    for (int off = 32; off >= 1; off >>= 1) ss += __shfl_xor(ss, off);
    const float rs = rsqrtf(ss * (1.f / 1024.f) + EPSF);
#pragma unroll
    for (int j = 0; j < 4; ++j) {
      uint2 o; o.x = pack2(v[j].x * rs * gg[j].x, v[j].y * rs * gg[j].y); o.y = pack2(v[j].z * rs * gg[j].z, v[j].w * rs * gg[j].w);
      *(uint2*)(h + (size_t)row * 1024 + (lane + 64 * j) * 4) = o;
    }
#pragma unroll
    for (int j = 0; j < 4; ++j) v[j] = nv[j];
    row = nrow;
  }
}

DI int lds_byte(int r, int c) { const int st = (r >> 4) * 2 + (c >> 5), rr = r & 15, cc = c & 31, ob = rr * 64 + cc * 2; return st * 1024 + (ob ^ (((ob >> 9) & 1) << 5)); }
DI void stage_rc(int b, int& R, int& C) { const int st = b / 1024, sb = b % 1024, swz = sb ^ (((sb >> 9) & 1) << 5); R = (st >> 1) * 16 + swz / 64; C = (st & 1) * 32 + (swz % 64) / 2; }

template <int EPI>
DI void gemm_phase(const u16* A, const u16* Bt, const int K, const int nN, u16* outb, const int ldc, const float* res, float* outf, char* smem) {
  constexpr int HTB = 16384;
  const int tid = tidx();
  const int wid = tid >> 6, lane = tid & 63, wr = wid >> 2, wc = wid & 3, fr = lane & 15, fq = lane >> 4;
  const int nM = 128, nwg = nM * nN, nt = K / 64;
  int sR0, sC0, sR1, sC1; stage_rc(tid * 16, sR0, sC0); stage_rc(tid * 16 + 8192, sR1, sC1);
  const unsigned vo0 = (unsigned)((sR0 * K + sC0) * 2), vo1 = (unsigned)((sR1 * K + sC1) * 2);
#define SA_(b, h) (smem + ((b) * 2 + (h)) * HTB)
#define SB_(b, h) (smem + (4 + (b) * 2 + (h)) * HTB)
#define STAGE(P, BASE, br, kt) do { const char* _g = (const char*)((BASE) + (size_t)(br) * K + (size_t)(kt) * 64); \
    unsigned _o0 = vo0, _o1 = vo1; asm volatile("" : "+v"(_o0), "+v"(_o1)); \
    __builtin_amdgcn_global_load_lds((const unsigned*)(_g + _o0), (LAS unsigned*)((P) + tid * 16), 16, 0, 0); \
    __builtin_amdgcn_global_load_lds((const unsigned*)(_g + _o1), (LAS unsigned*)((P) + tid * 16 + 8192), 16, 0, 0); } while (0)
#define LDA(dst, b, h) _Pragma("unroll") for (int m = 0; m < 4; ++m) _Pragma("unroll") for (int k = 0; k < 2; ++k) \
    dst[m][k] = *(const bf16x8*)(SA_(b, h) + lds_byte(wr * 64 + m * 16 + fr, k * 32 + fq * 8))
#define LDB(dst, b, h) _Pragma("unroll") for (int n = 0; n < 2; ++n) _Pragma("unroll") for (int k = 0; k < 2; ++k) \
    dst[n][k] = *(const bf16x8*)(SB_(b, h) + lds_byte(wc * 32 + n * 16 + fr, k * 32 + fq * 8))
#define MMA(ai, bj, At_, Bx_) do { __builtin_amdgcn_s_setprio(1); \
    _Pragma("unroll") for (int m = 0; m < 4; ++m) _Pragma("unroll") for (int n = 0; n < 2; ++n) _Pragma("unroll") for (int k = 0; k < 2; ++k) \
      acc[ai][bj][m][n] = __builtin_amdgcn_mfma_f32_16x16x32_bf16(Bx_[n][k], At_[m][k], acc[ai][bj][m][n], 0, 0, 0); \
    __builtin_amdgcn_s_setprio(0); } while (0)
#define WAIT_V(n) asm volatile("s_waitcnt vmcnt(" #n ")" ::: "memory")
#define WAIT_L(n) asm volatile("s_waitcnt lgkmcnt(" #n ")" ::: "memory")
#define BAR __builtin_amdgcn_s_barrier()
#define SCHED __builtin_amdgcn_sched_barrier(0)
  auto tile_of = [&](long Lq, int& brow_, int& bcol_, int& pn_) {
    int wgid = (int)Lq;
    { const int q = nwg / 8, r = nwg % 8, xcd = wgid % 8, off = wgid / 8; wgid = (xcd < r ? xcd * (q + 1) : r * (q + 1) + (xcd - r) * q) + off; }
    const int nig = 8 * nN, gid = wgid / nig, fm = gid * 8, gsz = (nM - fm) < 8 ? (nM - fm) : 8;
    const int pm = fm + ((wgid % nig) % gsz);
    pn_ = (wgid % nig) / gsz; brow_ = pm * 256; bcol_ = pn_ * 256;
  };
#define STAGE7(br_, bc_) do { STAGE(SB_(0, 0), Bt, bc_, 0); STAGE(SA_(0, 0), A, br_, 0); STAGE(SB_(0, 1), Bt, (bc_) + 128, 0); STAGE(SA_(0, 1), A, (br_) + 128, 0); \
    STAGE(SB_(1, 0), Bt, bc_, 1); STAGE(SA_(1, 0), A, br_, 1); STAGE(SB_(1, 1), Bt, (bc_) + 128, 1); } while (0)
  long L = blockIdx.x;
  bool have = L < nwg;
  int brow = 0, bcol = 0, pn = 0;
  __syncthreads();
  if (have) { tile_of(L, brow, bcol, pn); STAGE7(brow, bcol); }
  while (have) {
    f32x4v acc[2][2][4][2];
#pragma unroll
    for (int a = 0; a < 2; ++a)
#pragma unroll
      for (int b = 0; b < 2; ++b)
#pragma unroll
        for (int m = 0; m < 4; ++m)
#pragma unroll
          for (int n = 0; n < 2; ++n) acc[a][b][m][n] = (f32x4v){0.f, 0.f, 0.f, 0.f};
    bf16x8 At[4][2], B0[2][2], B1[2][2];
    if (wr == 1) BAR;
    WAIT_V(0); BAR;
    BAR;
    for (int t = 0; t < nt - 2; t += 2) {
      LDB(B0, 0, 0); SCHED; LDA(At, 0, 0); STAGE(SA_(1, 1), A, brow + 128, t + 1);
      WAIT_L(8); BAR; WAIT_L(0); MMA(0, 0, At, B0); BAR; SCHED;
      LDB(B1, 0, 1); STAGE(SB_(0, 0), Bt, bcol, t + 2);
      BAR; WAIT_L(0); MMA(0, 1, At, B1); BAR;
      LDA(At, 0, 1); STAGE(SA_(0, 0), A, brow, t + 2);
      BAR; WAIT_L(0); MMA(1, 0, At, B0); BAR; SCHED;
      STAGE(SB_(0, 1), Bt, bcol + 128, t + 2);
      WAIT_V(6); BAR; MMA(1, 1, At, B1); BAR;
      LDB(B0, 1, 0); SCHED; LDA(At, 1, 0); STAGE(SA_(0, 1), A, brow + 128, t + 2);
      WAIT_L(8); BAR; WAIT_L(0); MMA(0, 0, At, B0); BAR; SCHED;
      LDB(B1, 1, 1); STAGE(SB_(1, 0), Bt, bcol, t + 3);
      BAR; WAIT_L(0); MMA(0, 1, At, B1); BAR;
      LDA(At, 1, 1); STAGE(SA_(1, 0), A, brow, t + 3);
      BAR; WAIT_L(0); MMA(1, 0, At, B0); BAR; SCHED;
      STAGE(SB_(1, 1), Bt, bcol + 128, t + 3);
      WAIT_V(6); BAR; MMA(1, 1, At, B1); BAR;
    }
    { LDB(B0, 0, 0); LDA(At, 0, 0); STAGE(SA_(1, 1), A, brow + 128, nt - 1);
      BAR; WAIT_L(0); MMA(0, 0, At, B0); BAR;
      LDB(B1, 0, 1); BAR; WAIT_L(0); MMA(0, 1, At, B1); BAR;
      LDA(At, 0, 1); WAIT_V(4); BAR; WAIT_L(0); MMA(1, 0, At, B0); MMA(1, 1, At, B1); BAR; }
    { LDB(B0, 1, 0); LDA(At, 1, 0); WAIT_V(2); BAR; WAIT_L(0); MMA(0, 0, At, B0); BAR;
      LDB(B1, 1, 1); WAIT_V(0); BAR; WAIT_L(0); MMA(0, 1, At, B1); BAR;
      LDA(At, 1, 1); BAR; WAIT_L(0); MMA(1, 0, At, B0); MMA(1, 1, At, B1); BAR; }
    if (wr == 0) BAR;
    const long Ln = L + gridDim.x;
    const bool haven = Ln < nwg;
    int browN = 0, bcolN = 0, pnN = 0;
    if (haven) { tile_of(Ln, browN, bcolN, pnN); STAGE7(browN, bcolN); }
    int tid2 = tid; asm volatile("" : "+v"(tid2));
    const int fr2 = tid2 & 15, fq2 = (tid2 >> 4) & 3, wc2 = (tid2 >> 6) & 3, wr2 = tid2 >> 8;
#pragma unroll
    for (int ai = 0; ai < 2; ++ai)
#pragma unroll
      for (int m = 0; m < 4; ++m) {
        const size_t row = (size_t)(brow + ai * 128 + wr2 * 64 + m * 16 + fr2);
#pragma unroll
        for (int bj = 0; bj < 2; ++bj) {
          const int cb = bcol + bj * 128 + wc2 * 32 + fq2 * 4;
          if (EPI == 0) {
#pragma unroll
            for (int n = 0; n < 2; ++n) {
              uint2 o; o.x = pack2(acc[ai][bj][m][n][0], acc[ai][bj][m][n][1]); o.y = pack2(acc[ai][bj][m][n][2], acc[ai][bj][m][n][3]);
              *(uint2*)(outb + row * ldc + cb + n * 16) = o;
            }
          } else if (EPI == 1) {
#pragma unroll
            for (int n = 0; n < 2; ++n) {
              const size_t idx = row * 1024 + cb + n * 16;
              const f32x4v r4 = *(const f32x4v*)(res + idx);
              *(f32x4v*)(outf + idx) = r4 + acc[ai][bj][m][n];
            }
          } else {
            const f32x4v gv = acc[ai][bj][m][0], uv = acc[ai][bj][m][1];
            uint2 o; o.x = pack2(fsilu(gv[0]) * uv[0], fsilu(gv[1]) * uv[1]); o.y = pack2(fsilu(gv[2]) * uv[2], fsilu(gv[3]) * uv[3]);
            *(uint2*)(outb + row * DFF + ((bcol + bj * 128 + wc2 * 32) >> 1) + fq2 * 4) = o;
          }
        }
      }
    L = Ln; have = haven; brow = browN; bcol = bcolN; pn = pnN;
  }
  __syncthreads();
#undef STAGE7
#undef SA_
#undef SB_
#undef STAGE
#undef LDA
#undef LDB
#undef MMA
}

#define MFMA16(a, b, c) __builtin_amdgcn_mfma_f32_16x16x32_bf16((a), (b), (c), 0, 0, 0)
DI void hgrn_item(const Params& p, int li, int item, char* smem) {
  const int tid = tidx(), lane = tid & 63, w = tid >> 6, fr = lane & 15, fq = lane >> 4;
  const int kk = w >> 1, vt = w & 1;
  const int vs = item & 3, h = (item >> 2) & 3, b = item >> 4;
  const int tg = tid & 3, kch = tid >> 2;
  const int sv = tid >> 5, vv = tid & 31;
  const float lbv = p.lb[li * 512 + h * 128 + kch];
  const u16* base = p.proj + (size_t)b * S_ * LD_EVEN;
  const u16* pq = base + (size_t)(4 * tg) * LD_EVEN + h * 128 + kch;
  const u16* pv = base + (size_t)sv * LD_EVEN + 1024 + h * 128 + vs * 32 + vv;
  struct HRegs { unsigned q0, q1, q2, q3, f0, f1, f2, f3, v; };
  auto hload = [&](int c, HRegs& r) {
    const u16* pq2 = pq + (size_t)c * 16 * LD_EVEN;
    r.q0 = pq2[0]; r.q1 = pq2[LD_EVEN]; r.q2 = pq2[2 * LD_EVEN]; r.q3 = pq2[3 * LD_EVEN];
    r.f0 = pq2[512]; r.f1 = pq2[LD_EVEN + 512]; r.f2 = pq2[2 * LD_EVEN + 512]; r.f3 = pq2[3 * LD_EVEN + 512];
    r.v = pv[(size_t)c * 16 * LD_EVEN];
  };
  HRegs ra, rb;
  hload(0, ra); hload(1, rb);
  f32x4v S0 = {0.f, 0.f, 0.f, 0.f}, S1 = {0.f, 0.f, 0.f, 0.f};
  const f32x4v z4 = {0.f, 0.f, 0.f, 0.f};
  __syncthreads();
  constexpr int HBUF = 16896;
  auto prep = [&](const HRegs& rr, int par) {
    u16* Qt_ = (u16*)(smem + par * HBUF); u16* Kt_ = Qt_ + 16 * 136; u16* Kh_ = Kt_ + 16 * 136; u16* Vt_ = Kh_ + 128 * 24; float* Pc_ = (float*)(Vt_ + 32 * 24);
    float qv[4], kv[4], cs[4];
    const unsigned rq[4] = {rr.q0, rr.q1, rr.q2, rr.q3}, rf[4] = {rr.f0, rr.f1, rr.f2, rr.f3};
    float cp = 1.f;
#pragma unroll
    for (int i = 0; i < 4; ++i) {
      const float f = lbv + (1.f - lbv) * fsigmoid(__uint_as_float(rf[i] << 16));
      cp *= f; cs[i] = cp; kv[i] = 1.f - f; qv[i] = fsilu(__uint_as_float(rq[i] << 16));
    }
    const int bl = lane & ~3;
    const float t0 = __shfl(cp, bl), t1 = __shfl(cp, bl + 1), t2 = __shfl(cp, bl + 2), t3 = __shfl(cp, bl + 3);
    const float pre = (tg > 0 ? t0 : 1.f) * (tg > 1 ? t1 : 1.f) * (tg > 2 ? t2 : 1.f);
    const float PC = (t0 * t1) * (t2 * t3);
    float kh[4];
#pragma unroll
    for (int i = 0; i < 4; ++i) {
      const float P = fmaxf(pre * cs[i], 1e-30f);
      const float rP = __builtin_amdgcn_rcpf(P);
      const int t = 4 * tg + i;
      Qt_[t * 136 + kch] = f2bf(qv[i] * P);
      const float kr = kv[i] * rP;
      Kt_[t * 136 + kch] = f2bf(kr);
      kh[i] = kr * PC;
    }
    uint2 k2; k2.x = pack2(kh[0], kh[1]); k2.y = pack2(kh[2], kh[3]);
    *(uint2*)(Kh_ + kch * 24 + 4 * tg) = k2;
    if (tg == 0) Pc_[kch] = PC;
    Vt_[vv * 24 + sv] = (u16)rr.v;
  };
  auto mfma = [&](int par) {
    const u16* Qt_ = (const u16*)(smem + par * HBUF); const u16* Kt_ = Qt_ + 16 * 136; const u16* Kh_ = Kt_ + 16 * 136; const u16* Vt_ = Kh_ + 128 * 24;
    const float* Pc_ = (const float*)(Vt_ + 32 * 24);
    float* Op_ = (float*)(smem + 4 * HBUF) + par * 2048;
    const uint2 v2 = *(const uint2*)(Vt_ + (16 * vt + fr) * 24 + 4 * fq);
    const bf16x8 vb = as_bf16x8(make_uint4(v2.x, v2.y, 0u, 0u));
    const u16* qrow = Qt_ + fr * 136 + 32 * kk + 4 * fq;
    const uint2 qa = *(const uint2*)qrow, qb = *(const uint2*)(qrow + 16);
    const bf16x8 qfrag = as_bf16x8(make_uint4(qa.x, qa.y, qb.x, qb.y));
    const bf16x8 sfrag = as_bf16x8(make_uint4(pack2(S0[0], S0[1]), pack2(S0[2], S0[3]), pack2(S1[0], S1[1]), pack2(S1[2], S1[3])));
    f32x4v acc = MFMA16(qfrag, sfrag, z4);
    if (kk == 0) {
      f32x4v sa = z4;
#pragma unroll
      for (int ks = 0; ks < 4; ++ks) {
        const bf16x8 kf = *(const bf16x8*)(Kt_ + fr * 136 + 32 * ks + 8 * fq);
        const bf16x8 qf2 = *(const bf16x8*)(Qt_ + fr * 136 + 32 * ks + 8 * fq);
        sa = MFMA16(kf, qf2, sa);
      }
#pragma unroll
      for (int j = 0; j < 4; ++j) sa[j] = (4 * fq + j <= fr) ? sa[j] : 0.f;
      const bf16x8 afrag = as_bf16x8(make_uint4(pack2(sa[0], sa[1]), pack2(sa[2], sa[3]), 0u, 0u));
      acc = MFMA16(afrag, vb, acc);
    }
#pragma unroll
    for (int j = 0; j < 4; ++j) Op_[(w * 16 + 4 * fq + j) * 16 + fr] = acc[j];
    const float* pc0 = Pc_ + 32 * kk + 4 * fq;
#pragma unroll
    for (int j = 0; j < 4; ++j) { S0[j] *= pc0[j]; S1[j] *= pc0[16 + j]; }
    const uint2 h0 = *(const uint2*)(Kh_ + (32 * kk + fr) * 24 + 4 * fq);
    const uint2 h1v = *(const uint2*)(Kh_ + (32 * kk + 16 + fr) * 24 + 4 * fq);
    S0 = MFMA16(as_bf16x8(make_uint4(h0.x, h0.y, 0u, 0u)), vb, S0);
    S1 = MFMA16(as_bf16x8(make_uint4(h1v.x, h1v.y, 0u, 0u)), vb, S1);
  };
  auto reduce = [&](int c, int par) {
    const float* Op_ = (const float*)(smem + 4 * HBUF) + par * 2048;
    const int t = tid >> 5, v = tid & 31, vtt = v >> 4, vl = v & 15;
    float o = 0.f;
#pragma unroll
    for (int q = 0; q < 4; ++q) o += Op_[((2 * q + vtt) * 16 + t) * 16 + vl];
    p.hbuf[(size_t)(b * S_ + c * 16 + t) * 1024 + h * 128 + vs * 32 + v] = f2bf(o);
  };
  prep(ra, 0); prep(rb, 1); hload(2, ra); hload(3, rb);
  __syncthreads();
#pragma unroll 1
  for (int P = 0; P < 64; P += 2) {
    mfma(0); mfma(1);
    prep(ra, 2); prep(rb, 3);
    if (P + 2 < 64) { hload(2 * P + 4, ra); hload(2 * P + 5, rb); }
    __syncthreads();
    reduce(2 * P, 0); reduce(2 * P + 1, 1);
    mfma(2); mfma(3);
    if (P + 2 < 64) { prep(ra, 0); prep(rb, 1); if (P + 3 < 64) { hload(2 * P + 6, ra); hload(2 * P + 7, rb); } }
    __syncthreads();
    reduce(2 * P + 2, 2); reduce(2 * P + 3, 3);
  }
  __syncthreads();
}

DI void load_q(const u16* qrow, const float* __restrict__ gain, int hh, bf16x8 (&qf)[4]) {
  float f[4][8]; float ss = 0.f;
#pragma unroll
  for (int kk = 0; kk < 4; ++kk) {
    uint4 raw = *(const uint4*)(qrow + kk * 16 + hh * 8);
    unpack8(raw, f[kk]);
#pragma unroll
    for (int j = 0; j < 8; ++j) ss += f[kk][j] * f[kk][j];
  }
  ss += __shfl_xor(ss, 32);
  const float rs = rsqrtf(ss * (1.f / 64.f) + EPSF) * (0.125f * LOG2E);
#pragma unroll
  for (int kk = 0; kk < 4; ++kk) {
#pragma unroll
    for (int j = 0; j < 8; ++j) f[kk][j] *= rs * gain[kk * 16 + hh * 8 + j];
    qf[kk] = as_bf16x8(pack8(f[kk]));
  }
}

constexpr int VS = 68;
constexpr int KVBUF = 18432;
template <int NTH> struct KVRegs { u32x4v r[NTH == 256 ? 4 : 2]; };
DI void kv_ld2(const u16* src, size_t stride, int ra, int rb, int rlo, int rhi, int dp, u32x4v& x0, u32x4v& x1) {
  const u32x4v z = {0u, 0u, 0u, 0u};
  x0 = z; x1 = z;
  if (ra >= rlo && ra < rhi) x0 = *(const u32x4v*)(src + (size_t)ra * stride + dp * 8);
  if (rb >= rlo && rb < rhi) x1 = *(const u32x4v*)(src + (size_t)rb * stride + dp * 8);
}
template <int NTH>
DI void kv_load(int tid, const u16* kb, const u16* vb, size_t stride, int r0, int rlo, int rhi, KVRegs<NTH>& rg) {
  const int dp = tid & 7, kq = (tid & 255) >> 3;
  if (NTH == 256) {
    kv_ld2(kb, stride, r0 + kq, r0 + kq + 32, rlo, rhi, dp, rg.r[0], rg.r[1]);
    kv_ld2(vb, stride, r0 + 2 * kq, r0 + 2 * kq + 1, rlo, rhi, dp, rg.r[2], rg.r[3]);
  } else {
    if (tid < 256) kv_ld2(kb, stride, r0 + kq, r0 + kq + 32, rlo, rhi, dp, rg.r[0], rg.r[1]);
    else kv_ld2(vb, stride, r0 + 2 * kq, r0 + 2 * kq + 1, rlo, rhi, dp, rg.r[0], rg.r[1]);
  }
}
DI void k_store1(u32x4v x, int key, int dp, const float* __restrict__ kgain, u16* Ks) {
  uint4 kv = make_uint4(x[0], x[1], x[2], x[3]);
  if (kgain) {
    float f[8]; unpack8(kv, f);
    float ss = 0.f;
#pragma unroll
    for (int e = 0; e < 8; ++e) ss += f[e] * f[e];
    ss += __shfl_xor(ss, 1); ss += __shfl_xor(ss, 2); ss += __shfl_xor(ss, 4);
    const float rs = rsqrtf(ss * (1.f / 64.f) + EPSF);
#pragma unroll
    for (int e = 0; e < 8; ++e) f[e] *= rs * kgain[dp * 8 + e];
    kv = pack8(f);
  }
  *(uint4*)(Ks + key * 72 + dp * 8) = kv;
}
DI void v_store2(u32x4v v0, u32x4v v1, int kp, int dp, u16* Vts) {
  unsigned* vd = (unsigned*)(Vts + (dp * 8) * VS + 2 * kp);
#pragma unroll
  for (int d = 0; d < 4; ++d) {
    vd[(2 * d) * (VS / 2)] = (v0[d] & 0xffffu) | (v1[d] << 16);
    vd[(2 * d + 1) * (VS / 2)] = (v0[d] >> 16) | (v1[d] & 0xffff0000u);
  }
}
template <int NTH>
DI void kv_store(int tid, const KVRegs<NTH>& rg, const float* __restrict__ kgain, u16* Ks, u16* Vts) {
  const int dp = tid & 7, kq = (tid & 255) >> 3;
  if (NTH == 256) {
    k_store1(rg.r[0], kq, dp, kgain, Ks); k_store1(rg.r[1], kq + 32, dp, kgain, Ks);
    v_store2(rg.r[2], rg.r[3], kq, dp, Vts);
  } else {
    if (tid < 256) { k_store1(rg.r[0], kq, dp, kgain, Ks); k_store1(rg.r[1], kq + 32, dp, kgain, Ks); }
    else v_store2(rg.r[0], rg.r[1], kq, dp, Vts);
  }
}

DI void score_stage(const bf16x8 (&qf)[4], const u16* Ks, int lane, float sk, float sb, int lower, int lim, f32x16 (&s)[2], float& mx) {
  const int lr = lane & 31, hh = lane >> 5;
#pragma unroll
  for (int sub = 0; sub < 2; ++sub) {
#pragma unroll
    for (int i = 0; i < 16; ++i) s[sub][i] = fmaf(sk, (float)(sub * 32 + (i & 3) + 8 * (i >> 2)), sb);
#pragma unroll
    for (int kk = 0; kk < 4; ++kk) {
      bf16x8 kf = *(const bf16x8*)(Ks + (sub * 32 + lr) * 72 + kk * 16 + hh * 8);
      s[sub] = MFMA32(kf, qf[kk], s[sub]);
    }
  }
  if (lim < lower) { lower = 64; lim = 64; }
  const bool full = (lower <= 0) && (lim >= 63);
  if (!__all(full)) {
    const int lo2 = lower - 4 * hh; const unsigned rng = (unsigned)(lim - lower);
#pragma unroll
    for (int sub = 0; sub < 2; ++sub)
#pragma unroll
      for (int i = 0; i < 16; ++i) {
        const int kc = sub * 32 + (i & 3) + 8 * (i >> 2);
        s[sub][i] = ((unsigned)(kc - lo2) <= rng) ? s[sub][i] : -INFINITY;
      }
  }
  mx = -INFINITY;
#pragma unroll
  for (int sub = 0; sub < 2; ++sub)
#pragma unroll
    for (int i = 0; i < 16; ++i) mx = fmaxf(mx, s[sub][i]);
  mx = fmaxf(mx, __shfl_xor(mx, 32));
}

DI void pv_stage(const f32x16 (&s)[2], const u16* Vts, f32x16 (&o)[2], int lane) {
  const int lr = lane & 31, hh = lane >> 5;
#pragma unroll
  for (int sub = 0; sub < 2; ++sub)
#pragma unroll
    for (int st = 0; st < 2; ++st) {
      uint4 pk;
      pk.x = pack2(s[sub][8 * st + 0], s[sub][8 * st + 1]); pk.y = pack2(s[sub][8 * st + 2], s[sub][8 * st + 3]);
      pk.z = pack2(s[sub][8 * st + 4], s[sub][8 * st + 5]); pk.w = pack2(s[sub][8 * st + 6], s[sub][8 * st + 7]);
      const bf16x8 pf = as_bf16x8(pk);
#pragma unroll
      for (int dt = 0; dt < 2; ++dt) {
        const u16* vp = Vts + (dt * 32 + lr) * VS + sub * 32 + 16 * st + 4 * hh;
        const uint2 lo = *(const uint2*)vp, hi = *(const uint2*)(vp + 8);
        const bf16x8 vf = as_bf16x8(make_uint4(lo.x, lo.y, hi.x, hi.y));
        o[dt] = MFMA32(vf, pf, o[dt]);
      }
    }
}

DI void flash_stage(const bf16x8 (&qf)[4], const u16* Ks, const u16* Vts, f32x16 (&o)[2], float& m, float& l, int lane,
                    float sk, float sb, int lower, int lim) {
  f32x16 s[2]; float mx;
  score_stage(qf, Ks, lane, sk, sb, lower, lim, s, mx);
  const float mn = fmaxf(m, mx);
  const float alpha = fexp2(m - mn);
  const bool same = (mn == m);
  m = mn;
  float ls = 0.f;
#pragma unroll
  for (int sub = 0; sub < 2; ++sub)
#pragma unroll
    for (int i = 0; i < 16; ++i) { const float pv = fexp2(s[sub][i] - mn); s[sub][i] = pv; ls += pv; }
  l = l * alpha + ls;
  if (!__all(same)) {
#pragma unroll
    for (int dt = 0; dt < 2; ++dt)
#pragma unroll
      for (int i = 0; i < 16; ++i) o[dt][i] *= alpha;
  }
  pv_stage(s, Vts, o, lane);
}

DI void dilated_item(const Params& p, int li, int pairitem, char* smem) {
  const int tfull = tidx();
  const int half = tfull >> 8, tid = tfull & 255;
  const int item = pairitem * 2 + half;
  char* kvb = smem + half * (2 * KVBUF);
  const int lane = tid & 63, w = tid >> 6, lr = lane & 31, hh = lane >> 5;
  const int idx16 = item & 15; const int br = (item >> 4) % 3; const int hb = (item / 48) & 7; const int b = item / 384;
  const int d = br == 0 ? 1 : (br == 1 ? 4 : 16);
  const int tile = idx16 / d, resid = idx16 % d;
  const int st0 = (d >= 2 && tile == 0) ? 2 : 0;
  const int u0 = tile * 128;
  const int uq = u0 + 32 * w + lr; const int tq = uq * d + resid;
  const u16* prow = p.proj + (size_t)(b * S_ + tq) * LD_EVEN;
  bf16x8 qf[4];
  load_q(prow + 2048 + hb * 64, p.hy_qg + li * 64, hh, qf);
  const float slope2 = fexp2(-(float)(hb + 1)) * LOG2E;
  const float sk = slope2 * (float)d;
  const u16* kb = p.proj + (size_t)(b * S_ + resid) * LD_EVEN + 2560 + hb * 64;
  const u16* vb = kb + 512;
  const size_t stride = (size_t)d * LD_EVEN;
  const float* kg = p.hy_kg + li * 64;
  f32x16 o[2]; o[0] = zero16(); o[1] = zero16();
  float m = -1e30f, l = 0.f;
  const int uw = u0 + 32 * w;
  KVRegs<256> rg;
  kv_load<256>(tid, kb, vb, stride, u0 - 128 + 64 * st0, 0, 1 << 30, rg);
  __syncthreads();
  kv_store<256>(tid, rg, kg, (u16*)(kvb + (st0 & 1) * KVBUF), (u16*)(kvb + (st0 & 1) * KVBUF) + 64 * 72);
  kv_load<256>(tid, kb, vb, stride, u0 - 64 + 64 * st0, 0, 1 << 30, rg);
  __syncthreads();
#pragma unroll 1
  for (int st = st0; st < 4; ++st) {
    const int ub = u0 - 128 + 64 * st;
    u16* Ks = (u16*)(kvb + (st & 1) * KVBUF); u16* Vts = Ks + 64 * 72;
    if (st + 1 < 4) { u16* Kn = (u16*)(kvb + ((st + 1) & 1) * KVBUF); kv_store<256>(tid, rg, kg, Kn, Kn + 64 * 72); }
    if (st + 2 < 4) kv_load<256>(tid, kb, vb, stride, ub + 128, 0, 1 << 30, rg);
    if (ub + 63 >= 0 && ub <= uw + 31 && ub + 63 >= uw - 128) {
      const int lim = uq - ub;
      const int lower = max(lim - 128, -ub);
      const float sb = slope2 * (float)(ub * d + resid) + sk * (float)(4 * hh);
      flash_stage(qf, Ks, Vts, o, m, l, lane, sk, sb, lower, lim);
    }
    __syncthreads();
  }
  const float lt = l + __shfl_xor(l, 32);
  const float inv = 1.f / lt;
  const size_t trow = (size_t)br * T_ + (size_t)b * S_ + tq;
  if (hh == 0) p.lse[trow * 8 + hb] = (m + log2f(lt)) * LN2;
  u16* orow = p.obr + trow * 512 + hb * 64;
#pragma unroll
  for (int dt = 0; dt < 2; ++dt)
#pragma unroll
    for (int q4 = 0; q4 < 4; ++q4) {
      uint2 ov; ov.x = pack2(o[dt][4 * q4] * inv, o[dt][4 * q4 + 1] * inv); ov.y = pack2(o[dt][4 * q4 + 2] * inv, o[dt][4 * q4 + 3] * inv);
      *(uint2*)(orow + dt * 32 + 8 * q4 + 4 * hh) = ov;
    }
}

DI void post_even_phase(const Params& p, int li) {
  const int tid = tidx();
  const int rsel = tid >> 7, c8 = tid & 127;
  const int c = c8 * 8;
  const int nit = T_ / 4, step = gridDim.x;
  int it = blockIdx.x;
  if (c8 < 64) {
    float og[8];
#pragma unroll
    for (int j = 0; j < 8; ++j) og[j] = p.hy_og[li * 512 + c + j];
    u32x4v raw = {0u, 0u, 0u, 0u}, graw = {0u, 0u, 0u, 0u}, nraw = raw, ngraw = raw;
    if (it < nit) { const int t = it * 4 + rsel; raw = *(const u32x4v*)(p.hbuf + (size_t)t * 1024 + c); graw = *(const u32x4v*)(p.proj + (size_t)t * LD_EVEN + 1536 + c); }
    while (it < nit) {
      const int t = it * 4 + rsel, itn = it + step;
      if (itn < nit) { const int tn = itn * 4 + rsel; nraw = *(const u32x4v*)(p.hbuf + (size_t)tn * 1024 + c); ngraw = *(const u32x4v*)(p.proj + (size_t)tn * LD_EVEN + 1536 + c); }
      float o[8], gt[8], val[8];
      unpack8(make_uint4(raw[0], raw[1], raw[2], raw[3]), o); unpack8(make_uint4(graw[0], graw[1], graw[2], graw[3]), gt);
      float ss = 0.f;
#pragma unroll
      for (int j = 0; j < 8; ++j) ss += o[j] * o[j];
      ss += __shfl_xor(ss, 1); ss += __shfl_xor(ss, 2); ss += __shfl_xor(ss, 4); ss += __shfl_xor(ss, 8);
      const float rs = rsqrtf(ss * (1.f / 128.f) + EPSF);
#pragma unroll
      for (int j = 0; j < 8; ++j) val[j] = o[j] * rs * og[j] * fsilu(gt[j]);
      *(uint4*)(p.hbuf + (size_t)t * 1024 + c) = pack8(val);
      raw = nraw; graw = ngraw; it = itn;
    }
  } else {
    const int cb = c - 512, hb = cb >> 6;
    float l0 = 0.f, l1 = 0.f, l2 = 0.f, nl0 = 0.f, nl1 = 0.f, nl2 = 0.f;
    u32x4v a4 = {0u, 0u, 0u, 0u}, b4 = a4, c4 = a4, na4 = a4, nb4 = a4, nc4 = a4;
    if (it < nit) {
      const size_t t = (size_t)(it * 4 + rsel);
      l0 = p.lse[(t) * 8 + hb]; l1 = p.lse[((size_t)T_ + t) * 8 + hb]; l2 = p.lse[((size_t)2 * T_ + t) * 8 + hb];
      a4 = *(const u32x4v*)(p.obr + t * 512 + cb); b4 = *(const u32x4v*)(p.obr + ((size_t)T_ + t) * 512 + cb); c4 = *(const u32x4v*)(p.obr + ((size_t)2 * T_ + t) * 512 + cb);
    }
    while (it < nit) {
      const int t = it * 4 + rsel, itn = it + step;
      if (itn < nit) {
        const size_t tn = (size_t)(itn * 4 + rsel);
        nl0 = p.lse[(tn) * 8 + hb]; nl1 = p.lse[((size_t)T_ + tn) * 8 + hb]; nl2 = p.lse[((size_t)2 * T_ + tn) * 8 + hb];
        na4 = *(const u32x4v*)(p.obr + tn * 512 + cb); nb4 = *(const u32x4v*)(p.obr + ((size_t)T_ + tn) * 512 + cb); nc4 = *(const u32x4v*)(p.obr + ((size_t)2 * T_ + tn) * 512 + cb);
      }
      const float mx = fmaxf(l0, fmaxf(l1, l2));
      float w0 = __expf(l0 - mx), w1 = __expf(l1 - mx), w2 = __expf(l2 - mx);
      const float inv = 1.f / (w0 + w1 + w2);
      w0 *= inv; w1 *= inv; w2 *= inv;
      float a[8], bq[8], cq[8], val[8];
      unpack8(make_uint4(a4[0], a4[1], a4[2], a4[3]), a); unpack8(make_uint4(b4[0], b4[1], b4[2], b4[3]), bq); unpack8(make_uint4(c4[0], c4[1], c4[2], c4[3]), cq);
#pragma unroll
      for (int j = 0; j < 8; ++j) val[j] = w0 * a[j] + w1 * bq[j] + w2 * cq[j];
      *(uint4*)(p.hbuf + (size_t)t * 1024 + c) = pack8(val);
      l0 = nl0; l1 = nl1; l2 = nl2; a4 = na4; b4 = nb4; c4 = nc4; it = itn;
    }
  }
}

DI void compress_item(const Params& p, int li, int pairitem, char* smem) {
  const int tfull = tidx();
  const int half = tfull >> 8, tid = tfull & 255;
  const int item = pairitem * 2 + half;
  u16* hs = (u16*)(smem + half * 17408);
  float* outs = (float*)(smem + half * 17408 + 32 * 136 * 2);
  const int lane = tid & 63, w = tid >> 6, lr = lane & 31, hh = lane >> 5;
  const int nt = item & 3, g = (item >> 2) & 3, b = (item >> 4) & 15, kv = item >> 8;
  const int n = nt * 32 + lr; const int nc = n > 126 ? 126 : n;
  const int col = 1024 + kv * 256 + g * 64;
  const u16* arow = p.proj + (size_t)(b * S_ + 16 * nc) * LD_ODD + col;
  const u16* w1t = p.wt_c1 + (size_t)(li * 2 + kv) * 128 * 2048 + (size_t)(32 * w + lr) * 2048;
  f32x16 acc = zero16();
#pragma unroll 16
  for (int ks = 0; ks < 128; ++ks) {
    const int lidx = ks >> 2, dd = (ks & 3) * 16 + hh * 8;
    const bf16x8 a = as_bf16x8(*(const uint4*)(arow + (size_t)lidx * LD_ODD + dd));
    const bf16x8 bb = as_bf16x8(*(const uint4*)(w1t + ks * 16 + hh * 8));
    acc = MFMA32(a, bb, acc);
  }
  const float cb = p.c1[(li * 2 + kv) * 128 + 32 * w + lr];
  __syncthreads();
#pragma unroll
  for (int i = 0; i < 16; ++i) {
    const int r = (i & 3) + 8 * (i >> 2) + 4 * hh;
    hs[r * 136 + 32 * w + lr] = f2bf(fsilu(acc[i] + cb));
  }
  __syncthreads();
  if (w < 2) {
    const u16* w2t = p.wt_c2 + (size_t)(li * 2 + kv) * 64 * 128 + (size_t)(w * 32 + lr) * 128;
    f32x16 a2 = zero16();
#pragma unroll
    for (int kk = 0; kk < 8; ++kk) {
      const bf16x8 a = *(const bf16x8*)(hs + lr * 136 + kk * 16 + hh * 8);
      const bf16x8 bb = as_bf16x8(*(const uint4*)(w2t + kk * 16 + hh * 8));
      a2 = MFMA32(a, bb, a2);
    }
#pragma unroll
    for (int i = 0; i < 16; ++i) {
      const int r = (i & 3) + 8 * (i >> 2) + 4 * hh;
      outs[r * 65 + w * 32 + lr] = a2[i];
    }
  }
  __syncthreads();
  {
    const int r = tid >> 3, c8 = tid & 7;
    float v[8]; float ss = 0.f;
#pragma unroll
    for (int j = 0; j < 8; ++j) { v[j] = outs[r * 65 + c8 * 8 + j]; ss += v[j] * v[j]; }
    ss += __shfl_xor(ss, 1); ss += __shfl_xor(ss, 2); ss += __shfl_xor(ss, 4);
    if (kv == 0) {
      const float rs = rsqrtf(ss * (1.f / 64.f) + EPSF);
#pragma unroll
      for (int j = 0; j < 8; ++j) v[j] *= rs * p.nsa_kg[(li * 3 + 0) * 64 + c8 * 8 + j];
    }
    const int nn = nt * 32 + r;
    if (nn >= 127) {
#pragma unroll
      for (int j = 0; j < 8; ++j) v[j] = 0.f;
    }
    u16* dst = (kv == 0 ? p.kcmp : p.vcmp) + ((size_t)(b * 4 + g) * 128 + nn) * 64 + c8 * 8;
    *(uint4*)dst = pack8(v);
  }
  __syncthreads();
}

DI void nsa_knorm_phase(const Params& p, int li) {
  const int tid = tidx();
  for (int u = blockIdx.x * NT + tid; u < T_ * 64; u += gridDim.x * NT) {
    const int piece = u & 7, head = (u >> 3) & 3, br = (u >> 5) & 1, row = u >> 6;
    u16* ptr = p.proj + (size_t)row * LD_ODD + 1536 + br * 512 + head * 64 + piece * 8;
    float f[8]; unpack8(*(const uint4*)ptr, f);
    float ss = 0.f;
#pragma unroll
    for (int e = 0; e < 8; ++e) ss += f[e] * f[e];
    ss += __shfl_xor(ss, 1); ss += __shfl_xor(ss, 2); ss += __shfl_xor(ss, 4);
    const float rs = rsqrtf(ss * (1.f / 64.f) + EPSF);
    const float* kg = p.nsa_kg + (li * 3 + 1 + br) * 64 + piece * 8;
#pragma unroll
    for (int e = 0; e < 8; ++e) f[e] *= rs * kg[e];
    *(uint4*)ptr = pack8(f);
  }
}

DI void nsa_item(const Params& p, int li, int item, char* smem) {
  float* impA = (float*)(smem + 2 * KVBUF);
  float* impB = impA + 8448;
  float* imp = impB + 8448;
  unsigned* selm = (unsigned*)(imp + 64 * 33);
  const int tid = tidx(), lane = tid & 63, wv = tid >> 6, lr = lane & 31, hh = lane >> 5;
  const int w = lr & 3;
  const int tt = item & 31, g = (item >> 5) & 3, b = item >> 7;
  const int t0 = tt * 64; const int cur = t0 >> 6;
  const int hd = g * 4 + w;
  const int tokl = 8 * wv + (lr >> 2);
  const int tq = t0 + tokl;
  const u16* pb = p.proj + (size_t)b * S_ * LD_ODD;
  const u16* prow = pb + (size_t)tq * LD_ODD;
  bf16x8 qf[4];
  load_q(prow + g * 256 + w * 64, p.nsa_qg + li * 64, hh, qf);
  const float slope2 = fexp2(-0.5f * (float)(hd + 1)) * LOG2E;
  const float g0 = fsigmoid(bf2f(prow[2560 + 0 + g * 4 + w]));
  const float g1 = fsigmoid(bf2f(prow[2560 + 16 + g * 4 + w]));
  const float g2 = fsigmoid(bf2f(prow[2560 + 32 + g * 4 + w]));
  f32x16 ot[2]; ot[0] = zero16(); ot[1] = zero16();
  {
    const u16* kb = p.kcmp + (size_t)(b * 4 + g) * 128 * 64;
    const u16* vb = p.vcmp + (size_t)(b * 4 + g) * 128 * 64;
    const float sk = 16.f * slope2;
    const int limc = min((tq - 31) >> 4, 126);
    const int nst = (1024 > t0) ? 1 : 2;
    {
      KVRegs<512> rg0;
      kv_load<512>(tid, kb, vb, 64, 0, 0, 128, rg0);
      __syncthreads();
      kv_store<512>(tid, rg0, nullptr, (u16*)smem, (u16*)smem + 64 * 72);
      if (nst > 1) {
        kv_load<512>(tid, kb, vb, 64, 64, 0, 128, rg0);
        kv_store<512>(tid, rg0, nullptr, (u16*)(smem + KVBUF), (u16*)(smem + KVBUF) + 64 * 72);
      }
    }
    __syncthreads();
    float m = -1e30f, l = 0.f;
#pragma unroll
    for (int st = 0; st < 2; ++st) {
      if (st >= nst) continue;
      const u16* Ks = (const u16*)(smem + st * KVBUF);
      f32x16 s[2]; float mx;
      const float sb = slope2 * (float)(1024 * st + 31) + sk * (float)(4 * hh);
      score_stage(qf, Ks, lane, sk, sb, 0, limc - 64 * st, s, mx);
      const float mn = fmaxf(m, mx);
      float ls = 0.f;
#pragma unroll
      for (int sub = 0; sub < 2; ++sub)
#pragma unroll
        for (int i = 0; i < 16; ++i) ls += fexp2(s[sub][i] - mn);
      l = l * fexp2(m - mn) + ls;
      m = mn;
    }
    const float lt = l + __shfl_xor(l, 32);
    const float inv = lt > 0.f ? 1.f / lt : 0.f;
    f32x16 o[2]; o[0] = zero16(); o[1] = zero16();
#pragma unroll
    for (int st = 0; st < 2; ++st) {
      if (st >= nst) {
#pragma unroll
        for (int G = 0; G < 16; ++G) {
          if ((G & 1) == hh) { impA[(w * 64 + tokl) * 33 + 16 * st + G] = 0.f; impB[(w * 64 + tokl) * 33 + 16 * st + G] = 0.f; }
        }
        continue;
      }
      const u16* Ks = (const u16*)(smem + st * KVBUF); const u16* Vts = Ks + 64 * 72;
      f32x16 s[2]; float mx;
      const float sb = slope2 * (float)(1024 * st + 31) + sk * (float)(4 * hh);
      score_stage(qf, Ks, lane, sk, sb, 0, limc - 64 * st, s, mx);
#pragma unroll
      for (int sub = 0; sub < 2; ++sub)
#pragma unroll
        for (int i = 0; i < 16; ++i) s[sub][i] = fexp2(s[sub][i] - m) * inv;
#pragma unroll
      for (int sub = 0; sub < 2; ++sub)
#pragma unroll
        for (int q4 = 0; q4 < 4; ++q4) {
          const int G = 16 * st + 8 * sub + 2 * q4 + hh;
          impA[(w * 64 + tokl) * 33 + G] = (s[sub][4 * q4] + s[sub][4 * q4 + 1]) + (s[sub][4 * q4 + 2] + s[sub][4 * q4 + 3]);
          impB[(w * 64 + tokl) * 33 + G] = s[sub][4 * q4 + 3];
        }
      pv_stage(s, Vts, o, lane);
    }
#pragma unroll
    for (int dt = 0; dt < 2; ++dt)
#pragma unroll
      for (int i = 0; i < 16; ++i) ot[dt][i] += g0 * o[dt][i];
  }
  const u16* kbs = pb + 1536 + g * 64; const u16* vbs = pb + 1792 + g * 64;
  KVRegs<512> rg;
  kv_load<512>(tid, kbs, vbs, LD_ODD, 0, 0, S_, rg);
  __syncthreads();
  for (int idx = tid; idx < 2048; idx += NT) {
    const int tok = idx >> 5, mm = idx & 31;
    float a = 0.f;
#pragma unroll
    for (int ww = 0; ww < 4; ++ww) a += impA[(ww * 64 + tok) * 33 + mm] + (mm > 0 ? impB[(ww * 64 + tok) * 33 + mm - 1] : 0.f);
    imp[tok * 33 + mm] = a;
  }
  __syncthreads();
  float* ots = impA + tid;
#pragma unroll
  for (int dt = 0; dt < 2; ++dt)
#pragma unroll
    for (int i = 0; i < 16; ++i) ots[(dt * 16 + i) * NT] = ot[dt][i];
  {
    const int tok = tid >> 3, sub8 = tid & 7;
    unsigned sel = 1u | (1u << cur) | (cur > 0 ? (1u << (cur - 1)) : 0u);
    const int cnt = __popc(sel);
    float cv[4];
#pragma unroll
    for (int e = 0; e < 4; ++e) cv[e] = imp[tok * 33 + sub8 * 4 + e];
    for (int r = cnt; r < 8; ++r) {
      float bv = -1.f; int bi = 64;
#pragma unroll
      for (int e = 0; e < 4; ++e) {
        const int mm = sub8 * 4 + e;
        const bool ok = (mm <= cur) && !((sel >> mm) & 1u);
        if (ok && cv[e] > bv) { bv = cv[e]; bi = mm; }
      }
#pragma unroll
      for (int off = 1; off < 8; off <<= 1) {
        const float ov = __shfl_xor(bv, off); const int oi = __shfl_xor(bi, off);
        if (ov > bv || (ov == bv && oi < bi)) { bv = ov; bi = oi; }
      }
      if (bi < 64) sel |= 1u << bi;
    }
    if (sub8 == 0) selm[tok] = sel;
  }
  __syncthreads();
  const unsigned myMask = selm[tokl];
  unsigned uni = 0u;
#pragma unroll 8
  for (int i = 0; i < 64; ++i) uni |= selm[i];
  {
    f32x16 o[2]; o[0] = zero16(); o[1] = zero16();
    float m = -1e30f, l = 0.f;
    const float* kg = nullptr;
    unsigned rem = uni & (uni - 1u);
    int mb = 0;
    int mbn = rem ? __builtin_ctz(rem) : -1;
    kv_store<512>(tid, rg, kg, (u16*)smem, (u16*)smem + 64 * 72);
    if (mbn >= 0) kv_load<512>(tid, kbs, vbs, LD_ODD, 64 * mbn, 0, S_, rg);
    __syncthreads();
    int par = 0;
#pragma unroll 1
    while (true) {
      u16* Ks = (u16*)(smem + par * KVBUF); u16* Vts = Ks + 64 * 72;
      int mbn2 = -1;
      if (mbn >= 0) {
        u16* Kn = (u16*)(smem + (par ^ 1) * KVBUF);
        kv_store<512>(tid, rg, kg, Kn, Kn + 64 * 72);
        rem &= rem - 1u;
        mbn2 = rem ? __builtin_ctz(rem) : -1;
        if (mbn2 >= 0) kv_load<512>(tid, kbs, vbs, LD_ODD, 64 * mbn2, 0, S_, rg);
      }
      const bool selb = (myMask >> mb) & 1u;
      const float sb = slope2 * (float)(64 * mb) + slope2 * (float)(4 * hh);
      if (__any(selb)) flash_stage(qf, Ks, Vts, o, m, l, lane, slope2, sb, 0, selb ? (tq - 64 * mb) : -1);
      __syncthreads();
      if (mbn < 0) break;
      mb = mbn; mbn = mbn2; par ^= 1;
    }
    const float lt = l + __shfl_xor(l, 32);
    const float sc = g1 / lt;
#pragma unroll
    for (int dt = 0; dt < 2; ++dt)
#pragma unroll
      for (int i = 0; i < 16; ++i) ots[(dt * 16 + i) * NT] += sc * o[dt][i];
  }
  {
    f32x16 o[2]; o[0] = zero16(); o[1] = zero16();
    float m = -1e30f, l = 0.f;
    const u16* kb = pb + 2048 + g * 64; const u16* vb = pb + 2304 + g * 64;
    const float* kg = nullptr;
    const int mlo = (t0 - 511) < 0 ? 0 : ((t0 - 511) >> 6);
    kv_load<512>(tid, kb, vb, LD_ODD, 64 * mlo, 0, S_, rg);
    kv_store<512>(tid, rg, kg, (u16*)smem, (u16*)smem + 64 * 72);
    if (mlo + 1 <= cur) kv_load<512>(tid, kb, vb, LD_ODD, 64 * (mlo + 1), 0, S_, rg);
    __syncthreads();
#pragma unroll 1
    for (int mb = mlo; mb <= cur; ++mb) {
      const int par = (mb - mlo) & 1;
      u16* Ks = (u16*)(smem + par * KVBUF); u16* Vts = Ks + 64 * 72;
      if (mb + 1 <= cur) { u16* Kn = (u16*)(smem + (par ^ 1) * KVBUF); kv_store<512>(tid, rg, kg, Kn, Kn + 64 * 72); }
      if (mb + 2 <= cur) kv_load<512>(tid, kb, vb, LD_ODD, 64 * (mb + 2), 0, S_, rg);
      const int lim = tq - 64 * mb;
      const float sb = slope2 * (float)(64 * mb) + slope2 * (float)(4 * hh);
      flash_stage(qf, Ks, Vts, o, m, l, lane, slope2, sb, lim - 511, lim);
      __syncthreads();
    }
    const float lt = l + __shfl_xor(l, 32);
    const float sc = g2 / lt;
    u16* orow = p.hbuf + (size_t)(b * S_ + tq) * 1024 + g * 256 + w * 64;
#pragma unroll
    for (int dt = 0; dt < 2; ++dt)
#pragma unroll
      for (int q4 = 0; q4 < 4; ++q4) {
        const float a0 = ots[(dt * 16 + 4 * q4 + 0) * NT] + sc * o[dt][4 * q4 + 0], a1 = ots[(dt * 16 + 4 * q4 + 1) * NT] + sc * o[dt][4 * q4 + 1];
        const float a2 = ots[(dt * 16 + 4 * q4 + 2) * NT] + sc * o[dt][4 * q4 + 2], a3 = ots[(dt * 16 + 4 * q4 + 3) * NT] + sc * o[dt][4 * q4 + 3];
        uint2 ov; ov.x = pack2(a0, a1); ov.y = pack2(a2, a3);
        *(uint2*)(orow + dt * 32 + 8 * q4 + 4 * hh) = ov;
      }
  }
  __syncthreads();
}

DI void run_phase(const Params& p, int ph, char* smem) {
  if (ph == 0) { prep_phase(p, smem); return; }
  const int l = (ph - 1) >> 3, s = (ph - 1) & 7, li = l >> 1;
  const bool even = (l & 1) == 0;
  const float* xin = (l == 0) ? p.x : p.out;
  switch (s) {
    case 0: rmsnorm_phase(xin, p.attn_norm + l * 1024, p.hbuf); break;
    case 1:
      if (even) gemm_phase<0>(p.hbuf, p.wt_hy_in + (size_t)li * 3584 * 1024, 1024, 14, p.proj, LD_EVEN, nullptr, nullptr, smem);
      else gemm_phase<0>(p.hbuf, p.wt_nsa_in + (size_t)li * 2816 * 1024, 1024, 11, p.proj, LD_ODD, nullptr, nullptr, smem);
      break;
    case 2:
      if (even) {
        for (int item = blockIdx.x; item < 256 + 3072; item += gridDim.x) {
          if (item < 256) hgrn_item(p, li, item, smem); else dilated_item(p, li, item - 256, smem);
        }
      } else {
        for (int item = blockIdx.x; item < 256; item += gridDim.x) compress_item(p, li, item, smem);
        nsa_knorm_phase(p, li);
      }
      break;
    case 3:
      if (even) post_even_phase(p, li);
      else {
        for (int item = blockIdx.x; item < 2048; item += gridDim.x) {
          const int r = item / gridDim.x, i = item % gridDim.x;
          int it2 = item;
          if (gridDim.x == 256) {
            const int c = (i + 4 * (r >> 1)) & 31;
            const int tt = (r & 1) ? 31 - c : c;
            it2 = ((i >> 5) + 8 * r) * 32 + tt;
          }
          nsa_item(p, li, it2, smem);
        }
      }
      break;
    case 4:
      gemm_phase<1>(p.hbuf, (even ? p.wt_hy_out : p.wt_nsa_out) + (size_t)li * 1048576, 1024, 4, nullptr, 0, xin, p.out, smem);
      break;
    case 5: rmsnorm_phase(p.out, p.ffn_norm + l * 1024, p.hbuf); break;
    case 6: gemm_phase<2>(p.hbuf, p.wt_gu + (size_t)l * 5632 * 1024, 1024, 22, p.proj, DFF, nullptr, nullptr, smem); break;
    case 7: gemm_phase<1>(p.proj, p.wt_dn + (size_t)l * 1024 * 2816, 2816, 4, nullptr, 0, p.out, p.out, smem); break;
  }
}

__global__ void __launch_bounds__(512) mk_forward(Params p) {
  __shared__ __attribute__((aligned(16))) char smem[131072];
  __shared__ uint4 xb_words;
  cg::grid_group grid = cg::this_grid();
  if (__builtin_amdgcn_workitem_id_x() == 0) xb_words = make_uint4(0u, 0u, 0u, 0u);
  __syncthreads();
  const XcdBarrier xb = xcd_barrier_post(p.bar, (volatile LAS unsigned*)&xb_words);
  for (int ph = p.phase_lo; ph < p.phase_hi; ++ph) {
    run_phase(p, ph, smem);
    if (ph + 1 < p.phase_hi) {
      if (p.phase_hi < 0) grid.sync();
      xcd_barrier(xb);
    }
  }
}

extern "C" void kernel_launch(void* const* d_in, const int* in_sizes, int n_in, void* d_out, int out_size,
                              void* d_ws, size_t ws_size, hipStream_t stream) {
  static int grid_blocks = 0;
  if (!grid_blocks) {
    int dev = 0, cus = 0, per_cu = 0;
    hipGetDevice(&dev);
    hipDeviceGetAttribute(&cus, hipDeviceAttributeMultiprocessorCount, dev);
    hipOccupancyMaxActiveBlocksPerMultiprocessor(&per_cu, mk_forward, 512, 0);
    if (per_cu > 1) per_cu = 1;
    if (per_cu < 1) per_cu = 1;
    grid_blocks = cus * per_cu;
  }
  Params p;
  memset(&p, 0, sizeof(p));
  p.x = (const float*)d_in[0]; p.attn_norm = (const float*)d_in[1]; p.ffn_norm = (const float*)d_in[2];
  p.hy_w_in = (const float*)d_in[3]; p.hy_lb = (const float*)d_in[4]; p.hy_og = (const float*)d_in[5];
  p.hy_qg = (const float*)d_in[6]; p.hy_kg = (const float*)d_in[7]; p.hy_w_out = (const float*)d_in[8];
  p.nsa_w_in = (const float*)d_in[9]; p.nsa_qg = (const float*)d_in[10]; p.nsa_kg = (const float*)d_in[11];
  p.cmp_pe = (const float*)d_in[12]; p.cmp_w1 = (const float*)d_in[13]; p.cmp_w2 = (const float*)d_in[14];
  p.nsa_w_out = (const float*)d_in[15]; p.ffn_g = (const float*)d_in[16]; p.ffn_u = (const float*)d_in[17]; p.ffn_d = (const float*)d_in[18];
  p.out = (float*)d_out;
  char* ws = (char*)d_ws; size_t off = 0;
  auto take = [&](size_t bytes) { char* r = ws + off; off += (bytes + 255) & ~(size_t)255; return r; };
  p.wt_hy_in = (u16*)take((size_t)2 * 3584 * 1024 * 2);
  p.wt_hy_out = (u16*)take((size_t)2 * 1048576 * 2);
  p.wt_nsa_in = (u16*)take((size_t)2 * 2816 * 1024 * 2);
  p.wt_nsa_out = (u16*)take((size_t)2 * 1048576 * 2);
  p.wt_gu = (u16*)take((size_t)4 * 5632 * 1024 * 2);
  p.wt_dn = (u16*)take((size_t)4 * 1024 * 2816 * 2);
  p.wt_c1 = (u16*)take((size_t)4 * 128 * 2048 * 2);
  p.wt_c2 = (u16*)take((size_t)4 * 64 * 128 * 2);
  p.c1 = (float*)take(4 * 128 * 4);
  p.lb = (float*)take(2 * 512 * 4);
  p.lse = (float*)take((size_t)3 * T_ * 8 * 4);
  p.proj = (u16*)take((size_t)T_ * 3584 * 2);
  p.hbuf = (u16*)take((size_t)T_ * 1024 * 2);
  p.obr = (u16*)take((size_t)3 * T_ * 512 * 2);
  p.kcmp = (u16*)take((size_t)16 * 4 * 128 * 64 * 2);
  p.vcmp = (u16*)take((size_t)16 * 4 * 128 * 64 * 2);
  p.bar = (unsigned*)take(XCD_BAR_WORDS * 4);
  if (off > ws_size) { fprintf(stderr, "workspace too small: need %zu have %zu\n", off, ws_size); return; }
  const int NPH = 33;
  hipMemsetAsync(p.bar, 0, XCD_BAR_WORDS * 4, stream);
#if MK_MULTI
  for (int ph = 0; ph < NPH; ++ph) {
    p.phase_lo = ph; p.phase_hi = ph + 1;
    hipLaunchKernelGGL(mk_forward, dim3(grid_blocks), dim3(512), 0, stream, p);
  }
#else
  p.phase_lo = 0; p.phase_hi = NPH;
  void* args[] = {&p};
  hipError_t e = hipLaunchCooperativeKernel((void*)mk_forward, dim3(grid_blocks), dim3(512), args, 0, stream);
  if (e != hipSuccess) fprintf(stderr, "cooperative launch failed: %s (grid %d)\n", hipGetErrorString(e), grid_blocks);
#endif
}
```

```cpp
#include <hip/hip_runtime.h>
#include <hip/hip_cooperative_groups.h>
#include <cstdio>
#include <cstdint>
#include <cstring>
namespace cg = cooperative_groups;

typedef unsigned short u16;
using bf16x8 = __attribute__((ext_vector_type(8))) short;
using f32x16 = __attribute__((ext_vector_type(16))) float;
using u32x4v = __attribute__((ext_vector_type(4))) unsigned;
#define DI __device__ __forceinline__
#define MFMA32(a, b, c) __builtin_amdgcn_mfma_f32_32x32x16_bf16((a), (b), (c), 0, 0, 0)

#ifndef MK_MULTI
#define MK_MULTI 0
#endif

constexpr int T_ = 32768, S_ = 2048;
constexpr float EPSF = 1e-6f;
constexpr float LOG2E = 1.4426950408889634f, LN2 = 0.6931471805599453f;
constexpr int LD_EVEN = 3584, LD_ODD = 2816, DFF = 2816;
constexpr int NT = 512;
#define LAS __attribute__((address_space(3)))
using f32x4v = __attribute__((ext_vector_type(4))) float;

struct Params {
  const float* x; const float* attn_norm; const float* ffn_norm;
  const float* hy_w_in; const float* hy_lb; const float* hy_og; const float* hy_qg; const float* hy_kg; const float* hy_w_out;
  const float* nsa_w_in; const float* nsa_qg; const float* nsa_kg; const float* cmp_pe; const float* cmp_w1; const float* cmp_w2; const float* nsa_w_out;
  const float* ffn_g; const float* ffn_u; const float* ffn_d;
  float* out;
  u16* wt_hy_in; u16* wt_hy_out; u16* wt_nsa_in; u16* wt_nsa_out; u16* wt_gu; u16* wt_dn; u16* wt_c1; u16* wt_c2;
  float* c1; float* lb; float* lse;
  u16* proj; u16* hbuf; u16* obr; u16* kcmp; u16* vcmp;
  unsigned* bar;
  int phase_lo; int phase_hi;
};

DI int tidx() { int t = __builtin_amdgcn_workitem_id_x(); asm volatile("" : "+v"(t)); return t; }
DI float bf2f(u16 h) { return __uint_as_float(((unsigned)h) << 16); }
typedef __bf16 bf16x2_t __attribute__((ext_vector_type(2)));
typedef float f32x2_t __attribute__((ext_vector_type(2)));
DI unsigned pack2(float a, float b) { f32x2_t v = {a, b}; bf16x2_t r = __builtin_convertvector(v, bf16x2_t); return __builtin_bit_cast(unsigned, r); }
DI u16 f2bf(float x) { return (u16)(pack2(x, 0.f) & 0xffffu); }
DI float fsigmoid(float x) { return 1.f / (1.f + __expf(-x)); }
DI float fsilu(float x) { return x / (1.f + __expf(-x)); }
DI float fexp2(float x) { return __builtin_amdgcn_exp2f(x); }
DI void unpack8(uint4 v, float (&f)[8]) {
  f[0] = __uint_as_float(v.x << 16); f[1] = __uint_as_float(v.x & 0xffff0000u);
  f[2] = __uint_as_float(v.y << 16); f[3] = __uint_as_float(v.y & 0xffff0000u);
  f[4] = __uint_as_float(v.z << 16); f[5] = __uint_as_float(v.z & 0xffff0000u);
  f[6] = __uint_as_float(v.w << 16); f[7] = __uint_as_float(v.w & 0xffff0000u);
}
DI uint4 pack8(const float (&f)[8]) {
  uint4 o; o.x = pack2(f[0], f[1]); o.y = pack2(f[2], f[3]); o.z = pack2(f[4], f[5]); o.w = pack2(f[6], f[7]); return o;
}
DI bf16x8 as_bf16x8(uint4 v) { u32x4v t; t[0] = v.x; t[1] = v.y; t[2] = v.z; t[3] = v.w; return __builtin_bit_cast(bf16x8, t); }
DI f32x16 zero16() { f32x16 z;
#pragma unroll
  for (int i = 0; i < 16; ++i) z[i] = 0.f; return z; }


#define XB_TMO      128
#define XB_XCNT(j)  (256  + 64 * (j))
#define XB_XSUB(j)  (1280 + 64 * (j))
#define XB_XGEN(j)  (2304 + 64 * (j))
#define XB_TOP      3328
#define XB_TOPGEN   3392
#define XCD_BAR_WORDS 3456
#define XB_SPIN_CAP (1u << 18)
DI unsigned xb_ld(unsigned* p) { return __hip_atomic_load(p, __ATOMIC_RELAXED, __HIP_MEMORY_SCOPE_AGENT); }
DI unsigned xb_add(unsigned* p, unsigned v) { return __hip_atomic_fetch_add(p, v, __ATOMIC_RELAXED, __HIP_MEMORY_SCOPE_AGENT); }
DI unsigned xb_xcc_id() { return (unsigned)__builtin_amdgcn_s_getreg((3 << 11) | 20) & 0xFu; }
#define XB_SPIN(cond, bar) do { unsigned _sp = 0; while (cond) { __builtin_amdgcn_s_sleep(1); \
    if ((++_sp & 255u) == 0u) { if (xb_ld(&(bar)[XB_TMO])) break; if (_sp > XB_SPIN_CAP) { atomicAdd(&(bar)[XB_TMO], 1u); break; } } } } while (0)
struct XcdBarrier { unsigned* bar; unsigned x; volatile LAS unsigned* st; };
DI XcdBarrier xcd_barrier_post(unsigned* bar, volatile LAS unsigned* st) {
  XcdBarrier b; b.bar = bar; b.x = xb_xcc_id(); b.st = st;
  if (__builtin_amdgcn_workitem_id_x() == 0) (void)xb_add(&bar[XB_XCNT(b.x)], 1u);
  return b;
}
DI void xcd_barrier_complete(unsigned* bar, unsigned x, unsigned& nloc, unsigned& nx) {
  const unsigned G = gridDim.x * gridDim.y * gridDim.z;
  unsigned sum, cnt, mine, sp = 0u;
  for (;;) {
    sum = 0u; cnt = 0u; mine = 0u;
#pragma unroll
    for (unsigned j = 0; j < 16; ++j) { const unsigned c = xb_ld(&bar[XB_XCNT(j)]); sum += c; cnt += (c > 0u) ? 1u : 0u; mine = (j == x) ? c : mine; }
    if (sum == G) break;
    __builtin_amdgcn_s_sleep(1);
    if ((++sp & 255u) == 0u) { if (xb_ld(&bar[XB_TMO])) break; if (sp > XB_SPIN_CAP) { atomicAdd(&bar[XB_TMO], 1u); break; } }
  }
  nloc = mine > 0u ? mine : 1u; nx = cnt > 0u ? cnt : 1u;
}
DI void xcd_barrier(const XcdBarrier& b) {
  asm volatile("s_waitcnt vmcnt(0)" ::: "memory");
  __syncthreads();
  if (__builtin_amdgcn_workitem_id_x() == 0) {
    unsigned* bar = b.bar;
    __builtin_amdgcn_s_waitcnt(0);
    unsigned nloc = b.st[0], nx = b.st[1];
    if (nloc == 0u) { xcd_barrier_complete(bar, b.x, nloc, nx); b.st[0] = nloc; b.st[1] = nx; }
    const unsigned old = xb_add(&bar[XB_XSUB(b.x)], 1u);
    const unsigned gen = old / nloc;
    if (old + 1u == (gen + 1u) * nloc) {
      __builtin_amdgcn_fence(__ATOMIC_RELEASE, "agent");
      asm volatile("s_waitcnt vmcnt(0)" ::: "memory");
      const unsigned og = xb_add(&bar[XB_TOP], 1u);
      const unsigned tg = og / nx;
      if (og + 1u == (tg + 1u) * nx) xb_add(&bar[XB_TOPGEN], 1u);
      else XB_SPIN(xb_ld(&bar[XB_TOPGEN]) == tg, bar);
      __builtin_amdgcn_fence(__ATOMIC_ACQUIRE, "agent");
      xb_add(&bar[XB_XGEN(b.x)], 1u);
      asm volatile("s_waitcnt vmcnt(0)" ::: "memory");
    } else {
      XB_SPIN(xb_ld(&bar[XB_XGEN(b.x)]) == gen, bar);
      __builtin_amdgcn_fence(__ATOMIC_ACQUIRE, "agent");
      asm volatile("s_waitcnt vmcnt(0)" ::: "memory");
    }
  }
  __syncthreads();
}

struct PrepDesc { const float* src; u16* dst; int K, N, mode, tk, tn; };
DI PrepDesc prep_desc(const Params& p, int tile) {
  constexpr int G0 = 1792, G1 = 2304, G2 = 3712, G3 = 4224, G4 = 7040, G5 = 9856, G6 = 12672, G7 = 12928;
  PrepDesc d; int Np, lt; d.mode = 0;
  if (tile < G0) { int i = tile / 896; lt = tile % 896; d.src = p.hy_w_in + (size_t)i * 1024 * 3584; d.dst = p.wt_hy_in + (size_t)i * 3584 * 1024; d.K = 1024; d.N = 3584; Np = 3584; }
  else if (tile < G1) { int t = tile - G0; int i = t / 256; lt = t % 256; d.src = p.hy_w_out + (size_t)i * 1048576; d.dst = p.wt_hy_out + (size_t)i * 1048576; d.K = 1024; d.N = 1024; Np = 1024; }
  else if (tile < G2) { int t = tile - G1; int i = t / 704; lt = t % 704; d.src = p.nsa_w_in + (size_t)i * 1024 * 2608; d.dst = p.wt_nsa_in + (size_t)i * 2816 * 1024; d.K = 1024; d.N = 2608; Np = 2816; }
  else if (tile < G3) { int t = tile - G2; int i = t / 256; lt = t % 256; d.src = p.nsa_w_out + (size_t)i * 1048576; d.dst = p.wt_nsa_out + (size_t)i * 1048576; d.K = 1024; d.N = 1024; Np = 1024; }
  else if (tile < G4) { int t = tile - G3; int i = t / 704; lt = t % 704; d.src = p.ffn_g + (size_t)i * 1024 * 2816; d.dst = p.wt_gu + (size_t)i * 5632 * 1024; d.K = 1024; d.N = 2816; Np = 2816; d.mode = 1; }
  else if (tile < G5) { int t = tile - G4; int i = t / 704; lt = t % 704; d.src = p.ffn_u + (size_t)i * 1024 * 2816; d.dst = p.wt_gu + (size_t)i * 5632 * 1024; d.K = 1024; d.N = 2816; Np = 2816; d.mode = 2; }
  else if (tile < G6) { int t = tile - G5; int i = t / 704; lt = t % 704; d.src = p.ffn_d + (size_t)i * 2816 * 1024; d.dst = p.wt_dn + (size_t)i * 1024 * 2816; d.K = 2816; d.N = 1024; Np = 1024; }
  else if (tile < G7) { int t = tile - G6; int i = t / 64; lt = t % 64; d.src = p.cmp_w1 + (size_t)i * 2048 * 128; d.dst = p.wt_c1 + (size_t)i * 128 * 2048; d.K = 2048; d.N = 128; Np = 128; }
  else { int t = tile - G7; int i = t / 2; lt = t % 2; d.src = p.cmp_w2 + (size_t)i * 128 * 64; d.dst = p.wt_c2 + (size_t)i * 64 * 128; d.K = 128; d.N = 64; Np = 64; }
  const int ntn = Np / 64;
  d.tk = lt / ntn; d.tn = lt % ntn;
  return d;
}
DI void prep_load(const PrepDesc& d, int tid, float (&rv)[8]) {
  const int c = tid & 63; const int n = d.tn * 64 + c;
#pragma unroll
  for (int j = 0; j < 8; ++j) {
    const int r = (tid >> 6) + 8 * j;
    rv[j] = (n < d.N) ? d.src[(size_t)(d.tk * 64 + r) * d.N + n] : 0.f;
  }
}

DI void prep_phase(const Params& p, char* smem) {
  float* sm = (float*)smem;
  constexpr int G8 = 12936;
  const int tid = tidx();
  float rv[8];
  int tile = blockIdx.x;
  asm volatile("" : "+s"(tile));
  if (tile < G8) { const PrepDesc d0 = prep_desc(p, tile); prep_load(d0, tid, rv); }
  for (; tile < G8; tile += gridDim.x) {
    const PrepDesc d = prep_desc(p, tile);
    __syncthreads();
#pragma unroll
    for (int j = 0; j < 8; ++j) sm[((tid >> 6) + 8 * j) * 65 + (tid & 63)] = rv[j];
    __syncthreads();
    if (tile + (int)gridDim.x < G8) { const PrepDesc dn = prep_desc(p, tile + gridDim.x); prep_load(dn, tid, rv); }
    const int nl = tid >> 3, kp = tid & 7;
    const int n = d.tn * 64 + nl;
    int nd = n;
    if (d.mode == 1) nd = (n >> 4) * 32 + (n & 15);
    else if (d.mode == 2) nd = (n >> 4) * 32 + 16 + (n & 15);
    float v[8];
#pragma unroll
    for (int j = 0; j < 8; ++j) v[j] = sm[(kp * 8 + j) * 65 + nl];
    *(uint4*)(d.dst + (size_t)nd * d.K + d.tk * 64 + kp * 8) = pack8(v);
  }
  __syncthreads();
  if (blockIdx.x < 4) {
    const int mi = blockIdx.x;
    const float* pe = p.cmp_pe + (size_t)mi * 2048;
    const float* w1 = p.cmp_w1 + (size_t)mi * 2048 * 128;
    const int tq_ = tidx();
    const int o = tq_ & 127, half = tq_ >> 7;
    float a0 = 0.f, a1 = 0.f, a2 = 0.f, a3 = 0.f;
    for (int k = half * 512; k < half * 512 + 512; k += 4) {
      a0 += pe[k] * w1[(size_t)k * 128 + o]; a1 += pe[k + 1] * w1[(size_t)(k + 1) * 128 + o];
      a2 += pe[k + 2] * w1[(size_t)(k + 2) * 128 + o]; a3 += pe[k + 3] * w1[(size_t)(k + 3) * 128 + o];
    }
    sm[tq_] = (a0 + a1) + (a2 + a3);
    __syncthreads();
    if (tq_ < 128) p.c1[mi * 128 + tq_] = (sm[tq_] + sm[tq_ + 128]) + (sm[tq_ + 256] + sm[tq_ + 384]);
    __syncthreads();
  }
  if (blockIdx.x == 4 || (gridDim.x <= 4 && blockIdx.x == 0)) {
    for (int c = tidx(); c < 512; c += NT) {
      float l0 = p.hy_lb[c], l1 = p.hy_lb[512 + c];
      float mx = fmaxf(l0, l1); float e0 = __expf(l0 - mx), e1 = __expf(l1 - mx); float inv = 1.f / (e0 + e1);
      float p0 = e0 * inv, p1 = e1 * inv;
      p.lb[c] = p0 - p0; p.lb[512 + c] = (p0 + p1) - p0;
    }
  }
}

DI void rmsnorm_phase(const float* x, const float* __restrict__ g, u16* h) {
  const int t_ = tidx();
  const int wave = t_ >> 6, lane = t_ & 63;
  const int stride = gridDim.x * 8;
  int row = blockIdx.x * 8 + wave;
  float4 v[4], nv[4];
  float4 gg[4];
#pragma unroll
  for (int j = 0; j < 4; ++j) gg[j] = ((const float4*)g)[lane + 64 * j];
  if (row < T_) {
    const float4* xr = (const float4*)(x + (size_t)row * 1024);
#pragma unroll
    for (int j = 0; j < 4; ++j) v[j] = xr[lane + 64 * j];
  }
  while (row < T_) {
    const int nrow = row + stride;
    if (nrow < T_) {
      const float4* xr = (const float4*)(x + (size_t)nrow * 1024);
#pragma unroll
      for (int j = 0; j < 4; ++j) nv[j] = xr[lane + 64 * j];
    }
    float ss = 0.f;
#pragma unroll
    for (int j = 0; j < 4; ++j) ss += v[j].x * v[j].x + v[j].y * v[j].y + v[j].z * v[j].z + v[j].w * v[j].w;
#pragma unroll
    for (int off = 32; off >= 1; off >>= 1) ss += __shfl_xor(ss, off);
    const float rs = rsqrtf(ss * (1.f / 1024.f) + EPSF);
#pragma unroll
    for (int j = 0; j < 4; ++j) {
      uint2 o; o.x = pack2(v[j].x * rs * gg[j].x, v[j].y * rs * gg[j].y); o.y = pack2(v[j].z * rs * gg[j].z, v[j].w * rs * gg[j].w);
      *(uint2*)(h + (size_t)row * 1024 + (lane + 64 * j) * 4) = o;
    }
#pragma unroll
    for (int j = 0; j < 4; ++j) v[j] = nv[j];
    row = nrow;
  }
}

DI int lds_byte(int r, int c) { const int st = (r >> 4) * 2 + (c >> 5), rr = r & 15, cc = c & 31, ob = rr * 64 + cc * 2; return st * 1024 + (ob ^ (((ob >> 9) & 1) << 5)); }
DI void stage_rc(int b, int& R, int& C) { const int st = b / 1024, sb = b % 1024, swz = sb ^ (((sb >> 9) & 1) << 5); R = (st >> 1) * 16 + swz / 64; C = (st & 1) * 32 + (swz % 64) / 2; }

template <int EPI>
DI void gemm_phase(const u16* A, const u16* Bt, const int K, const int nN, u16* outb, const int ldc, const float* res, float* outf, char* smem, const bool rev = false) {
  constexpr int HTB = 16384;
  const int tid = tidx();
  const int wid = tid >> 6, lane = tid & 63, wr = wid >> 2, wc = wid & 3, fr = lane & 15, fq = lane >> 4;
  const int nM = 128, nwg = nM * nN, nt = K / 64;
  int sR0, sC0, sR1, sC1; stage_rc(tid * 16, sR0, sC0); stage_rc(tid * 16 + 8192, sR1, sC1);
  const unsigned vo0 = (unsigned)((sR0 * K + sC0) * 2), vo1 = (unsigned)((sR1 * K + sC1) * 2);
#define SA_(b, h) (smem + ((b) * 2 + (h)) * HTB)
#define SB_(b, h) (smem + (4 + (b) * 2 + (h)) * HTB)
#define STAGE(P, BASE, br, kt) do { const char* _g = (const char*)((BASE) + (size_t)(br) * K + (size_t)(kt) * 64); \
    unsigned _o0 = vo0, _o1 = vo1; asm volatile("" : "+v"(_o0), "+v"(_o1)); \
    __builtin_amdgcn_global_load_lds((const unsigned*)(_g + _o0), (LAS unsigned*)((P) + tid * 16), 16, 0, 0); \
    __builtin_amdgcn_global_load_lds((const unsigned*)(_g + _o1), (LAS unsigned*)((P) + tid * 16 + 8192), 16, 0, 0); } while (0)
#define LDA(dst, b, h) _Pragma("unroll") for (int m = 0; m < 4; ++m) _Pragma("unroll") for (int k = 0; k < 2; ++k) \
    dst[m][k] = *(const bf16x8*)(SA_(b, h) + lds_byte(wr * 64 + m * 16 + fr, k * 32 + fq * 8))
#define LDB(dst, b, h) _Pragma("unroll") for (int n = 0; n < 2; ++n) _Pragma("unroll") for (int k = 0; k < 2; ++k) \
    dst[n][k] = *(const bf16x8*)(SB_(b, h) + lds_byte(wc * 32 + n * 16 + fr, k * 32 + fq * 8))
#define MMA(ai, bj, At_, Bx_) do { __builtin_amdgcn_s_setprio(1); \
    _Pragma("unroll") for (int m = 0; m < 4; ++m) _Pragma("unroll") for (int n = 0; n < 2; ++n) _Pragma("unroll") for (int k = 0; k < 2; ++k) \
      acc[ai][bj][m][n] = __builtin_amdgcn_mfma_f32_16x16x32_bf16(Bx_[n][k], At_[m][k], acc[ai][bj][m][n], 0, 0, 0); \
    __builtin_amdgcn_s_setprio(0); } while (0)
#define WAIT_V(n) asm volatile("s_waitcnt vmcnt(" #n ")" ::: "memory")
#define WAIT_L(n) asm volatile("s_waitcnt lgkmcnt(" #n ")" ::: "memory")
#define BAR __builtin_amdgcn_s_barrier()
#define SCHED __builtin_amdgcn_sched_barrier(0)
  auto tile_of = [&](long Lq, int& brow_, int& bcol_, int& pn_) {
    int wgid = (int)Lq;
    { const int q = nwg / 8, r = nwg % 8, xcd = wgid % 8, off = wgid / 8; wgid = (xcd < r ? xcd * (q + 1) : r * (q + 1) + (xcd - r) * q) + off; }
    const int nig = 8 * nN, gid = wgid / nig, fm = gid * 8, gsz = (nM - fm) < 8 ? (nM - fm) : 8;
    const int pm = fm + ((wgid % nig) % gsz);
    pn_ = (wgid % nig) / gsz; brow_ = (rev ? (nM - 1 - pm) : pm) * 256; bcol_ = pn_ * 256;
  };
#define STAGE7(br_, bc_) do { STAGE(SB_(0, 0), Bt, bc_, 0); STAGE(SA_(0, 0), A, br_, 0); STAGE(SB_(0, 1), Bt, (bc_) + 128, 0); STAGE(SA_(0, 1), A, (br_) + 128, 0); \
    STAGE(SB_(1, 0), Bt, bc_, 1); STAGE(SA_(1, 0), A, br_, 1); STAGE(SB_(1, 1), Bt, (bc_) + 128, 1); } while (0)
  long L = blockIdx.x;
  bool have = L < nwg;
  int brow = 0, bcol = 0, pn = 0;
  __syncthreads();
  if (have) { tile_of(L, brow, bcol, pn); STAGE7(brow, bcol); }
  while (have) {
    f32x4v acc[2][2][4][2];
#pragma unroll
    for (int a = 0; a < 2; ++a)
#pragma unroll
      for (int b = 0; b < 2; ++b)
#pragma unroll
        for (int m = 0; m < 4; ++m)
#pragma unroll
          for (int n = 0; n < 2; ++n) acc[a][b][m][n] = (f32x4v){0.f, 0.f, 0.f, 0.f};
    bf16x8 At[4][2], B0[2][2], B1[2][2];
    if (wr == 1) BAR;
    WAIT_V(0); BAR;
    BAR;
    for (int t = 0; t < nt - 2; t += 2) {
      LDB(B0, 0, 0); SCHED; LDA(At, 0, 0); STAGE(SA_(1, 1), A, brow + 128, t + 1);
      WAIT_L(8); BAR; WAIT_L(0); MMA(0, 0, At, B0); BAR; SCHED;
      LDB(B1, 0, 1); STAGE(SB_(0, 0), Bt, bcol, t + 2);
      BAR; WAIT_L(0); MMA(0, 1, At, B1); BAR;
      LDA(At, 0, 1); STAGE(SA_(0, 0), A, brow, t + 2);
      BAR; WAIT_L(0); MMA(1, 0, At, B0); BAR; SCHED;
      STAGE(SB_(0, 1), Bt, bcol + 128, t + 2);
      WAIT_V(6); BAR; MMA(1, 1, At, B1); BAR;
      LDB(B0, 1, 0); SCHED; LDA(At, 1, 0); STAGE(SA_(0, 1), A, brow + 128, t + 2);
      WAIT_L(8); BAR; WAIT_L(0); MMA(0, 0, At, B0); BAR; SCHED;
      LDB(B1, 1, 1); STAGE(SB_(1, 0), Bt, bcol, t + 3);
      BAR; WAIT_L(0); MMA(0, 1, At, B1); BAR;
      LDA(At, 1, 1); STAGE(SA_(1, 0), A, brow, t + 3);
      BAR; WAIT_L(0); MMA(1, 0, At, B0); BAR; SCHED;
      STAGE(SB_(1, 1), Bt, bcol + 128, t + 3);
      WAIT_V(6); BAR; MMA(1, 1, At, B1); BAR;
    }
    { LDB(B0, 0, 0); LDA(At, 0, 0); STAGE(SA_(1, 1), A, brow + 128, nt - 1);
      BAR; WAIT_L(0); MMA(0, 0, At, B0); BAR;
      LDB(B1, 0, 1); BAR; WAIT_L(0); MMA(0, 1, At, B1); BAR;
      LDA(At, 0, 1); WAIT_V(4); BAR; WAIT_L(0); MMA(1, 0, At, B0); MMA(1, 1, At, B1); BAR; }
    { LDB(B0, 1, 0); LDA(At, 1, 0); WAIT_V(2); BAR; WAIT_L(0); MMA(0, 0, At, B0); BAR;
      LDB(B1, 1, 1); WAIT_V(0); BAR; WAIT_L(0); MMA(0, 1, At, B1); BAR;
      LDA(At, 1, 1); BAR; WAIT_L(0); MMA(1, 0, At, B0); MMA(1, 1, At, B1); BAR; }
    if (wr == 0) BAR;
    const long Ln = L + gridDim.x;
    const bool haven = Ln < nwg;
    int browN = 0, bcolN = 0, pnN = 0;
    if (haven) { tile_of(Ln, browN, bcolN, pnN); STAGE7(browN, bcolN); }
    int tid2 = tid; asm volatile("" : "+v"(tid2));
    const int fr2 = tid2 & 15, fq2 = (tid2 >> 4) & 3, wc2 = (tid2 >> 6) & 3, wr2 = tid2 >> 8;
    if (EPI == 1) {
#pragma unroll
      for (int am = 0; am < 4; ++am) {
        const int ai = am >> 1, m0 = (am & 1) * 2;
        f32x4v rb[2][2][2];
        const float* rbase = res + (size_t)(brow + ai * 128 + wr2 * 64 + m0 * 16 + fr2) * 1024 + bcol + wc2 * 32 + fq2 * 4;
        float* obase = outf + (size_t)(brow + ai * 128 + wr2 * 64 + m0 * 16 + fr2) * 1024 + bcol + wc2 * 32 + fq2 * 4;
#pragma unroll
        for (int m = 0; m < 2; ++m)
#pragma unroll
          for (int bj = 0; bj < 2; ++bj)
#pragma unroll
            for (int n = 0; n < 2; ++n) rb[m][bj][n] = *(const f32x4v*)(rbase + (size_t)m * 16 * 1024 + bj * 128 + n * 16);
        asm volatile("" ::: "memory");
#pragma unroll
        for (int m = 0; m < 2; ++m)
#pragma unroll
          for (int bj = 0; bj < 2; ++bj)
#pragma unroll
            for (int n = 0; n < 2; ++n) *(f32x4v*)(obase + (size_t)m * 16 * 1024 + bj * 128 + n * 16) = rb[m][bj][n] + acc[ai][bj][m0 + m][n];
        asm volatile("" ::: "memory");
      }
    } else {
#pragma unroll
    for (int ai = 0; ai < 2; ++ai)
#pragma unroll
      for (int m = 0; m < 4; ++m) {
        const size_t row = (size_t)(brow + ai * 128 + wr2 * 64 + m * 16 + fr2);
#pragma unroll
        for (int bj = 0; bj < 2; ++bj) {
          const int cb = bcol + bj * 128 + wc2 * 32 + fq2 * 4;
          if (EPI == 0) {
#pragma unroll
            for (int n = 0; n < 2; ++n) {
              uint2 o; o.x = pack2(acc[ai][bj][m][n][0], acc[ai][bj][m][n][1]); o.y = pack2(acc[ai][bj][m][n][2], acc[ai][bj][m][n][3]);
              *(uint2*)(outb + row * ldc + cb + n * 16) = o;
            }
          } else {
            const f32x4v gv = acc[ai][bj][m][0], uv = acc[ai][bj][m][1];
            uint2 o; o.x = pack2(fsilu(gv[0]) * uv[0], fsilu(gv[1]) * uv[1]); o.y = pack2(fsilu(gv[2]) * uv[2], fsilu(gv[3]) * uv[3]);
            *(uint2*)(outb + row * DFF + ((bcol + bj * 128 + wc2 * 32) >> 1) + fq2 * 4) = o;
          }
        }
      }
    }
    L = Ln; have = haven; brow = browN; bcol = bcolN; pn = pnN;
  }
  __syncthreads();
#undef STAGE7
#undef SA_
#undef SB_
#undef STAGE
#undef LDA
#undef LDB
#undef MMA
}

#define MFMA16(a, b, c) __builtin_amdgcn_mfma_f32_16x16x32_bf16((a), (b), (c), 0, 0, 0)
DI void hgrn_item(const Params& p, int li, int item, char* smem) {
  const int tid = tidx(), lane = tid & 63, w = tid >> 6, fr = lane & 15, fq = lane >> 4;
  const int kk = w >> 1, vt = w & 1;
  const int vs = item & 3, h = (item >> 2) & 3, b = item >> 4;
  const int tg = tid & 3, kch = tid >> 2;
  const int sv = tid >> 5, vv = tid & 31;
  const float lbv = p.lb[li * 512 + h * 128 + kch];
  const u16* base = p.proj + (size_t)b * S_ * LD_EVEN;
  const u16* pq = base + (size_t)(4 * tg) * LD_EVEN + h * 128 + kch;
  const u16* pv = base + (size_t)sv * LD_EVEN + 1024 + h * 128 + vs * 32 + vv;
  struct HRegs { unsigned q0, q1, q2, q3, f0, f1, f2, f3, v; };
  auto hload = [&](int c, HRegs& r) {
    const u16* pq2 = pq + (size_t)c * 16 * LD_EVEN;
    r.q0 = pq2[0]; r.q1 = pq2[LD_EVEN]; r.q2 = pq2[2 * LD_EVEN]; r.q3 = pq2[3 * LD_EVEN];
    r.f0 = pq2[512]; r.f1 = pq2[LD_EVEN + 512]; r.f2 = pq2[2 * LD_EVEN + 512]; r.f3 = pq2[3 * LD_EVEN + 512];
    r.v = pv[(size_t)c * 16 * LD_EVEN];
  };
  HRegs ra, rb;
  hload(0, ra); hload(1, rb);
  f32x4v S0 = {0.f, 0.f, 0.f, 0.f}, S1 = {0.f, 0.f, 0.f, 0.f};
  const f32x4v z4 = {0.f, 0.f, 0.f, 0.f};
  __syncthreads();
  constexpr int HBUF = 16896;
  auto prep = [&](const HRegs& rr, int par) {
    u16* Qt_ = (u16*)(smem + par * HBUF); u16* Kt_ = Qt_ + 16 * 136; u16* Kh_ = Kt_ + 16 * 136; u16* Vt_ = Kh_ + 128 * 24; float* Pc_ = (float*)(Vt_ + 32 * 24);
    float qv[4], kv[4], cs[4];
    const unsigned rq[4] = {rr.q0, rr.q1, rr.q2, rr.q3}, rf[4] = {rr.f0, rr.f1, rr.f2, rr.f3};
    float cp = 1.f;
#pragma unroll
    for (int i = 0; i < 4; ++i) {
      const float f = lbv + (1.f - lbv) * fsigmoid(__uint_as_float(rf[i] << 16));
      cp *= f; cs[i] = cp; kv[i] = 1.f - f; qv[i] = fsilu(__uint_as_float(rq[i] << 16));
    }
    const int bl = lane & ~3;
    const float t0 = __shfl(cp, bl), t1 = __shfl(cp, bl + 1), t2 = __shfl(cp, bl + 2), t3 = __shfl(cp, bl + 3);
    const float pre = (tg > 0 ? t0 : 1.f) * (tg > 1 ? t1 : 1.f) * (tg > 2 ? t2 : 1.f);
    const float PC = (t0 * t1) * (t2 * t3);
    float kh[4];
#pragma unroll
    for (int i = 0; i < 4; ++i) {
      const float P = fmaxf(pre * cs[i], 1e-30f);
      const float rP = __builtin_amdgcn_rcpf(P);
      const int t = 4 * tg + i;
      Qt_[t * 136 + kch] = f2bf(qv[i] * P);
      const float kr = kv[i] * rP;
      Kt_[t * 136 + kch] = f2bf(kr);
      kh[i] = kr * PC;
    }
    uint2 k2; k2.x = pack2(kh[0], kh[1]); k2.y = pack2(kh[2], kh[3]);
    *(uint2*)(Kh_ + kch * 24 + 4 * tg) = k2;
    if (tg == 0) Pc_[kch] = PC;
    Vt_[vv * 24 + sv] = (u16)rr.v;
  };
  auto mfma = [&](int par) {
    const u16* Qt_ = (const u16*)(smem + par * HBUF); const u16* Kt_ = Qt_ + 16 * 136; const u16* Kh_ = Kt_ + 16 * 136; const u16* Vt_ = Kh_ + 128 * 24;
    const float* Pc_ = (const float*)(Vt_ + 32 * 24);
    float* Op_ = (float*)(smem + 4 * HBUF) + par * 2048;
    const uint2 v2 = *(const uint2*)(Vt_ + (16 * vt + fr) * 24 + 4 * fq);
    const bf16x8 vb = as_bf16x8(make_uint4(v2.x, v2.y, 0u, 0u));
    const u16* qrow = Qt_ + fr * 136 + 32 * kk + 4 * fq;
    const uint2 qa = *(const uint2*)qrow, qb = *(const uint2*)(qrow + 16);
    const bf16x8 qfrag = as_bf16x8(make_uint4(qa.x, qa.y, qb.x, qb.y));
    const bf16x8 sfrag = as_bf16x8(make_uint4(pack2(S0[0], S0[1]), pack2(S0[2], S0[3]), pack2(S1[0], S1[1]), pack2(S1[2], S1[3])));
    f32x4v acc = MFMA16(qfrag, sfrag, z4);
    if (kk == 0) {
      f32x4v sa = z4;
#pragma unroll
      for (int ks = 0; ks < 4; ++ks) {
        const bf16x8 kf = *(const bf16x8*)(Kt_ + fr * 136 + 32 * ks + 8 * fq);
        const bf16x8 qf2 = *(const bf16x8*)(Qt_ + fr * 136 + 32 * ks + 8 * fq);
        sa = MFMA16(kf, qf2, sa);
      }
#pragma unroll
      for (int j = 0; j < 4; ++j) sa[j] = (4 * fq + j <= fr) ? sa[j] : 0.f;
      const bf16x8 afrag = as_bf16x8(make_uint4(pack2(sa[0], sa[1]), pack2(sa[2], sa[3]), 0u, 0u));
      acc = MFMA16(afrag, vb, acc);
    }
#pragma unroll
    for (int j = 0; j < 4; ++j) Op_[(w * 16 + 4 * fq + j) * 16 + fr] = acc[j];
    const float* pc0 = Pc_ + 32 * kk + 4 * fq;
#pragma unroll
    for (int j = 0; j < 4; ++j) { S0[j] *= pc0[j]; S1[j] *= pc0[16 + j]; }
    const uint2 h0 = *(const uint2*)(Kh_ + (32 * kk + fr) * 24 + 4 * fq);
    const uint2 h1v = *(const uint2*)(Kh_ + (32 * kk + 16 + fr) * 24 + 4 * fq);
    S0 = MFMA16(as_bf16x8(make_uint4(h0.x, h0.y, 0u, 0u)), vb, S0);
    S1 = MFMA16(as_bf16x8(make_uint4(h1v.x, h1v.y, 0u, 0u)), vb, S1);
  };
  auto reduce = [&](int c, int par) {
    const float* Op_ = (const float*)(smem + 4 * HBUF) + par * 2048;
    const int t = tid >> 5, v = tid & 31, vtt = v >> 4, vl = v & 15;
    float o = 0.f;
#pragma unroll
    for (int q = 0; q < 4; ++q) o += Op_[((2 * q + vtt) * 16 + t) * 16 + vl];
    p.hbuf[(size_t)(b * S_ + c * 16 + t) * 1024 + h * 128 + vs * 32 + v] = f2bf(o);
  };
  prep(ra, 0); prep(rb, 1); hload(2, ra); hload(3, rb);
  __syncthreads();
#pragma unroll 1
  for (int P = 0; P < 64; P += 2) {
    mfma(0); mfma(1);
    prep(ra, 2); prep(rb, 3);
    if (P + 2 < 64) { hload(2 * P + 4, ra); hload(2 * P + 5, rb); }
    __syncthreads();
    reduce(2 * P, 0); reduce(2 * P + 1, 1);
    mfma(2); mfma(3);
    if (P + 2 < 64) { prep(ra, 0); prep(rb, 1); if (P + 3 < 64) { hload(2 * P + 6, ra); hload(2 * P + 7, rb); } }
    __syncthreads();
    reduce(2 * P + 2, 2); reduce(2 * P + 3, 3);
  }
  __syncthreads();
}

DI void load_q(const u16* qrow, const float* __restrict__ gain, int hh, bf16x8 (&qf)[4]) {
  float f[4][8]; float ss = 0.f;
#pragma unroll
  for (int kk = 0; kk < 4; ++kk) {
    uint4 raw = *(const uint4*)(qrow + kk * 16 + hh * 8);
    unpack8(raw, f[kk]);
#pragma unroll
    for (int j = 0; j < 8; ++j) ss += f[kk][j] * f[kk][j];
  }
  ss += __shfl_xor(ss, 32);
  const float rs = rsqrtf(ss * (1.f / 64.f) + EPSF) * (0.125f * LOG2E);
#pragma unroll
  for (int kk = 0; kk < 4; ++kk) {
#pragma unroll
    for (int j = 0; j < 8; ++j) f[kk][j] *= rs * gain[kk * 16 + hh * 8 + j];
    qf[kk] = as_bf16x8(pack8(f[kk]));
  }
}

constexpr int VS = 68;
constexpr int KVBUF = 18432;
template <int NTH> struct KVRegs { u32x4v r[NTH == 256 ? 4 : 2]; };
DI void kv_ld2(const u16* src, size_t stride, int ra, int rb, int rlo, int rhi, int dp, u32x4v& x0, u32x4v& x1) {
  const u32x4v z = {0u, 0u, 0u, 0u};
  x0 = z; x1 = z;
  if (ra >= rlo && ra < rhi) x0 = *(const u32x4v*)(src + (size_t)ra * stride + dp * 8);
  if (rb >= rlo && rb < rhi) x1 = *(const u32x4v*)(src + (size_t)rb * stride + dp * 8);
}
template <int NTH>
DI void kv_load(int tid, const u16* kb, const u16* vb, size_t stride, int r0, int rlo, int rhi, KVRegs<NTH>& rg) {
  const int dp = tid & 7, kq = (tid & 255) >> 3;
  if (NTH == 256) {
    kv_ld2(kb, stride, r0 + kq, r0 + kq + 32, rlo, rhi, dp, rg.r[0], rg.r[1]);
    kv_ld2(vb, stride, r0 + 2 * kq, r0 + 2 * kq + 1, rlo, rhi, dp, rg.r[2], rg.r[3]);
  } else {
    if (tid < 256) kv_ld2(kb, stride, r0 + kq, r0 + kq + 32, rlo, rhi, dp, rg.r[0], rg.r[1]);
    else kv_ld2(vb, stride, r0 + 2 * kq, r0 + 2 * kq + 1, rlo, rhi, dp, rg.r[0], rg.r[1]);
  }
}
DI void k_store1(u32x4v x, int key, int dp, const float* __restrict__ kgain, u16* Ks) {
  uint4 kv = make_uint4(x[0], x[1], x[2], x[3]);
  if (kgain) {
    float f[8]; unpack8(kv, f);
    float ss = 0.f;
#pragma unroll
    for (int e = 0; e < 8; ++e) ss += f[e] * f[e];
    ss += __shfl_xor(ss, 1); ss += __shfl_xor(ss, 2); ss += __shfl_xor(ss, 4);
    const float rs = rsqrtf(ss * (1.f / 64.f) + EPSF);
#pragma unroll
    for (int e = 0; e < 8; ++e) f[e] *= rs * kgain[dp * 8 + e];
    kv = pack8(f);
  }
  *(uint4*)(Ks + key * 72 + dp * 8) = kv;
}
DI void v_store2(u32x4v v0, u32x4v v1, int kp, int dp, u16* Vts) {
  unsigned* vd = (unsigned*)(Vts + (dp * 8) * VS + 2 * kp);
#pragma unroll
  for (int d = 0; d < 4; ++d) {
    vd[(2 * d) * (VS / 2)] = (v0[d] & 0xffffu) | (v1[d] << 16);
    vd[(2 * d + 1) * (VS / 2)] = (v0[d] >> 16) | (v1[d] & 0xffff0000u);
  }
}
template <int NTH>
DI void kv_store(int tid, const KVRegs<NTH>& rg, const float* __restrict__ kgain, u16* Ks, u16* Vts) {
  const int dp = tid & 7, kq = (tid & 255) >> 3;
  if (NTH == 256) {
    k_store1(rg.r[0], kq, dp, kgain, Ks); k_store1(rg.r[1], kq + 32, dp, kgain, Ks);
    v_store2(rg.r[2], rg.r[3], kq, dp, Vts);
  } else {
    if (tid < 256) { k_store1(rg.r[0], kq, dp, kgain, Ks); k_store1(rg.r[1], kq + 32, dp, kgain, Ks); }
    else v_store2(rg.r[0], rg.r[1], kq, dp, Vts);
  }
}

DI void score_stage(const bf16x8 (&qf)[4], const u16* Ks, int lane, float sk, float sb, int lower, int lim, f32x16 (&s)[2], float& mx) {
  const int lr = lane & 31, hh = lane >> 5;
#pragma unroll
  for (int sub = 0; sub < 2; ++sub) {
#pragma unroll
    for (int i = 0; i < 16; ++i) s[sub][i] = fmaf(sk, (float)(sub * 32 + (i & 3) + 8 * (i >> 2)), sb);
#pragma unroll
    for (int kk = 0; kk < 4; ++kk) {
      bf16x8 kf = *(const bf16x8*)(Ks + (sub * 32 + lr) * 72 + kk * 16 + hh * 8);
      s[sub] = MFMA32(kf, qf[kk], s[sub]);
    }
  }
  if (lim < lower) { lower = 64; lim = 64; }
  const bool full = (lower <= 0) && (lim >= 63);
  if (!__all(full)) {
    const int lo2 = lower - 4 * hh; const unsigned rng = (unsigned)(lim - lower);
#pragma unroll
    for (int sub = 0; sub < 2; ++sub)
#pragma unroll
      for (int i = 0; i < 16; ++i) {
        const int kc = sub * 32 + (i & 3) + 8 * (i >> 2);
        s[sub][i] = ((unsigned)(kc - lo2) <= rng) ? s[sub][i] : -INFINITY;
      }
  }
  mx = -INFINITY;
#pragma unroll
  for (int sub = 0; sub < 2; ++sub)
#pragma unroll
    for (int i = 0; i < 16; ++i) mx = fmaxf(mx, s[sub][i]);
  mx = fmaxf(mx, __shfl_xor(mx, 32));
}

DI void pv_stage(const f32x16 (&s)[2], const u16* Vts, f32x16 (&o)[2], int lane) {
  const int lr = lane & 31, hh = lane >> 5;
#pragma unroll
  for (int sub = 0; sub < 2; ++sub)
#pragma unroll
    for (int st = 0; st < 2; ++st) {
      uint4 pk;
      pk.x = pack2(s[sub][8 * st + 0], s[sub][8 * st + 1]); pk.y = pack2(s[sub][8 * st + 2], s[sub][8 * st + 3]);
      pk.z = pack2(s[sub][8 * st + 4], s[sub][8 * st + 5]); pk.w = pack2(s[sub][8 * st + 6], s[sub][8 * st + 7]);
      const bf16x8 pf = as_bf16x8(pk);
#pragma unroll
      for (int dt = 0; dt < 2; ++dt) {
        const u16* vp = Vts + (dt * 32 + lr) * VS + sub * 32 + 16 * st + 4 * hh;
        const uint2 lo = *(const uint2*)vp, hi = *(const uint2*)(vp + 8);
        const bf16x8 vf = as_bf16x8(make_uint4(lo.x, lo.y, hi.x, hi.y));
        o[dt] = MFMA32(vf, pf, o[dt]);
      }
    }
}

DI void flash_stage(const bf16x8 (&qf)[4], const u16* Ks, const u16* Vts, f32x16 (&o)[2], float& m, float& l, int lane,
                    float sk, float sb, int lower, int lim) {
  f32x16 s[2]; float mx;
  score_stage(qf, Ks, lane, sk, sb, lower, lim, s, mx);
  const float mn = fmaxf(m, mx);
  const float alpha = fexp2(m - mn);
  const bool same = (mn == m);
  m = mn;
  float ls = 0.f;
#pragma unroll
  for (int sub = 0; sub < 2; ++sub)
#pragma unroll
    for (int i = 0; i < 16; ++i) { const float pv = fexp2(s[sub][i] - mn); s[sub][i] = pv; ls += pv; }
  l = l * alpha + ls;
  if (!__all(same)) {
#pragma unroll
    for (int dt = 0; dt < 2; ++dt)
#pragma unroll
      for (int i = 0; i < 16; ++i) o[dt][i] *= alpha;
  }
  pv_stage(s, Vts, o, lane);
}

DI void dilated_item(const Params& p, int li, int pairitem, char* smem) {
  const int tfull = tidx();
  const int half = tfull >> 8, tid = tfull & 255;
  const int item = pairitem * 2 + half;
  char* kvb = smem + half * (2 * KVBUF);
  const int lane = tid & 63, w = tid >> 6, lr = lane & 31, hh = lane >> 5;
  const int idx16 = item & 15; const int br = (item >> 4) % 3; const int hb = (item / 48) & 7; const int b = item / 384;
  const int d = br == 0 ? 1 : (br == 1 ? 4 : 16);
  const int tile = idx16 / d, resid = idx16 % d;
  const int st0 = (d >= 2 && tile == 0) ? 2 : 0;
  const int u0 = tile * 128;
  const int uq = u0 + 32 * w + lr; const int tq = uq * d + resid;
  const u16* prow = p.proj + (size_t)(b * S_ + tq) * LD_EVEN;
  bf16x8 qf[4];
  load_q(prow + 2048 + hb * 64, p.hy_qg + li * 64, hh, qf);
  const float slope2 = fexp2(-(float)(hb + 1)) * LOG2E;
  const float sk = slope2 * (float)d;
  const u16* kb = p.proj + (size_t)(b * S_ + resid) * LD_EVEN + 2560 + hb * 64;
  const u16* vb = kb + 512;
  const size_t stride = (size_t)d * LD_EVEN;
  const float* kg = p.hy_kg + li * 64;
  f32x16 o[2]; o[0] = zero16(); o[1] = zero16();
  float m = -1e30f, l = 0.f;
  const int uw = u0 + 32 * w;
  KVRegs<256> rg;
  kv_load<256>(tid, kb, vb, stride, u0 - 128 + 64 * st0, 0, 1 << 30, rg);
  __syncthreads();
  kv_store<256>(tid, rg, kg, (u16*)(kvb + (st0 & 1) * KVBUF), (u16*)(kvb + (st0 & 1) * KVBUF) + 64 * 72);
  kv_load<256>(tid, kb, vb, stride, u0 - 64 + 64 * st0, 0, 1 << 30, rg);
  __syncthreads();
#pragma unroll 1
  for (int st = st0; st < 4; ++st) {
    const int ub = u0 - 128 + 64 * st;
    u16* Ks = (u16*)(kvb + (st & 1) * KVBUF); u16* Vts = Ks + 64 * 72;
    if (st + 1 < 4) { u16* Kn = (u16*)(kvb + ((st + 1) & 1) * KVBUF); kv_store<256>(tid, rg, kg, Kn, Kn + 64 * 72); }
    if (st + 2 < 4) kv_load<256>(tid, kb, vb, stride, ub + 128, 0, 1 << 30, rg);
    if (ub + 63 >= 0 && ub <= uw + 31 && ub + 63 >= uw - 128) {
      const int lim = uq - ub;
      const int lower = max(lim - 128, -ub);
      const float sb = slope2 * (float)(ub * d + resid) + sk * (float)(4 * hh);
      flash_stage(qf, Ks, Vts, o, m, l, lane, sk, sb, lower, lim);
    }
    __syncthreads();
  }
  const float lt = l + __shfl_xor(l, 32);
  const float inv = 1.f / lt;
  const size_t trow = (size_t)br * T_ + (size_t)b * S_ + tq;
  if (hh == 0) p.lse[trow * 8 + hb] = (m + log2f(lt)) * LN2;
  u16* orow = p.obr + trow * 512 + hb * 64;
#pragma unroll
  for (int dt = 0; dt < 2; ++dt)
#pragma unroll
    for (int q4 = 0; q4 < 4; ++q4) {
      uint2 ov; ov.x = pack2(o[dt][4 * q4] * inv, o[dt][4 * q4 + 1] * inv); ov.y = pack2(o[dt][4 * q4 + 2] * inv, o[dt][4 * q4 + 3] * inv);
      *(uint2*)(orow + dt * 32 + 8 * q4 + 4 * hh) = ov;
    }
}

DI void post_even_phase(const Params& p, int li) {
  const int tid = tidx();
  const int rsel = tid >> 7, c8 = tid & 127;
  const int c = c8 * 8;
  const int nit = T_ / 4, step = gridDim.x;
  int it = blockIdx.x;
  if (c8 < 64) {
    float og[8];
#pragma unroll
    for (int j = 0; j < 8; ++j) og[j] = p.hy_og[li * 512 + c + j];
    u32x4v raw = {0u, 0u, 0u, 0u}, graw = {0u, 0u, 0u, 0u}, nraw = raw, ngraw = raw;
    if (it < nit) { const int t = it * 4 + rsel; raw = *(const u32x4v*)(p.hbuf + (size_t)t * 1024 + c); graw = *(const u32x4v*)(p.proj + (size_t)t * LD_EVEN + 1536 + c); }
    while (it < nit) {
      const int t = it * 4 + rsel, itn = it + step;
      if (itn < nit) { const int tn = itn * 4 + rsel; nraw = *(const u32x4v*)(p.hbuf + (size_t)tn * 1024 + c); ngraw = *(const u32x4v*)(p.proj + (size_t)tn * LD_EVEN + 1536 + c); }
      float o[8], gt[8], val[8];
      unpack8(make_uint4(raw[0], raw[1], raw[2], raw[3]), o); unpack8(make_uint4(graw[0], graw[1], graw[2], graw[3]), gt);
      float ss = 0.f;
#pragma unroll
      for (int j = 0; j < 8; ++j) ss += o[j] * o[j];
      ss += __shfl_xor(ss, 1); ss += __shfl_xor(ss, 2); ss += __shfl_xor(ss, 4); ss += __shfl_xor(ss, 8);
      const float rs = rsqrtf(ss * (1.f / 128.f) + EPSF);
#pragma unroll
      for (int j = 0; j < 8; ++j) val[j] = o[j] * rs * og[j] * fsilu(gt[j]);
      *(uint4*)(p.hbuf + (size_t)t * 1024 + c) = pack8(val);
      raw = nraw; graw = ngraw; it = itn;
    }
  } else {
    const int cb = c - 512, hb = cb >> 6;
    float l0 = 0.f, l1 = 0.f, l2 = 0.f, nl0 = 0.f, nl1 = 0.f, nl2 = 0.f;
    u32x4v a4 = {0u, 0u, 0u, 0u}, b4 = a4, c4 = a4, na4 = a4, nb4 = a4, nc4 = a4;
    if (it < nit) {
      const size_t t = (size_t)(it * 4 + rsel);
      l0 = p.lse[(t) * 8 + hb]; l1 = p.lse[((size_t)T_ + t) * 8 + hb]; l2 = p.lse[((size_t)2 * T_ + t) * 8 + hb];
      a4 = *(const u32x4v*)(p.obr + t * 512 + cb); b4 = *(const u32x4v*)(p.obr + ((size_t)T_ + t) * 512 + cb); c4 = *(const u32x4v*)(p.obr + ((size_t)2 * T_ + t) * 512 + cb);
    }
    while (it < nit) {
      const int t = it * 4 + rsel, itn = it + step;
      if (itn < nit) {
        const size_t tn = (size_t)(itn * 4 + rsel);
        nl0 = p.lse[(tn) * 8 + hb]; nl1 = p.lse[((size_t)T_ + tn) * 8 + hb]; nl2 = p.lse[((size_t)2 * T_ + tn) * 8 + hb];
        na4 = *(const u32x4v*)(p.obr + tn * 512 + cb); nb4 = *(const u32x4v*)(p.obr + ((size_t)T_ + tn) * 512 + cb); nc4 = *(const u32x4v*)(p.obr + ((size_t)2 * T_ + tn) * 512 + cb);
      }
      const float mx = fmaxf(l0, fmaxf(l1, l2));
      float w0 = __expf(l0 - mx), w1 = __expf(l1 - mx), w2 = __expf(l2 - mx);
      const float inv = 1.f / (w0 + w1 + w2);
      w0 *= inv; w1 *= inv; w2 *= inv;
      float a[8], bq[8], cq[8], val[8];
      unpack8(make_uint4(a4[0], a4[1], a4[2], a4[3]), a); unpack8(make_uint4(b4[0], b4[1], b4[2], b4[3]), bq); unpack8(make_uint4(c4[0], c4[1], c4[2], c4[3]), cq);
#pragma unroll
      for (int j = 0; j < 8; ++j) val[j] = w0 * a[j] + w1 * bq[j] + w2 * cq[j];
      *(uint4*)(p.hbuf + (size_t)t * 1024 + c) = pack8(val);
      l0 = nl0; l1 = nl1; l2 = nl2; a4 = na4; b4 = nb4; c4 = nc4; it = itn;
    }
  }
}

DI void compress_item(const Params& p, int li, int pairitem, char* smem) {
  const int tfull = tidx();
  const int half = tfull >> 8, tid = tfull & 255;
  const int item = pairitem * 2 + half;
  u16* hs = (u16*)(smem + half * 17408);
  float* outs = (float*)(smem + half * 17408 + 32 * 136 * 2);
  const int lane = tid & 63, w = tid >> 6, lr = lane & 31, hh = lane >> 5;
  const int nt = item & 3, g = (item >> 2) & 3, b = (item >> 4) & 15, kv = item >> 8;
  const int n = nt * 32 + lr; const int nc = n > 126 ? 126 : n;
  const int col = 1024 + kv * 256 + g * 64;
  const u16* arow = p.proj + (size_t)(b * S_ + 16 * nc) * LD_ODD + col;
  const u16* w1t = p.wt_c1 + (size_t)(li * 2 + kv) * 128 * 2048 + (size_t)(32 * w + lr) * 2048;
  f32x16 acc = zero16();
#pragma unroll 16
  for (int ks = 0; ks < 128; ++ks) {
    const int lidx = ks >> 2, dd = (ks & 3) * 16 + hh * 8;
    const bf16x8 a = as_bf16x8(*(const uint4*)(arow + (size_t)lidx * LD_ODD + dd));
    const bf16x8 bb = as_bf16x8(*(const uint4*)(w1t + ks * 16 + hh * 8));
    acc = MFMA32(a, bb, acc);
  }
  const float cb = p.c1[(li * 2 + kv) * 128 + 32 * w + lr];
  __syncthreads();
#pragma unroll
  for (int i = 0; i < 16; ++i) {
    const int r = (i & 3) + 8 * (i >> 2) + 4 * hh;
    hs[r * 136 + 32 * w + lr] = f2bf(fsilu(acc[i] + cb));
  }
  __syncthreads();
  if (w < 2) {
    const u16* w2t = p.wt_c2 + (size_t)(li * 2 + kv) * 64 * 128 + (size_t)(w * 32 + lr) * 128;
    f32x16 a2 = zero16();
#pragma unroll
    for (int kk = 0; kk < 8; ++kk) {
      const bf16x8 a = *(const bf16x8*)(hs + lr * 136 + kk * 16 + hh * 8);
      const bf16x8 bb = as_bf16x8(*(const uint4*)(w2t + kk * 16 + hh * 8));
      a2 = MFMA32(a, bb, a2);
    }
#pragma unroll
    for (int i = 0; i < 16; ++i) {
      const int r = (i & 3) + 8 * (i >> 2) + 4 * hh;
      outs[r * 65 + w * 32 + lr] = a2[i];
    }
  }
  __syncthreads();
  {
    const int r = tid >> 3, c8 = tid & 7;
    float v[8]; float ss = 0.f;
#pragma unroll
    for (int j = 0; j < 8; ++j) { v[j] = outs[r * 65 + c8 * 8 + j]; ss += v[j] * v[j]; }
    ss += __shfl_xor(ss, 1); ss += __shfl_xor(ss, 2); ss += __shfl_xor(ss, 4);
    if (kv == 0) {
      const float rs = rsqrtf(ss * (1.f / 64.f) + EPSF);
#pragma unroll
      for (int j = 0; j < 8; ++j) v[j] *= rs * p.nsa_kg[(li * 3 + 0) * 64 + c8 * 8 + j];
    }
    const int nn = nt * 32 + r;
    if (nn >= 127) {
#pragma unroll
      for (int j = 0; j < 8; ++j) v[j] = 0.f;
    }
    u16* dst = (kv == 0 ? p.kcmp : p.vcmp) + ((size_t)(b * 4 + g) * 128 + nn) * 64 + c8 * 8;
    *(uint4*)dst = pack8(v);
  }
  __syncthreads();
}

DI void nsa_knorm_phase(const Params& p, int li) {
  const int tid = tidx();
  for (int u0 = blockIdx.x * NT + tid; u0 < T_ * 64; u0 += gridDim.x * NT * 4) {
    u32x4v raw[4];
#pragma unroll
    for (int q = 0; q < 4; ++q) {
      const int u = u0 + q * gridDim.x * NT;
      const int piece = u & 7, head = (u >> 3) & 3, br = (u >> 5) & 1, row = u >> 6;
      raw[q] = *(const u32x4v*)(p.proj + (size_t)row * LD_ODD + 1536 + br * 512 + head * 64 + piece * 8);
    }
    asm volatile("" ::: "memory");
#pragma unroll
    for (int q = 0; q < 4; ++q) {
      const int u = u0 + q * gridDim.x * NT;
      const int piece = u & 7, head = (u >> 3) & 3, br = (u >> 5) & 1, row = u >> 6;
      float f[8]; unpack8(make_uint4(raw[q][0], raw[q][1], raw[q][2], raw[q][3]), f);
      float ss = 0.f;
#pragma unroll
      for (int e = 0; e < 8; ++e) ss += f[e] * f[e];
      ss += __shfl_xor(ss, 1); ss += __shfl_xor(ss, 2); ss += __shfl_xor(ss, 4);
      const float rs = rsqrtf(ss * (1.f / 64.f) + EPSF);
      const float* kg = p.nsa_kg + (li * 3 + 1 + br) * 64 + piece * 8;
#pragma unroll
      for (int e = 0; e < 8; ++e) f[e] *= rs * kg[e];
      *(uint4*)(p.proj + (size_t)row * LD_ODD + 1536 + br * 512 + head * 64 + piece * 8) = pack8(f);
    }
  }
}

DI void nsa_item(const Params& p, int li, int item, char* smem) {
  float* impA = (float*)(smem + 2 * KVBUF);
  float* impB = impA + 8448;
  float* imp = impB + 8448;
  unsigned* selm = (unsigned*)(imp + 64 * 33);
  const int tid = tidx(), lane = tid & 63, wv = tid >> 6, lr = lane & 31, hh = lane >> 5;
  const int w = lr & 3;
  const int tt = item & 31, g = (item >> 5) & 3, b = item >> 7;
  const int t0 = tt * 64; const int cur = t0 >> 6;
  const int hd = g * 4 + w;
  const int tokl = 8 * wv + (lr >> 2);
  const int tq = t0 + tokl;
  const u16* pb = p.proj + (size_t)b * S_ * LD_ODD;
  const u16* prow = pb + (size_t)tq * LD_ODD;
  bf16x8 qf[4];
  load_q(prow + g * 256 + w * 64, p.nsa_qg + li * 64, hh, qf);
  const float slope2 = fexp2(-0.5f * (float)(hd + 1)) * LOG2E;
  const float g0 = fsigmoid(bf2f(prow[2560 + 0 + g * 4 + w]));
  const float g1 = fsigmoid(bf2f(prow[2560 + 16 + g * 4 + w]));
  const float g2 = fsigmoid(bf2f(prow[2560 + 32 + g * 4 + w]));
  f32x16 ot[2]; ot[0] = zero16(); ot[1] = zero16();
  {
    const u16* kb = p.kcmp + (size_t)(b * 4 + g) * 128 * 64;
    const u16* vb = p.vcmp + (size_t)(b * 4 + g) * 128 * 64;
    const float sk = 16.f * slope2;
    const int limc = min((tq - 31) >> 4, 126);
    const int nst = (1024 > t0) ? 1 : 2;
    {
      KVRegs<512> rg0;
      kv_load<512>(tid, kb, vb, 64, 0, 0, 128, rg0);
      __syncthreads();
      kv_store<512>(tid, rg0, nullptr, (u16*)smem, (u16*)smem + 64 * 72);
      if (nst > 1) {
        kv_load<512>(tid, kb, vb, 64, 64, 0, 128, rg0);
        kv_store<512>(tid, rg0, nullptr, (u16*)(smem + KVBUF), (u16*)(smem + KVBUF) + 64 * 72);
      }
    }
    __syncthreads();
    float m = -1e30f, l = 0.f;
#pragma unroll
    for (int st = 0; st < 2; ++st) {
      if (st >= nst) continue;
      const u16* Ks = (const u16*)(smem + st * KVBUF);
      f32x16 s[2]; float mx;
      const float sb = slope2 * (float)(1024 * st + 31) + sk * (float)(4 * hh);
      score_stage(qf, Ks, lane, sk, sb, 0, limc - 64 * st, s, mx);
      const float mn = fmaxf(m, mx);
      float ls = 0.f;
#pragma unroll
      for (int sub = 0; sub < 2; ++sub)
#pragma unroll
        for (int i = 0; i < 16; ++i) ls += fexp2(s[sub][i] - mn);
      l = l * fexp2(m - mn) + ls;
      m = mn;
    }
    const float lt = l + __shfl_xor(l, 32);
    const float inv = lt > 0.f ? 1.f / lt : 0.f;
    f32x16 o[2]; o[0] = zero16(); o[1] = zero16();
#pragma unroll
    for (int st = 0; st < 2; ++st) {
      if (st >= nst) {
#pragma unroll
        for (int G = 0; G < 16; ++G) {
          if ((G & 1) == hh) { impA[(w * 64 + tokl) * 33 + 16 * st + G] = 0.f; impB[(w * 64 + tokl) * 33 + 16 * st + G] = 0.f; }
        }
        continue;
      }
      const u16* Ks = (const u16*)(smem + st * KVBUF); const u16* Vts = Ks + 64 * 72;
      f32x16 s[2]; float mx;
      const float sb = slope2 * (float)(1024 * st + 31) + sk * (float)(4 * hh);
      score_stage(qf, Ks, lane, sk, sb, 0, limc - 64 * st, s, mx);
#pragma unroll
      for (int sub = 0; sub < 2; ++sub)
#pragma unroll
        for (int i = 0; i < 16; ++i) s[sub][i] = fexp2(s[sub][i] - m) * inv;
#pragma unroll
      for (int sub = 0; sub < 2; ++sub)
#pragma unroll
        for (int q4 = 0; q4 < 4; ++q4) {
          const int G = 16 * st + 8 * sub + 2 * q4 + hh;
          impA[(w * 64 + tokl) * 33 + G] = (s[sub][4 * q4] + s[sub][4 * q4 + 1]) + (s[sub][4 * q4 + 2] + s[sub][4 * q4 + 3]);
          impB[(w * 64 + tokl) * 33 + G] = s[sub][4 * q4 + 3];
        }
      pv_stage(s, Vts, o, lane);
    }
#pragma unroll
    for (int dt = 0; dt < 2; ++dt)
#pragma unroll
      for (int i = 0; i < 16; ++i) ot[dt][i] += g0 * o[dt][i];
  }
  const u16* kbs = pb + 1536 + g * 64; const u16* vbs = pb + 1792 + g * 64;
  KVRegs<512> rg;
  kv_load<512>(tid, kbs, vbs, LD_ODD, 0, 0, S_, rg);
  __syncthreads();
  for (int idx = tid; idx < 2048; idx += NT) {
    const int tok = idx >> 5, mm = idx & 31;
    float a = 0.f;
#pragma unroll
    for (int ww = 0; ww < 4; ++ww) a += impA[(ww * 64 + tok) * 33 + mm] + (mm > 0 ? impB[(ww * 64 + tok) * 33 + mm - 1] : 0.f);
    imp[tok * 33 + mm] = a;
  }
  __syncthreads();
  float* ots = impA + tid;
#pragma unroll
  for (int dt = 0; dt < 2; ++dt)
#pragma unroll
    for (int i = 0; i < 16; ++i) ots[(dt * 16 + i) * NT] = ot[dt][i];
  {
    const int tok = tid >> 3, sub8 = tid & 7;
    unsigned sel = 1u | (1u << cur) | (cur > 0 ? (1u << (cur - 1)) : 0u);
    const int cnt = __popc(sel);
    float cv[4];
#pragma unroll
    for (int e = 0; e < 4; ++e) cv[e] = imp[tok * 33 + sub8 * 4 + e];
    for (int r = cnt; r < 8; ++r) {
      float bv = -1.f; int bi = 64;
#pragma unroll
      for (int e = 0; e < 4; ++e) {
        const int mm = sub8 * 4 + e;
        const bool ok = (mm <= cur) && !((sel >> mm) & 1u);
        if (ok && cv[e] > bv) { bv = cv[e]; bi = mm; }
      }
#pragma unroll
      for (int off = 1; off < 8; off <<= 1) {
        const float ov = __shfl_xor(bv, off); const int oi = __shfl_xor(bi, off);
        if (ov > bv || (ov == bv && oi < bi)) { bv = ov; bi = oi; }
      }
      if (bi < 64) sel |= 1u << bi;
    }
    if (sub8 == 0) selm[tok] = sel;
  }
  __syncthreads();
  const unsigned myMask = selm[tokl];
  unsigned uni = 0u;
#pragma unroll 8
  for (int i = 0; i < 64; ++i) uni |= selm[i];
  {
    f32x16 o[2]; o[0] = zero16(); o[1] = zero16();
    float m = -1e30f, l = 0.f;
    const float* kg = nullptr;
    unsigned rem = uni & (uni - 1u);
    int mb = 0;
    int mbn = rem ? __builtin_ctz(rem) : -1;
    kv_store<512>(tid, rg, kg, (u16*)smem, (u16*)smem + 64 * 72);
    if (mbn >= 0) kv_load<512>(tid, kbs, vbs, LD_ODD, 64 * mbn, 0, S_, rg);
    __syncthreads();
    int par = 0;
#pragma unroll 1
    while (true) {
      u16* Ks = (u16*)(smem + par * KVBUF); u16* Vts = Ks + 64 * 72;
      int mbn2 = -1;
      if (mbn >= 0) {
        u16* Kn = (u16*)(smem + (par ^ 1) * KVBUF);
        kv_store<512>(tid, rg, kg, Kn, Kn + 64 * 72);
        rem &= rem - 1u;
        mbn2 = rem ? __builtin_ctz(rem) : -1;
        if (mbn2 >= 0) kv_load<512>(tid, kbs, vbs, LD_ODD, 64 * mbn2, 0, S_, rg);
      }
      const bool selb = (myMask >> mb) & 1u;
      const float sb = slope2 * (float)(64 * mb) + slope2 * (float)(4 * hh);
      if (__any(selb)) flash_stage(qf, Ks, Vts, o, m, l, lane, slope2, sb, 0, selb ? (tq - 64 * mb) : -1);
      __syncthreads();
      if (mbn < 0) break;
      mb = mbn; mbn = mbn2; par ^= 1;
    }
    const float lt = l + __shfl_xor(l, 32);
    const float sc = g1 / lt;
#pragma unroll
    for (int dt = 0; dt < 2; ++dt)
#pragma unroll
      for (int i = 0; i < 16; ++i) ots[(dt * 16 + i) * NT] += sc * o[dt][i];
  }
  {
    f32x16 o[2]; o[0] = zero16(); o[1] = zero16();
    float m = -1e30f, l = 0.f;
    const u16* kb = pb + 2048 + g * 64; const u16* vb = pb + 2304 + g * 64;
    const float* kg = nullptr;
    const int mlo = (t0 - 511) < 0 ? 0 : ((t0 - 511) >> 6);
    kv_load<512>(tid, kb, vb, LD_ODD, 64 * mlo, 0, S_, rg);
    kv_store<512>(tid, rg, kg, (u16*)smem, (u16*)smem + 64 * 72);
    if (mlo + 1 <= cur) kv_load<512>(tid, kb, vb, LD_ODD, 64 * (mlo + 1), 0, S_, rg);
    __syncthreads();
#pragma unroll 1
    for (int mb = mlo; mb <= cur; ++mb) {
      const int par = (mb - mlo) & 1;
      u16* Ks = (u16*)(smem + par * KVBUF); u16* Vts = Ks + 64 * 72;
      if (mb + 1 <= cur) { u16* Kn = (u16*)(smem + (par ^ 1) * KVBUF); kv_store<512>(tid, rg, kg, Kn, Kn + 64 * 72); }
      if (mb + 2 <= cur) kv_load<512>(tid, kb, vb, LD_ODD, 64 * (mb + 2), 0, S_, rg);
      const int lim = tq - 64 * mb;
      const float sb = slope2 * (float)(64 * mb) + slope2 * (float)(4 * hh);
      flash_stage(qf, Ks, Vts, o, m, l, lane, slope2, sb, lim - 511, lim);
      __syncthreads();
    }
    const float lt = l + __shfl_xor(l, 32);
    const float sc = g2 / lt;
    u16* orow = p.hbuf + (size_t)(b * S_ + tq) * 1024 + g * 256 + w * 64;
#pragma unroll
    for (int dt = 0; dt < 2; ++dt)
#pragma unroll
      for (int q4 = 0; q4 < 4; ++q4) {
        const float a0 = ots[(dt * 16 + 4 * q4 + 0) * NT] + sc * o[dt][4 * q4 + 0], a1 = ots[(dt * 16 + 4 * q4 + 1) * NT] + sc * o[dt][4 * q4 + 1];
        const float a2 = ots[(dt * 16 + 4 * q4 + 2) * NT] + sc * o[dt][4 * q4 + 2], a3 = ots[(dt * 16 + 4 * q4 + 3) * NT] + sc * o[dt][4 * q4 + 3];
        uint2 ov; ov.x = pack2(a0, a1); ov.y = pack2(a2, a3);
        *(uint2*)(orow + dt * 32 + 8 * q4 + 4 * hh) = ov;
      }
  }
  __syncthreads();
}

DI void run_phase(const Params& p, int ph, char* smem) {
  if (ph == 0) { prep_phase(p, smem); return; }
  const int l = (ph - 1) >> 3, s = (ph - 1) & 7, li = l >> 1;
  const bool even = (l & 1) == 0;
  const float* xin = (l == 0) ? p.x : p.out;
  switch (s) {
    case 0: rmsnorm_phase(xin, p.attn_norm + l * 1024, p.hbuf); break;
    case 1:
      if (even) gemm_phase<0>(p.hbuf, p.wt_hy_in + (size_t)li * 3584 * 1024, 1024, 14, p.proj, LD_EVEN, nullptr, nullptr, smem);
      else gemm_phase<0>(p.hbuf, p.wt_nsa_in + (size_t)li * 2816 * 1024, 1024, 11, p.proj, LD_ODD, nullptr, nullptr, smem);
      break;
    case 2:
      if (even) {
        for (int item = blockIdx.x; item < 256 + 3072; item += gridDim.x) {
          if (item < 256) hgrn_item(p, li, item, smem); else dilated_item(p, li, item - 256, smem);
        }
      } else {
        for (int item = blockIdx.x; item < 256; item += gridDim.x) compress_item(p, li, item, smem);
        nsa_knorm_phase(p, li);
      }
      break;
    case 3:
      if (even) post_even_phase(p, li);
      else {
        for (int item = blockIdx.x; item < 2048; item += gridDim.x) {
          const int r = item / gridDim.x, i = item % gridDim.x;
          int it2 = item;
          if (gridDim.x == 256) {
            const int c = (i + 4 * (r >> 1)) & 31;
            const int tt = (r & 1) ? 31 - c : c;
            it2 = ((i >> 5) + 8 * r) * 32 + tt;
          }
          nsa_item(p, li, it2, smem);
        }
      }
      break;
    case 4:
      gemm_phase<1>(p.hbuf, (even ? p.wt_hy_out : p.wt_nsa_out) + (size_t)li * 1048576, 1024, 4, nullptr, 0, xin, p.out, smem);
      break;
    case 5: rmsnorm_phase(p.out, p.ffn_norm + l * 1024, p.hbuf); break;
    case 6: gemm_phase<2>(p.hbuf, p.wt_gu + (size_t)l * 5632 * 1024, 1024, 22, p.proj, DFF, nullptr, nullptr, smem); break;
    case 7: gemm_phase<1>(p.proj, p.wt_dn + (size_t)l * 1024 * 2816, 2816, 4, nullptr, 0, p.out, p.out, smem, true); break;
  }
}

__global__ void __launch_bounds__(512) mk_forward(Params p) {
  __shared__ __attribute__((aligned(16))) char smem[131072];
  __shared__ uint4 xb_words;
  cg::grid_group grid = cg::this_grid();
  if (__builtin_amdgcn_workitem_id_x() == 0) xb_words = make_uint4(0u, 0u, 0u, 0u);
  __syncthreads();
  const XcdBarrier xb = xcd_barrier_post(p.bar, (volatile LAS unsigned*)&xb_words);
  for (int ph = p.phase_lo; ph < p.phase_hi; ++ph) {
    run_phase(p, ph, smem);
    if (ph + 1 < p.phase_hi) {
      if (p.phase_hi < 0) grid.sync();
      xcd_barrier(xb);
    }
  }
}

extern "C" void kernel_launch(void* const* d_in, const int* in_sizes, int n_in, void* d_out, int out_size,
                              void* d_ws, size_t ws_size, hipStream_t stream) {
  static int grid_blocks = 0;
  if (!grid_blocks) {
    int dev = 0, cus = 0, per_cu = 0;
    hipGetDevice(&dev);
    hipDeviceGetAttribute(&cus, hipDeviceAttributeMultiprocessorCount, dev);
    hipOccupancyMaxActiveBlocksPerMultiprocessor(&per_cu, mk_forward, 512, 0);
    if (per_cu > 1) per_cu = 1;
    if (per_cu < 1) per_cu = 1;
    grid_blocks = cus * per_cu;
  }
  Params p;
  memset(&p, 0, sizeof(p));
  p.x = (const float*)d_in[0]; p.attn_norm = (const float*)d_in[1]; p.ffn_norm = (const float*)d_in[2];
  p.hy_w_in = (const float*)d_in[3]; p.hy_lb = (const float*)d_in[4]; p.hy_og = (const float*)d_in[5];
  p.hy_qg = (const float*)d_in[6]; p.hy_kg = (const float*)d_in[7]; p.hy_w_out = (const float*)d_in[8];
  p.nsa_w_in = (const float*)d_in[9]; p.nsa_qg = (const float*)d_in[10]; p.nsa_kg = (const float*)d_in[11];
  p.cmp_pe = (const float*)d_in[12]; p.cmp_w1 = (const float*)d_in[13]; p.cmp_w2 = (const float*)d_in[14];
  p.nsa_w_out = (const float*)d_in[15]; p.ffn_g = (const float*)d_in[16]; p.ffn_u = (const float*)d_in[17]; p.ffn_d = (const float*)d_in[18];
  p.out = (float*)d_out;
  char* ws = (char*)d_ws; size_t off = 0;
  auto take = [&](size_t bytes) { char* r = ws + off; off += (bytes + 255) & ~(size_t)255; return r; };
  p.wt_hy_in = (u16*)take((size_t)2 * 3584 * 1024 * 2);
  p.wt_hy_out = (u16*)take((size_t)2 * 1048576 * 2);
  p.wt_nsa_in = (u16*)take((size_t)2 * 2816 * 1024 * 2);
  p.wt_nsa_out = (u16*)take((size_t)2 * 1048576 * 2);
  p.wt_gu = (u16*)take((size_t)4 * 5632 * 1024 * 2);
  p.wt_dn = (u16*)take((size_t)4 * 1024 * 2816 * 2);
  p.wt_c1 = (u16*)take((size_t)4 * 128 * 2048 * 2);
  p.wt_c2 = (u16*)take((size_t)4 * 64 * 128 * 2);
  p.c1 = (float*)take(4 * 128 * 4);
  p.lb = (float*)take(2 * 512 * 4);
  p.lse = (float*)take((size_t)3 * T_ * 8 * 4);
  p.proj = (u16*)take((size_t)T_ * 3584 * 2);
  p.hbuf = (u16*)take((size_t)T_ * 1024 * 2);
  p.obr = (u16*)take((size_t)3 * T_ * 512 * 2);
  p.kcmp = (u16*)take((size_t)16 * 4 * 128 * 64 * 2);
  p.vcmp = (u16*)take((size_t)16 * 4 * 128 * 64 * 2);
  p.bar = (unsigned*)take(XCD_BAR_WORDS * 4);
  if (off > ws_size) { fprintf(stderr, "workspace too small: need %zu have %zu\n", off, ws_size); return; }
  const int NPH = 33;
  hipMemsetAsync(p.bar, 0, XCD_BAR_WORDS * 4, stream);
#if MK_MULTI
  for (int ph = 0; ph < NPH; ++ph) {
    p.phase_lo = ph; p.phase_hi = ph + 1;
    hipLaunchKernelGGL(mk_forward, dim3(grid_blocks), dim3(512), 0, stream, p);
  }
#else
  p.phase_lo = 0; p.phase_hi = NPH;
  void* args[] = {&p};
  hipError_t e = hipLaunchCooperativeKernel((void*)mk_forward, dim3(grid_blocks), dim3(512), args, 0, stream);
  if (e != hipSuccess) fprintf(stderr, "cooperative launch failed: %s (grid %d)\n", hipGetErrorString(e), grid_blocks);
#endif
}
```

```cpp
#include <hip/hip_runtime.h>
#include <hip/hip_cooperative_groups.h>
#include <cstdio>
#include <cstdint>
#include <cstring>
namespace cg = cooperative_groups;

typedef unsigned short u16;
using bf16x8 = __attribute__((ext_vector_type(8))) short;
using f32x16 = __attribute__((ext_vector_type(16))) float;
using u32x4v = __attribute__((ext_vector_type(4))) unsigned;
#define DI __device__ __forceinline__
#define MFMA32(a, b, c) __builtin_amdgcn_mfma_f32_32x32x16_bf16((a), (b), (c), 0, 0, 0)

#ifndef MK_MULTI
#define MK_MULTI 0
#endif

constexpr int T_ = 32768, S_ = 2048;
constexpr float EPSF = 1e-6f;
constexpr float LOG2E = 1.4426950408889634f, LN2 = 0.6931471805599453f;
constexpr int LD_EVEN = 3584, LD_ODD = 2816, DFF = 2816;
constexpr int NT = 512;
#define LAS __attribute__((address_space(3)))
using f32x4v = __attribute__((ext_vector_type(4))) float;

struct Params {
  const float* x; const float* attn_norm; const float* ffn_norm;
  const float* hy_w_in; const float* hy_lb; const float* hy_og; const float* hy_qg; const float* hy_kg; const float* hy_w_out;
  const float* nsa_w_in; const float* nsa_qg; const float* nsa_kg; const float* cmp_pe; const float* cmp_w1; const float* cmp_w2; const float* nsa_w_out;
  const float* ffn_g; const float* ffn_u; const float* ffn_d;
  float* out;
  u16* wt_hy_in; u16* wt_hy_out; u16* wt_nsa_in; u16* wt_nsa_out; u16* wt_gu; u16* wt_dn; u16* wt_c1; u16* wt_c2;
  float* c1; float* lb; float* lse;
  u16* proj; u16* hbuf; u16* obr; u16* kcmp; u16* vcmp;
  unsigned* bar;
  int phase_lo; int phase_hi;
};

DI int tidx() { int t = __builtin_amdgcn_workitem_id_x(); asm volatile("" : "+v"(t)); return t; }
DI float bf2f(u16 h) { return __uint_as_float(((unsigned)h) << 16); }
typedef __bf16 bf16x2_t __attribute__((ext_vector_type(2)));
typedef float f32x2_t __attribute__((ext_vector_type(2)));
DI unsigned pack2(float a, float b) { f32x2_t v = {a, b}; bf16x2_t r = __builtin_convertvector(v, bf16x2_t); return __builtin_bit_cast(unsigned, r); }
DI u16 f2bf(float x) { return (u16)(pack2(x, 0.f) & 0xffffu); }
DI float fsigmoid(float x) { return 1.f / (1.f + __expf(-x)); }
DI float fsilu(float x) { return x / (1.f + __expf(-x)); }
DI float fexp2(float x) { return __builtin_amdgcn_exp2f(x); }
DI void unpack8(uint4 v, float (&f)[8]) {
  f[0] = __uint_as_float(v.x << 16); f[1] = __uint_as_float(v.x & 0xffff0000u);
  f[2] = __uint_as_float(v.y << 16); f[3] = __uint_as_float(v.y & 0xffff0000u);
  f[4] = __uint_as_float(v.z << 16); f[5] = __uint_as_float(v.z & 0xffff0000u);
  f[6] = __uint_as_float(v.w << 16); f[7] = __uint_as_float(v.w & 0xffff0000u);
}
DI uint4 pack8(const float (&f)[8]) {
  uint4 o; o.x = pack2(f[0], f[1]); o.y = pack2(f[2], f[3]); o.z = pack2(f[4], f[5]); o.w = pack2(f[6], f[7]); return o;
}
DI bf16x8 as_bf16x8(uint4 v) { u32x4v t; t[0] = v.x; t[1] = v.y; t[2] = v.z; t[3] = v.w; return __builtin_bit_cast(bf16x8, t); }
DI f32x16 zero16() { f32x16 z;
#pragma unroll
  for (int i = 0; i < 16; ++i) z[i] = 0.f; return z; }


#define XB_TMO      128
#define XB_XCNT(j)  (256  + 64 * (j))
#define XB_XSUB(j)  (1280 + 64 * (j))
#define XB_XGEN(j)  (2304 + 64 * (j))
#define XB_TOP      3328
#define XB_TOPGEN   3392
#define XCD_BAR_WORDS 3456
#define XB_SPIN_CAP (1u << 18)
DI unsigned xb_ld(unsigned* p) { return __hip_atomic_load(p, __ATOMIC_RELAXED, __HIP_MEMORY_SCOPE_AGENT); }
DI unsigned xb_add(unsigned* p, unsigned v) { return __hip_atomic_fetch_add(p, v, __ATOMIC_RELAXED, __HIP_MEMORY_SCOPE_AGENT); }
DI unsigned xb_xcc_id() { return (unsigned)__builtin_amdgcn_s_getreg((3 << 11) | 20) & 0xFu; }
#define XB_SPIN(cond, bar) do { unsigned _sp = 0; while (cond) { __builtin_amdgcn_s_sleep(1); \
    if ((++_sp & 255u) == 0u) { if (xb_ld(&(bar)[XB_TMO])) break; if (_sp > XB_SPIN_CAP) { atomicAdd(&(bar)[XB_TMO], 1u); break; } } } } while (0)
struct XcdBarrier { unsigned* bar; unsigned x; volatile LAS unsigned* st; };
DI XcdBarrier xcd_barrier_post(unsigned* bar, volatile LAS unsigned* st) {
  XcdBarrier b; b.bar = bar; b.x = xb_xcc_id(); b.st = st;
  if (__builtin_amdgcn_workitem_id_x() == 0) (void)xb_add(&bar[XB_XCNT(b.x)], 1u);
  return b;
}
DI void xcd_barrier_complete(unsigned* bar, unsigned x, unsigned& nloc, unsigned& nx) {
  const unsigned G = gridDim.x * gridDim.y * gridDim.z;
  unsigned sum, cnt, mine, sp = 0u;
  for (;;) {
    sum = 0u; cnt = 0u; mine = 0u;
#pragma unroll
    for (unsigned j = 0; j < 16; ++j) { const unsigned c = xb_ld(&bar[XB_XCNT(j)]); sum += c; cnt += (c > 0u) ? 1u : 0u; mine = (j == x) ? c : mine; }
    if (sum == G) break;
    __builtin_amdgcn_s_sleep(1);
    if ((++sp & 255u) == 0u) { if (xb_ld(&bar[XB_TMO])) break; if (sp > XB_SPIN_CAP) { atomicAdd(&bar[XB_TMO], 1u); break; } }
  }
  nloc = mine > 0u ? mine : 1u; nx = cnt > 0u ? cnt : 1u;
}
DI void xcd_barrier(const XcdBarrier& b) {
  asm volatile("s_waitcnt vmcnt(0)" ::: "memory");
  __syncthreads();
  if (__builtin_amdgcn_workitem_id_x() == 0) {
    unsigned* bar = b.bar;
    __builtin_amdgcn_s_waitcnt(0);
    unsigned nloc = b.st[0], nx = b.st[1];
    if (nloc == 0u) { xcd_barrier_complete(bar, b.x, nloc, nx); b.st[0] = nloc; b.st[1] = nx; }
    const unsigned old = xb_add(&bar[XB_XSUB(b.x)], 1u);
    const unsigned gen = old / nloc;
    if (old + 1u == (gen + 1u) * nloc) {
      __builtin_amdgcn_fence(__ATOMIC_RELEASE, "agent");
      asm volatile("s_waitcnt vmcnt(0)" ::: "memory");
      const unsigned og = xb_add(&bar[XB_TOP], 1u);
      const unsigned tg = og / nx;
      if (og + 1u == (tg + 1u) * nx) xb_add(&bar[XB_TOPGEN], 1u);
      else XB_SPIN(xb_ld(&bar[XB_TOPGEN]) == tg, bar);
      __builtin_amdgcn_fence(__ATOMIC_ACQUIRE, "agent");
      xb_add(&bar[XB_XGEN(b.x)], 1u);
      asm volatile("s_waitcnt vmcnt(0)" ::: "memory");
    } else {
      XB_SPIN(xb_ld(&bar[XB_XGEN(b.x)]) == gen, bar);
      __builtin_amdgcn_fence(__ATOMIC_ACQUIRE, "agent");
      asm volatile("s_waitcnt vmcnt(0)" ::: "memory");
    }
  }
  __syncthreads();
}

struct PrepDesc { const float* src; u16* dst; int K, N, mode, tk, tn; };
DI PrepDesc prep_desc(const Params& p, int tile) {
  constexpr int G0 = 1792, G1 = 2304, G2 = 3712, G3 = 4224, G4 = 7040, G5 = 9856, G6 = 12672, G7 = 12928;
  PrepDesc d; int Np, lt; d.mode = 0;
  if (tile < G0) { int i = tile / 896; lt = tile % 896; d.src = p.hy_w_in + (size_t)i * 1024 * 3584; d.dst = p.wt_hy_in + (size_t)i * 3584 * 1024; d.K = 1024; d.N = 3584; Np = 3584; }
  else if (tile < G1) { int t = tile - G0; int i = t / 256; lt = t % 256; d.src = p.hy_w_out + (size_t)i * 1048576; d.dst = p.wt_hy_out + (size_t)i * 1048576; d.K = 1024; d.N = 1024; Np = 1024; }
  else if (tile < G2) { int t = tile - G1; int i = t / 704; lt = t % 704; d.src = p.nsa_w_in + (size_t)i * 1024 * 2608; d.dst = p.wt_nsa_in + (size_t)i * 2816 * 1024; d.K = 1024; d.N = 2608; Np = 2816; }
  else if (tile < G3) { int t = tile - G2; int i = t / 256; lt = t % 256; d.src = p.nsa_w_out + (size_t)i * 1048576; d.dst = p.wt_nsa_out + (size_t)i * 1048576; d.K = 1024; d.N = 1024; Np = 1024; }
  else if (tile < G4) { int t = tile - G3; int i = t / 704; lt = t % 704; d.src = p.ffn_g + (size_t)i * 1024 * 2816; d.dst = p.wt_gu + (size_t)i * 5632 * 1024; d.K = 1024; d.N = 2816; Np = 2816; d.mode = 1; }
  else if (tile < G5) { int t = tile - G4; int i = t / 704; lt = t % 704; d.src = p.ffn_u + (size_t)i * 1024 * 2816; d.dst = p.wt_gu + (size_t)i * 5632 * 1024; d.K = 1024; d.N = 2816; Np = 2816; d.mode = 2; }
  else if (tile < G6) { int t = tile - G5; int i = t / 704; lt = t % 704; d.src = p.ffn_d + (size_t)i * 2816 * 1024; d.dst = p.wt_dn + (size_t)i * 1024 * 2816; d.K = 2816; d.N = 1024; Np = 1024; }
  else if (tile < G7) { int t = tile - G6; int i = t / 64; lt = t % 64; d.src = p.cmp_w1 + (size_t)i * 2048 * 128; d.dst = p.wt_c1 + (size_t)i * 128 * 2048; d.K = 2048; d.N = 128; Np = 128; }
  else { int t = tile - G7; int i = t / 2; lt = t % 2; d.src = p.cmp_w2 + (size_t)i * 128 * 64; d.dst = p.wt_c2 + (size_t)i * 64 * 128; d.K = 128; d.N = 64; Np = 64; }
  const int ntn = Np / 64;
  d.tk = lt / ntn; d.tn = lt % ntn;
  return d;
}
DI void prep_load(const PrepDesc& d, int tid, float (&rv)[8]) {
  const int c = tid & 63; const int n = d.tn * 64 + c;
#pragma unroll
  for (int j = 0; j < 8; ++j) {
    const int r = (tid >> 6) + 8 * j;
    rv[j] = (n < d.N) ? d.src[(size_t)(d.tk * 64 + r) * d.N + n] : 0.f;
  }
}

DI void prep_phase(const Params& p, char* smem) {
  float* sm = (float*)smem;
  constexpr int G8 = 12936;
  const int tid = tidx();
  float rv[8];
  int tile = blockIdx.x;
  asm volatile("" : "+s"(tile));
  if (tile < G8) { const PrepDesc d0 = prep_desc(p, tile); prep_load(d0, tid, rv); }
  for (; tile < G8; tile += gridDim.x) {
    const PrepDesc d = prep_desc(p, tile);
    __syncthreads();
#pragma unroll
    for (int j = 0; j < 8; ++j) sm[((tid >> 6) + 8 * j) * 65 + (tid & 63)] = rv[j];
    __syncthreads();
    if (tile + (int)gridDim.x < G8) { const PrepDesc dn = prep_desc(p, tile + gridDim.x); prep_load(dn, tid, rv); }
    const int nl = tid >> 3, kp = tid & 7;
    const int n = d.tn * 64 + nl;
    int nd = n;
    if (d.mode == 1) nd = (n >> 4) * 32 + (n & 15);
    else if (d.mode == 2) nd = (n >> 4) * 32 + 16 + (n & 15);
    float v[8];
#pragma unroll
    for (int j = 0; j < 8; ++j) v[j] = sm[(kp * 8 + j) * 65 + nl];
    *(uint4*)(d.dst + (size_t)nd * d.K + d.tk * 64 + kp * 8) = pack8(v);
  }
  __syncthreads();
  if (blockIdx.x < 4) {
    const int mi = blockIdx.x;
    const float* pe = p.cmp_pe + (size_t)mi * 2048;
    const float* w1 = p.cmp_w1 + (size_t)mi * 2048 * 128;
    const int tq_ = tidx();
    const int o = tq_ & 127, half = tq_ >> 7;
    float a0 = 0.f, a1 = 0.f, a2 = 0.f, a3 = 0.f;
    for (int k = half * 512; k < half * 512 + 512; k += 4) {
      a0 += pe[k] * w1[(size_t)k * 128 + o]; a1 += pe[k + 1] * w1[(size_t)(k + 1) * 128 + o];
      a2 += pe[k + 2] * w1[(size_t)(k + 2) * 128 + o]; a3 += pe[k + 3] * w1[(size_t)(k + 3) * 128 + o];
    }
    sm[tq_] = (a0 + a1) + (a2 + a3);
    __syncthreads();
    if (tq_ < 128) p.c1[mi * 128 + tq_] = (sm[tq_] + sm[tq_ + 128]) + (sm[tq_ + 256] + sm[tq_ + 384]);
    __syncthreads();
  }
  if (blockIdx.x == 4 || (gridDim.x <= 4 && blockIdx.x == 0)) {
    for (int c = tidx(); c < 512; c += NT) {
      float l0 = p.hy_lb[c], l1 = p.hy_lb[512 + c];
      float mx = fmaxf(l0, l1); float e0 = __expf(l0 - mx), e1 = __expf(l1 - mx); float inv = 1.f / (e0 + e1);
      float p0 = e0 * inv, p1 = e1 * inv;
      p.lb[c] = p0 - p0; p.lb[512 + c] = (p0 + p1) - p0;
    }
  }
}

DI void rmsnorm_phase(const float* x, const float* __restrict__ g, u16* h) {
  const int t_ = tidx();
  const int wave = t_ >> 6, lane = t_ & 63;
  const int stride = gridDim.x * 8;
  int row = blockIdx.x * 8 + wave;
  float4 v[4], nv[4];
  float4 gg[4];
#pragma unroll
  for (int j = 0; j < 4; ++j) gg[j] = ((const float4*)g)[lane + 64 * j];
  if (row < T_) {
    const float4* xr = (const float4*)(x + (size_t)row * 1024);
#pragma unroll
    for (int j = 0; j < 4; ++j) v[j] = xr[lane + 64 * j];
  }
  while (row < T_) {
    const int nrow = row + stride;
    if (nrow < T_) {
      const float4* xr = (const float4*)(x + (size_t)nrow * 1024);
#pragma unroll
      for (int j = 0; j < 4; ++j) nv[j] = xr[lane + 64 * j];
    }
    float ss = 0.f;
#pragma unroll
    for (int j = 0; j < 4; ++j) ss += v[j].x * v[j].x + v[j].y * v[j].y + v[j].z * v[j].z + v[j].w * v[j].w;
#pragma unroll
    for (int off = 32; off >= 1; off >>= 1) ss += __shfl_xor(ss, off);
    const float rs = rsqrtf(ss * (1.f / 1024.f) + EPSF);
#pragma unroll
    for (int j = 0; j < 4; ++j) {
      uint2 o; o.x = pack2(v[j].x * rs * gg[j].x, v[j].y * rs * gg[j].y); o.y = pack2(v[j].z * rs * gg[j].z, v[j].w * rs * gg[j].w);
      *(uint2*)(h + (size_t)row * 1024 + (lane + 64 * j) * 4) = o;
    }
#pragma unroll
    for (int j = 0; j < 4; ++j) v[j] = nv[j];
    row = nrow;
  }
}

DI int lds_byte(int r, int c) { const int st = (r >> 4) * 2 + (c >> 5), rr = r & 15, cc = c & 31, ob = rr * 64 + cc * 2; return st * 1024 + (ob ^ (((ob >> 9) & 1) << 5)); }
DI void stage_rc(int b, int& R, int& C) { const int st = b / 1024, sb = b % 1024, swz = sb ^ (((sb >> 9) & 1) << 5); R = (st >> 1) * 16 + swz / 64; C = (st & 1) * 32 + (swz % 64) / 2; }

template <int EPI>
DI void gemm_phase(const u16* A, const u16* Bt, const int K, const int nN, u16* outb, const int ldc, const float* res, float* outf, char* smem, const bool rev = false) {
  constexpr int HTB = 16384;
  const int tid = tidx();
  const int wid = tid >> 6, lane = tid & 63, wr = wid >> 2, wc = wid & 3, fr = lane & 15, fq = lane >> 4;
  const int nM = 128, nwg = nM * nN, nt = K / 64;
  int sR0, sC0, sR1, sC1; stage_rc(tid * 16, sR0, sC0); stage_rc(tid * 16 + 8192, sR1, sC1);
  const unsigned vo0 = (unsigned)((sR0 * K + sC0) * 2), vo1 = (unsigned)((sR1 * K + sC1) * 2);
#define SA_(b, h) (smem + ((b) * 2 + (h)) * HTB)
#define SB_(b, h) (smem + (4 + (b) * 2 + (h)) * HTB)
#define STAGE(P, BASE, br, kt) do { const char* _g = (const char*)((BASE) + (size_t)(br) * K + (size_t)(kt) * 64); \
    unsigned _o0 = vo0, _o1 = vo1; asm volatile("" : "+v"(_o0), "+v"(_o1)); \
    __builtin_amdgcn_global_load_lds((const unsigned*)(_g + _o0), (LAS unsigned*)((P) + tid * 16), 16, 0, 0); \
    __builtin_amdgcn_global_load_lds((const unsigned*)(_g + _o1), (LAS unsigned*)((P) + tid * 16 + 8192), 16, 0, 0); } while (0)
  const int ob_ = fr * 64 + fq * 16, swz_ = ob_ ^ (((ob_ >> 9) & 1) << 5);
  const int aoff = wr * 8192 + swz_, boff = wc * 4096 + swz_;
#define LDA(dst, b, h) _Pragma("unroll") for (int m = 0; m < 4; ++m) _Pragma("unroll") for (int k = 0; k < 2; ++k) \
    dst[m][k] = *(const bf16x8*)(SA_(b, h) + aoff + m * 2048 + k * 1024)
#define LDB(dst, b, h) _Pragma("unroll") for (int n = 0; n < 2; ++n) _Pragma("unroll") for (int k = 0; k < 2; ++k) \
    dst[n][k] = *(const bf16x8*)(SB_(b, h) + boff + n * 2048 + k * 1024)
#define MMA(ai, bj, At_, Bx_) do { __builtin_amdgcn_s_setprio(1); \
    _Pragma("unroll") for (int m = 0; m < 4; ++m) _Pragma("unroll") for (int n = 0; n < 2; ++n) _Pragma("unroll") for (int k = 0; k < 2; ++k) \
      acc[ai][bj][m][n] = __builtin_amdgcn_mfma_f32_16x16x32_bf16(Bx_[n][k], At_[m][k], acc[ai][bj][m][n], 0, 0, 0); \
    __builtin_amdgcn_s_setprio(0); } while (0)
#define WAIT_V(n) asm volatile("s_waitcnt vmcnt(" #n ")" ::: "memory")
#define WAIT_L(n) asm volatile("s_waitcnt lgkmcnt(" #n ")" ::: "memory")
#define BAR __builtin_amdgcn_s_barrier()
#define SCHED __builtin_amdgcn_sched_barrier(0)
  auto tile_of = [&](long Lq, int& brow_, int& bcol_, int& pn_) {
    int wgid = (int)Lq;
    { const int q = nwg / 8, r = nwg % 8, xcd = wgid % 8, off = wgid / 8; wgid = (xcd < r ? xcd * (q + 1) : r * (q + 1) + (xcd - r) * q) + off; }
    const int nig = 8 * nN, gid = wgid / nig, fm = gid * 8, gsz = (nM - fm) < 8 ? (nM - fm) : 8;
    const int pm = fm + ((wgid % nig) % gsz);
    pn_ = (wgid % nig) / gsz; brow_ = (rev ? (nM - 1 - pm) : pm) * 256; bcol_ = pn_ * 256;
  };
#define STAGE7(br_, bc_) do { STAGE(SB_(0, 0), Bt, bc_, 0); STAGE(SA_(0, 0), A, br_, 0); STAGE(SB_(0, 1), Bt, (bc_) + 128, 0); STAGE(SA_(0, 1), A, (br_) + 128, 0); \
    STAGE(SB_(1, 0), Bt, bc_, 1); STAGE(SA_(1, 0), A, br_, 1); STAGE(SB_(1, 1), Bt, (bc_) + 128, 1); } while (0)
  long L = blockIdx.x;
  bool have = L < nwg;
  int brow = 0, bcol = 0, pn = 0;
  __syncthreads();
  if (have) { tile_of(L, brow, bcol, pn); STAGE7(brow, bcol); }
  while (have) {
    f32x4v acc[2][2][4][2];
#pragma unroll
    for (int a = 0; a < 2; ++a)
#pragma unroll
      for (int b = 0; b < 2; ++b)
#pragma unroll
        for (int m = 0; m < 4; ++m)
#pragma unroll
          for (int n = 0; n < 2; ++n) acc[a][b][m][n] = (f32x4v){0.f, 0.f, 0.f, 0.f};
    bf16x8 At[4][2], B0[2][2], B1[2][2];
    if (wr == 1) BAR;
    WAIT_V(0); BAR;
    BAR;
    for (int t = 0; t < nt - 2; t += 2) {
      LDB(B0, 0, 0); SCHED; LDA(At, 0, 0); STAGE(SA_(1, 1), A, brow + 128, t + 1);
      WAIT_L(8); BAR; WAIT_L(0); MMA(0, 0, At, B0); BAR; SCHED;
      LDB(B1, 0, 1); STAGE(SB_(0, 0), Bt, bcol, t + 2);
      BAR; WAIT_L(0); MMA(0, 1, At, B1); BAR;
      LDA(At, 0, 1); STAGE(SA_(0, 0), A, brow, t + 2);
      BAR; WAIT_L(0); MMA(1, 0, At, B0); BAR; SCHED;
      STAGE(SB_(0, 1), Bt, bcol + 128, t + 2);
      WAIT_V(6); BAR; MMA(1, 1, At, B1); BAR;
      LDB(B0, 1, 0); SCHED; LDA(At, 1, 0); STAGE(SA_(0, 1), A, brow + 128, t + 2);
      WAIT_L(8); BAR; WAIT_L(0); MMA(0, 0, At, B0); BAR; SCHED;
      LDB(B1, 1, 1); STAGE(SB_(1, 0), Bt, bcol, t + 3);
      BAR; WAIT_L(0); MMA(0, 1, At, B1); BAR;
      LDA(At, 1, 1); STAGE(SA_(1, 0), A, brow, t + 3);
      BAR; WAIT_L(0); MMA(1, 0, At, B0); BAR; SCHED;
      STAGE(SB_(1, 1), Bt, bcol + 128, t + 3);
      WAIT_V(6); BAR; MMA(1, 1, At, B1); BAR;
    }
    { LDB(B0, 0, 0); LDA(At, 0, 0); STAGE(SA_(1, 1), A, brow + 128, nt - 1);
      BAR; WAIT_L(0); MMA(0, 0, At, B0); BAR;
      LDB(B1, 0, 1); BAR; WAIT_L(0); MMA(0, 1, At, B1); BAR;
      LDA(At, 0, 1); WAIT_V(4); BAR; WAIT_L(0); MMA(1, 0, At, B0); MMA(1, 1, At, B1); BAR; }
    { LDB(B0, 1, 0); LDA(At, 1, 0); WAIT_V(2); BAR; WAIT_L(0); MMA(0, 0, At, B0); BAR;
      LDB(B1, 1, 1); WAIT_V(0); BAR; WAIT_L(0); MMA(0, 1, At, B1); BAR;
      LDA(At, 1, 1); BAR; WAIT_L(0); MMA(1, 0, At, B0); MMA(1, 1, At, B1); BAR; }
    if (wr == 0) BAR;
    const long Ln = L + gridDim.x;
    const bool haven = Ln < nwg;
    int browN = 0, bcolN = 0, pnN = 0;
    if (haven) { tile_of(Ln, browN, bcolN, pnN); STAGE7(browN, bcolN); }
    int tid2 = tid; asm volatile("" : "+v"(tid2));
    const int fr2 = tid2 & 15, fq2 = (tid2 >> 4) & 3, wc2 = (tid2 >> 6) & 3, wr2 = tid2 >> 8;
    if (EPI == 1) {
#pragma unroll
      for (int am = 0; am < 4; ++am) {
        const int ai = am >> 1, m0 = (am & 1) * 2;
        f32x4v rb[2][2][2];
        const float* rbase = res + (size_t)(brow + ai * 128 + wr2 * 64 + m0 * 16 + fr2) * 1024 + bcol + wc2 * 32 + fq2 * 4;
        float* obase = outf + (size_t)(brow + ai * 128 + wr2 * 64 + m0 * 16 + fr2) * 1024 + bcol + wc2 * 32 + fq2 * 4;
#pragma unroll
        for (int m = 0; m < 2; ++m)
#pragma unroll
          for (int bj = 0; bj < 2; ++bj)
#pragma unroll
            for (int n = 0; n < 2; ++n) rb[m][bj][n] = *(const f32x4v*)(rbase + (size_t)m * 16 * 1024 + bj * 128 + n * 16);
        asm volatile("" ::: "memory");
#pragma unroll
        for (int m = 0; m < 2; ++m)
#pragma unroll
          for (int bj = 0; bj < 2; ++bj)
#pragma unroll
            for (int n = 0; n < 2; ++n) *(f32x4v*)(obase + (size_t)m * 16 * 1024 + bj * 128 + n * 16) = rb[m][bj][n] + acc[ai][bj][m0 + m][n];
        asm volatile("" ::: "memory");
      }
    } else {
#pragma unroll
    for (int ai = 0; ai < 2; ++ai)
#pragma unroll
      for (int m = 0; m < 4; ++m) {
        const size_t row = (size_t)(brow + ai * 128 + wr2 * 64 + m * 16 + fr2);
#pragma unroll
        for (int bj = 0; bj < 2; ++bj) {
          const int cb = bcol + bj * 128 + wc2 * 32 + fq2 * 4;
          if (EPI == 0) {
#pragma unroll
            for (int n = 0; n < 2; ++n) {
              uint2 o; o.x = pack2(acc[ai][bj][m][n][0], acc[ai][bj][m][n][1]); o.y = pack2(acc[ai][bj][m][n][2], acc[ai][bj][m][n][3]);
              *(uint2*)(outb + row * ldc + cb + n * 16) = o;
            }
          } else {
            const f32x4v gv = acc[ai][bj][m][0], uv = acc[ai][bj][m][1];
            uint2 o; o.x = pack2(fsilu(gv[0]) * uv[0], fsilu(gv[1]) * uv[1]); o.y = pack2(fsilu(gv[2]) * uv[2], fsilu(gv[3]) * uv[3]);
            *(uint2*)(outb + row * DFF + ((bcol + bj * 128 + wc2 * 32) >> 1) + fq2 * 4) = o;
          }
        }
      }
    }
    L = Ln; have = haven; brow = browN; bcol = bcolN; pn = pnN;
  }
  __syncthreads();
#undef STAGE7
#undef SA_
#undef SB_
#undef STAGE
#undef LDA
#undef LDB
#undef MMA
}

#define MFMA16(a, b, c) __builtin_amdgcn_mfma_f32_16x16x32_bf16((a), (b), (c), 0, 0, 0)
DI void hgrn_item(const Params& p, int li, int item, char* smem) {
  const int tid = tidx(), lane = tid & 63, w = tid >> 6, fr = lane & 15, fq = lane >> 4;
  const int kk = w >> 1, vt = w & 1;
  const int vs = item & 3, h = (item >> 2) & 3, b = item >> 4;
  const int tg = tid & 3, kch = tid >> 2;
  const int sv = tid >> 5, vv = tid & 31;
  const float lbv = p.lb[li * 512 + h * 128 + kch];
  const u16* base = p.proj + (size_t)b * S_ * LD_EVEN;
  const u16* pq = base + (size_t)(4 * tg) * LD_EVEN + h * 128 + kch;
  const u16* pv = base + (size_t)sv * LD_EVEN + 1024 + h * 128 + vs * 32 + vv;
  struct HRegs { unsigned q0, q1, q2, q3, f0, f1, f2, f3, v; };
  auto hload = [&](int c, HRegs& r) {
    const u16* pq2 = pq + (size_t)c * 16 * LD_EVEN;
    r.q0 = pq2[0]; r.q1 = pq2[LD_EVEN]; r.q2 = pq2[2 * LD_EVEN]; r.q3 = pq2[3 * LD_EVEN];
    r.f0 = pq2[512]; r.f1 = pq2[LD_EVEN + 512]; r.f2 = pq2[2 * LD_EVEN + 512]; r.f3 = pq2[3 * LD_EVEN + 512];
    r.v = pv[(size_t)c * 16 * LD_EVEN];
  };
  HRegs ra, rb;
  hload(0, ra); hload(1, rb);
  f32x4v S0 = {0.f, 0.f, 0.f, 0.f}, S1 = {0.f, 0.f, 0.f, 0.f};
  const f32x4v z4 = {0.f, 0.f, 0.f, 0.f};
  __syncthreads();
  constexpr int HBUF = 16896;
  auto prep = [&](const HRegs& rr, int par) {
    u16* Qt_ = (u16*)(smem + par * HBUF); u16* Kt_ = Qt_ + 16 * 136; u16* Kh_ = Kt_ + 16 * 136; u16* Vt_ = Kh_ + 128 * 24; float* Pc_ = (float*)(Vt_ + 32 * 24);
    float qv[4], kv[4], cs[4];
    const unsigned rq[4] = {rr.q0, rr.q1, rr.q2, rr.q3}, rf[4] = {rr.f0, rr.f1, rr.f2, rr.f3};
    float cp = 1.f;
#pragma unroll
    for (int i = 0; i < 4; ++i) {
      const float f = lbv + (1.f - lbv) * fsigmoid(__uint_as_float(rf[i] << 16));
      cp *= f; cs[i] = cp; kv[i] = 1.f - f; qv[i] = fsilu(__uint_as_float(rq[i] << 16));
    }
    const int bl = lane & ~3;
    const float t0 = __shfl(cp, bl), t1 = __shfl(cp, bl + 1), t2 = __shfl(cp, bl + 2), t3 = __shfl(cp, bl + 3);
    const float pre = (tg > 0 ? t0 : 1.f) * (tg > 1 ? t1 : 1.f) * (tg > 2 ? t2 : 1.f);
    const float PC = (t0 * t1) * (t2 * t3);
    float kh[4];
#pragma unroll
    for (int i = 0; i < 4; ++i) {
      const float P = fmaxf(pre * cs[i], 1e-30f);
      const float rP = __builtin_amdgcn_rcpf(P);
      const int t = 4 * tg + i;
      Qt_[t * 136 + kch] = f2bf(qv[i] * P);
      const float kr = kv[i] * rP;
      Kt_[t * 136 + kch] = f2bf(kr);
      kh[i] = kr * PC;
    }
    uint2 k2; k2.x = pack2(kh[0], kh[1]); k2.y = pack2(kh[2], kh[3]);
    *(uint2*)(Kh_ + kch * 24 + 4 * tg) = k2;
    if (tg == 0) Pc_[kch] = PC;
    Vt_[vv * 24 + sv] = (u16)rr.v;
  };
  auto mfma = [&](int par) {
    const u16* Qt_ = (const u16*)(smem + par * HBUF); const u16* Kt_ = Qt_ + 16 * 136; const u16* Kh_ = Kt_ + 16 * 136; const u16* Vt_ = Kh_ + 128 * 24;
    const float* Pc_ = (const float*)(Vt_ + 32 * 24);
    float* Op_ = (float*)(smem + 4 * HBUF) + par * 2048;
    const uint2 v2 = *(const uint2*)(Vt_ + (16 * vt + fr) * 24 + 4 * fq);
    const bf16x8 vb = as_bf16x8(make_uint4(v2.x, v2.y, 0u, 0u));
    const u16* qrow = Qt_ + fr * 136 + 32 * kk + 4 * fq;
    const uint2 qa = *(const uint2*)qrow, qb = *(const uint2*)(qrow + 16);
    const bf16x8 qfrag = as_bf16x8(make_uint4(qa.x, qa.y, qb.x, qb.y));
    const bf16x8 sfrag = as_bf16x8(make_uint4(pack2(S0[0], S0[1]), pack2(S0[2], S0[3]), pack2(S1[0], S1[1]), pack2(S1[2], S1[3])));
    f32x4v acc = MFMA16(qfrag, sfrag, z4);
    if (kk == 0) {
      f32x4v sa = z4;
#pragma unroll
      for (int ks = 0; ks < 4; ++ks) {
        const bf16x8 kf = *(const bf16x8*)(Kt_ + fr * 136 + 32 * ks + 8 * fq);
        const bf16x8 qf2 = *(const bf16x8*)(Qt_ + fr * 136 + 32 * ks + 8 * fq);
        sa = MFMA16(kf, qf2, sa);
      }
#pragma unroll
      for (int j = 0; j < 4; ++j) sa[j] = (4 * fq + j <= fr) ? sa[j] : 0.f;
      const bf16x8 afrag = as_bf16x8(make_uint4(pack2(sa[0], sa[1]), pack2(sa[2], sa[3]), 0u, 0u));
      acc = MFMA16(afrag, vb, acc);
    }
#pragma unroll
    for (int j = 0; j < 4; ++j) Op_[(w * 16 + 4 * fq + j) * 16 + fr] = acc[j];
    const float* pc0 = Pc_ + 32 * kk + 4 * fq;
#pragma unroll
    for (int j = 0; j < 4; ++j) { S0[j] *= pc0[j]; S1[j] *= pc0[16 + j]; }
    const uint2 h0 = *(const uint2*)(Kh_ + (32 * kk + fr) * 24 + 4 * fq);
    const uint2 h1v = *(const uint2*)(Kh_ + (32 * kk + 16 + fr) * 24 + 4 * fq);
    S0 = MFMA16(as_bf16x8(make_uint4(h0.x, h0.y, 0u, 0u)), vb, S0);
    S1 = MFMA16(as_bf16x8(make_uint4(h1v.x, h1v.y, 0u, 0u)), vb, S1);
  };
  auto reduce = [&](int c, int par) {
    const float* Op_ = (const float*)(smem + 4 * HBUF) + par * 2048;
    const int t = tid >> 5, v = tid & 31, vtt = v >> 4, vl = v & 15;
    float o = 0.f;
#pragma unroll
    for (int q = 0; q < 4; ++q) o += Op_[((2 * q + vtt) * 16 + t) * 16 + vl];
    p.hbuf[(size_t)(b * S_ + c * 16 + t) * 1024 + h * 128 + vs * 32 + v] = f2bf(o);
  };
  prep(ra, 0); prep(rb, 1); hload(2, ra); hload(3, rb);
  __syncthreads();
#pragma unroll 1
  for (int P = 0; P < 64; P += 2) {
    mfma(0); mfma(1);
    prep(ra, 2); prep(rb, 3);
    if (P + 2 < 64) { hload(2 * P + 4, ra); hload(2 * P + 5, rb); }
    __syncthreads();
    reduce(2 * P, 0); reduce(2 * P + 1, 1);
    mfma(2); mfma(3);
    if (P + 2 < 64) { prep(ra, 0); prep(rb, 1); if (P + 3 < 64) { hload(2 * P + 6, ra); hload(2 * P + 7, rb); } }
    __syncthreads();
    reduce(2 * P + 2, 2); reduce(2 * P + 3, 3);
  }
  __syncthreads();
}

DI void load_q(const u16* qrow, const float* __restrict__ gain, int hh, bf16x8 (&qf)[4]) {
  float f[4][8]; float ss = 0.f;
#pragma unroll
  for (int kk = 0; kk < 4; ++kk) {
    uint4 raw = *(const uint4*)(qrow + kk * 16 + hh * 8);
    unpack8(raw, f[kk]);
#pragma unroll
    for (int j = 0; j < 8; ++j) ss += f[kk][j] * f[kk][j];
  }
  ss += __shfl_xor(ss, 32);
  const float rs = rsqrtf(ss * (1.f / 64.f) + EPSF) * (0.125f * LOG2E);
#pragma unroll
  for (int kk = 0; kk < 4; ++kk) {
#pragma unroll
    for (int j = 0; j < 8; ++j) f[kk][j] *= rs * gain[kk * 16 + hh * 8 + j];
    qf[kk] = as_bf16x8(pack8(f[kk]));
  }
}

constexpr int VS = 68;
constexpr int KVBUF = 18432;
template <int NTH> struct KVRegs { u32x4v r[NTH == 256 ? 4 : 2]; };
DI void kv_ld2(const u16* src, size_t stride, int ra, int rb, int rlo, int rhi, int dp, u32x4v& x0, u32x4v& x1) {
  const u32x4v z = {0u, 0u, 0u, 0u};
  x0 = z; x1 = z;
  if (ra >= rlo && ra < rhi) x0 = *(const u32x4v*)(src + (size_t)ra * stride + dp * 8);
  if (rb >= rlo && rb < rhi) x1 = *(const u32x4v*)(src + (size_t)rb * stride + dp * 8);
}
template <int NTH>
DI void kv_load(int tid, const u16* kb, const u16* vb, size_t stride, int r0, int rlo, int rhi, KVRegs<NTH>& rg) {
  const int dp = tid & 7, kq = (tid & 255) >> 3;
  if (NTH == 256) {
    kv_ld2(kb, stride, r0 + kq, r0 + kq + 32, rlo, rhi, dp, rg.r[0], rg.r[1]);
    kv_ld2(vb, stride, r0 + 2 * kq, r0 + 2 * kq + 1, rlo, rhi, dp, rg.r[2], rg.r[3]);
  } else {
    if (tid < 256) kv_ld2(kb, stride, r0 + kq, r0 + kq + 32, rlo, rhi, dp, rg.r[0], rg.r[1]);
    else kv_ld2(vb, stride, r0 + 2 * kq, r0 + 2 * kq + 1, rlo, rhi, dp, rg.r[0], rg.r[1]);
  }
}
DI void k_store1(u32x4v x, int key, int dp, const float* __restrict__ kgain, u16* Ks) {
  uint4 kv = make_uint4(x[0], x[1], x[2], x[3]);
  if (kgain) {
    float f[8]; unpack8(kv, f);
    float ss = 0.f;
#pragma unroll
    for (int e = 0; e < 8; ++e) ss += f[e] * f[e];
    ss += __shfl_xor(ss, 1); ss += __shfl_xor(ss, 2); ss += __shfl_xor(ss, 4);
    const float rs = rsqrtf(ss * (1.f / 64.f) + EPSF);
#pragma unroll
    for (int e = 0; e < 8; ++e) f[e] *= rs * kgain[dp * 8 + e];
    kv = pack8(f);
  }
  *(uint4*)(Ks + key * 72 + dp * 8) = kv;
}
DI void v_store2(u32x4v v0, u32x4v v1, int kp, int dp, u16* Vts) {
  unsigned* vd = (unsigned*)(Vts + (dp * 8) * VS + 2 * kp);
#pragma unroll
  for (int d = 0; d < 4; ++d) {
    vd[(2 * d) * (VS / 2)] = (v0[d] & 0xffffu) | (v1[d] << 16);
    vd[(2 * d + 1) * (VS / 2)] = (v0[d] >> 16) | (v1[d] & 0xffff0000u);
  }
}
template <int NTH>
DI void kv_store(int tid, const KVRegs<NTH>& rg, const float* __restrict__ kgain, u16* Ks, u16* Vts) {
  const int dp = tid & 7, kq = (tid & 255) >> 3;
  if (NTH == 256) {
    k_store1(rg.r[0], kq, dp, kgain, Ks); k_store1(rg.r[1], kq + 32, dp, kgain, Ks);
    v_store2(rg.r[2], rg.r[3], kq, dp, Vts);
  } else {
    if (tid < 256) { k_store1(rg.r[0], kq, dp, kgain, Ks); k_store1(rg.r[1], kq + 32, dp, kgain, Ks); }
    else v_store2(rg.r[0], rg.r[1], kq, dp, Vts);
  }
}

DI void score_stage(const bf16x8 (&qf)[4], const u16* Ks, int lane, float sk, float sb, int lower, int lim, f32x16 (&s)[2], float& mx) {
  const int lr = lane & 31, hh = lane >> 5;
#pragma unroll
  for (int sub = 0; sub < 2; ++sub) {
#pragma unroll
    for (int i = 0; i < 16; ++i) s[sub][i] = fmaf(sk, (float)(sub * 32 + (i & 3) + 8 * (i >> 2)), sb);
#pragma unroll
    for (int kk = 0; kk < 4; ++kk) {
      bf16x8 kf = *(const bf16x8*)(Ks + (sub * 32 + lr) * 72 + kk * 16 + hh * 8);
      s[sub] = MFMA32(kf, qf[kk], s[sub]);
    }
  }
  if (lim < lower) { lower = 64; lim = 64; }
  const bool full = (lower <= 0) && (lim >= 63);
  if (!__all(full)) {
    const int lo2 = lower - 4 * hh; const unsigned rng = (unsigned)(lim - lower);
#pragma unroll
    for (int sub = 0; sub < 2; ++sub)
#pragma unroll
      for (int i = 0; i < 16; ++i) {
        const int kc = sub * 32 + (i & 3) + 8 * (i >> 2);
        s[sub][i] = ((unsigned)(kc - lo2) <= rng) ? s[sub][i] : -INFINITY;
      }
  }
  mx = -INFINITY;
#pragma unroll
  for (int sub = 0; sub < 2; ++sub)
#pragma unroll
    for (int i = 0; i < 16; ++i) mx = fmaxf(mx, s[sub][i]);
  mx = fmaxf(mx, __shfl_xor(mx, 32));
}

DI void pv_stage(const f32x16 (&s)[2], const u16* Vts, f32x16 (&o)[2], int lane) {
  const int lr = lane & 31, hh = lane >> 5;
#pragma unroll
  for (int sub = 0; sub < 2; ++sub)
#pragma unroll
    for (int st = 0; st < 2; ++st) {
      uint4 pk;
      pk.x = pack2(s[sub][8 * st + 0], s[sub][8 * st + 1]); pk.y = pack2(s[sub][8 * st + 2], s[sub][8 * st + 3]);
      pk.z = pack2(s[sub][8 * st + 4], s[sub][8 * st + 5]); pk.w = pack2(s[sub][8 * st + 6], s[sub][8 * st + 7]);
      const bf16x8 pf = as_bf16x8(pk);
#pragma unroll
      for (int dt = 0; dt < 2; ++dt) {
        const u16* vp = Vts + (dt * 32 + lr) * VS + sub * 32 + 16 * st + 4 * hh;
        const uint2 lo = *(const uint2*)vp, hi = *(const uint2*)(vp + 8);
        const bf16x8 vf = as_bf16x8(make_uint4(lo.x, lo.y, hi.x, hi.y));
        o[dt] = MFMA32(vf, pf, o[dt]);
      }
    }
}

DI void flash_stage(const bf16x8 (&qf)[4], const u16* Ks, const u16* Vts, f32x16 (&o)[2], float& m, float& l, int lane,
                    float sk, float sb, int lower, int lim) {
  f32x16 s[2]; float mx;
  score_stage(qf, Ks, lane, sk, sb, lower, lim, s, mx);
  const float mn = fmaxf(m, mx);
  const float alpha = fexp2(m - mn);
  const bool same = (mn == m);
  m = mn;
  float ls = 0.f;
#pragma unroll
  for (int sub = 0; sub < 2; ++sub)
#pragma unroll
    for (int i = 0; i < 16; ++i) { const float pv = fexp2(s[sub][i] - mn); s[sub][i] = pv; ls += pv; }
  l = l * alpha + ls;
  if (!__all(same)) {
#pragma unroll
    for (int dt = 0; dt < 2; ++dt)
#pragma unroll
      for (int i = 0; i < 16; ++i) o[dt][i] *= alpha;
  }
  pv_stage(s, Vts, o, lane);
}

DI void dilated_item(const Params& p, int li, int pairitem, char* smem) {
  const int tfull = tidx();
  const int half = tfull >> 8, tid = tfull & 255;
  const int item = pairitem * 2 + half;
  char* kvb = smem + half * (2 * KVBUF);
  const int lane = tid & 63, w = tid >> 6, lr = lane & 31, hh = lane >> 5;
  const int idx16 = item & 15; const int br = (item >> 4) % 3; const int hb = (item / 48) & 7; const int b = item / 384;
  const int d = br == 0 ? 1 : (br == 1 ? 4 : 16);
  const int tile = idx16 / d, resid = idx16 % d;
  const int st0 = (d >= 2 && tile == 0) ? 2 : 0;
  const int u0 = tile * 128;
  const int uq = u0 + 32 * w + lr; const int tq = uq * d + resid;
  const u16* prow = p.proj + (size_t)(b * S_ + tq) * LD_EVEN;
  bf16x8 qf[4];
  load_q(prow + 2048 + hb * 64, p.hy_qg + li * 64, hh, qf);
  const float slope2 = fexp2(-(float)(hb + 1)) * LOG2E;
  const float sk = slope2 * (float)d;
  const u16* kb = p.proj + (size_t)(b * S_ + resid) * LD_EVEN + 2560 + hb * 64;
  const u16* vb = kb + 512;
  const size_t stride = (size_t)d * LD_EVEN;
  const float* kg = p.hy_kg + li * 64;
  f32x16 o[2]; o[0] = zero16(); o[1] = zero16();
  float m = -1e30f, l = 0.f;
  const int uw = u0 + 32 * w;
  KVRegs<256> rg;
  kv_load<256>(tid, kb, vb, stride, u0 - 128 + 64 * st0, 0, 1 << 30, rg);
  __syncthreads();
  kv_store<256>(tid, rg, kg, (u16*)(kvb + (st0 & 1) * KVBUF), (u16*)(kvb + (st0 & 1) * KVBUF) + 64 * 72);
  kv_load<256>(tid, kb, vb, stride, u0 - 64 + 64 * st0, 0, 1 << 30, rg);
  __syncthreads();
#pragma unroll 1
  for (int st = st0; st < 4; ++st) {
    const int ub = u0 - 128 + 64 * st;
    u16* Ks = (u16*)(kvb + (st & 1) * KVBUF); u16* Vts = Ks + 64 * 72;
    if (st + 1 < 4) { u16* Kn = (u16*)(kvb + ((st + 1) & 1) * KVBUF); kv_store<256>(tid, rg, kg, Kn, Kn + 64 * 72); }
    if (st + 2 < 4) kv_load<256>(tid, kb, vb, stride, ub + 128, 0, 1 << 30, rg);
    if (ub + 63 >= 0 && ub <= uw + 31 && ub + 63 >= uw - 128) {
      const int lim = uq - ub;
      const int lower = max(lim - 128, -ub);
      const float sb = slope2 * (float)(ub * d + resid) + sk * (float)(4 * hh);
      flash_stage(qf, Ks, Vts, o, m, l, lane, sk, sb, lower, lim);
    }
    __syncthreads();
  }
  const float lt = l + __shfl_xor(l, 32);
  const float inv = 1.f / lt;
  const size_t trow = (size_t)br * T_ + (size_t)b * S_ + tq;
  if (hh == 0) p.lse[trow * 8 + hb] = (m + log2f(lt)) * LN2;
  u16* orow = p.obr + trow * 512 + hb * 64;
#pragma unroll
  for (int dt = 0; dt < 2; ++dt)
#pragma unroll
    for (int q4 = 0; q4 < 4; ++q4) {
      uint2 ov; ov.x = pack2(o[dt][4 * q4] * inv, o[dt][4 * q4 + 1] * inv); ov.y = pack2(o[dt][4 * q4 + 2] * inv, o[dt][4 * q4 + 3] * inv);
      *(uint2*)(orow + dt * 32 + 8 * q4 + 4 * hh) = ov;
    }
}

DI void post_even_phase(const Params& p, int li) {
  const int tid = tidx();
  const int rsel = tid >> 7, c8 = tid & 127;
  const int c = c8 * 8;
  const int nit = T_ / 4, step = gridDim.x;
  int it = blockIdx.x;
  if (c8 < 64) {
    float og[8];
#pragma unroll
    for (int j = 0; j < 8; ++j) og[j] = p.hy_og[li * 512 + c + j];
    u32x4v raw = {0u, 0u, 0u, 0u}, graw = {0u, 0u, 0u, 0u}, nraw = raw, ngraw = raw;
    if (it < nit) { const int t = it * 4 + rsel; raw = *(const u32x4v*)(p.hbuf + (size_t)t * 1024 + c); graw = *(const u32x4v*)(p.proj + (size_t)t * LD_EVEN + 1536 + c); }
    while (it < nit) {
      const int t = it * 4 + rsel, itn = it + step;
      if (itn < nit) { const int tn = itn * 4 + rsel; nraw = *(const u32x4v*)(p.hbuf + (size_t)tn * 1024 + c); ngraw = *(const u32x4v*)(p.proj + (size_t)tn * LD_EVEN + 1536 + c); }
      float o[8], gt[8], val[8];
      unpack8(make_uint4(raw[0], raw[1], raw[2], raw[3]), o); unpack8(make_uint4(graw[0], graw[1], graw[2], graw[3]), gt);
      float ss = 0.f;
#pragma unroll
      for (int j = 0; j < 8; ++j) ss += o[j] * o[j];
      ss += __shfl_xor(ss, 1); ss += __shfl_xor(ss, 2); ss += __shfl_xor(ss, 4); ss += __shfl_xor(ss, 8);
      const float rs = rsqrtf(ss * (1.f / 128.f) + EPSF);
#pragma unroll
      for (int j = 0; j < 8; ++j) val[j] = o[j] * rs * og[j] * fsilu(gt[j]);
      *(uint4*)(p.hbuf + (size_t)t * 1024 + c) = pack8(val);
      raw = nraw; graw = ngraw; it = itn;
    }
  } else {
    const int cb = c - 512, hb = cb >> 6;
    float l0 = 0.f, l1 = 0.f, l2 = 0.f, nl0 = 0.f, nl1 = 0.f, nl2 = 0.f;
    u32x4v a4 = {0u, 0u, 0u, 0u}, b4 = a4, c4 = a4, na4 = a4, nb4 = a4, nc4 = a4;
    if (it < nit) {
      const size_t t = (size_t)(it * 4 + rsel);
      l0 = p.lse[(t) * 8 + hb]; l1 = p.lse[((size_t)T_ + t) * 8 + hb]; l2 = p.lse[((size_t)2 * T_ + t) * 8 + hb];
      a4 = *(const u32x4v*)(p.obr + t * 512 + cb); b4 = *(const u32x4v*)(p.obr + ((size_t)T_ + t) * 512 + cb); c4 = *(const u32x4v*)(p.obr + ((size_t)2 * T_ + t) * 512 + cb);
    }
    while (it < nit) {
      const int t = it * 4 + rsel, itn = it + step;
      if (itn < nit) {
        const size_t tn = (size_t)(itn * 4 + rsel);
        nl0 = p.lse[(tn) * 8 + hb]; nl1 = p.lse[((size_t)T_ + tn) * 8 + hb]; nl2 = p.lse[((size_t)2 * T_ + tn) * 8 + hb];
        na4 = *(const u32x4v*)(p.obr + tn * 512 + cb); nb4 = *(const u32x4v*)(p.obr + ((size_t)T_ + tn) * 512 + cb); nc4 = *(const u32x4v*)(p.obr + ((size_t)2 * T_ + tn) * 512 + cb);
      }
      const float mx = fmaxf(l0, fmaxf(l1, l2));
      float w0 = __expf(l0 - mx), w1 = __expf(l1 - mx), w2 = __expf(l2 - mx);
      const float inv = 1.f / (w0 + w1 + w2);
      w0 *= inv; w1 *= inv; w2 *= inv;
      float a[8], bq[8], cq[8], val[8];
      unpack8(make_uint4(a4[0], a4[1], a4[2], a4[3]), a); unpack8(make_uint4(b4[0], b4[1], b4[2], b4[3]), bq); unpack8(make_uint4(c4[0], c4[1], c4[2], c4[3]), cq);
#pragma unroll
      for (int j = 0; j < 8; ++j) val[j] = w0 * a[j] + w1 * bq[j] + w2 * cq[j];
      *(uint4*)(p.hbuf + (size_t)t * 1024 + c) = pack8(val);
      l0 = nl0; l1 = nl1; l2 = nl2; a4 = na4; b4 = nb4; c4 = nc4; it = itn;
    }
  }
}

DI void compress_item(const Params& p, int li, int pairitem, char* smem) {
  const int tfull = tidx();
  const int half = tfull >> 8, tid = tfull & 255;
  const int item = pairitem * 2 + half;
  u16* hs = (u16*)(smem + half * 17408);
  float* outs = (float*)(smem + half * 17408 + 32 * 136 * 2);
  const int lane = tid & 63, w = tid >> 6, lr = lane & 31, hh = lane >> 5;
  const int nt = item & 3, g = (item >> 2) & 3, b = (item >> 4) & 15, kv = item >> 8;
  const int n = nt * 32 + lr; const int nc = n > 126 ? 126 : n;
  const int col = 1024 + kv * 256 + g * 64;
  const u16* arow = p.proj + (size_t)(b * S_ + 16 * nc) * LD_ODD + col;
  const u16* w1t = p.wt_c1 + (size_t)(li * 2 + kv) * 128 * 2048 + (size_t)(32 * w + lr) * 2048;
  f32x16 acc = zero16();
#pragma unroll 16
  for (int ks = 0; ks < 128; ++ks) {
    const int lidx = ks >> 2, dd = (ks & 3) * 16 + hh * 8;
    const bf16x8 a = as_bf16x8(*(const uint4*)(arow + (size_t)lidx * LD_ODD + dd));
    const bf16x8 bb = as_bf16x8(*(const uint4*)(w1t + ks * 16 + hh * 8));
    acc = MFMA32(a, bb, acc);
  }
  const float cb = p.c1[(li * 2 + kv) * 128 + 32 * w + lr];
  __syncthreads();
#pragma unroll
  for (int i = 0; i < 16; ++i) {
    const int r = (i & 3) + 8 * (i >> 2) + 4 * hh;
    hs[r * 136 + 32 * w + lr] = f2bf(fsilu(acc[i] + cb));
  }
  __syncthreads();
  if (w < 2) {
    const u16* w2t = p.wt_c2 + (size_t)(li * 2 + kv) * 64 * 128 + (size_t)(w * 32 + lr) * 128;
    f32x16 a2 = zero16();
#pragma unroll
    for (int kk = 0; kk < 8; ++kk) {
      const bf16x8 a = *(const bf16x8*)(hs + lr * 136 + kk * 16 + hh * 8);
      const bf16x8 bb = as_bf16x8(*(const uint4*)(w2t + kk * 16 + hh * 8));
      a2 = MFMA32(a, bb, a2);
    }
#pragma unroll
    for (int i = 0; i < 16; ++i) {
      const int r = (i & 3) + 8 * (i >> 2) + 4 * hh;
      outs[r * 65 + w * 32 + lr] = a2[i];
    }
  }
  __syncthreads();
  {
    const int r = tid >> 3, c8 = tid & 7;
    float v[8]; float ss = 0.f;
#pragma unroll
    for (int j = 0; j < 8; ++j) { v[j] = outs[r * 65 + c8 * 8 + j]; ss += v[j] * v[j]; }
    ss += __shfl_xor(ss, 1); ss += __shfl_xor(ss, 2); ss += __shfl_xor(ss, 4);
    if (kv == 0) {
      const float rs = rsqrtf(ss * (1.f / 64.f) + EPSF);
#pragma unroll
      for (int j = 0; j < 8; ++j) v[j] *= rs * p.nsa_kg[(li * 3 + 0) * 64 + c8 * 8 + j];
    }
    const int nn = nt * 32 + r;
    if (nn >= 127) {
#pragma unroll
      for (int j = 0; j < 8; ++j) v[j] = 0.f;
    }
    u16* dst = (kv == 0 ? p.kcmp : p.vcmp) + ((size_t)(b * 4 + g) * 128 + nn) * 64 + c8 * 8;
    *(uint4*)dst = pack8(v);
  }
  __syncthreads();
}

DI void nsa_knorm_phase(const Params& p, int li) {
  const int tid = tidx();
  for (int u0 = blockIdx.x * NT + tid; u0 < T_ * 64; u0 += gridDim.x * NT * 4) {
    u32x4v raw[4];
#pragma unroll
    for (int q = 0; q < 4; ++q) {
      const int u = u0 + q * gridDim.x * NT;
      const int piece = u & 7, head = (u >> 3) & 3, br = (u >> 5) & 1, row = u >> 6;
      raw[q] = *(const u32x4v*)(p.proj + (size_t)row * LD_ODD + 1536 + br * 512 + head * 64 + piece * 8);
    }
    asm volatile("" ::: "memory");
#pragma unroll
    for (int q = 0; q < 4; ++q) {
      const int u = u0 + q * gridDim.x * NT;
      const int piece = u & 7, head = (u >> 3) & 3, br = (u >> 5) & 1, row = u >> 6;
      float f[8]; unpack8(make_uint4(raw[q][0], raw[q][1], raw[q][2], raw[q][3]), f);
      float ss = 0.f;
#pragma unroll
      for (int e = 0; e < 8; ++e) ss += f[e] * f[e];
      ss += __shfl_xor(ss, 1); ss += __shfl_xor(ss, 2); ss += __shfl_xor(ss, 4);
      const float rs = rsqrtf(ss * (1.f / 64.f) + EPSF);
      const float* kg = p.nsa_kg + (li * 3 + 1 + br) * 64 + piece * 8;
#pragma unroll
      for (int e = 0; e < 8; ++e) f[e] *= rs * kg[e];
      *(uint4*)(p.proj + (size_t)row * LD_ODD + 1536 + br * 512 + head * 64 + piece * 8) = pack8(f);
    }
  }
}

DI void nsa_item(const Params& p, int li, int item, char* smem) {
  float* impA = (float*)(smem + 2 * KVBUF);
  float* impB = impA + 8448;
  float* imp = impB + 8448;
  unsigned* selm = (unsigned*)(imp + 64 * 33);
  const int tid = tidx(), lane = tid & 63, wv = tid >> 6, lr = lane & 31, hh = lane >> 5;
  const int w = lr & 3;
  const int tt = item & 31, g = (item >> 5) & 3, b = item >> 7;
  const int t0 = tt * 64; const int cur = t0 >> 6;
  const int hd = g * 4 + w;
  const int tokl = 8 * wv + (lr >> 2);
  const int tq = t0 + tokl;
  const u16* pb = p.proj + (size_t)b * S_ * LD_ODD;
  const u16* prow = pb + (size_t)tq * LD_ODD;
  bf16x8 qf[4];
  load_q(prow + g * 256 + w * 64, p.nsa_qg + li * 64, hh, qf);
  const float slope2 = fexp2(-0.5f * (float)(hd + 1)) * LOG2E;
  const float g0 = fsigmoid(bf2f(prow[2560 + 0 + g * 4 + w]));
  const float g1 = fsigmoid(bf2f(prow[2560 + 16 + g * 4 + w]));
  const float g2 = fsigmoid(bf2f(prow[2560 + 32 + g * 4 + w]));
  f32x16 ot[2]; ot[0] = zero16(); ot[1] = zero16();
  {
    const u16* kb = p.kcmp + (size_t)(b * 4 + g) * 128 * 64;
    const u16* vb = p.vcmp + (size_t)(b * 4 + g) * 128 * 64;
    const float sk = 16.f * slope2;
    const int limc = min((tq - 31) >> 4, 126);
    const int nst = (1024 > t0) ? 1 : 2;
    {
      KVRegs<512> rg0;
      kv_load<512>(tid, kb, vb, 64, 0, 0, 128, rg0);
      __syncthreads();
      kv_store<512>(tid, rg0, nullptr, (u16*)smem, (u16*)smem + 64 * 72);
      if (nst > 1) {
        kv_load<512>(tid, kb, vb, 64, 64, 0, 128, rg0);
        kv_store<512>(tid, rg0, nullptr, (u16*)(smem + KVBUF), (u16*)(smem + KVBUF) + 64 * 72);
      }
    }
    __syncthreads();
    float m = -1e30f, l = 0.f;
#pragma unroll
    for (int st = 0; st < 2; ++st) {
      if (st >= nst) continue;
      const u16* Ks = (const u16*)(smem + st * KVBUF);
      f32x16 s[2]; float mx;
      const float sb = slope2 * (float)(1024 * st + 31) + sk * (float)(4 * hh);
      score_stage(qf, Ks, lane, sk, sb, 0, limc - 64 * st, s, mx);
      const float mn = fmaxf(m, mx);
      float ls = 0.f;
#pragma unroll
      for (int sub = 0; sub < 2; ++sub)
#pragma unroll
        for (int i = 0; i < 16; ++i) ls += fexp2(s[sub][i] - mn);
      l = l * fexp2(m - mn) + ls;
      m = mn;
    }
    const float lt = l + __shfl_xor(l, 32);
    const float inv = lt > 0.f ? 1.f / lt : 0.f;
    f32x16 o[2]; o[0] = zero16(); o[1] = zero16();
#pragma unroll
    for (int st = 0; st < 2; ++st) {
      if (st >= nst) {
#pragma unroll
        for (int G = 0; G < 16; ++G) {
          if ((G & 1) == hh) { impA[(w * 64 + tokl) * 33 + 16 * st + G] = 0.f; impB[(w * 64 + tokl) * 33 + 16 * st + G] = 0.f; }
        }
        continue;
      }
      const u16* Ks = (const u16*)(smem + st * KVBUF); const u16* Vts = Ks + 64 * 72;
      f32x16 s[2]; float mx;
      const float sb = slope2 * (float)(1024 * st + 31) + sk * (float)(4 * hh);
      score_stage(qf, Ks, lane, sk, sb, 0, limc - 64 * st, s, mx);
#pragma unroll
      for (int sub = 0; sub < 2; ++sub)
#pragma unroll
        for (int i = 0; i < 16; ++i) s[sub][i] = fexp2(s[sub][i] - m) * inv;
#pragma unroll
      for (int sub = 0; sub < 2; ++sub)
#pragma unroll
        for (int q4 = 0; q4 < 4; ++q4) {
          const int G = 16 * st + 8 * sub + 2 * q4 + hh;
          impA[(w * 64 + tokl) * 33 + G] = (s[sub][4 * q4] + s[sub][4 * q4 + 1]) + (s[sub][4 * q4 + 2] + s[sub][4 * q4 + 3]);
          impB[(w * 64 + tokl) * 33 + G] = s[sub][4 * q4 + 3];
        }
      pv_stage(s, Vts, o, lane);
    }
#pragma unroll
    for (int dt = 0; dt < 2; ++dt)
#pragma unroll
      for (int i = 0; i < 16; ++i) ot[dt][i] += g0 * o[dt][i];
  }
  const u16* kbs = pb + 1536 + g * 64; const u16* vbs = pb + 1792 + g * 64;
  KVRegs<512> rg;
  kv_load<512>(tid, kbs, vbs, LD_ODD, 0, 0, S_, rg);
  __syncthreads();
  for (int idx = tid; idx < 2048; idx += NT) {
    const int tok = idx >> 5, mm = idx & 31;
    float a = 0.f;
#pragma unroll
    for (int ww = 0; ww < 4; ++ww) a += impA[(ww * 64 + tok) * 33 + mm] + (mm > 0 ? impB[(ww * 64 + tok) * 33 + mm - 1] : 0.f);
    imp[tok * 33 + mm] = a;
  }
  __syncthreads();
  float* ots = impA + tid;
#pragma unroll
  for (int dt = 0; dt < 2; ++dt)
#pragma unroll
    for (int i = 0; i < 16; ++i) ots[(dt * 16 + i) * NT] = ot[dt][i];
  {
    const int tok = tid >> 3, sub8 = tid & 7;
    unsigned sel = 1u | (1u << cur) | (cur > 0 ? (1u << (cur - 1)) : 0u);
    const int cnt = __popc(sel);
    float cv[4];
#pragma unroll
    for (int e = 0; e < 4; ++e) cv[e] = imp[tok * 33 + sub8 * 4 + e];
    for (int r = cnt; r < 8; ++r) {
      float bv = -1.f; int bi = 64;
#pragma unroll
      for (int e = 0; e < 4; ++e) {
        const int mm = sub8 * 4 + e;
        const bool ok = (mm <= cur) && !((sel >> mm) & 1u);
        if (ok && cv[e] > bv) { bv = cv[e]; bi = mm; }
      }
#pragma unroll
      for (int off = 1; off < 8; off <<= 1) {
        const float ov = __shfl_xor(bv, off); const int oi = __shfl_xor(bi, off);
        if (ov > bv || (ov == bv && oi < bi)) { bv = ov; bi = oi; }
      }
      if (bi < 64) sel |= 1u << bi;
    }
    if (sub8 == 0) selm[tok] = sel;
  }
  __syncthreads();
  const unsigned myMask = selm[tokl];
  unsigned uni = 0u;
#pragma unroll 8
  for (int i = 0; i < 64; ++i) uni |= selm[i];
  {
    f32x16 o[2]; o[0] = zero16(); o[1] = zero16();
    float m = -1e30f, l = 0.f;
    const float* kg = nullptr;
    unsigned rem = uni & (uni - 1u);
    int mb = 0;
    int mbn = rem ? __builtin_ctz(rem) : -1;
    kv_store<512>(tid, rg, kg, (u16*)smem, (u16*)smem + 64 * 72);
    if (mbn >= 0) kv_load<512>(tid, kbs, vbs, LD_ODD, 64 * mbn, 0, S_, rg);
    __syncthreads();
    int par = 0;
#pragma unroll 1
    while (true) {
      u16* Ks = (u16*)(smem + par * KVBUF); u16* Vts = Ks + 64 * 72;
      int mbn2 = -1;
      if (mbn >= 0) {
        u16* Kn = (u16*)(smem + (par ^ 1) * KVBUF);
        kv_store<512>(tid, rg, kg, Kn, Kn + 64 * 72);
        rem &= rem - 1u;
        mbn2 = rem ? __builtin_ctz(rem) : -1;
        if (mbn2 >= 0) kv_load<512>(tid, kbs, vbs, LD_ODD, 64 * mbn2, 0, S_, rg);
      }
      const bool selb = (myMask >> mb) & 1u;
      const float sb = slope2 * (float)(64 * mb) + slope2 * (float)(4 * hh);
      if (__any(selb)) flash_stage(qf, Ks, Vts, o, m, l, lane, slope2, sb, 0, selb ? (tq - 64 * mb) : -1);
      __syncthreads();
      if (mbn < 0) break;
      mb = mbn; mbn = mbn2; par ^= 1;
    }
    const float lt = l + __shfl_xor(l, 32);
    const float sc = g1 / lt;
#pragma unroll
    for (int dt = 0; dt < 2; ++dt)
#pragma unroll
      for (int i = 0; i < 16; ++i) ots[(dt * 16 + i) * NT] += sc * o[dt][i];
  }
  {
    f32x16 o[2]; o[0] = zero16(); o[1] = zero16();
    float m = -1e30f, l = 0.f;
    const u16* kb = pb + 2048 + g * 64; const u16* vb = pb + 2304 + g * 64;
    const float* kg = nullptr;
    const int mlo = (t0 - 511) < 0 ? 0 : ((t0 - 511) >> 6);
    kv_load<512>(tid, kb, vb, LD_ODD, 64 * mlo, 0, S_, rg);
    kv_store<512>(tid, rg, kg, (u16*)smem, (u16*)smem + 64 * 72);
    if (mlo + 1 <= cur) kv_load<512>(tid, kb, vb, LD_ODD, 64 * (mlo + 1), 0, S_, rg);
    __syncthreads();
#pragma unroll 1
    for (int mb = mlo; mb <= cur; ++mb) {
      const int par = (mb - mlo) & 1;
      u16* Ks = (u16*)(smem + par * KVBUF); u16* Vts = Ks + 64 * 72;
      if (mb + 1 <= cur) { u16* Kn = (u16*)(smem + (par ^ 1) * KVBUF); kv_store<512>(tid, rg, kg, Kn, Kn + 64 * 72); }
      if (mb + 2 <= cur) kv_load<512>(tid, kb, vb, LD_ODD, 64 * (mb + 2), 0, S_, rg);
      const int lim = tq - 64 * mb;
      const float sb = slope2 * (float)(64 * mb) + slope2 * (float)(4 * hh);
      flash_stage(qf, Ks, Vts, o, m, l, lane, slope2, sb, lim - 511, lim);
      __syncthreads();
    }
    const float lt = l + __shfl_xor(l, 32);
    const float sc = g2 / lt;
    u16* orow = p.hbuf + (size_t)(b * S_ + tq) * 1024 + g * 256 + w * 64;
#pragma unroll
    for (int dt = 0; dt < 2; ++dt)
#pragma unroll
      for (int q4 = 0; q4 < 4; ++q4) {
        const float a0 = ots[(dt * 16 + 4 * q4 + 0) * NT] + sc * o[dt][4 * q4 + 0], a1 = ots[(dt * 16 + 4 * q4 + 1) * NT] + sc * o[dt][4 * q4 + 1];
        const float a2 = ots[(dt * 16 + 4 * q4 + 2) * NT] + sc * o[dt][4 * q4 + 2], a3 = ots[(dt * 16 + 4 * q4 + 3) * NT] + sc * o[dt][4 * q4 + 3];
        uint2 ov; ov.x = pack2(a0, a1); ov.y = pack2(a2, a3);
        *(uint2*)(orow + dt * 32 + 8 * q4 + 4 * hh) = ov;
      }
  }
  __syncthreads();
}

DI void run_phase(const Params& p, int ph, char* smem) {
  if (ph == 0) { prep_phase(p, smem); return; }
  const int l = (ph - 1) >> 3, s = (ph - 1) & 7, li = l >> 1;
  const bool even = (l & 1) == 0;
  const float* xin = (l == 0) ? p.x : p.out;
  switch (s) {
    case 0: rmsnorm_phase(xin, p.attn_norm + l * 1024, p.hbuf); break;
    case 1:
      if (even) gemm_phase<0>(p.hbuf, p.wt_hy_in + (size_t)li * 3584 * 1024, 1024, 14, p.proj, LD_EVEN, nullptr, nullptr, smem);
      else gemm_phase<0>(p.hbuf, p.wt_nsa_in + (size_t)li * 2816 * 1024, 1024, 11, p.proj, LD_ODD, nullptr, nullptr, smem);
      break;
    case 2:
      if (even) {
        for (int item = blockIdx.x; item < 256 + 3072; item += gridDim.x) {
          if (item < 256) hgrn_item(p, li, item, smem); else dilated_item(p, li, item - 256, smem);
        }
      } else {
        for (int item = blockIdx.x; item < 256; item += gridDim.x) compress_item(p, li, item, smem);
        nsa_knorm_phase(p, li);
      }
      break;
    case 3:
      if (even) post_even_phase(p, li);
      else {
        for (int item = blockIdx.x; item < 2048; item += gridDim.x) {
          const int r = item / gridDim.x, i = item % gridDim.x;
          int it2 = item;
          if (gridDim.x == 256) {
            const int c = (i + 4 * (r >> 1)) & 31;
            const int tt = (r & 1) ? 31 - c : c;
            it2 = ((i >> 5) + 8 * r) * 32 + tt;
          }
          nsa_item(p, li, it2, smem);
        }
      }
      break;
    case 4:
      gemm_phase<1>(p.hbuf, (even ? p.wt_hy_out : p.wt_nsa_out) + (size_t)li * 1048576, 1024, 4, nullptr, 0, xin, p.out, smem);
      break;
    case 5: rmsnorm_phase(p.out, p.ffn_norm + l * 1024, p.hbuf); break;
    case 6: gemm_phase<2>(p.hbuf, p.wt_gu + (size_t)l * 5632 * 1024, 1024, 22, p.proj, DFF, nullptr, nullptr, smem); break;
    case 7: gemm_phase<1>(p.proj, p.wt_dn + (size_t)l * 1024 * 2816, 2816, 4, nullptr, 0, p.out, p.out, smem, true); break;
  }
}

constexpr int DYN_LDS = 131072;
extern __shared__ __attribute__((aligned(16))) char dyn_smem[];
__global__ void __launch_bounds__(512) mk_forward(Params p) {
  char* smem = dyn_smem;
  __shared__ uint4 xb_words;
  cg::grid_group grid = cg::this_grid();
  if (__builtin_amdgcn_workitem_id_x() == 0) xb_words = make_uint4(0u, 0u, 0u, 0u);
  __syncthreads();
  const XcdBarrier xb = xcd_barrier_post(p.bar, (volatile LAS unsigned*)&xb_words);
  for (int ph = p.phase_lo; ph < p.phase_hi; ++ph) {
    run_phase(p, ph, smem);
    if (ph + 1 < p.phase_hi) {
      if (p.phase_hi < 0) grid.sync();
      xcd_barrier(xb);
    }
  }
}

extern "C" void kernel_launch(void* const* d_in, const int* in_sizes, int n_in, void* d_out, int out_size,
                              void* d_ws, size_t ws_size, hipStream_t stream) {
  static int grid_blocks = 0;
  if (!grid_blocks) {
    int dev = 0, cus = 0, per_cu = 0;
    hipGetDevice(&dev);
    hipDeviceGetAttribute(&cus, hipDeviceAttributeMultiprocessorCount, dev);
    hipFuncSetAttribute((const void*)mk_forward, hipFuncAttributeMaxDynamicSharedMemorySize, DYN_LDS);
    hipOccupancyMaxActiveBlocksPerMultiprocessor(&per_cu, mk_forward, 512, DYN_LDS);
    if (per_cu > 1) per_cu = 1;
    if (per_cu < 1) per_cu = 1;
    grid_blocks = cus * per_cu;
  }
  Params p;
  memset(&p, 0, sizeof(p));
  p.x = (const float*)d_in[0]; p.attn_norm = (const float*)d_in[1]; p.ffn_norm = (const float*)d_in[2];
  p.hy_w_in = (const float*)d_in[3]; p.hy_lb = (const float*)d_in[4]; p.hy_og = (const float*)d_in[5];
  p.hy_qg = (const float*)d_in[6]; p.hy_kg = (const float*)d_in[7]; p.hy_w_out = (const float*)d_in[8];
  p.nsa_w_in = (const float*)d_in[9]; p.nsa_qg = (const float*)d_in[10]; p.nsa_kg = (const float*)d_in[11];
  p.cmp_pe = (const float*)d_in[12]; p.cmp_w1 = (const float*)d_in[13]; p.cmp_w2 = (const float*)d_in[14];
  p.nsa_w_out = (const float*)d_in[15]; p.ffn_g = (const float*)d_in[16]; p.ffn_u = (const float*)d_in[17]; p.ffn_d = (const float*)d_in[18];
  p.out = (float*)d_out;
  char* ws = (char*)d_ws; size_t off = 0;
  auto take = [&](size_t bytes) { char* r = ws + off; off += (bytes + 255) & ~(size_t)255; return r; };
  p.wt_hy_in = (u16*)take((size_t)2 * 3584 * 1024 * 2);
  p.wt_hy_out = (u16*)take((size_t)2 * 1048576 * 2);
  p.wt_nsa_in = (u16*)take((size_t)2 * 2816 * 1024 * 2);
  p.wt_nsa_out = (u16*)take((size_t)2 * 1048576 * 2);
  p.wt_gu = (u16*)take((size_t)4 * 5632 * 1024 * 2);
  p.wt_dn = (u16*)take((size_t)4 * 1024 * 2816 * 2);
  p.wt_c1 = (u16*)take((size_t)4 * 128 * 2048 * 2);
  p.wt_c2 = (u16*)take((size_t)4 * 64 * 128 * 2);
  p.c1 = (float*)take(4 * 128 * 4);
  p.lb = (float*)take(2 * 512 * 4);
  p.lse = (float*)take((size_t)3 * T_ * 8 * 4);
  p.proj = (u16*)take((size_t)T_ * 3584 * 2);
  p.hbuf = (u16*)take((size_t)T_ * 1024 * 2);
  p.obr = (u16*)take((size_t)3 * T_ * 512 * 2);
  p.kcmp = (u16*)take((size_t)16 * 4 * 128 * 64 * 2);
  p.vcmp = (u16*)take((size_t)16 * 4 * 128 * 64 * 2);
  p.bar = (unsigned*)take(XCD_BAR_WORDS * 4);
  if (off > ws_size) { fprintf(stderr, "workspace too small: need %zu have %zu\n", off, ws_size); return; }
  const int NPH = 33;
  hipMemsetAsync(p.bar, 0, XCD_BAR_WORDS * 4, stream);
#if MK_MULTI
  for (int ph = 0; ph < NPH; ++ph) {
    p.phase_lo = ph; p.phase_hi = ph + 1;
    hipLaunchKernelGGL(mk_forward, dim3(grid_blocks), dim3(512), DYN_LDS, stream, p);
  }
#else
  p.phase_lo = 0; p.phase_hi = NPH;
  void* args[] = {&p};
  hipError_t e = hipLaunchCooperativeKernel((void*)mk_forward, dim3(grid_blocks), dim3(512), args, DYN_LDS, stream);
  if (e != hipSuccess) fprintf(stderr, "cooperative launch failed: %s (grid %d)\n", hipGetErrorString(e), grid_blocks);
#endif
}
```

```cpp
#include <hip/hip_runtime.h>
#include <hip/hip_cooperative_groups.h>
#include <cstdio>
#include <cstdint>
#include <cstring>
namespace cg = cooperative_groups;

typedef unsigned short u16;
using bf16x8 = __attribute__((ext_vector_type(8))) short;
using f32x16 = __attribute__((ext_vector_type(16))) float;
using u32x4v = __attribute__((ext_vector_type(4))) unsigned;
#define DI __device__ __forceinline__
#define MFMA32(a, b, c) __builtin_amdgcn_mfma_f32_32x32x16_bf16((a), (b), (c), 0, 0, 0)

#ifndef MK_MULTI
#define MK_MULTI 0
#endif

constexpr int T_ = 32768, S_ = 2048;
constexpr float EPSF = 1e-6f;
constexpr float LOG2E = 1.4426950408889634f, LN2 = 0.6931471805599453f;
constexpr int LD_EVEN = 3584, LD_ODD = 2816, DFF = 2816;
constexpr int NT = 512;
#define LAS __attribute__((address_space(3)))
using f32x4v = __attribute__((ext_vector_type(4))) float;

struct Params {
  const float* x; const float* attn_norm; const float* ffn_norm;
  const float* hy_w_in; const float* hy_lb; const float* hy_og; const float* hy_qg; const float* hy_kg; const float* hy_w_out;
  const float* nsa_w_in; const float* nsa_qg; const float* nsa_kg; const float* cmp_pe; const float* cmp_w1; const float* cmp_w2; const float* nsa_w_out;
  const float* ffn_g; const float* ffn_u; const float* ffn_d;
  float* out;
  u16* wt_hy_in; u16* wt_hy_out; u16* wt_nsa_in; u16* wt_nsa_out; u16* wt_gu; u16* wt_dn; u16* wt_c1; u16* wt_c2;
  float* c1; float* lb; float* lse;
  u16* proj; u16* hbuf; u16* obr; u16* kcmp; u16* vcmp;
  unsigned* bar;
  int phase_lo; int phase_hi;
};

DI int tidx() { int t = __builtin_amdgcn_workitem_id_x(); asm volatile("" : "+v"(t)); return t; }
DI float bf2f(u16 h) { return __uint_as_float(((unsigned)h) << 16); }
typedef __bf16 bf16x2_t __attribute__((ext_vector_type(2)));
typedef float f32x2_t __attribute__((ext_vector_type(2)));
DI unsigned pack2(float a, float b) { f32x2_t v = {a, b}; bf16x2_t r = __builtin_convertvector(v, bf16x2_t); return __builtin_bit_cast(unsigned, r); }
DI u16 f2bf(float x) { return (u16)(pack2(x, 0.f) & 0xffffu); }
DI float fsigmoid(float x) { return 1.f / (1.f + __expf(-x)); }
DI float fsilu(float x) { return x / (1.f + __expf(-x)); }
DI float fexp2(float x) { return __builtin_amdgcn_exp2f(x); }
DI void unpack8(uint4 v, float (&f)[8]) {
  f[0] = __uint_as_float(v.x << 16); f[1] = __uint_as_float(v.x & 0xffff0000u);
  f[2] = __uint_as_float(v.y << 16); f[3] = __uint_as_float(v.y & 0xffff0000u);
  f[4] = __uint_as_float(v.z << 16); f[5] = __uint_as_float(v.z & 0xffff0000u);
  f[6] = __uint_as_float(v.w << 16); f[7] = __uint_as_float(v.w & 0xffff0000u);
}
DI uint4 pack8(const float (&f)[8]) {
  uint4 o; o.x = pack2(f[0], f[1]); o.y = pack2(f[2], f[3]); o.z = pack2(f[4], f[5]); o.w = pack2(f[6], f[7]); return o;
}
DI bf16x8 as_bf16x8(uint4 v) { u32x4v t; t[0] = v.x; t[1] = v.y; t[2] = v.z; t[3] = v.w; return __builtin_bit_cast(bf16x8, t); }
DI f32x16 zero16() { f32x16 z;
#pragma unroll
  for (int i = 0; i < 16; ++i) z[i] = 0.f; return z; }


#define XB_TMO      128
#define XB_XCNT(j)  (256  + 64 * (j))
#define XB_XSUB(j)  (1280 + 64 * (j))
#define XB_XGEN(j)  (2304 + 64 * (j))
#define XB_TOP      3328
#define XB_TOPGEN   3392
#define XCD_BAR_WORDS 3456
#define XB_SPIN_CAP (1u << 18)
DI unsigned xb_ld(unsigned* p) { return __hip_atomic_load(p, __ATOMIC_RELAXED, __HIP_MEMORY_SCOPE_AGENT); }
DI unsigned xb_add(unsigned* p, unsigned v) { return __hip_atomic_fetch_add(p, v, __ATOMIC_RELAXED, __HIP_MEMORY_SCOPE_AGENT); }
DI unsigned xb_xcc_id() { return (unsigned)__builtin_amdgcn_s_getreg((3 << 11) | 20) & 0xFu; }
#define XB_SPIN(cond, bar) do { unsigned _sp = 0; while (cond) { __builtin_amdgcn_s_sleep(1); \
    if ((++_sp & 255u) == 0u) { if (xb_ld(&(bar)[XB_TMO])) break; if (_sp > XB_SPIN_CAP) { atomicAdd(&(bar)[XB_TMO], 1u); break; } } } } while (0)
struct XcdBarrier { unsigned* bar; unsigned x; volatile LAS unsigned* st; };
DI XcdBarrier xcd_barrier_post(unsigned* bar, volatile LAS unsigned* st) {
  XcdBarrier b; b.bar = bar; b.x = xb_xcc_id(); b.st = st;
  if (__builtin_amdgcn_workitem_id_x() == 0) (void)xb_add(&bar[XB_XCNT(b.x)], 1u);
  return b;
}
DI void xcd_barrier_complete(unsigned* bar, unsigned x, unsigned& nloc, unsigned& nx) {
  const unsigned G = gridDim.x * gridDim.y * gridDim.z;
  unsigned sum, cnt, mine, sp = 0u;
  for (;;) {
    sum = 0u; cnt = 0u; mine = 0u;
#pragma unroll
    for (unsigned j = 0; j < 16; ++j) { const unsigned c = xb_ld(&bar[XB_XCNT(j)]); sum += c; cnt += (c > 0u) ? 1u : 0u; mine = (j == x) ? c : mine; }
    if (sum == G) break;
    __builtin_amdgcn_s_sleep(1);
    if ((++sp & 255u) == 0u) { if (xb_ld(&bar[XB_TMO])) break; if (sp > XB_SPIN_CAP) { atomicAdd(&bar[XB_TMO], 1u); break; } }
  }
  nloc = mine > 0u ? mine : 1u; nx = cnt > 0u ? cnt : 1u;
}
DI void xcd_barrier(const XcdBarrier& b) {
  asm volatile("s_waitcnt vmcnt(0)" ::: "memory");
  __syncthreads();
  if (__builtin_amdgcn_workitem_id_x() == 0) {
    unsigned* bar = b.bar;
    __builtin_amdgcn_s_waitcnt(0);
    unsigned nloc = b.st[0], nx = b.st[1];
    if (nloc == 0u) { xcd_barrier_complete(bar, b.x, nloc, nx); b.st[0] = nloc; b.st[1] = nx; }
    const unsigned old = xb_add(&bar[XB_XSUB(b.x)], 1u);
    const unsigned gen = old / nloc;
    if (old + 1u == (gen + 1u) * nloc) {
      __builtin_amdgcn_fence(__ATOMIC_RELEASE, "agent");
      asm volatile("s_waitcnt vmcnt(0)" ::: "memory");
      const unsigned og = xb_add(&bar[XB_TOP], 1u);
      const unsigned tg = og / nx;
      if (og + 1u == (tg + 1u) * nx) xb_add(&bar[XB_TOPGEN], 1u);
      else XB_SPIN(xb_ld(&bar[XB_TOPGEN]) == tg, bar);
      __builtin_amdgcn_fence(__ATOMIC_ACQUIRE, "agent");
      xb_add(&bar[XB_XGEN(b.x)], 1u);
      asm volatile("s_waitcnt vmcnt(0)" ::: "memory");
    } else {
      XB_SPIN(xb_ld(&bar[XB_XGEN(b.x)]) == gen, bar);
      __builtin_amdgcn_fence(__ATOMIC_ACQUIRE, "agent");
      asm volatile("s_waitcnt vmcnt(0)" ::: "memory");
    }
  }
  __syncthreads();
}

struct PrepDesc { const float* src; u16* dst; int K, N, mode, tk, tn; };
DI PrepDesc prep_desc(const Params& p, int tile) {
  constexpr int G0 = 1792, G1 = 2304, G2 = 3712, G3 = 4224, G4 = 7040, G5 = 9856, G6 = 12672, G7 = 12928;
  PrepDesc d; int Np, lt; d.mode = 0;
  if (tile < G0) { int i = tile / 896; lt = tile % 896; d.src = p.hy_w_in + (size_t)i * 1024 * 3584; d.dst = p.wt_hy_in + (size_t)i * 3584 * 1024; d.K = 1024; d.N = 3584; Np = 3584; }
  else if (tile < G1) { int t = tile - G0; int i = t / 256; lt = t % 256; d.src = p.hy_w_out + (size_t)i * 1048576; d.dst = p.wt_hy_out + (size_t)i * 1048576; d.K = 1024; d.N = 1024; Np = 1024; }
  else if (tile < G2) { int t = tile - G1; int i = t / 704; lt = t % 704; d.src = p.nsa_w_in + (size_t)i * 1024 * 2608; d.dst = p.wt_nsa_in + (size_t)i * 2816 * 1024; d.K = 1024; d.N = 2608; Np = 2816; }
  else if (tile < G3) { int t = tile - G2; int i = t / 256; lt = t % 256; d.src = p.nsa_w_out + (size_t)i * 1048576; d.dst = p.wt_nsa_out + (size_t)i * 1048576; d.K = 1024; d.N = 1024; Np = 1024; }
  else if (tile < G4) { int t = tile - G3; int i = t / 704; lt = t % 704; d.src = p.ffn_g + (size_t)i * 1024 * 2816; d.dst = p.wt_gu + (size_t)i * 5632 * 1024; d.K = 1024; d.N = 2816; Np = 2816; d.mode = 1; }
  else if (tile < G5) { int t = tile - G4; int i = t / 704; lt = t % 704; d.src = p.ffn_u + (size_t)i * 1024 * 2816; d.dst = p.wt_gu + (size_t)i * 5632 * 1024; d.K = 1024; d.N = 2816; Np = 2816; d.mode = 2; }
  else if (tile < G6) { int t = tile - G5; int i = t / 704; lt = t % 704; d.src = p.ffn_d + (size_t)i * 2816 * 1024; d.dst = p.wt_dn + (size_t)i * 1024 * 2816; d.K = 2816; d.N = 1024; Np = 1024; }
  else if (tile < G7) { int t = tile - G6; int i = t / 64; lt = t % 64; d.src = p.cmp_w1 + (size_t)i * 2048 * 128; d.dst = p.wt_c1 + (size_t)i * 128 * 2048; d.K = 2048; d.N = 128; Np = 128; }
  else { int t = tile - G7; int i = t / 2; lt = t % 2; d.src = p.cmp_w2 + (size_t)i * 128 * 64; d.dst = p.wt_c2 + (size_t)i * 64 * 128; d.K = 128; d.N = 64; Np = 64; }
  const int ntn = Np / 64;
  d.tk = lt / ntn; d.tn = lt % ntn;
  return d;
}
DI void prep_load(const PrepDesc& d, int tid, float (&rv)[8]) {
  const int c = tid & 63; const int n = d.tn * 64 + c; const int nc = n < d.N ? n : d.N - 1;
#pragma unroll
  for (int j = 0; j < 8; ++j) {
    const int r = (tid >> 6) + 8 * j;
    rv[j] = d.src[(size_t)(d.tk * 64 + r) * d.N + nc];
  }
}

DI void prep_phase(const Params& p, char* smem) {
  float* sm = (float*)smem;
  constexpr int G8 = 12936;
  const int tid = tidx();
  float rv[8];
  int tile = blockIdx.x;
  asm volatile("" : "+s"(tile));
  if (tile < G8) { const PrepDesc d0 = prep_desc(p, tile); prep_load(d0, tid, rv); }
  for (; tile < G8; tile += gridDim.x) {
    const PrepDesc d = prep_desc(p, tile);
    __syncthreads();
#pragma unroll
    for (int j = 0; j < 8; ++j) sm[((tid >> 6) + 8 * j) * 65 + (tid & 63)] = rv[j];
    __syncthreads();
    if (tile + (int)gridDim.x < G8) { const PrepDesc dn = prep_desc(p, tile + gridDim.x); prep_load(dn, tid, rv); }
    const int nl = tid >> 3, kp = tid & 7;
    const int n = d.tn * 64 + nl;
    int nd = n;
    if (d.mode == 1) nd = (n >> 4) * 32 + (n & 15);
    else if (d.mode == 2) nd = (n >> 4) * 32 + 16 + (n & 15);
    float v[8];
#pragma unroll
    for (int j = 0; j < 8; ++j) v[j] = sm[(kp * 8 + j) * 65 + nl];
    *(uint4*)(d.dst + (size_t)nd * d.K + d.tk * 64 + kp * 8) = pack8(v);
  }
  __syncthreads();
  if (blockIdx.x < 4) {
    const int mi = blockIdx.x;
    const float* pe = p.cmp_pe + (size_t)mi * 2048;
    const float* w1 = p.cmp_w1 + (size_t)mi * 2048 * 128;
    const int tq_ = tidx();
    const int o = tq_ & 127, half = tq_ >> 7;
    float a0 = 0.f, a1 = 0.f, a2 = 0.f, a3 = 0.f;
    for (int k = half * 512; k < half * 512 + 512; k += 4) {
      a0 += pe[k] * w1[(size_t)k * 128 + o]; a1 += pe[k + 1] * w1[(size_t)(k + 1) * 128 + o];
      a2 += pe[k + 2] * w1[(size_t)(k + 2) * 128 + o]; a3 += pe[k + 3] * w1[(size_t)(k + 3) * 128 + o];
    }
    sm[tq_] = (a0 + a1) + (a2 + a3);
    __syncthreads();
    if (tq_ < 128) p.c1[mi * 128 + tq_] = (sm[tq_] + sm[tq_ + 128]) + (sm[tq_ + 256] + sm[tq_ + 384]);
    __syncthreads();
  }
  if (blockIdx.x == 4 || (gridDim.x <= 4 && blockIdx.x == 0)) {
    for (int c = tidx(); c < 512; c += NT) {
      float l0 = p.hy_lb[c], l1 = p.hy_lb[512 + c];
      float mx = fmaxf(l0, l1); float e0 = __expf(l0 - mx), e1 = __expf(l1 - mx); float inv = 1.f / (e0 + e1);
      float p0 = e0 * inv, p1 = e1 * inv;
      p.lb[c] = p0 - p0; p.lb[512 + c] = (p0 + p1) - p0;
    }
  }
}

DI void rmsnorm_phase(const float* x, const float* __restrict__ g, u16* h) {
  const int t_ = tidx();
  const int wave = t_ >> 6, lane = t_ & 63;
  const int stride = gridDim.x * 8;
  int row = blockIdx.x * 8 + wave;
  float4 v[4], nv[4];
  float4 gg[4];
#pragma unroll
  for (int j = 0; j < 4; ++j) gg[j] = ((const float4*)g)[lane + 64 * j];
  if (row < T_) {
    const float4* xr = (const float4*)(x + (size_t)row * 1024);
#pragma unroll
    for (int j = 0; j < 4; ++j) v[j] = xr[lane + 64 * j];
  }
  while (row < T_) {
    const int nrow = row + stride;
    if (nrow < T_) {
      const float4* xr = (const float4*)(x + (size_t)nrow * 1024);
#pragma unroll
      for (int j = 0; j < 4; ++j) nv[j] = xr[lane + 64 * j];
    }
    float ss = 0.f;
#pragma unroll
    for (int j = 0; j < 4; ++j) ss += v[j].x * v[j].x + v[j].y * v[j].y + v[j].z * v[j].z + v[j].w * v[j].w;
#pragma unroll
    for (int off = 32; off >= 1; off >>= 1) ss += __shfl_xor(ss, off);
    const float rs = rsqrtf(ss * (1.f / 1024.f) + EPSF);
#pragma unroll
    for (int j = 0; j < 4; ++j) {
      uint2 o; o.x = pack2(v[j].x * rs * gg[j].x, v[j].y * rs * gg[j].y); o.y = pack2(v[j].z * rs * gg[j].z, v[j].w * rs * gg[j].w);
      *(uint2*)(h + (size_t)row * 1024 + (lane + 64 * j) * 4) = o;
    }
#pragma unroll
    for (int j = 0; j < 4; ++j) v[j] = nv[j];
    row = nrow;
  }
}

DI int lds_byte(int r, int c) { const int st = (r >> 4) * 2 + (c >> 5), rr = r & 15, cc = c & 31, ob = rr * 64 + cc * 2; return st * 1024 + (ob ^ (((ob >> 9) & 1) << 5)); }
DI void stage_rc(int b, int& R, int& C) { const int st = b / 1024, sb = b % 1024, swz = sb ^ (((sb >> 9) & 1) << 5); R = (st >> 1) * 16 + swz / 64; C = (st & 1) * 32 + (swz % 64) / 2; }

template <int EPI>
DI void gemm_phase(const u16* A, const u16* Bt, const int K, const int nN, u16* outb, const int ldc, const float* res, float* outf, char* smem, const bool rev = false) {
  constexpr int HTB = 16384;
  const int tid = tidx();
  const int wid = tid >> 6, lane = tid & 63, wr = wid >> 2, wc = wid & 3, fr = lane & 15, fq = lane >> 4;
  const int nM = 128, nwg = nM * nN, nt = K / 64;
  int sR0, sC0, sR1, sC1; stage_rc(tid * 16, sR0, sC0); stage_rc(tid * 16 + 8192, sR1, sC1);
  const unsigned vo0 = (unsigned)((sR0 * K + sC0) * 2), vo1 = (unsigned)((sR1 * K + sC1) * 2);
#define SA_(b, h) (smem + ((b) * 2 + (h)) * HTB)
#define SB_(b, h) (smem + (4 + (b) * 2 + (h)) * HTB)
#define STAGE(P, BASE, br, kt) do { const char* _g = (const char*)((BASE) + (size_t)(br) * K + (size_t)(kt) * 64); \
    unsigned _o0 = vo0, _o1 = vo1; asm volatile("" : "+v"(_o0), "+v"(_o1)); \
    __builtin_amdgcn_global_load_lds((const unsigned*)(_g + _o0), (LAS unsigned*)((P) + tid * 16), 16, 0, 0); \
    __builtin_amdgcn_global_load_lds((const unsigned*)(_g + _o1), (LAS unsigned*)((P) + tid * 16 + 8192), 16, 0, 0); } while (0)
  const int ob_ = fr * 64 + fq * 16, swz_ = ob_ ^ (((ob_ >> 9) & 1) << 5);
  const int aoff = wr * 8192 + swz_, boff = wc * 4096 + swz_;
#define LDA(dst, b, h) _Pragma("unroll") for (int m = 0; m < 4; ++m) _Pragma("unroll") for (int k = 0; k < 2; ++k) \
    dst[m][k] = *(const bf16x8*)(SA_(b, h) + aoff + m * 2048 + k * 1024)
#define LDB(dst, b, h) _Pragma("unroll") for (int n = 0; n < 2; ++n) _Pragma("unroll") for (int k = 0; k < 2; ++k) \
    dst[n][k] = *(const bf16x8*)(SB_(b, h) + boff + n * 2048 + k * 1024)
#define MMA(ai, bj, At_, Bx_) do { __builtin_amdgcn_s_setprio(1); \
    _Pragma("unroll") for (int m = 0; m < 4; ++m) _Pragma("unroll") for (int n = 0; n < 2; ++n) _Pragma("unroll") for (int k = 0; k < 2; ++k) \
      acc[ai][bj][m][n] = __builtin_amdgcn_mfma_f32_16x16x32_bf16(Bx_[n][k], At_[m][k], acc[ai][bj][m][n], 0, 0, 0); \
    __builtin_amdgcn_s_setprio(0); } while (0)
#define WAIT_V(n) asm volatile("s_waitcnt vmcnt(" #n ")" ::: "memory")
#define WAIT_L(n) asm volatile("s_waitcnt lgkmcnt(" #n ")" ::: "memory")
#define BAR __builtin_amdgcn_s_barrier()
#define SCHED __builtin_amdgcn_sched_barrier(0)
  auto tile_of = [&](long Lq, int& brow_, int& bcol_, int& pn_) {
    int wgid = (int)Lq;
    { const int q = nwg / 8, r = nwg % 8, xcd = wgid % 8, off = wgid / 8; wgid = (xcd < r ? xcd * (q + 1) : r * (q + 1) + (xcd - r) * q) + off; }
    const int nig = 8 * nN, gid = wgid / nig, fm = gid * 8, gsz = (nM - fm) < 8 ? (nM - fm) : 8;
    const int pm = fm + ((wgid % nig) % gsz);
    pn_ = (wgid % nig) / gsz; brow_ = (rev ? (nM - 1 - pm) : pm) * 256; bcol_ = pn_ * 256;
  };
#define STAGE7(br_, bc_) do { STAGE(SB_(0, 0), Bt, bc_, 0); STAGE(SA_(0, 0), A, br_, 0); STAGE(SB_(0, 1), Bt, (bc_) + 128, 0); STAGE(SA_(0, 1), A, (br_) + 128, 0); \
    STAGE(SB_(1, 0), Bt, bc_, 1); STAGE(SA_(1, 0), A, br_, 1); STAGE(SB_(1, 1), Bt, (bc_) + 128, 1); } while (0)
  long L = blockIdx.x;
  bool have = L < nwg;
  int brow = 0, bcol = 0, pn = 0;
  __syncthreads();
  if (have) { tile_of(L, brow, bcol, pn); STAGE7(brow, bcol); }
  while (have) {
    f32x4v acc[2][2][4][2];
#pragma unroll
    for (int a = 0; a < 2; ++a)
#pragma unroll
      for (int b = 0; b < 2; ++b)
#pragma unroll
        for (int m = 0; m < 4; ++m)
#pragma unroll
          for (int n = 0; n < 2; ++n) acc[a][b][m][n] = (f32x4v){0.f, 0.f, 0.f, 0.f};
    bf16x8 At[4][2], B0[2][2], B1[2][2];
    if (wr == 1) BAR;
    WAIT_V(0); BAR;
    BAR;
    for (int t = 0; t < nt - 2; t += 2) {
      LDB(B0, 0, 0); SCHED; LDA(At, 0, 0); STAGE(SA_(1, 1), A, brow + 128, t + 1);
      WAIT_L(8); BAR; WAIT_L(0); MMA(0, 0, At, B0); BAR; SCHED;
      LDB(B1, 0, 1); STAGE(SB_(0, 0), Bt, bcol, t + 2);
      BAR; WAIT_L(0); MMA(0, 1, At, B1); BAR;
      LDA(At, 0, 1); STAGE(SA_(0, 0), A, brow, t + 2);
      BAR; WAIT_L(0); MMA(1, 0, At, B0); BAR; SCHED;
      STAGE(SB_(0, 1), Bt, bcol + 128, t + 2);
      WAIT_V(6); BAR; MMA(1, 1, At, B1); BAR;
      LDB(B0, 1, 0); SCHED; LDA(At, 1, 0); STAGE(SA_(0, 1), A, brow + 128, t + 2);
      WAIT_L(8); BAR; WAIT_L(0); MMA(0, 0, At, B0); BAR; SCHED;
      LDB(B1, 1, 1); STAGE(SB_(1, 0), Bt, bcol, t + 3);
      BAR; WAIT_L(0); MMA(0, 1, At, B1); BAR;
      LDA(At, 1, 1); STAGE(SA_(1, 0), A, brow, t + 3);
      BAR; WAIT_L(0); MMA(1, 0, At, B0); BAR; SCHED;
      STAGE(SB_(1, 1), Bt, bcol + 128, t + 3);
      WAIT_V(6); BAR; MMA(1, 1, At, B1); BAR;
    }
    { LDB(B0, 0, 0); LDA(At, 0, 0); STAGE(SA_(1, 1), A, brow + 128, nt - 1);
      BAR; WAIT_L(0); MMA(0, 0, At, B0); BAR;
      LDB(B1, 0, 1); BAR; WAIT_L(0); MMA(0, 1, At, B1); BAR;
      LDA(At, 0, 1); WAIT_V(4); BAR; WAIT_L(0); MMA(1, 0, At, B0); MMA(1, 1, At, B1); BAR; }
    { LDB(B0, 1, 0); LDA(At, 1, 0); WAIT_V(2); BAR; WAIT_L(0); MMA(0, 0, At, B0); BAR;
      LDB(B1, 1, 1); WAIT_V(0); BAR; WAIT_L(0); MMA(0, 1, At, B1); BAR;
      LDA(At, 1, 1); BAR; WAIT_L(0); MMA(1, 0, At, B0); MMA(1, 1, At, B1); BAR; }
    if (wr == 0) BAR;
    const long Ln = L + gridDim.x;
    const bool haven = Ln < nwg;
    int browN = 0, bcolN = 0, pnN = 0;
    if (haven) { tile_of(Ln, browN, bcolN, pnN); STAGE7(browN, bcolN); }
    int tid2 = tid; asm volatile("" : "+v"(tid2));
    const int fr2 = tid2 & 15, fq2 = (tid2 >> 4) & 3, wc2 = (tid2 >> 6) & 3, wr2 = tid2 >> 8;
    if (EPI == 1) {
#pragma unroll
      for (int am = 0; am < 4; ++am) {
        const int ai = am >> 1, m0 = (am & 1) * 2;
        f32x4v rb[2][2][2];
        const float* rbase = res + (size_t)(brow + ai * 128 + wr2 * 64 + m0 * 16 + fr2) * 1024 + bcol + wc2 * 32 + fq2 * 4;
        float* obase = outf + (size_t)(brow + ai * 128 + wr2 * 64 + m0 * 16 + fr2) * 1024 + bcol + wc2 * 32 + fq2 * 4;
#pragma unroll
        for (int m = 0; m < 2; ++m)
#pragma unroll
          for (int bj = 0; bj < 2; ++bj)
#pragma unroll
            for (int n = 0; n < 2; ++n) rb[m][bj][n] = *(const f32x4v*)(rbase + (size_t)m * 16 * 1024 + bj * 128 + n * 16);
        asm volatile("" ::: "memory");
#pragma unroll
        for (int m = 0; m < 2; ++m)
#pragma unroll
          for (int bj = 0; bj < 2; ++bj)
#pragma unroll
            for (int n = 0; n < 2; ++n) *(f32x4v*)(obase + (size_t)m * 16 * 1024 + bj * 128 + n * 16) = rb[m][bj][n] + acc[ai][bj][m0 + m][n];
        asm volatile("" ::: "memory");
      }
    } else {
#pragma unroll
    for (int ai = 0; ai < 2; ++ai)
#pragma unroll
      for (int m = 0; m < 4; ++m) {
        const size_t row = (size_t)(brow + ai * 128 + wr2 * 64 + m * 16 + fr2);
#pragma unroll
        for (int bj = 0; bj < 2; ++bj) {
          const int cb = bcol + bj * 128 + wc2 * 32 + fq2 * 4;
          if (EPI == 0) {
#pragma unroll
            for (int n = 0; n < 2; ++n) {
              uint2 o; o.x = pack2(acc[ai][bj][m][n][0], acc[ai][bj][m][n][1]); o.y = pack2(acc[ai][bj][m][n][2], acc[ai][bj][m][n][3]);
              *(uint2*)(outb + row * ldc + cb + n * 16) = o;
            }
          } else {
            const f32x4v gv = acc[ai][bj][m][0], uv = acc[ai][bj][m][1];
            uint2 o; o.x = pack2(fsilu(gv[0]) * uv[0], fsilu(gv[1]) * uv[1]); o.y = pack2(fsilu(gv[2]) * uv[2], fsilu(gv[3]) * uv[3]);
            *(uint2*)(outb + row * DFF + ((bcol + bj * 128 + wc2 * 32) >> 1) + fq2 * 4) = o;
          }
        }
      }
    }
    L = Ln; have = haven; brow = browN; bcol = bcolN; pn = pnN;
  }
  __syncthreads();
#undef STAGE7
#undef SA_
#undef SB_
#undef STAGE
#undef LDA
#undef LDB
#undef MMA
}

#define MFMA16(a, b, c) __builtin_amdgcn_mfma_f32_16x16x32_bf16((a), (b), (c), 0, 0, 0)
DI void hgrn_item(const Params& p, int li, int item, char* smem) {
  const int tid = tidx(), lane = tid & 63, w = tid >> 6, fr = lane & 15, fq = lane >> 4;
  const int kk = w >> 1, vt = w & 1;
  const int vs = item & 3, h = (item >> 2) & 3, b = item >> 4;
  const int tg = tid & 3, kch = tid >> 2;
  const int sv = tid >> 5, vv = tid & 31;
  const float lbv = p.lb[li * 512 + h * 128 + kch];
  const u16* base = p.proj + (size_t)b * S_ * LD_EVEN;
  const u16* pq = base + (size_t)(4 * tg) * LD_EVEN + h * 128 + kch;
  const u16* pv = base + (size_t)sv * LD_EVEN + 1024 + h * 128 + vs * 32 + vv;
  struct HRegs { unsigned q0, q1, q2, q3, f0, f1, f2, f3, v; };
  auto hload = [&](int c, HRegs& r) {
    const u16* pq2 = pq + (size_t)c * 16 * LD_EVEN;
    r.q0 = pq2[0]; r.q1 = pq2[LD_EVEN]; r.q2 = pq2[2 * LD_EVEN]; r.q3 = pq2[3 * LD_EVEN];
    r.f0 = pq2[512]; r.f1 = pq2[LD_EVEN + 512]; r.f2 = pq2[2 * LD_EVEN + 512]; r.f3 = pq2[3 * LD_EVEN + 512];
    r.v = pv[(size_t)c * 16 * LD_EVEN];
  };
  HRegs ra, rb;
  hload(0, ra); hload(1, rb);
  f32x4v S0 = {0.f, 0.f, 0.f, 0.f}, S1 = {0.f, 0.f, 0.f, 0.f};
  const f32x4v z4 = {0.f, 0.f, 0.f, 0.f};
  __syncthreads();
  constexpr int HBUF = 16896;
  auto prep = [&](const HRegs& rr, int par) {
    u16* Qt_ = (u16*)(smem + par * HBUF); u16* Kt_ = Qt_ + 16 * 136; u16* Kh_ = Kt_ + 16 * 136; u16* Vt_ = Kh_ + 128 * 24; float* Pc_ = (float*)(Vt_ + 32 * 24);
    float qv[4], kv[4], cs[4];
    const unsigned rq[4] = {rr.q0, rr.q1, rr.q2, rr.q3}, rf[4] = {rr.f0, rr.f1, rr.f2, rr.f3};
    float cp = 1.f;
#pragma unroll
    for (int i = 0; i < 4; ++i) {
      const float f = lbv + (1.f - lbv) * fsigmoid(__uint_as_float(rf[i] << 16));
      cp *= f; cs[i] = cp; kv[i] = 1.f - f; qv[i] = fsilu(__uint_as_float(rq[i] << 16));
    }
    const int bl = lane & ~3;
    const float t0 = __shfl(cp, bl), t1 = __shfl(cp, bl + 1), t2 = __shfl(cp, bl + 2), t3 = __shfl(cp, bl + 3);
    const float pre = (tg > 0 ? t0 : 1.f) * (tg > 1 ? t1 : 1.f) * (tg > 2 ? t2 : 1.f);
    const float PC = (t0 * t1) * (t2 * t3);
    float kh[4];
#pragma unroll
    for (int i = 0; i < 4; ++i) {
      const float P = fmaxf(pre * cs[i], 1e-30f);
      const float rP = __builtin_amdgcn_rcpf(P);
      const int t = 4 * tg + i;
      Qt_[t * 136 + kch] = f2bf(qv[i] * P);
      const float kr = kv[i] * rP;
      Kt_[t * 136 + kch] = f2bf(kr);
      kh[i] = kr * PC;
    }
    uint2 k2; k2.x = pack2(kh[0], kh[1]); k2.y = pack2(kh[2], kh[3]);
    *(uint2*)(Kh_ + kch * 24 + 4 * tg) = k2;
    if (tg == 0) Pc_[kch] = PC;
    Vt_[vv * 24 + sv] = (u16)rr.v;
  };
  auto mfma = [&](int par) {
    const u16* Qt_ = (const u16*)(smem + par * HBUF); const u16* Kt_ = Qt_ + 16 * 136; const u16* Kh_ = Kt_ + 16 * 136; const u16* Vt_ = Kh_ + 128 * 24;
    const float* Pc_ = (const float*)(Vt_ + 32 * 24);
    float* Op_ = (float*)(smem + 4 * HBUF) + par * 2048;
    const uint2 v2 = *(const uint2*)(Vt_ + (16 * vt + fr) * 24 + 4 * fq);
    const bf16x8 vb = as_bf16x8(make_uint4(v2.x, v2.y, 0u, 0u));
    const u16* qrow = Qt_ + fr * 136 + 32 * kk + 4 * fq;
    const uint2 qa = *(const uint2*)qrow, qb = *(const uint2*)(qrow + 16);
    const bf16x8 qfrag = as_bf16x8(make_uint4(qa.x, qa.y, qb.x, qb.y));
    const bf16x8 sfrag = as_bf16x8(make_uint4(pack2(S0[0], S0[1]), pack2(S0[2], S0[3]), pack2(S1[0], S1[1]), pack2(S1[2], S1[3])));
    f32x4v acc = MFMA16(qfrag, sfrag, z4);
    if (kk == 0) {
      f32x4v sa = z4;
#pragma unroll
      for (int ks = 0; ks < 4; ++ks) {
        const bf16x8 kf = *(const bf16x8*)(Kt_ + fr * 136 + 32 * ks + 8 * fq);
        const bf16x8 qf2 = *(const bf16x8*)(Qt_ + fr * 136 + 32 * ks + 8 * fq);
        sa = MFMA16(kf, qf2, sa);
      }
#pragma unroll
      for (int j = 0; j < 4; ++j) sa[j] = (4 * fq + j <= fr) ? sa[j] : 0.f;
      const bf16x8 afrag = as_bf16x8(make_uint4(pack2(sa[0], sa[1]), pack2(sa[2], sa[3]), 0u, 0u));
      acc = MFMA16(afrag, vb, acc);
    }
#pragma unroll
    for (int j = 0; j < 4; ++j) Op_[(w * 16 + 4 * fq + j) * 16 + fr] = acc[j];
    const float* pc0 = Pc_ + 32 * kk + 4 * fq;
#pragma unroll
    for (int j = 0; j < 4; ++j) { S0[j] *= pc0[j]; S1[j] *= pc0[16 + j]; }
    const uint2 h0 = *(const uint2*)(Kh_ + (32 * kk + fr) * 24 + 4 * fq);
    const uint2 h1v = *(const uint2*)(Kh_ + (32 * kk + 16 + fr) * 24 + 4 * fq);
    S0 = MFMA16(as_bf16x8(make_uint4(h0.x, h0.y, 0u, 0u)), vb, S0);
    S1 = MFMA16(as_bf16x8(make_uint4(h1v.x, h1v.y, 0u, 0u)), vb, S1);
  };
  auto reduce = [&](int c, int par) {
    const float* Op_ = (const float*)(smem + 4 * HBUF) + par * 2048;
    const int t = tid >> 5, v = tid & 31, vtt = v >> 4, vl = v & 15;
    float o = 0.f;
#pragma unroll
    for (int q = 0; q < 4; ++q) o += Op_[((2 * q + vtt) * 16 + t) * 16 + vl];
    p.hbuf[(size_t)(b * S_ + c * 16 + t) * 1024 + h * 128 + vs * 32 + v] = f2bf(o);
  };
  prep(ra, 0); prep(rb, 1); hload(2, ra); hload(3, rb);
  __syncthreads();
#pragma unroll 1
  for (int P = 0; P < 64; P += 2) {
    mfma(0); mfma(1);
    prep(ra, 2); prep(rb, 3);
    if (P + 2 < 64) { hload(2 * P + 4, ra); hload(2 * P + 5, rb); }
    __syncthreads();
    reduce(2 * P, 0); reduce(2 * P + 1, 1);
    mfma(2); mfma(3);
    if (P + 2 < 64) { prep(ra, 0); prep(rb, 1); if (P + 3 < 64) { hload(2 * P + 6, ra); hload(2 * P + 7, rb); } }
    __syncthreads();
    reduce(2 * P + 2, 2); reduce(2 * P + 3, 3);
  }
  __syncthreads();
}

DI void load_q(const u16* qrow, const float* __restrict__ gain, int hh, bf16x8 (&qf)[4]) {
  float f[4][8]; float ss = 0.f;
#pragma unroll
  for (int kk = 0; kk < 4; ++kk) {
    uint4 raw = *(const uint4*)(qrow + kk * 16 + hh * 8);
    unpack8(raw, f[kk]);
#pragma unroll
    for (int j = 0; j < 8; ++j) ss += f[kk][j] * f[kk][j];
  }
  ss += __shfl_xor(ss, 32);
  const float rs = rsqrtf(ss * (1.f / 64.f) + EPSF) * (0.125f * LOG2E);
#pragma unroll
  for (int kk = 0; kk < 4; ++kk) {
#pragma unroll
    for (int j = 0; j < 8; ++j) f[kk][j] *= rs * gain[kk * 16 + hh * 8 + j];
    qf[kk] = as_bf16x8(pack8(f[kk]));
  }
}

constexpr int VS = 68;
constexpr int KVBUF = 18432;
template <int NTH> struct KVRegs { u32x4v r[NTH == 256 ? 4 : 2]; };
DI void kv_ld2(const u16* src, size_t stride, int ra, int rb, int rlo, int rhi, int dp, u32x4v& x0, u32x4v& x1) {
  const int ca = ra < rlo ? rlo : ra, cb = rb < rlo ? rlo : rb;
  x0 = *(const u32x4v*)(src + (size_t)ca * stride + dp * 8);
  x1 = *(const u32x4v*)(src + (size_t)cb * stride + dp * 8);
}
template <int NTH>
DI void kv_load(int tid, const u16* kb, const u16* vb, size_t stride, int r0, int rlo, int rhi, KVRegs<NTH>& rg) {
  const int dp = tid & 7, kq = (tid & 255) >> 3;
  if (NTH == 256) {
    kv_ld2(kb, stride, r0 + kq, r0 + kq + 32, rlo, rhi, dp, rg.r[0], rg.r[1]);
    kv_ld2(vb, stride, r0 + 2 * kq, r0 + 2 * kq + 1, rlo, rhi, dp, rg.r[2], rg.r[3]);
  } else {
    if (tid < 256) kv_ld2(kb, stride, r0 + kq, r0 + kq + 32, rlo, rhi, dp, rg.r[0], rg.r[1]);
    else kv_ld2(vb, stride, r0 + 2 * kq, r0 + 2 * kq + 1, rlo, rhi, dp, rg.r[0], rg.r[1]);
  }
}
DI void k_store1(u32x4v x, int key, int dp, const float* __restrict__ kgain, u16* Ks) {
  uint4 kv = make_uint4(x[0], x[1], x[2], x[3]);
  if (kgain) {
    float f[8]; unpack8(kv, f);
    float ss = 0.f;
#pragma unroll
    for (int e = 0; e < 8; ++e) ss += f[e] * f[e];
    ss += __shfl_xor(ss, 1); ss += __shfl_xor(ss, 2); ss += __shfl_xor(ss, 4);
    const float rs = rsqrtf(ss * (1.f / 64.f) + EPSF);
#pragma unroll
    for (int e = 0; e < 8; ++e) f[e] *= rs * kgain[dp * 8 + e];
    kv = pack8(f);
  }
  *(uint4*)(Ks + key * 72 + dp * 8) = kv;
}
DI void v_store2(u32x4v v0, u32x4v v1, int kp, int dp, u16* Vts) {
  unsigned* vd = (unsigned*)(Vts + (dp * 8) * VS + 2 * kp);
#pragma unroll
  for (int d = 0; d < 4; ++d) {
    vd[(2 * d) * (VS / 2)] = (v0[d] & 0xffffu) | (v1[d] << 16);
    vd[(2 * d + 1) * (VS / 2)] = (v0[d] >> 16) | (v1[d] & 0xffff0000u);
  }
}
template <int NTH>
DI void kv_store(int tid, const KVRegs<NTH>& rg, const float* __restrict__ kgain, u16* Ks, u16* Vts) {
  const int dp = tid & 7, kq = (tid & 255) >> 3;
  if (NTH == 256) {
    k_store1(rg.r[0], kq, dp, kgain, Ks); k_store1(rg.r[1], kq + 32, dp, kgain, Ks);
    v_store2(rg.r[2], rg.r[3], kq, dp, Vts);
  } else {
    if (tid < 256) { k_store1(rg.r[0], kq, dp, kgain, Ks); k_store1(rg.r[1], kq + 32, dp, kgain, Ks); }
    else v_store2(rg.r[0], rg.r[1], kq, dp, Vts);
  }
}

DI void score_stage(const bf16x8 (&qf)[4], const u16* Ks, int lane, float sk, float sb, int lower, int lim, f32x16 (&s)[2], float& mx) {
  const int lr = lane & 31, hh = lane >> 5;
#pragma unroll
  for (int sub = 0; sub < 2; ++sub) {
#pragma unroll
    for (int i = 0; i < 16; ++i) s[sub][i] = fmaf(sk, (float)(sub * 32 + (i & 3) + 8 * (i >> 2)), sb);
#pragma unroll
    for (int kk = 0; kk < 4; ++kk) {
      bf16x8 kf = *(const bf16x8*)(Ks + (sub * 32 + lr) * 72 + kk * 16 + hh * 8);
      s[sub] = MFMA32(kf, qf[kk], s[sub]);
    }
  }
  if (lim < lower) { lower = 64; lim = 64; }
  const bool full = (lower <= 0) && (lim >= 63);
  if (!__all(full)) {
    const int lo2 = lower - 4 * hh; const unsigned rng = (unsigned)(lim - lower);
#pragma unroll
    for (int sub = 0; sub < 2; ++sub)
#pragma unroll
      for (int i = 0; i < 16; ++i) {
        const int kc = sub * 32 + (i & 3) + 8 * (i >> 2);
        s[sub][i] = ((unsigned)(kc - lo2) <= rng) ? s[sub][i] : -INFINITY;
      }
  }
  mx = -INFINITY;
#pragma unroll
  for (int sub = 0; sub < 2; ++sub)
#pragma unroll
    for (int i = 0; i < 16; ++i) mx = fmaxf(mx, s[sub][i]);
  mx = fmaxf(mx, __shfl_xor(mx, 32));
}

DI void pv_stage(const f32x16 (&s)[2], const u16* Vts, f32x16 (&o)[2], int lane) {
  const int lr = lane & 31, hh = lane >> 5;
#pragma unroll
  for (int sub = 0; sub < 2; ++sub)
#pragma unroll
    for (int st = 0; st < 2; ++st) {
      uint4 pk;
      pk.x = pack2(s[sub][8 * st + 0], s[sub][8 * st + 1]); pk.y = pack2(s[sub][8 * st + 2], s[sub][8 * st + 3]);
      pk.z = pack2(s[sub][8 * st + 4], s[sub][8 * st + 5]); pk.w = pack2(s[sub][8 * st + 6], s[sub][8 * st + 7]);
      const bf16x8 pf = as_bf16x8(pk);
#pragma unroll
      for (int dt = 0; dt < 2; ++dt) {
        const u16* vp = Vts + (dt * 32 + lr) * VS + sub * 32 + 16 * st + 4 * hh;
        const uint2 lo = *(const uint2*)vp, hi = *(const uint2*)(vp + 8);
        const bf16x8 vf = as_bf16x8(make_uint4(lo.x, lo.y, hi.x, hi.y));
        o[dt] = MFMA32(vf, pf, o[dt]);
      }
    }
}

DI void flash_stage(const bf16x8 (&qf)[4], const u16* Ks, const u16* Vts, f32x16 (&o)[2], float& m, float& l, int lane,
                    float sk, float sb, int lower, int lim) {
  f32x16 s[2]; float mx;
  score_stage(qf, Ks, lane, sk, sb, lower, lim, s, mx);
  const float mn = fmaxf(m, mx);
  const float alpha = fexp2(m - mn);
  const bool same = (mn == m);
  m = mn;
  float ls = 0.f;
#pragma unroll
  for (int sub = 0; sub < 2; ++sub)
#pragma unroll
    for (int i = 0; i < 16; ++i) { const float pv = fexp2(s[sub][i] - mn); s[sub][i] = pv; ls += pv; }
  l = l * alpha + ls;
  if (!__all(same)) {
#pragma unroll
    for (int dt = 0; dt < 2; ++dt)
#pragma unroll
      for (int i = 0; i < 16; ++i) o[dt][i] *= alpha;
  }
  pv_stage(s, Vts, o, lane);
}

DI void dilated_item(const Params& p, int li, int pairitem, char* smem) {
  const int tfull = tidx();
  const int half = tfull >> 8, tid = tfull & 255;
  const int item = pairitem * 2 + half;
  char* kvb = smem + half * (2 * KVBUF);
  const int lane = tid & 63, w = tid >> 6, lr = lane & 31, hh = lane >> 5;
  const int idx16 = item & 15; const int br = (item >> 4) % 3; const int hb = (item / 48) & 7; const int b = item / 384;
  const int d = br == 0 ? 1 : (br == 1 ? 4 : 16);
  const int tile = idx16 / d, resid = idx16 % d;
  const int st0 = (d >= 2 && tile == 0) ? 2 : 0;
  const int u0 = tile * 128;
  const int uq = u0 + 32 * w + lr; const int tq = uq * d + resid;
  const u16* prow = p.proj + (size_t)(b * S_ + tq) * LD_EVEN;
  bf16x8 qf[4];
  load_q(prow + 2048 + hb * 64, p.hy_qg + li * 64, hh, qf);
  const float slope2 = fexp2(-(float)(hb + 1)) * LOG2E;
  const float sk = slope2 * (float)d;
  const u16* kb = p.proj + (size_t)(b * S_ + resid) * LD_EVEN + 2560 + hb * 64;
  const u16* vb = kb + 512;
  const size_t stride = (size_t)d * LD_EVEN;
  const float* kg = p.hy_kg + li * 64;
  f32x16 o[2]; o[0] = zero16(); o[1] = zero16();
  float m = -1e30f, l = 0.f;
  const int uw = u0 + 32 * w;
  KVRegs<256> rg;
  kv_load<256>(tid, kb, vb, stride, u0 - 128 + 64 * st0, 0, 1 << 30, rg);
  __syncthreads();
  kv_store<256>(tid, rg, kg, (u16*)(kvb + (st0 & 1) * KVBUF), (u16*)(kvb + (st0 & 1) * KVBUF) + 64 * 72);
  kv_load<256>(tid, kb, vb, stride, u0 - 64 + 64 * st0, 0, 1 << 30, rg);
  __syncthreads();
#pragma unroll 1
  for (int st = st0; st < 4; ++st) {
    const int ub = u0 - 128 + 64 * st;
    u16* Ks = (u16*)(kvb + (st & 1) * KVBUF); u16* Vts = Ks + 64 * 72;
    if (st + 1 < 4) { u16* Kn = (u16*)(kvb + ((st + 1) & 1) * KVBUF); kv_store<256>(tid, rg, kg, Kn, Kn + 64 * 72); }
    if (st + 2 < 4) kv_load<256>(tid, kb, vb, stride, ub + 128, 0, 1 << 30, rg);
    if (ub + 63 >= 0 && ub <= uw + 31 && ub + 63 >= uw - 128) {
      const int lim = uq - ub;
      const int lower = max(lim - 128, -ub);
      const float sb = slope2 * (float)(ub * d + resid) + sk * (float)(4 * hh);
      flash_stage(qf, Ks, Vts, o, m, l, lane, sk, sb, lower, lim);
    }
    __syncthreads();
  }
  const float lt = l + __shfl_xor(l, 32);
  const float inv = 1.f / lt;
  const size_t trow = (size_t)br * T_ + (size_t)b * S_ + tq;
  if (hh == 0) p.lse[trow * 8 + hb] = (m + log2f(lt)) * LN2;
  u16* orow = p.obr + trow * 512 + hb * 64;
#pragma unroll
  for (int dt = 0; dt < 2; ++dt)
#pragma unroll
    for (int q4 = 0; q4 < 4; ++q4) {
      uint2 ov; ov.x = pack2(o[dt][4 * q4] * inv, o[dt][4 * q4 + 1] * inv); ov.y = pack2(o[dt][4 * q4 + 2] * inv, o[dt][4 * q4 + 3] * inv);
      *(uint2*)(orow + dt * 32 + 8 * q4 + 4 * hh) = ov;
    }
}

DI void post_even_phase(const Params& p, int li) {
  const int tid = tidx();
  const int rsel = tid >> 7, c8 = tid & 127;
  const int c = c8 * 8;
  const int nit = T_ / 4, step = gridDim.x;
  int it = blockIdx.x;
  if (c8 < 64) {
    float og[8];
#pragma unroll
    for (int j = 0; j < 8; ++j) og[j] = p.hy_og[li * 512 + c + j];
    u32x4v raw = {0u, 0u, 0u, 0u}, graw = {0u, 0u, 0u, 0u}, nraw = raw, ngraw = raw;
    if (it < nit) { const int t = it * 4 + rsel; raw = *(const u32x4v*)(p.hbuf + (size_t)t * 1024 + c); graw = *(const u32x4v*)(p.proj + (size_t)t * LD_EVEN + 1536 + c); }
    while (it < nit) {
      const int t = it * 4 + rsel, itn = it + step;
      if (itn < nit) { const int tn = itn * 4 + rsel; nraw = *(const u32x4v*)(p.hbuf + (size_t)tn * 1024 + c); ngraw = *(const u32x4v*)(p.proj + (size_t)tn * LD_EVEN + 1536 + c); }
      float o[8], gt[8], val[8];
      unpack8(make_uint4(raw[0], raw[1], raw[2], raw[3]), o); unpack8(make_uint4(graw[0], graw[1], graw[2], graw[3]), gt);
      float ss = 0.f;
#pragma unroll
      for (int j = 0; j < 8; ++j) ss += o[j] * o[j];
      ss += __shfl_xor(ss, 1); ss += __shfl_xor(ss, 2); ss += __shfl_xor(ss, 4); ss += __shfl_xor(ss, 8);
      const float rs = rsqrtf(ss * (1.f / 128.f) + EPSF);
#pragma unroll
      for (int j = 0; j < 8; ++j) val[j] = o[j] * rs * og[j] * fsilu(gt[j]);
      *(uint4*)(p.hbuf + (size_t)t * 1024 + c) = pack8(val);
      raw = nraw; graw = ngraw; it = itn;
    }
  } else {
    const int cb = c - 512, hb = cb >> 6;
    float l0 = 0.f, l1 = 0.f, l2 = 0.f, nl0 = 0.f, nl1 = 0.f, nl2 = 0.f;
    u32x4v a4 = {0u, 0u, 0u, 0u}, b4 = a4, c4 = a4, na4 = a4, nb4 = a4, nc4 = a4;
    if (it < nit) {
      const size_t t = (size_t)(it * 4 + rsel);
      l0 = p.lse[(t) * 8 + hb]; l1 = p.lse[((size_t)T_ + t) * 8 + hb]; l2 = p.lse[((size_t)2 * T_ + t) * 8 + hb];
      a4 = *(const u32x4v*)(p.obr + t * 512 + cb); b4 = *(const u32x4v*)(p.obr + ((size_t)T_ + t) * 512 + cb); c4 = *(const u32x4v*)(p.obr + ((size_t)2 * T_ + t) * 512 + cb);
    }
    while (it < nit) {
      const int t = it * 4 + rsel, itn = it + step;
      if (itn < nit) {
        const size_t tn = (size_t)(itn * 4 + rsel);
        nl0 = p.lse[(tn) * 8 + hb]; nl1 = p.lse[((size_t)T_ + tn) * 8 + hb]; nl2 = p.lse[((size_t)2 * T_ + tn) * 8 + hb];
        na4 = *(const u32x4v*)(p.obr + tn * 512 + cb); nb4 = *(const u32x4v*)(p.obr + ((size_t)T_ + tn) * 512 + cb); nc4 = *(const u32x4v*)(p.obr + ((size_t)2 * T_ + tn) * 512 + cb);
      }
      const float mx = fmaxf(l0, fmaxf(l1, l2));
      float w0 = __expf(l0 - mx), w1 = __expf(l1 - mx), w2 = __expf(l2 - mx);
      const float inv = 1.f / (w0 + w1 + w2);
      w0 *= inv; w1 *= inv; w2 *= inv;
      float a[8], bq[8], cq[8], val[8];
      unpack8(make_uint4(a4[0], a4[1], a4[2], a4[3]), a); unpack8(make_uint4(b4[0], b4[1], b4[2], b4[3]), bq); unpack8(make_uint4(c4[0], c4[1], c4[2], c4[3]), cq);
#pragma unroll
      for (int j = 0; j < 8; ++j) val[j] = w0 * a[j] + w1 * bq[j] + w2 * cq[j];
      *(uint4*)(p.hbuf + (size_t)t * 1024 + c) = pack8(val);
      l0 = nl0; l1 = nl1; l2 = nl2; a4 = na4; b4 = nb4; c4 = nc4; it = itn;
    }
  }
}

DI void compress_item(const Params& p, int li, int pairitem, char* smem) {
  const int tfull = tidx();
  const int half = tfull >> 8, tid = tfull & 255;
  const int item = pairitem * 2 + half;
  u16* hs = (u16*)(smem + half * 17408);
  float* outs = (float*)(smem + half * 17408 + 32 * 136 * 2);
  const int lane = tid & 63, w = tid >> 6, lr = lane & 31, hh = lane >> 5;
  const int nt = item & 3, g = (item >> 2) & 3, b = (item >> 4) & 15, kv = item >> 8;
  const int n = nt * 32 + lr; const int nc = n > 126 ? 126 : n;
  const int col = 1024 + kv * 256 + g * 64;
  const u16* arow = p.proj + (size_t)(b * S_ + 16 * nc) * LD_ODD + col;
  const u16* w1t = p.wt_c1 + (size_t)(li * 2 + kv) * 128 * 2048 + (size_t)(32 * w + lr) * 2048;
  f32x16 acc = zero16();
#pragma unroll 1
  for (int k0 = 0; k0 < 128; k0 += 8) {
    u32x4v fa[8], fb[8];
#pragma unroll
    for (int j = 0; j < 8; ++j) {
      const int ks = k0 + j;
      const int lidx = ks >> 2, dd = (ks & 3) * 16 + hh * 8;
      fa[j] = *(const u32x4v*)(arow + (size_t)lidx * LD_ODD + dd);
      fb[j] = *(const u32x4v*)(w1t + ks * 16 + hh * 8);
    }
    asm volatile("" ::: "memory");
#pragma unroll
    for (int j = 0; j < 8; ++j) acc = MFMA32(__builtin_bit_cast(bf16x8, fa[j]), __builtin_bit_cast(bf16x8, fb[j]), acc);
  }
  const float cb = p.c1[(li * 2 + kv) * 128 + 32 * w + lr];
  __syncthreads();
#pragma unroll
  for (int i = 0; i < 16; ++i) {
    const int r = (i & 3) + 8 * (i >> 2) + 4 * hh;
    hs[r * 136 + 32 * w + lr] = f2bf(fsilu(acc[i] + cb));
  }
  __syncthreads();
  if (w < 2) {
    const u16* w2t = p.wt_c2 + (size_t)(li * 2 + kv) * 64 * 128 + (size_t)(w * 32 + lr) * 128;
    f32x16 a2 = zero16();
    u32x4v fb2[8];
#pragma unroll
    for (int kk = 0; kk < 8; ++kk) fb2[kk] = *(const u32x4v*)(w2t + kk * 16 + hh * 8);
    asm volatile("" ::: "memory");
#pragma unroll
    for (int kk = 0; kk < 8; ++kk) {
      const bf16x8 a = *(const bf16x8*)(hs + lr * 136 + kk * 16 + hh * 8);
      a2 = MFMA32(a, __builtin_bit_cast(bf16x8, fb2[kk]), a2);
    }
#pragma unroll
    for (int i = 0; i < 16; ++i) {
      const int r = (i & 3) + 8 * (i >> 2) + 4 * hh;
      outs[r * 65 + w * 32 + lr] = a2[i];
    }
  }
  __syncthreads();
  {
    const int r = tid >> 3, c8 = tid & 7;
    float v[8]; float ss = 0.f;
#pragma unroll
    for (int j = 0; j < 8; ++j) { v[j] = outs[r * 65 + c8 * 8 + j]; ss += v[j] * v[j]; }
    ss += __shfl_xor(ss, 1); ss += __shfl_xor(ss, 2); ss += __shfl_xor(ss, 4);
    if (kv == 0) {
      const float rs = rsqrtf(ss * (1.f / 64.f) + EPSF);
#pragma unroll
      for (int j = 0; j < 8; ++j) v[j] *= rs * p.nsa_kg[(li * 3 + 0) * 64 + c8 * 8 + j];
    }
    const int nn = nt * 32 + r;
    if (nn >= 127) {
#pragma unroll
      for (int j = 0; j < 8; ++j) v[j] = 0.f;
    }
    u16* dst = (kv == 0 ? p.kcmp : p.vcmp) + ((size_t)(b * 4 + g) * 128 + nn) * 64 + c8 * 8;
    *(uint4*)dst = pack8(v);
  }
  __syncthreads();
}

DI void nsa_knorm_phase(const Params& p, int li) {
  const int tid = tidx();
  for (int u0 = blockIdx.x * NT + tid; u0 < T_ * 64; u0 += gridDim.x * NT * 4) {
    u32x4v raw[4];
#pragma unroll
    for (int q = 0; q < 4; ++q) {
      const int u = u0 + q * gridDim.x * NT;
      const int piece = u & 7, head = (u >> 3) & 3, br = (u >> 5) & 1, row = u >> 6;
      raw[q] = *(const u32x4v*)(p.proj + (size_t)row * LD_ODD + 1536 + br * 512 + head * 64 + piece * 8);
    }
    asm volatile("" ::: "memory");
#pragma unroll
    for (int q = 0; q < 4; ++q) {
      const int u = u0 + q * gridDim.x * NT;
      const int piece = u & 7, head = (u >> 3) & 3, br = (u >> 5) & 1, row = u >> 6;
      float f[8]; unpack8(make_uint4(raw[q][0], raw[q][1], raw[q][2], raw[q][3]), f);
      float ss = 0.f;
#pragma unroll
      for (int e = 0; e < 8; ++e) ss += f[e] * f[e];
      ss += __shfl_xor(ss, 1); ss += __shfl_xor(ss, 2); ss += __shfl_xor(ss, 4);
      const float rs = rsqrtf(ss * (1.f / 64.f) + EPSF);
      const float* kg = p.nsa_kg + (li * 3 + 1 + br) * 64 + piece * 8;
#pragma unroll
      for (int e = 0; e < 8; ++e) f[e] *= rs * kg[e];
      *(uint4*)(p.proj + (size_t)row * LD_ODD + 1536 + br * 512 + head * 64 + piece * 8) = pack8(f);
    }
  }
}

DI void nsa_item(const Params& p, int li, int item, char* smem) {
  float* impA = (float*)(smem + 2 * KVBUF);
  float* impB = impA + 8448;
  float* imp = impB + 8448;
  unsigned* selm = (unsigned*)(imp + 64 * 33);
  const int tid = tidx(), lane = tid & 63, wv = tid >> 6, lr = lane & 31, hh = lane >> 5;
  const int w = lr & 3;
  const int tt = item & 31, g = (item >> 5) & 3, b = item >> 7;
  const int t0 = tt * 64; const int cur = t0 >> 6;
  const int hd = g * 4 + w;
  const int tokl = 8 * wv + (lr >> 2);
  const int tq = t0 + tokl;
  const u16* pb = p.proj + (size_t)b * S_ * LD_ODD;
  const u16* prow = pb + (size_t)tq * LD_ODD;
  bf16x8 qf[4];
  load_q(prow + g * 256 + w * 64, p.nsa_qg + li * 64, hh, qf);
  const float slope2 = fexp2(-0.5f * (float)(hd + 1)) * LOG2E;
  const float g0 = fsigmoid(bf2f(prow[2560 + 0 + g * 4 + w]));
  const float g1 = fsigmoid(bf2f(prow[2560 + 16 + g * 4 + w]));
  const float g2 = fsigmoid(bf2f(prow[2560 + 32 + g * 4 + w]));
  f32x16 ot[2]; ot[0] = zero16(); ot[1] = zero16();
  {
    const u16* kb = p.kcmp + (size_t)(b * 4 + g) * 128 * 64;
    const u16* vb = p.vcmp + (size_t)(b * 4 + g) * 128 * 64;
    const float sk = 16.f * slope2;
    const int limc = min((tq - 31) >> 4, 126);
    const int nst = (1024 > t0) ? 1 : 2;
    {
      KVRegs<512> rg0;
      kv_load<512>(tid, kb, vb, 64, 0, 0, 128, rg0);
      __syncthreads();
      kv_store<512>(tid, rg0, nullptr, (u16*)smem, (u16*)smem + 64 * 72);
      if (nst > 1) {
        kv_load<512>(tid, kb, vb, 64, 64, 0, 128, rg0);
        kv_store<512>(tid, rg0, nullptr, (u16*)(smem + KVBUF), (u16*)(smem + KVBUF) + 64 * 72);
      }
    }
    __syncthreads();
    float m = -1e30f, l = 0.f;
#pragma unroll
    for (int st = 0; st < 2; ++st) {
      if (st >= nst) continue;
      const u16* Ks = (const u16*)(smem + st * KVBUF);
      f32x16 s[2]; float mx;
      const float sb = slope2 * (float)(1024 * st + 31) + sk * (float)(4 * hh);
      score_stage(qf, Ks, lane, sk, sb, 0, limc - 64 * st, s, mx);
      const float mn = fmaxf(m, mx);
      float ls = 0.f;
#pragma unroll
      for (int sub = 0; sub < 2; ++sub)
#pragma unroll
        for (int i = 0; i < 16; ++i) ls += fexp2(s[sub][i] - mn);
      l = l * fexp2(m - mn) + ls;
      m = mn;
    }
    const float lt = l + __shfl_xor(l, 32);
    const float inv = lt > 0.f ? 1.f / lt : 0.f;
    f32x16 o[2]; o[0] = zero16(); o[1] = zero16();
#pragma unroll
    for (int st = 0; st < 2; ++st) {
      if (st >= nst) {
#pragma unroll
        for (int G = 0; G < 16; ++G) {
          if ((G & 1) == hh) { impA[(w * 64 + tokl) * 33 + 16 * st + G] = 0.f; impB[(w * 64 + tokl) * 33 + 16 * st + G] = 0.f; }
        }
        continue;
      }
      const u16* Ks = (const u16*)(smem + st * KVBUF); const u16* Vts = Ks + 64 * 72;
      f32x16 s[2]; float mx;
      const float sb = slope2 * (float)(1024 * st + 31) + sk * (float)(4 * hh);
      score_stage(qf, Ks, lane, sk, sb, 0, limc - 64 * st, s, mx);
#pragma unroll
      for (int sub = 0; sub < 2; ++sub)
#pragma unroll
        for (int i = 0; i < 16; ++i) s[sub][i] = fexp2(s[sub][i] - m) * inv;
#pragma unroll
      for (int sub = 0; sub < 2; ++sub)
#pragma unroll
        for (int q4 = 0; q4 < 4; ++q4) {
          const int G = 16 * st + 8 * sub + 2 * q4 + hh;
          impA[(w * 64 + tokl) * 33 + G] = (s[sub][4 * q4] + s[sub][4 * q4 + 1]) + (s[sub][4 * q4 + 2] + s[sub][4 * q4 + 3]);
          impB[(w * 64 + tokl) * 33 + G] = s[sub][4 * q4 + 3];
        }
      pv_stage(s, Vts, o, lane);
    }
#pragma unroll
    for (int dt = 0; dt < 2; ++dt)
#pragma unroll
      for (int i = 0; i < 16; ++i) ot[dt][i] += g0 * o[dt][i];
  }
  const u16* kbs = pb + 1536 + g * 64; const u16* vbs = pb + 1792 + g * 64;
  KVRegs<512> rg;
  kv_load<512>(tid, kbs, vbs, LD_ODD, 0, 0, S_, rg);
  __syncthreads();
  for (int idx = tid; idx < 2048; idx += NT) {
    const int tok = idx >> 5, mm = idx & 31;
    float a = 0.f;
#pragma unroll
    for (int ww = 0; ww < 4; ++ww) a += impA[(ww * 64 + tok) * 33 + mm] + (mm > 0 ? impB[(ww * 64 + tok) * 33 + mm - 1] : 0.f);
    imp[tok * 33 + mm] = a;
  }
  __syncthreads();
  float* ots = impA + tid;
#pragma unroll
  for (int dt = 0; dt < 2; ++dt)
#pragma unroll
    for (int i = 0; i < 16; ++i) ots[(dt * 16 + i) * NT] = ot[dt][i];
  {
    const int tok = tid >> 3, sub8 = tid & 7;
    unsigned sel = 1u | (1u << cur) | (cur > 0 ? (1u << (cur - 1)) : 0u);
    const int cnt = __popc(sel);
    float cv[4];
#pragma unroll
    for (int e = 0; e < 4; ++e) cv[e] = imp[tok * 33 + sub8 * 4 + e];
    for (int r = cnt; r < 8; ++r) {
      float bv = -1.f; int bi = 64;
#pragma unroll
      for (int e = 0; e < 4; ++e) {
        const int mm = sub8 * 4 + e;
        const bool ok = (mm <= cur) && !((sel >> mm) & 1u);
        if (ok && cv[e] > bv) { bv = cv[e]; bi = mm; }
      }
#pragma unroll
      for (int off = 1; off < 8; off <<= 1) {
        const float ov = __shfl_xor(bv, off); const int oi = __shfl_xor(bi, off);
        if (ov > bv || (ov == bv && oi < bi)) { bv = ov; bi = oi; }
      }
      if (bi < 64) sel |= 1u << bi;
    }
    if (sub8 == 0) selm[tok] = sel;
  }
  __syncthreads();
  const unsigned myMask = selm[tokl];
  unsigned uni = 0u;
#pragma unroll 8
  for (int i = 0; i < 64; ++i) uni |= selm[i];
  {
    f32x16 o[2]; o[0] = zero16(); o[1] = zero16();
    float m = -1e30f, l = 0.f;
    const float* kg = nullptr;
    unsigned rem = uni & (uni - 1u);
    int mb = 0;
    int mbn = rem ? __builtin_ctz(rem) : -1;
    kv_store<512>(tid, rg, kg, (u16*)smem, (u16*)smem + 64 * 72);
    if (mbn >= 0) kv_load<512>(tid, kbs, vbs, LD_ODD, 64 * mbn, 0, S_, rg);
    __syncthreads();
    int par = 0;
#pragma unroll 1
    while (true) {
      u16* Ks = (u16*)(smem + par * KVBUF); u16* Vts = Ks + 64 * 72;
      int mbn2 = -1;
      if (mbn >= 0) {
        u16* Kn = (u16*)(smem + (par ^ 1) * KVBUF);
        kv_store<512>(tid, rg, kg, Kn, Kn + 64 * 72);
        rem &= rem - 1u;
        mbn2 = rem ? __builtin_ctz(rem) : -1;
        if (mbn2 >= 0) kv_load<512>(tid, kbs, vbs, LD_ODD, 64 * mbn2, 0, S_, rg);
      }
      const bool selb = (myMask >> mb) & 1u;
      const float sb = slope2 * (float)(64 * mb) + slope2 * (float)(4 * hh);
      if (__any(selb)) flash_stage(qf, Ks, Vts, o, m, l, lane, slope2, sb, 0, selb ? (tq - 64 * mb) : -1);
      __syncthreads();
      if (mbn < 0) break;
      mb = mbn; mbn = mbn2; par ^= 1;
    }
    const float lt = l + __shfl_xor(l, 32);
    const float sc = g1 / lt;
#pragma unroll
    for (int dt = 0; dt < 2; ++dt)
#pragma unroll
      for (int i = 0; i < 16; ++i) ots[(dt * 16 + i) * NT] += sc * o[dt][i];
  }
  {
    f32x16 o[2]; o[0] = zero16(); o[1] = zero16();
    float m = -1e30f, l = 0.f;
    const u16* kb = pb + 2048 + g * 64; const u16* vb = pb + 2304 + g * 64;
    const float* kg = nullptr;
    const int mlo = (t0 - 511) < 0 ? 0 : ((t0 - 511) >> 6);
    kv_load<512>(tid, kb, vb, LD_ODD, 64 * mlo, 0, S_, rg);
    kv_store<512>(tid, rg, kg, (u16*)smem, (u16*)smem + 64 * 72);
    if (mlo + 1 <= cur) kv_load<512>(tid, kb, vb, LD_ODD, 64 * (mlo + 1), 0, S_, rg);
    __syncthreads();
#pragma unroll 1
    for (int mb = mlo; mb <= cur; ++mb) {
      const int par = (mb - mlo) & 1;
      u16* Ks = (u16*)(smem + par * KVBUF); u16* Vts = Ks + 64 * 72;
      if (mb + 1 <= cur) { u16* Kn = (u16*)(smem + (par ^ 1) * KVBUF); kv_store<512>(tid, rg, kg, Kn, Kn + 64 * 72); }
      if (mb + 2 <= cur) kv_load<512>(tid, kb, vb, LD_ODD, 64 * (mb + 2), 0, S_, rg);
      const int lim = tq - 64 * mb;
      const float sb = slope2 * (float)(64 * mb) + slope2 * (float)(4 * hh);
      flash_stage(qf, Ks, Vts, o, m, l, lane, slope2, sb, lim - 511, lim);
      __syncthreads();
    }
    const float lt = l + __shfl_xor(l, 32);
    const float sc = g2 / lt;
    u16* orow = p.hbuf + (size_t)(b * S_ + tq) * 1024 + g * 256 + w * 64;
#pragma unroll
    for (int dt = 0; dt < 2; ++dt)
#pragma unroll
      for (int q4 = 0; q4 < 4; ++q4) {
        const float a0 = ots[(dt * 16 + 4 * q4 + 0) * NT] + sc * o[dt][4 * q4 + 0], a1 = ots[(dt * 16 + 4 * q4 + 1) * NT] + sc * o[dt][4 * q4 + 1];
        const float a2 = ots[(dt * 16 + 4 * q4 + 2) * NT] + sc * o[dt][4 * q4 + 2], a3 = ots[(dt * 16 + 4 * q4 + 3) * NT] + sc * o[dt][4 * q4 + 3];
        uint2 ov; ov.x = pack2(a0, a1); ov.y = pack2(a2, a3);
        *(uint2*)(orow + dt * 32 + 8 * q4 + 4 * hh) = ov;
      }
  }
  __syncthreads();
}

DI void run_phase(const Params& p, int ph, char* smem) {
  if (ph == 0) { prep_phase(p, smem); return; }
  const int l = (ph - 1) >> 3, s = (ph - 1) & 7, li = l >> 1;
  const bool even = (l & 1) == 0;
  const float* xin = (l == 0) ? p.x : p.out;
  switch (s) {
    case 0: rmsnorm_phase(xin, p.attn_norm + l * 1024, p.hbuf); break;
    case 1:
      if (even) gemm_phase<0>(p.hbuf, p.wt_hy_in + (size_t)li * 3584 * 1024, 1024, 14, p.proj, LD_EVEN, nullptr, nullptr, smem);
      else gemm_phase<0>(p.hbuf, p.wt_nsa_in + (size_t)li * 2816 * 1024, 1024, 11, p.proj, LD_ODD, nullptr, nullptr, smem);
      break;
    case 2:
      if (even) {
        for (int item = blockIdx.x; item < 256 + 3072; item += gridDim.x) {
          if (item < 256) hgrn_item(p, li, item, smem); else dilated_item(p, li, item - 256, smem);
        }
      } else {
        for (int item = blockIdx.x; item < 256; item += gridDim.x) compress_item(p, li, item, smem);
        nsa_knorm_phase(p, li);
      }
      break;
    case 3:
      if (even) post_even_phase(p, li);
      else {
        for (int item = blockIdx.x; item < 2048; item += gridDim.x) {
          const int r = item / gridDim.x, i = item % gridDim.x;
          int it2 = item;
          if (gridDim.x == 256) {
            const int c = (i + 4 * (r >> 1)) & 31;
            const int tt = (r & 1) ? 31 - c : c;
            it2 = ((i >> 5) + 8 * r) * 32 + tt;
          }
          nsa_item(p, li, it2, smem);
        }
      }
      break;
    case 4:
      gemm_phase<1>(p.hbuf, (even ? p.wt_hy_out : p.wt_nsa_out) + (size_t)li * 1048576, 1024, 4, nullptr, 0, xin, p.out, smem);
      break;
    case 5: rmsnorm_phase(p.out, p.ffn_norm + l * 1024, p.hbuf); break;
    case 6: gemm_phase<2>(p.hbuf, p.wt_gu + (size_t)l * 5632 * 1024, 1024, 22, p.proj, DFF, nullptr, nullptr, smem); break;
    case 7: gemm_phase<1>(p.proj, p.wt_dn + (size_t)l * 1024 * 2816, 2816, 4, nullptr, 0, p.out, p.out, smem, true); break;
  }
}

constexpr int DYN_LDS = 131072;
extern __shared__ __attribute__((aligned(16))) char dyn_smem[];
__global__ void __launch_bounds__(512) mk_forward(Params p) {
  char* smem = dyn_smem;
  __shared__ uint4 xb_words;
  cg::grid_group grid = cg::this_grid();
  if (__builtin_amdgcn_workitem_id_x() == 0) xb_words = make_uint4(0u, 0u, 0u, 0u);
  __syncthreads();
  const XcdBarrier xb = xcd_barrier_post(p.bar, (volatile LAS unsigned*)&xb_words);
  for (int ph = p.phase_lo; ph < p.phase_hi; ++ph) {
    run_phase(p, ph, smem);
    if (ph + 1 < p.phase_hi) {
      if (p.phase_hi < 0) grid.sync();
      xcd_barrier(xb);
    }
  }
}

extern "C" void kernel_launch(void* const* d_in, const int* in_sizes, int n_in, void* d_out, int out_size,
                              void* d_ws, size_t ws_size, hipStream_t stream) {
  static int grid_blocks = 0;
  if (!grid_blocks) {
    int dev = 0, cus = 0, per_cu = 0;
    hipGetDevice(&dev);
    hipDeviceGetAttribute(&cus, hipDeviceAttributeMultiprocessorCount, dev);
    hipFuncSetAttribute((const void*)mk_forward, hipFuncAttributeMaxDynamicSharedMemorySize, DYN_LDS);
    hipOccupancyMaxActiveBlocksPerMultiprocessor(&per_cu, mk_forward, 512, DYN_LDS);
    if (per_cu > 1) per_cu = 1;
    if (per_cu < 1) per_cu = 1;
    grid_blocks = cus * per_cu;
  }
  Params p;
  memset(&p, 0, sizeof(p));
  p.x = (const float*)d_in[0]; p.attn_norm = (const float*)d_in[1]; p.ffn_norm = (const float*)d_in[2];
  p.hy_w_in = (const float*)d_in[3]; p.hy_lb = (const float*)d_in[4]; p.hy_og = (const float*)d_in[5];
  p.hy_qg = (const float*)d_in[6]; p.hy_kg = (const float*)d_in[7]; p.hy_w_out = (const float*)d_in[8];
  p.nsa_w_in = (const float*)d_in[9]; p.nsa_qg = (const float*)d_in[10]; p.nsa_kg = (const float*)d_in[11];
  p.cmp_pe = (const float*)d_in[12]; p.cmp_w1 = (const float*)d_in[13]; p.cmp_w2 = (const float*)d_in[14];
  p.nsa_w_out = (const float*)d_in[15]; p.ffn_g = (const float*)d_in[16]; p.ffn_u = (const float*)d_in[17]; p.ffn_d = (const float*)d_in[18];
  p.out = (float*)d_out;
  char* ws = (char*)d_ws; size_t off = 0;
  auto take = [&](size_t bytes) { char* r = ws + off; off += (bytes + 255) & ~(size_t)255; return r; };
  p.wt_hy_in = (u16*)take((size_t)2 * 3584 * 1024 * 2);
  p.wt_hy_out = (u16*)take((size_t)2 * 1048576 * 2);
  p.wt_nsa_in = (u16*)take((size_t)2 * 2816 * 1024 * 2);
  p.wt_nsa_out = (u16*)take((size_t)2 * 1048576 * 2);
  p.wt_gu = (u16*)take((size_t)4 * 5632 * 1024 * 2);
  p.wt_dn = (u16*)take((size_t)4 * 1024 * 2816 * 2);
  p.wt_c1 = (u16*)take((size_t)4 * 128 * 2048 * 2);
  p.wt_c2 = (u16*)take((size_t)4 * 64 * 128 * 2);
  p.c1 = (float*)take(4 * 128 * 4);
  p.lb = (float*)take(2 * 512 * 4);
  p.lse = (float*)take((size_t)3 * T_ * 8 * 4);
  p.proj = (u16*)take((size_t)T_ * 3584 * 2);
  p.hbuf = (u16*)take((size_t)T_ * 1024 * 2);
  p.obr = (u16*)take((size_t)3 * T_ * 512 * 2);
  p.kcmp = (u16*)take((size_t)16 * 4 * 128 * 64 * 2);
  p.vcmp = (u16*)take((size_t)16 * 4 * 128 * 64 * 2);
  p.bar = (unsigned*)take(XCD_BAR_WORDS * 4);
  if (off > ws_size) { fprintf(stderr, "workspace too small: need %zu have %zu\n", off, ws_size); return; }
  const int NPH = 33;
  hipMemsetAsync(p.bar, 0, XCD_BAR_WORDS * 4, stream);
#if MK_MULTI
  for (int ph = 0; ph < NPH; ++ph) {
    p.phase_lo = ph; p.phase_hi = ph + 1;
    hipLaunchKernelGGL(mk_forward, dim3(grid_blocks), dim3(512), DYN_LDS, stream, p);
  }
#else
  p.phase_lo = 0; p.phase_hi = NPH;
  void* args[] = {&p};
  hipError_t e = hipLaunchCooperativeKernel((void*)mk_forward, dim3(grid_blocks), dim3(512), args, DYN_LDS, stream);
  if (e != hipSuccess) fprintf(stderr, "cooperative launch failed: %s (grid %d)\n", hipGetErrorString(e), grid_blocks);
#endif
}
```

```cpp
#include <hip/hip_runtime.h>
#include <hip/hip_cooperative_groups.h>
#include <cstdio>
#include <cstdint>
#include <cstring>
namespace cg = cooperative_groups;

typedef unsigned short u16;
using bf16x8 = __attribute__((ext_vector_type(8))) short;
using f32x16 = __attribute__((ext_vector_type(16))) float;
using u32x4v = __attribute__((ext_vector_type(4))) unsigned;
#define DI __device__ __forceinline__
#define MFMA32(a, b, c) __builtin_amdgcn_mfma_f32_32x32x16_bf16((a), (b), (c), 0, 0, 0)

#ifndef MK_MULTI
#define MK_MULTI 0
#endif

constexpr int T_ = 32768, S_ = 2048;
constexpr float EPSF = 1e-6f;
constexpr float LOG2E = 1.4426950408889634f, LN2 = 0.6931471805599453f;
constexpr int LD_EVEN = 3584, LD_ODD = 2816, DFF = 2816;
constexpr int NT = 512;
#define LAS __attribute__((address_space(3)))
using f32x4v = __attribute__((ext_vector_type(4))) float;

struct Params {
  const float* x; const float* attn_norm; const float* ffn_norm;
  const float* hy_w_in; const float* hy_lb; const float* hy_og; const float* hy_qg; const float* hy_kg; const float* hy_w_out;
  const float* nsa_w_in; const float* nsa_qg; const float* nsa_kg; const float* cmp_pe; const float* cmp_w1; const float* cmp_w2; const float* nsa_w_out;
  const float* ffn_g; const float* ffn_u; const float* ffn_d;
  float* out;
  u16* wt_hy_in; u16* wt_hy_out; u16* wt_nsa_in; u16* wt_nsa_out; u16* wt_gu; u16* wt_dn; u16* wt_c1; u16* wt_c2;
  float* c1; float* lb; float* lse;
  u16* proj; u16* hbuf; u16* obr; u16* kcmp; u16* vcmp;
  unsigned* bar;
  int phase_lo; int phase_hi;
};

DI int tidx() { int t = __builtin_amdgcn_workitem_id_x(); asm volatile("" : "+v"(t)); return t; }
DI float bf2f(u16 h) { return __uint_as_float(((unsigned)h) << 16); }
typedef __bf16 bf16x2_t __attribute__((ext_vector_type(2)));
typedef float f32x2_t __attribute__((ext_vector_type(2)));
DI unsigned pack2(float a, float b) { f32x2_t v = {a, b}; bf16x2_t r = __builtin_convertvector(v, bf16x2_t); return __builtin_bit_cast(unsigned, r); }
DI u16 f2bf(float x) { return (u16)(pack2(x, 0.f) & 0xffffu); }
DI float fsigmoid(float x) { return __builtin_amdgcn_rcpf(1.f + __expf(-x)); }
DI float fsilu(float x) { return x * __builtin_amdgcn_rcpf(1.f + __expf(-x)); }
DI float fexp2(float x) { return __builtin_amdgcn_exp2f(x); }
DI void unpack8(uint4 v, float (&f)[8]) {
  f[0] = __uint_as_float(v.x << 16); f[1] = __uint_as_float(v.x & 0xffff0000u);
  f[2] = __uint_as_float(v.y << 16); f[3] = __uint_as_float(v.y & 0xffff0000u);
  f[4] = __uint_as_float(v.z << 16); f[5] = __uint_as_float(v.z & 0xffff0000u);
  f[6] = __uint_as_float(v.w << 16); f[7] = __uint_as_float(v.w & 0xffff0000u);
}
DI uint4 pack8(const float (&f)[8]) {
  uint4 o; o.x = pack2(f[0], f[1]); o.y = pack2(f[2], f[3]); o.z = pack2(f[4], f[5]); o.w = pack2(f[6], f[7]); return o;
}
DI bf16x8 as_bf16x8(uint4 v) { u32x4v t; t[0] = v.x; t[1] = v.y; t[2] = v.z; t[3] = v.w; return __builtin_bit_cast(bf16x8, t); }
DI f32x16 zero16() { f32x16 z;
#pragma unroll
  for (int i = 0; i < 16; ++i) z[i] = 0.f; return z; }


#define XB_TMO      128
#define XB_XCNT(j)  (256  + 64 * (j))
#define XB_XSUB(j)  (1280 + 64 * (j))
#define XB_XGEN(j)  (2304 + 64 * (j))
#define XB_TOP      3328
#define XB_TOPGEN   3392
#define XCD_BAR_WORDS 3456
#define XB_SPIN_CAP (1u << 18)
DI unsigned xb_ld(unsigned* p) { return __hip_atomic_load(p, __ATOMIC_RELAXED, __HIP_MEMORY_SCOPE_AGENT); }
DI unsigned xb_add(unsigned* p, unsigned v) { return __hip_atomic_fetch_add(p, v, __ATOMIC_RELAXED, __HIP_MEMORY_SCOPE_AGENT); }
DI unsigned xb_xcc_id() { return (unsigned)__builtin_amdgcn_s_getreg((3 << 11) | 20) & 0xFu; }
#define XB_SPIN(cond, bar) do { unsigned _sp = 0; while (cond) { __builtin_amdgcn_s_sleep(1); \
    if ((++_sp & 255u) == 0u) { if (xb_ld(&(bar)[XB_TMO])) break; if (_sp > XB_SPIN_CAP) { atomicAdd(&(bar)[XB_TMO], 1u); break; } } } } while (0)
struct XcdBarrier { unsigned* bar; unsigned x; volatile LAS unsigned* st; };
DI XcdBarrier xcd_barrier_post(unsigned* bar, volatile LAS unsigned* st) {
  XcdBarrier b; b.bar = bar; b.x = xb_xcc_id(); b.st = st;
  if (__builtin_amdgcn_workitem_id_x() == 0) (void)xb_add(&bar[XB_XCNT(b.x)], 1u);
  return b;
}
DI void xcd_barrier_complete(unsigned* bar, unsigned x, unsigned& nloc, unsigned& nx) {
  const unsigned G = gridDim.x * gridDim.y * gridDim.z;
  unsigned sum, cnt, mine, sp = 0u;
  for (;;) {
    sum = 0u; cnt = 0u; mine = 0u;
#pragma unroll
    for (unsigned j = 0; j < 16; ++j) { const unsigned c = xb_ld(&bar[XB_XCNT(j)]); sum += c; cnt += (c > 0u) ? 1u : 0u; mine = (j == x) ? c : mine; }
    if (sum == G) break;
    __builtin_amdgcn_s_sleep(1);
    if ((++sp & 255u) == 0u) { if (xb_ld(&bar[XB_TMO])) break; if (sp > XB_SPIN_CAP) { atomicAdd(&bar[XB_TMO], 1u); break; } }
  }
  nloc = mine > 0u ? mine : 1u; nx = cnt > 0u ? cnt : 1u;
}
DI void xcd_barrier(const XcdBarrier& b) {
  asm volatile("s_waitcnt vmcnt(0)" ::: "memory");
  __syncthreads();
  if (__builtin_amdgcn_workitem_id_x() == 0) {
    unsigned* bar = b.bar;
    __builtin_amdgcn_s_waitcnt(0);
    unsigned nloc = b.st[0], nx = b.st[1];
    if (nloc == 0u) { xcd_barrier_complete(bar, b.x, nloc, nx); b.st[0] = nloc; b.st[1] = nx; }
    const unsigned old = xb_add(&bar[XB_XSUB(b.x)], 1u);
    const unsigned gen = old / nloc;
    if (old + 1u == (gen + 1u) * nloc) {
      __builtin_amdgcn_fence(__ATOMIC_RELEASE, "agent");
      asm volatile("s_waitcnt vmcnt(0)" ::: "memory");
      const unsigned og = xb_add(&bar[XB_TOP], 1u);
      const unsigned tg = og / nx;
      if (og + 1u == (tg + 1u) * nx) xb_add(&bar[XB_TOPGEN], 1u);
      else XB_SPIN(xb_ld(&bar[XB_TOPGEN]) == tg, bar);
      __builtin_amdgcn_fence(__ATOMIC_ACQUIRE, "agent");
      xb_add(&bar[XB_XGEN(b.x)], 1u);
      asm volatile("s_waitcnt vmcnt(0)" ::: "memory");
    } else {
      XB_SPIN(xb_ld(&bar[XB_XGEN(b.x)]) == gen, bar);
      __builtin_amdgcn_fence(__ATOMIC_ACQUIRE, "agent");
      asm volatile("s_waitcnt vmcnt(0)" ::: "memory");
    }
  }
  __syncthreads();
}

struct PrepDesc { const float* src; u16* dst; int K, N, mode, tk, tn; };
DI PrepDesc prep_desc(const Params& p, int tile) {
  constexpr int G0 = 1792, G1 = 2304, G2 = 3712, G3 = 4224, G4 = 7040, G5 = 9856, G6 = 12672, G7 = 12928;
  PrepDesc d; int Np, lt; d.mode = 0;
  if (tile < G0) { int i = tile / 896; lt = tile % 896; d.src = p.hy_w_in + (size_t)i * 1024 * 3584; d.dst = p.wt_hy_in + (size_t)i * 3584 * 1024; d.K = 1024; d.N = 3584; Np = 3584; }
  else if (tile < G1) { int t = tile - G0; int i = t / 256; lt = t % 256; d.src = p.hy_w_out + (size_t)i * 1048576; d.dst = p.wt_hy_out + (size_t)i * 1048576; d.K = 1024; d.N = 1024; Np = 1024; }
  else if (tile < G2) { int t = tile - G1; int i = t / 704; lt = t % 704; d.src = p.nsa_w_in + (size_t)i * 1024 * 2608; d.dst = p.wt_nsa_in + (size_t)i * 2816 * 1024; d.K = 1024; d.N = 2608; Np = 2816; }
  else if (tile < G3) { int t = tile - G2; int i = t / 256; lt = t % 256; d.src = p.nsa_w_out + (size_t)i * 1048576; d.dst = p.wt_nsa_out + (size_t)i * 1048576; d.K = 1024; d.N = 1024; Np = 1024; }
  else if (tile < G4) { int t = tile - G3; int i = t / 704; lt = t % 704; d.src = p.ffn_g + (size_t)i * 1024 * 2816; d.dst = p.wt_gu + (size_t)i * 5632 * 1024; d.K = 1024; d.N = 2816; Np = 2816; d.mode = 1; }
  else if (tile < G5) { int t = tile - G4; int i = t / 704; lt = t % 704; d.src = p.ffn_u + (size_t)i * 1024 * 2816; d.dst = p.wt_gu + (size_t)i * 5632 * 1024; d.K = 1024; d.N = 2816; Np = 2816; d.mode = 2; }
  else if (tile < G6) { int t = tile - G5; int i = t / 704; lt = t % 704; d.src = p.ffn_d + (size_t)i * 2816 * 1024; d.dst = p.wt_dn + (size_t)i * 1024 * 2816; d.K = 2816; d.N = 1024; Np = 1024; }
  else if (tile < G7) { int t = tile - G6; int i = t / 64; lt = t % 64; d.src = p.cmp_w1 + (size_t)i * 2048 * 128; d.dst = p.wt_c1 + (size_t)i * 128 * 2048; d.K = 2048; d.N = 128; Np = 128; }
  else { int t = tile - G7; int i = t / 2; lt = t % 2; d.src = p.cmp_w2 + (size_t)i * 128 * 64; d.dst = p.wt_c2 + (size_t)i * 64 * 128; d.K = 128; d.N = 64; Np = 64; }
  const int ntn = Np / 64;
  d.tk = lt / ntn; d.tn = lt % ntn;
  return d;
}
DI void prep_load(const PrepDesc& d, int tid, float (&rv)[8]) {
  const int c = tid & 63; const int n = d.tn * 64 + c; const int nc = n < d.N ? n : d.N - 1;
#pragma unroll
  for (int j = 0; j < 8; ++j) {
    const int r = (tid >> 6) + 8 * j;
    rv[j] = d.src[(size_t)(d.tk * 64 + r) * d.N + nc];
  }
}

DI void prep_phase(const Params& p, char* smem) {
  float* sm = (float*)smem;
  constexpr int G8 = 12936;
  const int tid = tidx();
  float rv[8];
  int tile = blockIdx.x;
  asm volatile("" : "+s"(tile));
  if (tile < G8) { const PrepDesc d0 = prep_desc(p, tile); prep_load(d0, tid, rv); }
  for (; tile < G8; tile += gridDim.x) {
    const PrepDesc d = prep_desc(p, tile);
    __syncthreads();
#pragma unroll
    for (int j = 0; j < 8; ++j) sm[((tid >> 6) + 8 * j) * 65 + (tid & 63)] = rv[j];
    __syncthreads();
    if (tile + (int)gridDim.x < G8) { const PrepDesc dn = prep_desc(p, tile + gridDim.x); prep_load(dn, tid, rv); }
    const int nl = tid >> 3, kp = tid & 7;
    const int n = d.tn * 64 + nl;
    int nd = n;
    if (d.mode == 1) nd = (n >> 4) * 32 + (n & 15);
    else if (d.mode == 2) nd = (n >> 4) * 32 + 16 + (n & 15);
    float v[8];
#pragma unroll
    for (int j = 0; j < 8; ++j) v[j] = sm[(kp * 8 + j) * 65 + nl];
    *(uint4*)(d.dst + (size_t)nd * d.K + d.tk * 64 + kp * 8) = pack8(v);
  }
  __syncthreads();
  if (blockIdx.x < 4) {
    const int mi = blockIdx.x;
    const float* pe = p.cmp_pe + (size_t)mi * 2048;
    const float* w1 = p.cmp_w1 + (size_t)mi * 2048 * 128;
    const int tq_ = tidx();
    const int o = tq_ & 127, half = tq_ >> 7;
    float a0 = 0.f, a1 = 0.f, a2 = 0.f, a3 = 0.f;
    for (int k = half * 512; k < half * 512 + 512; k += 4) {
      a0 += pe[k] * w1[(size_t)k * 128 + o]; a1 += pe[k + 1] * w1[(size_t)(k + 1) * 128 + o];
      a2 += pe[k + 2] * w1[(size_t)(k + 2) * 128 + o]; a3 += pe[k + 3] * w1[(size_t)(k + 3) * 128 + o];
    }
    sm[tq_] = (a0 + a1) + (a2 + a3);
    __syncthreads();
    if (tq_ < 128) p.c1[mi * 128 + tq_] = (sm[tq_] + sm[tq_ + 128]) + (sm[tq_ + 256] + sm[tq_ + 384]);
    __syncthreads();
  }
  if (blockIdx.x == 4 || (gridDim.x <= 4 && blockIdx.x == 0)) {
    for (int c = tidx(); c < 512; c += NT) {
      float l0 = p.hy_lb[c], l1 = p.hy_lb[512 + c];
      float mx = fmaxf(l0, l1); float e0 = __expf(l0 - mx), e1 = __expf(l1 - mx); float inv = 1.f / (e0 + e1);
      float p0 = e0 * inv, p1 = e1 * inv;
      p.lb[c] = p0 - p0; p.lb[512 + c] = (p0 + p1) - p0;
    }
  }
}

DI void rmsnorm_phase(const float* x, const float* __restrict__ g, u16* h) {
  const int t_ = tidx();
  const int wave = t_ >> 6, lane = t_ & 63;
  const int stride = gridDim.x * 8;
  int row = blockIdx.x * 8 + wave;
  float4 v[4], nv[4];
  float4 gg[4];
#pragma unroll
  for (int j = 0; j < 4; ++j) gg[j] = ((const float4*)g)[lane + 64 * j];
  if (row < T_) {
    const float4* xr = (const float4*)(x + (size_t)row * 1024);
#pragma unroll
    for (int j = 0; j < 4; ++j) v[j] = xr[lane + 64 * j];
  }
  while (row < T_) {
    const int nrow = row + stride;
    if (nrow < T_) {
      const float4* xr = (const float4*)(x + (size_t)nrow * 1024);
#pragma unroll
      for (int j = 0; j < 4; ++j) nv[j] = xr[lane + 64 * j];
    }
    float ss = 0.f;
#pragma unroll
    for (int j = 0; j < 4; ++j) ss += v[j].x * v[j].x + v[j].y * v[j].y + v[j].z * v[j].z + v[j].w * v[j].w;
#pragma unroll
    for (int off = 32; off >= 1; off >>= 1) ss += __shfl_xor(ss, off);
    const float rs = rsqrtf(ss * (1.f / 1024.f) + EPSF);
#pragma unroll
    for (int j = 0; j < 4; ++j) {
      uint2 o; o.x = pack2(v[j].x * rs * gg[j].x, v[j].y * rs * gg[j].y); o.y = pack2(v[j].z * rs * gg[j].z, v[j].w * rs * gg[j].w);
      *(uint2*)(h + (size_t)row * 1024 + (lane + 64 * j) * 4) = o;
    }
#pragma unroll
    for (int j = 0; j < 4; ++j) v[j] = nv[j];
    row = nrow;
  }
}

DI int lds_byte(int r, int c) { const int st = (r >> 4) * 2 + (c >> 5), rr = r & 15, cc = c & 31, ob = rr * 64 + cc * 2; return st * 1024 + (ob ^ (((ob >> 9) & 1) << 5)); }
DI void stage_rc(int b, int& R, int& C) { const int st = b / 1024, sb = b % 1024, swz = sb ^ (((sb >> 9) & 1) << 5); R = (st >> 1) * 16 + swz / 64; C = (st & 1) * 32 + (swz % 64) / 2; }

template <int EPI>
DI void gemm_phase(const u16* A, const u16* Bt, const int K, const int nN, u16* outb, const int ldc, const float* res, float* outf, char* smem, const bool rev = false) {
  constexpr int HTB = 16384;
  const int tid = tidx();
  const int wid = tid >> 6, lane = tid & 63, wr = wid >> 2, wc = wid & 3, fr = lane & 15, fq = lane >> 4;
  const int nM = 128, nwg = nM * nN, nt = K / 64;
  int sR0, sC0, sR1, sC1; stage_rc(tid * 16, sR0, sC0); stage_rc(tid * 16 + 8192, sR1, sC1);
  const unsigned vo0 = (unsigned)((sR0 * K + sC0) * 2), vo1 = (unsigned)((sR1 * K + sC1) * 2);
#define SA_(b, h) (smem + ((b) * 2 + (h)) * HTB)
#define SB_(b, h) (smem + (4 + (b) * 2 + (h)) * HTB)
#define STAGE(P, BASE, br, kt) do { const char* _g = (const char*)((BASE) + (size_t)(br) * K + (size_t)(kt) * 64); \
    unsigned _o0 = vo0, _o1 = vo1; asm volatile("" : "+v"(_o0), "+v"(_o1)); \
    __builtin_amdgcn_global_load_lds((const unsigned*)(_g + _o0), (LAS unsigned*)((P) + tid * 16), 16, 0, 0); \
    __builtin_amdgcn_global_load_lds((const unsigned*)(_g + _o1), (LAS unsigned*)((P) + tid * 16 + 8192), 16, 0, 0); } while (0)
  const int ob_ = fr * 64 + fq * 16, swz_ = ob_ ^ (((ob_ >> 9) & 1) << 5);
  const int aoff = wr * 8192 + swz_, boff = wc * 4096 + swz_;
#define LDA(dst, b, h) _Pragma("unroll") for (int m = 0; m < 4; ++m) _Pragma("unroll") for (int k = 0; k < 2; ++k) \
    dst[m][k] = *(const bf16x8*)(SA_(b, h) + aoff + m * 2048 + k * 1024)
#define LDB(dst, b, h) _Pragma("unroll") for (int n = 0; n < 2; ++n) _Pragma("unroll") for (int k = 0; k < 2; ++k) \
    dst[n][k] = *(const bf16x8*)(SB_(b, h) + boff + n * 2048 + k * 1024)
#define MMA(ai, bj, At_, Bx_) do { __builtin_amdgcn_s_setprio(1); \
    _Pragma("unroll") for (int m = 0; m < 4; ++m) _Pragma("unroll") for (int n = 0; n < 2; ++n) _Pragma("unroll") for (int k = 0; k < 2; ++k) \
      acc[ai][bj][m][n] = __builtin_amdgcn_mfma_f32_16x16x32_bf16(Bx_[n][k], At_[m][k], acc[ai][bj][m][n], 0, 0, 0); \
    __builtin_amdgcn_s_setprio(0); } while (0)
#define WAIT_V(n) asm volatile("s_waitcnt vmcnt(" #n ")" ::: "memory")
#define WAIT_L(n) asm volatile("s_waitcnt lgkmcnt(" #n ")" ::: "memory")
#define BAR __builtin_amdgcn_s_barrier()
#define SCHED __builtin_amdgcn_sched_barrier(0)
  auto tile_of = [&](long Lq, int& brow_, int& bcol_, int& pn_) {
    int wgid = (int)Lq;
    { const int q = nwg / 8, r = nwg % 8, xcd = wgid % 8, off = wgid / 8; wgid = (xcd < r ? xcd * (q + 1) : r * (q + 1) + (xcd - r) * q) + off; }
    const int nig = 8 * nN, gid = wgid / nig, fm = gid * 8, gsz = (nM - fm) < 8 ? (nM - fm) : 8;
    const int pm = fm + ((wgid % nig) % gsz);
    pn_ = (wgid % nig) / gsz; brow_ = (rev ? (nM - 1 - pm) : pm) * 256; bcol_ = pn_ * 256;
  };
#define STAGE7(br_, bc_) do { STAGE(SB_(0, 0), Bt, bc_, 0); STAGE(SA_(0, 0), A, br_, 0); STAGE(SB_(0, 1), Bt, (bc_) + 128, 0); STAGE(SA_(0, 1), A, (br_) + 128, 0); \
    STAGE(SB_(1, 0), Bt, bc_, 1); STAGE(SA_(1, 0), A, br_, 1); STAGE(SB_(1, 1), Bt, (bc_) + 128, 1); } while (0)
  long L = blockIdx.x;
  bool have = L < nwg;
  int brow = 0, bcol = 0, pn = 0;
  __syncthreads();
  if (have) { tile_of(L, brow, bcol, pn); STAGE7(brow, bcol); }
  while (have) {
    f32x4v acc[2][2][4][2];
#pragma unroll
    for (int a = 0; a < 2; ++a)
#pragma unroll
      for (int b = 0; b < 2; ++b)
#pragma unroll
        for (int m = 0; m < 4; ++m)
#pragma unroll
          for (int n = 0; n < 2; ++n) acc[a][b][m][n] = (f32x4v){0.f, 0.f, 0.f, 0.f};
    bf16x8 At[4][2], B0[2][2], B1[2][2];
    if (wr == 1) BAR;
    WAIT_V(0); BAR;
    BAR;
    for (int t = 0; t < nt - 2; t += 2) {
      LDB(B0, 0, 0); SCHED; LDA(At, 0, 0); STAGE(SA_(1, 1), A, brow + 128, t + 1);
      WAIT_L(8); BAR; WAIT_L(0); MMA(0, 0, At, B0); BAR; SCHED;
      LDB(B1, 0, 1); STAGE(SB_(0, 0), Bt, bcol, t + 2);
      BAR; WAIT_L(0); MMA(0, 1, At, B1); BAR;
      LDA(At, 0, 1); STAGE(SA_(0, 0), A, brow, t + 2);
      BAR; WAIT_L(0); MMA(1, 0, At, B0); BAR; SCHED;
      STAGE(SB_(0, 1), Bt, bcol + 128, t + 2);
      WAIT_V(6); BAR; MMA(1, 1, At, B1); BAR;
      LDB(B0, 1, 0); SCHED; LDA(At, 1, 0); STAGE(SA_(0, 1), A, brow + 128, t + 2);
      WAIT_L(8); BAR; WAIT_L(0); MMA(0, 0, At, B0); BAR; SCHED;
      LDB(B1, 1, 1); STAGE(SB_(1, 0), Bt, bcol, t + 3);
      BAR; WAIT_L(0); MMA(0, 1, At, B1); BAR;
      LDA(At, 1, 1); STAGE(SA_(1, 0), A, brow, t + 3);
      BAR; WAIT_L(0); MMA(1, 0, At, B0); BAR; SCHED;
      STAGE(SB_(1, 1), Bt, bcol + 128, t + 3);
      WAIT_V(6); BAR; MMA(1, 1, At, B1); BAR;
    }
    { LDB(B0, 0, 0); LDA(At, 0, 0); STAGE(SA_(1, 1), A, brow + 128, nt - 1);
      BAR; WAIT_L(0); MMA(0, 0, At, B0); BAR;
      LDB(B1, 0, 1); BAR; WAIT_L(0); MMA(0, 1, At, B1); BAR;
      LDA(At, 0, 1); WAIT_V(4); BAR; WAIT_L(0); MMA(1, 0, At, B0); MMA(1, 1, At, B1); BAR; }
    { LDB(B0, 1, 0); LDA(At, 1, 0); WAIT_V(2); BAR; WAIT_L(0); MMA(0, 0, At, B0); BAR;
      LDB(B1, 1, 1); WAIT_V(0); BAR; WAIT_L(0); MMA(0, 1, At, B1); BAR;
      LDA(At, 1, 1); BAR; WAIT_L(0); MMA(1, 0, At, B0); MMA(1, 1, At, B1); BAR; }
    if (wr == 0) BAR;
    const long Ln = L + gridDim.x;
    const bool haven = Ln < nwg;
    int browN = 0, bcolN = 0, pnN = 0;
    if (haven) { tile_of(Ln, browN, bcolN, pnN); STAGE7(browN, bcolN); }
    int tid2 = tid; asm volatile("" : "+v"(tid2));
    const int fr2 = tid2 & 15, fq2 = (tid2 >> 4) & 3, wc2 = (tid2 >> 6) & 3, wr2 = tid2 >> 8;
    if (EPI == 1) {
#pragma unroll
      for (int am = 0; am < 4; ++am) {
        const int ai = am >> 1, m0 = (am & 1) * 2;
        f32x4v rb[2][2][2];
        const float* rbase = res + (size_t)(brow + ai * 128 + wr2 * 64 + m0 * 16 + fr2) * 1024 + bcol + wc2 * 32 + fq2 * 4;
        float* obase = outf + (size_t)(brow + ai * 128 + wr2 * 64 + m0 * 16 + fr2) * 1024 + bcol + wc2 * 32 + fq2 * 4;
#pragma unroll
        for (int m = 0; m < 2; ++m)
#pragma unroll
          for (int bj = 0; bj < 2; ++bj)
#pragma unroll
            for (int n = 0; n < 2; ++n) rb[m][bj][n] = *(const f32x4v*)(rbase + (size_t)m * 16 * 1024 + bj * 128 + n * 16);
        asm volatile("" ::: "memory");
#pragma unroll
        for (int m = 0; m < 2; ++m)
#pragma unroll
          for (int bj = 0; bj < 2; ++bj)
#pragma unroll
            for (int n = 0; n < 2; ++n) *(f32x4v*)(obase + (size_t)m * 16 * 1024 + bj * 128 + n * 16) = rb[m][bj][n] + acc[ai][bj][m0 + m][n];
        asm volatile("" ::: "memory");
      }
    } else {
#pragma unroll
    for (int ai = 0; ai < 2; ++ai)
#pragma unroll
      for (int m = 0; m < 4; ++m) {
        const size_t row = (size_t)(brow + ai * 128 + wr2 * 64 + m * 16 + fr2);
#pragma unroll
        for (int bj = 0; bj < 2; ++bj) {
          const int cb = bcol + bj * 128 + wc2 * 32 + fq2 * 4;
          if (EPI == 0) {
#pragma unroll
            for (int n = 0; n < 2; ++n) {
              uint2 o; o.x = pack2(acc[ai][bj][m][n][0], acc[ai][bj][m][n][1]); o.y = pack2(acc[ai][bj][m][n][2], acc[ai][bj][m][n][3]);
              *(uint2*)(outb + row * ldc + cb + n * 16) = o;
            }
          } else {
            const f32x4v gv = acc[ai][bj][m][0], uv = acc[ai][bj][m][1];
            uint2 o; o.x = pack2(fsilu(gv[0]) * uv[0], fsilu(gv[1]) * uv[1]); o.y = pack2(fsilu(gv[2]) * uv[2], fsilu(gv[3]) * uv[3]);
            *(uint2*)(outb + row * DFF + ((bcol + bj * 128 + wc2 * 32) >> 1) + fq2 * 4) = o;
          }
        }
      }
    }
    L = Ln; have = haven; brow = browN; bcol = bcolN; pn = pnN;
  }
  __syncthreads();
#undef STAGE7
#undef SA_
#undef SB_
#undef STAGE
#undef LDA
#undef LDB
#undef MMA
}

#define MFMA16(a, b, c) __builtin_amdgcn_mfma_f32_16x16x32_bf16((a), (b), (c), 0, 0, 0)
DI void hgrn_item(const Params& p, int li, int item, char* smem) {
  const int tid = tidx(), lane = tid & 63, w = tid >> 6, fr = lane & 15, fq = lane >> 4;
  const int kk = w >> 1, vt = w & 1;
  const int vs = item & 3, h = (item >> 2) & 3, b = item >> 4;
  const int tg = tid & 3, kch = tid >> 2;
  const int sv = tid >> 5, vv = tid & 31;
  const float lbv = p.lb[li * 512 + h * 128 + kch];
  const u16* base = p.proj + (size_t)b * S_ * LD_EVEN;
  const u16* pq = base + (size_t)(4 * tg) * LD_EVEN + h * 128 + kch;
  const u16* pv = base + (size_t)sv * LD_EVEN + 1024 + h * 128 + vs * 32 + vv;
  struct HRegs { unsigned q0, q1, q2, q3, f0, f1, f2, f3, v; };
  auto hload = [&](int c, HRegs& r) {
    const u16* pq2 = pq + (size_t)c * 16 * LD_EVEN;
    r.q0 = pq2[0]; r.q1 = pq2[LD_EVEN]; r.q2 = pq2[2 * LD_EVEN]; r.q3 = pq2[3 * LD_EVEN];
    r.f0 = pq2[512]; r.f1 = pq2[LD_EVEN + 512]; r.f2 = pq2[2 * LD_EVEN + 512]; r.f3 = pq2[3 * LD_EVEN + 512];
    r.v = pv[(size_t)c * 16 * LD_EVEN];
  };
  HRegs ra, rb;
  hload(0, ra); hload(1, rb);
  f32x4v S0 = {0.f, 0.f, 0.f, 0.f}, S1 = {0.f, 0.f, 0.f, 0.f};
  const f32x4v z4 = {0.f, 0.f, 0.f, 0.f};
  __syncthreads();
  constexpr int HBUF = 16896;
  auto prep = [&](const HRegs& rr, int par) {
    u16* Qt_ = (u16*)(smem + par * HBUF); u16* Kt_ = Qt_ + 16 * 136; u16* Kh_ = Kt_ + 16 * 136; u16* Vt_ = Kh_ + 128 * 24; float* Pc_ = (float*)(Vt_ + 32 * 24);
    float qv[4], kv[4], cs[4];
    const unsigned rq[4] = {rr.q0, rr.q1, rr.q2, rr.q3}, rf[4] = {rr.f0, rr.f1, rr.f2, rr.f3};
    float cp = 1.f;
#pragma unroll
    for (int i = 0; i < 4; ++i) {
      const float f = lbv + (1.f - lbv) * fsigmoid(__uint_as_float(rf[i] << 16));
      cp *= f; cs[i] = cp; kv[i] = 1.f - f; qv[i] = fsilu(__uint_as_float(rq[i] << 16));
    }
    const int bl = lane & ~3;
    const float t0 = __shfl(cp, bl), t1 = __shfl(cp, bl + 1), t2 = __shfl(cp, bl + 2), t3 = __shfl(cp, bl + 3);
    const float pre = (tg > 0 ? t0 : 1.f) * (tg > 1 ? t1 : 1.f) * (tg > 2 ? t2 : 1.f);
    const float PC = (t0 * t1) * (t2 * t3);
    float kh[4];
#pragma unroll
    for (int i = 0; i < 4; ++i) {
      const float P = fmaxf(pre * cs[i], 1e-30f);
      const float rP = __builtin_amdgcn_rcpf(P);
      const int t = 4 * tg + i;
      Qt_[t * 136 + kch] = f2bf(qv[i] * P);
      const float kr = kv[i] * rP;
      Kt_[t * 136 + kch] = f2bf(kr);
      kh[i] = kr * PC;
    }
    uint2 k2; k2.x = pack2(kh[0], kh[1]); k2.y = pack2(kh[2], kh[3]);
    *(uint2*)(Kh_ + kch * 24 + 4 * tg) = k2;
    if (tg == 0) Pc_[kch] = PC;
    Vt_[vv * 24 + sv] = (u16)rr.v;
  };
  auto mfma = [&](int par) {
    const u16* Qt_ = (const u16*)(smem + par * HBUF); const u16* Kt_ = Qt_ + 16 * 136; const u16* Kh_ = Kt_ + 16 * 136; const u16* Vt_ = Kh_ + 128 * 24;
    const float* Pc_ = (const float*)(Vt_ + 32 * 24);
    float* Op_ = (float*)(smem + 4 * HBUF) + par * 2048;
    const uint2 v2 = *(const uint2*)(Vt_ + (16 * vt + fr) * 24 + 4 * fq);
    const bf16x8 vb = as_bf16x8(make_uint4(v2.x, v2.y, 0u, 0u));
    const u16* qrow = Qt_ + fr * 136 + 32 * kk + 4 * fq;
    const uint2 qa = *(const uint2*)qrow, qb = *(const uint2*)(qrow + 16);
    const bf16x8 qfrag = as_bf16x8(make_uint4(qa.x, qa.y, qb.x, qb.y));
    const bf16x8 sfrag = as_bf16x8(make_uint4(pack2(S0[0], S0[1]), pack2(S0[2], S0[3]), pack2(S1[0], S1[1]), pack2(S1[2], S1[3])));
    f32x4v acc = MFMA16(qfrag, sfrag, z4);
    if (kk == 0) {
      f32x4v sa = z4;
#pragma unroll
      for (int ks = 0; ks < 4; ++ks) {
        const bf16x8 kf = *(const bf16x8*)(Kt_ + fr * 136 + 32 * ks + 8 * fq);
        const bf16x8 qf2 = *(const bf16x8*)(Qt_ + fr * 136 + 32 * ks + 8 * fq);
        sa = MFMA16(kf, qf2, sa);
      }
#pragma unroll
      for (int j = 0; j < 4; ++j) sa[j] = (4 * fq + j <= fr) ? sa[j] : 0.f;
      const bf16x8 afrag = as_bf16x8(make_uint4(pack2(sa[0], sa[1]), pack2(sa[2], sa[3]), 0u, 0u));
      acc = MFMA16(afrag, vb, acc);
    }
#pragma unroll
    for (int j = 0; j < 4; ++j) Op_[(w * 16 + 4 * fq + j) * 16 + fr] = acc[j];
    const float* pc0 = Pc_ + 32 * kk + 4 * fq;
#pragma unroll
    for (int j = 0; j < 4; ++j) { S0[j] *= pc0[j]; S1[j] *= pc0[16 + j]; }
    const uint2 h0 = *(const uint2*)(Kh_ + (32 * kk + fr) * 24 + 4 * fq);
    const uint2 h1v = *(const uint2*)(Kh_ + (32 * kk + 16 + fr) * 24 + 4 * fq);
    S0 = MFMA16(as_bf16x8(make_uint4(h0.x, h0.y, 0u, 0u)), vb, S0);
    S1 = MFMA16(as_bf16x8(make_uint4(h1v.x, h1v.y, 0u, 0u)), vb, S1);
  };
  auto reduce = [&](int c, int par) {
    const float* Op_ = (const float*)(smem + 4 * HBUF) + par * 2048;
    const int t = tid >> 5, v = tid & 31, vtt = v >> 4, vl = v & 15;
    float o = 0.f;
#pragma unroll
    for (int q = 0; q < 4; ++q) o += Op_[((2 * q + vtt) * 16 + t) * 16 + vl];
    p.hbuf[(size_t)(b * S_ + c * 16 + t) * 1024 + h * 128 + vs * 32 + v] = f2bf(o);
  };
  prep(ra, 0); prep(rb, 1); hload(2, ra); hload(3, rb);
  __syncthreads();
#pragma unroll 1
  for (int P = 0; P < 64; P += 2) {
    mfma(0); mfma(1);
    prep(ra, 2); prep(rb, 3);
    if (P + 2 < 64) { hload(2 * P + 4, ra); hload(2 * P + 5, rb); }
    __syncthreads();
    reduce(2 * P, 0); reduce(2 * P + 1, 1);
    mfma(2); mfma(3);
    if (P + 2 < 64) { prep(ra, 0); prep(rb, 1); if (P + 3 < 64) { hload(2 * P + 6, ra); hload(2 * P + 7, rb); } }
    __syncthreads();
    reduce(2 * P + 2, 2); reduce(2 * P + 3, 3);
  }
  __syncthreads();
}

DI void load_q(const u16* qrow, const float* __restrict__ gain, int hh, bf16x8 (&qf)[4]) {
  float f[4][8]; float ss = 0.f;
#pragma unroll
  for (int kk = 0; kk < 4; ++kk) {
    uint4 raw = *(const uint4*)(qrow + kk * 16 + hh * 8);
    unpack8(raw, f[kk]);
#pragma unroll
    for (int j = 0; j < 8; ++j) ss += f[kk][j] * f[kk][j];
  }
  ss += __shfl_xor(ss, 32);
  const float rs = rsqrtf(ss * (1.f / 64.f) + EPSF) * (0.125f * LOG2E);
#pragma unroll
  for (int kk = 0; kk < 4; ++kk) {
#pragma unroll
    for (int j = 0; j < 8; ++j) f[kk][j] *= rs * gain[kk * 16 + hh * 8 + j];
    qf[kk] = as_bf16x8(pack8(f[kk]));
  }
}

constexpr int VS = 68;
constexpr int KVBUF = 18432;
template <int NTH> struct KVRegs { u32x4v r[NTH == 256 ? 4 : 2]; };
DI void kv_ld2(const u16* src, size_t stride, int ra, int rb, int rlo, int rhi, int dp, u32x4v& x0, u32x4v& x1) {
  const int ca = ra < rlo ? rlo : ra, cb = rb < rlo ? rlo : rb;
  x0 = *(const u32x4v*)(src + (size_t)ca * stride + dp * 8);
  x1 = *(const u32x4v*)(src + (size_t)cb * stride + dp * 8);
}
template <int NTH>
DI void kv_load(int tid, const u16* kb, const u16* vb, size_t stride, int r0, int rlo, int rhi, KVRegs<NTH>& rg) {
  const int dp = tid & 7, kq = (tid & 255) >> 3;
  if (NTH == 256) {
    kv_ld2(kb, stride, r0 + kq, r0 + kq + 32, rlo, rhi, dp, rg.r[0], rg.r[1]);
    kv_ld2(vb, stride, r0 + 2 * kq, r0 + 2 * kq + 1, rlo, rhi, dp, rg.r[2], rg.r[3]);
  } else {
    if (tid < 256) kv_ld2(kb, stride, r0 + kq, r0 + kq + 32, rlo, rhi, dp, rg.r[0], rg.r[1]);
    else kv_ld2(vb, stride, r0 + 2 * kq, r0 + 2 * kq + 1, rlo, rhi, dp, rg.r[0], rg.r[1]);
  }
}
DI void k_store1(u32x4v x, int key, int dp, const float* __restrict__ kgain, u16* Ks) {
  uint4 kv = make_uint4(x[0], x[1], x[2], x[3]);
  if (kgain) {
    float f[8]; unpack8(kv, f);
    float ss = 0.f;
#pragma unroll
    for (int e = 0; e < 8; ++e) ss += f[e] * f[e];
    ss += __shfl_xor(ss, 1); ss += __shfl_xor(ss, 2); ss += __shfl_xor(ss, 4);
    const float rs = rsqrtf(ss * (1.f / 64.f) + EPSF);
#pragma unroll
    for (int e = 0; e < 8; ++e) f[e] *= rs * kgain[dp * 8 + e];
    kv = pack8(f);
  }
  *(uint4*)(Ks + key * 72 + dp * 8) = kv;
}
DI void v_store2(u32x4v v0, u32x4v v1, int kp, int dp, u16* Vts) {
  unsigned* vd = (unsigned*)(Vts + (dp * 8) * VS + 2 * kp);
#pragma unroll
  for (int d = 0; d < 4; ++d) {
    vd[(2 * d) * (VS / 2)] = (v0[d] & 0xffffu) | (v1[d] << 16);
    vd[(2 * d + 1) * (VS / 2)] = (v0[d] >> 16) | (v1[d] & 0xffff0000u);
  }
}
template <int NTH>
DI void kv_store(int tid, const KVRegs<NTH>& rg, const float* __restrict__ kgain, u16* Ks, u16* Vts) {
  const int dp = tid & 7, kq = (tid & 255) >> 3;
  if (NTH == 256) {
    k_store1(rg.r[0], kq, dp, kgain, Ks); k_store1(rg.r[1], kq + 32, dp, kgain, Ks);
    v_store2(rg.r[2], rg.r[3], kq, dp, Vts);
  } else {
    if (tid < 256) { k_store1(rg.r[0], kq, dp, kgain, Ks); k_store1(rg.r[1], kq + 32, dp, kgain, Ks); }
    else v_store2(rg.r[0], rg.r[1], kq, dp, Vts);
  }
}

DI void score_stage(const bf16x8 (&qf)[4], const u16* Ks, int lane, float sk, float sb, int lower, int lim, f32x16 (&s)[2], float& mx) {
  const int lr = lane & 31, hh = lane >> 5;
#pragma unroll
  for (int sub = 0; sub < 2; ++sub) {
#pragma unroll
    for (int i = 0; i < 16; ++i) s[sub][i] = fmaf(sk, (float)(sub * 32 + (i & 3) + 8 * (i >> 2)), sb);
#pragma unroll
    for (int kk = 0; kk < 4; ++kk) {
      bf16x8 kf = *(const bf16x8*)(Ks + (sub * 32 + lr) * 72 + kk * 16 + hh * 8);
      s[sub] = MFMA32(kf, qf[kk], s[sub]);
    }
  }
  if (lim < lower) { lower = 64; lim = 64; }
  const bool full = (lower <= 0) && (lim >= 63);
  if (!__all(full)) {
    const int lo2 = lower - 4 * hh; const unsigned rng = (unsigned)(lim - lower);
#pragma unroll
    for (int sub = 0; sub < 2; ++sub)
#pragma unroll
      for (int i = 0; i < 16; ++i) {
        const int kc = sub * 32 + (i & 3) + 8 * (i >> 2);
        s[sub][i] = ((unsigned)(kc - lo2) <= rng) ? s[sub][i] : -INFINITY;
      }
  }
  mx = -INFINITY;
#pragma unroll
  for (int sub = 0; sub < 2; ++sub)
#pragma unroll
    for (int i = 0; i < 16; ++i) mx = fmaxf(mx, s[sub][i]);
  mx = fmaxf(mx, __shfl_xor(mx, 32));
}

DI void pv_stage(const f32x16 (&s)[2], const u16* Vts, f32x16 (&o)[2], int lane) {
  const int lr = lane & 31, hh = lane >> 5;
#pragma unroll
  for (int sub = 0; sub < 2; ++sub)
#pragma unroll
    for (int st = 0; st < 2; ++st) {
      uint4 pk;
      pk.x = pack2(s[sub][8 * st + 0], s[sub][8 * st + 1]); pk.y = pack2(s[sub][8 * st + 2], s[sub][8 * st + 3]);
      pk.z = pack2(s[sub][8 * st + 4], s[sub][8 * st + 5]); pk.w = pack2(s[sub][8 * st + 6], s[sub][8 * st + 7]);
      const bf16x8 pf = as_bf16x8(pk);
#pragma unroll
      for (int dt = 0; dt < 2; ++dt) {
        const u16* vp = Vts + (dt * 32 + lr) * VS + sub * 32 + 16 * st + 4 * hh;
        const uint2 lo = *(const uint2*)vp, hi = *(const uint2*)(vp + 8);
        const bf16x8 vf = as_bf16x8(make_uint4(lo.x, lo.y, hi.x, hi.y));
        o[dt] = MFMA32(vf, pf, o[dt]);
      }
    }
}

DI void flash_stage(const bf16x8 (&qf)[4], const u16* Ks, const u16* Vts, f32x16 (&o)[2], float& m, float& l, int lane,
                    float sk, float sb, int lower, int lim) {
  f32x16 s[2]; float mx;
  score_stage(qf, Ks, lane, sk, sb, lower, lim, s, mx);
  const float mn = fmaxf(m, mx);
  const float alpha = fexp2(m - mn);
  const bool same = (mn == m);
  m = mn;
  float ls = 0.f;
#pragma unroll
  for (int sub = 0; sub < 2; ++sub)
#pragma unroll
    for (int i = 0; i < 16; ++i) { const float pv = fexp2(s[sub][i] - mn); s[sub][i] = pv; ls += pv; }
  l = l * alpha + ls;
  if (!__all(same)) {
#pragma unroll
    for (int dt = 0; dt < 2; ++dt)
#pragma unroll
      for (int i = 0; i < 16; ++i) o[dt][i] *= alpha;
  }
  pv_stage(s, Vts, o, lane);
}

DI void dilated_item(const Params& p, int li, int pairitem, char* smem) {
  const int tfull = tidx();
  const int half = tfull >> 8, tid = tfull & 255;
  const int item = pairitem * 2 + half;
  char* kvb = smem + half * (2 * KVBUF);
  const int lane = tid & 63, w = tid >> 6, lr = lane & 31, hh = lane >> 5;
  const int idx16 = item & 15; const int br = (item >> 4) % 3; const int hb = (item / 48) & 7; const int b = item / 384;
  const int d = br == 0 ? 1 : (br == 1 ? 4 : 16);
  const int tile = idx16 / d, resid = idx16 % d;
  const int st0 = (d >= 2 && tile == 0) ? 2 : 0;
  const int u0 = tile * 128;
  const int uq = u0 + 32 * w + lr; const int tq = uq * d + resid;
  const u16* prow = p.proj + (size_t)(b * S_ + tq) * LD_EVEN;
  bf16x8 qf[4];
  load_q(prow + 2048 + hb * 64, p.hy_qg + li * 64, hh, qf);
  const float slope2 = fexp2(-(float)(hb + 1)) * LOG2E;
  const float sk = slope2 * (float)d;
  const u16* kb = p.proj + (size_t)(b * S_ + resid) * LD_EVEN + 2560 + hb * 64;
  const u16* vb = kb + 512;
  const size_t stride = (size_t)d * LD_EVEN;
  const float* kg = p.hy_kg + li * 64;
  f32x16 o[2]; o[0] = zero16(); o[1] = zero16();
  float m = -1e30f, l = 0.f;
  const int uw = u0 + 32 * w;
  KVRegs<256> rg;
  kv_load<256>(tid, kb, vb, stride, u0 - 128 + 64 * st0, 0, 1 << 30, rg);
  __syncthreads();
  kv_store<256>(tid, rg, kg, (u16*)(kvb + (st0 & 1) * KVBUF), (u16*)(kvb + (st0 & 1) * KVBUF) + 64 * 72);
  kv_load<256>(tid, kb, vb, stride, u0 - 64 + 64 * st0, 0, 1 << 30, rg);
  __syncthreads();
#pragma unroll 1
  for (int st = st0; st < 4; ++st) {
    const int ub = u0 - 128 + 64 * st;
    u16* Ks = (u16*)(kvb + (st & 1) * KVBUF); u16* Vts = Ks + 64 * 72;
    if (st + 1 < 4) { u16* Kn = (u16*)(kvb + ((st + 1) & 1) * KVBUF); kv_store<256>(tid, rg, kg, Kn, Kn + 64 * 72); }
    if (st + 2 < 4) kv_load<256>(tid, kb, vb, stride, ub + 128, 0, 1 << 30, rg);
    if (ub + 63 >= 0 && ub <= uw + 31 && ub + 63 >= uw - 128) {
      const int lim = uq - ub;
      const int lower = max(lim - 128, -ub);
      const float sb = slope2 * (float)(ub * d + resid) + sk * (float)(4 * hh);
      flash_stage(qf, Ks, Vts, o, m, l, lane, sk, sb, lower, lim);
    }
    __syncthreads();
  }
  const float lt = l + __shfl_xor(l, 32);
  const float inv = 1.f / lt;
  const size_t trow = (size_t)br * T_ + (size_t)b * S_ + tq;
  if (hh == 0) p.lse[trow * 8 + hb] = (m + log2f(lt)) * LN2;
  u16* orow = p.obr + trow * 512 + hb * 64;
#pragma unroll
  for (int dt = 0; dt < 2; ++dt)
#pragma unroll
    for (int q4 = 0; q4 < 4; ++q4) {
      uint2 ov; ov.x = pack2(o[dt][4 * q4] * inv, o[dt][4 * q4 + 1] * inv); ov.y = pack2(o[dt][4 * q4 + 2] * inv, o[dt][4 * q4 + 3] * inv);
      *(uint2*)(orow + dt * 32 + 8 * q4 + 4 * hh) = ov;
    }
}

DI void post_even_phase(const Params& p, int li) {
  const int tid = tidx();
  const int rsel = tid >> 7, c8 = tid & 127;
  const int c = c8 * 8;
  const int nit = T_ / 4, step = gridDim.x;
  int it = blockIdx.x;
  if (c8 < 64) {
    float og[8];
#pragma unroll
    for (int j = 0; j < 8; ++j) og[j] = p.hy_og[li * 512 + c + j];
    u32x4v raw = {0u, 0u, 0u, 0u}, graw = {0u, 0u, 0u, 0u}, nraw = raw, ngraw = raw;
    if (it < nit) { const int t = it * 4 + rsel; raw = *(const u32x4v*)(p.hbuf + (size_t)t * 1024 + c); graw = *(const u32x4v*)(p.proj + (size_t)t * LD_EVEN + 1536 + c); }
    while (it < nit) {
      const int t = it * 4 + rsel, itn = it + step;
      if (itn < nit) { const int tn = itn * 4 + rsel; nraw = *(const u32x4v*)(p.hbuf + (size_t)tn * 1024 + c); ngraw = *(const u32x4v*)(p.proj + (size_t)tn * LD_EVEN + 1536 + c); }
      float o[8], gt[8], val[8];
      unpack8(make_uint4(raw[0], raw[1], raw[2], raw[3]), o); unpack8(make_uint4(graw[0], graw[1], graw[2], graw[3]), gt);
      float ss = 0.f;
#pragma unroll
      for (int j = 0; j < 8; ++j) ss += o[j] * o[j];
      ss += __shfl_xor(ss, 1); ss += __shfl_xor(ss, 2); ss += __shfl_xor(ss, 4); ss += __shfl_xor(ss, 8);
      const float rs = rsqrtf(ss * (1.f / 128.f) + EPSF);
#pragma unroll
      for (int j = 0; j < 8; ++j) val[j] = o[j] * rs * og[j] * fsilu(gt[j]);
      *(uint4*)(p.hbuf + (size_t)t * 1024 + c) = pack8(val);
      raw = nraw; graw = ngraw; it = itn;
    }
  } else {
    const int cb = c - 512, hb = cb >> 6;
    float l0 = 0.f, l1 = 0.f, l2 = 0.f, nl0 = 0.f, nl1 = 0.f, nl2 = 0.f;
    u32x4v a4 = {0u, 0u, 0u, 0u}, b4 = a4, c4 = a4, na4 = a4, nb4 = a4, nc4 = a4;
    if (it < nit) {
      const size_t t = (size_t)(it * 4 + rsel);
      l0 = p.lse[(t) * 8 + hb]; l1 = p.lse[((size_t)T_ + t) * 8 + hb]; l2 = p.lse[((size_t)2 * T_ + t) * 8 + hb];
      a4 = *(const u32x4v*)(p.obr + t * 512 + cb); b4 = *(const u32x4v*)(p.obr + ((size_t)T_ + t) * 512 + cb); c4 = *(const u32x4v*)(p.obr + ((size_t)2 * T_ + t) * 512 + cb);
    }
    while (it < nit) {
      const int t = it * 4 + rsel, itn = it + step;
      if (itn < nit) {
        const size_t tn = (size_t)(itn * 4 + rsel);
        nl0 = p.lse[(tn) * 8 + hb]; nl1 = p.lse[((size_t)T_ + tn) * 8 + hb]; nl2 = p.lse[((size_t)2 * T_ + tn) * 8 + hb];
        na4 = *(const u32x4v*)(p.obr + tn * 512 + cb); nb4 = *(const u32x4v*)(p.obr + ((size_t)T_ + tn) * 512 + cb); nc4 = *(const u32x4v*)(p.obr + ((size_t)2 * T_ + tn) * 512 + cb);
      }
      const float mx = fmaxf(l0, fmaxf(l1, l2));
      float w0 = __expf(l0 - mx), w1 = __expf(l1 - mx), w2 = __expf(l2 - mx);
      const float inv = 1.f / (w0 + w1 + w2);
      w0 *= inv; w1 *= inv; w2 *= inv;
      float a[8], bq[8], cq[8], val[8];
      unpack8(make_uint4(a4[0], a4[1], a4[2], a4[3]), a); unpack8(make_uint4(b4[0], b4[1], b4[2], b4[3]), bq); unpack8(make_uint4(c4[0], c4[1], c4[2], c4[3]), cq);
#pragma unroll
      for (int j = 0; j < 8; ++j) val[j] = w0 * a[j] + w1 * bq[j] + w2 * cq[j];
      *(uint4*)(p.hbuf + (size_t)t * 1024 + c) = pack8(val);
      l0 = nl0; l1 = nl1; l2 = nl2; a4 = na4; b4 = nb4; c4 = nc4; it = itn;
    }
  }
}

DI void compress_item(const Params& p, int li, int pairitem, char* smem) {
  const int tfull = tidx();
  const int half = tfull >> 8, tid = tfull & 255;
  const int item = pairitem * 2 + half;
  u16* hs = (u16*)(smem + half * 17408);
  float* outs = (float*)(smem + half * 17408 + 32 * 136 * 2);
  const int lane = tid & 63, w = tid >> 6, lr = lane & 31, hh = lane >> 5;
  const int nt = item & 3, g = (item >> 2) & 3, b = (item >> 4) & 15, kv = item >> 8;
  const int n = nt * 32 + lr; const int nc = n > 126 ? 126 : n;
  const int col = 1024 + kv * 256 + g * 64;
  const u16* arow = p.proj + (size_t)(b * S_ + 16 * nc) * LD_ODD + col;
  const u16* w1t = p.wt_c1 + (size_t)(li * 2 + kv) * 128 * 2048 + (size_t)(32 * w + lr) * 2048;
  f32x16 acc = zero16();
#pragma unroll 1
  for (int k0 = 0; k0 < 128; k0 += 8) {
    u32x4v fa[8], fb[8];
#pragma unroll
    for (int j = 0; j < 8; ++j) {
      const int ks = k0 + j;
      const int lidx = ks >> 2, dd = (ks & 3) * 16 + hh * 8;
      fa[j] = *(const u32x4v*)(arow + (size_t)lidx * LD_ODD + dd);
      fb[j] = *(const u32x4v*)(w1t + ks * 16 + hh * 8);
    }
    asm volatile("" ::: "memory");
#pragma unroll
    for (int j = 0; j < 8; ++j) acc = MFMA32(__builtin_bit_cast(bf16x8, fa[j]), __builtin_bit_cast(bf16x8, fb[j]), acc);
  }
  const float cb = p.c1[(li * 2 + kv) * 128 + 32 * w + lr];
  __syncthreads();
#pragma unroll
  for (int i = 0; i < 16; ++i) {
    const int r = (i & 3) + 8 * (i >> 2) + 4 * hh;
    hs[r * 136 + 32 * w + lr] = f2bf(fsilu(acc[i] + cb));
  }
  __syncthreads();
  if (w < 2) {
    const u16* w2t = p.wt_c2 + (size_t)(li * 2 + kv) * 64 * 128 + (size_t)(w * 32 + lr) * 128;
    f32x16 a2 = zero16();
    u32x4v fb2[8];
#pragma unroll
    for (int kk = 0; kk < 8; ++kk) fb2[kk] = *(const u32x4v*)(w2t + kk * 16 + hh * 8);
    asm volatile("" ::: "memory");
#pragma unroll
    for (int kk = 0; kk < 8; ++kk) {
      const bf16x8 a = *(const bf16x8*)(hs + lr * 136 + kk * 16 + hh * 8);
      a2 = MFMA32(a, __builtin_bit_cast(bf16x8, fb2[kk]), a2);
    }
#pragma unroll
    for (int i = 0; i < 16; ++i) {
      const int r = (i & 3) + 8 * (i >> 2) + 4 * hh;
      outs[r * 65 + w * 32 + lr] = a2[i];
    }
  }
  __syncthreads();
  {
    const int r = tid >> 3, c8 = tid & 7;
    float v[8]; float ss = 0.f;
#pragma unroll
    for (int j = 0; j < 8; ++j) { v[j] = outs[r * 65 + c8 * 8 + j]; ss += v[j] * v[j]; }
    ss += __shfl_xor(ss, 1); ss += __shfl_xor(ss, 2); ss += __shfl_xor(ss, 4);
    if (kv == 0) {
      const float rs = rsqrtf(ss * (1.f / 64.f) + EPSF);
#pragma unroll
      for (int j = 0; j < 8; ++j) v[j] *= rs * p.nsa_kg[(li * 3 + 0) * 64 + c8 * 8 + j];
    }
    const int nn = nt * 32 + r;
    if (nn >= 127) {
#pragma unroll
      for (int j = 0; j < 8; ++j) v[j] = 0.f;
    }
    u16* dst = (kv == 0 ? p.kcmp : p.vcmp) + ((size_t)(b * 4 + g) * 128 + nn) * 64 + c8 * 8;
    *(uint4*)dst = pack8(v);
  }
  __syncthreads();
}

DI void nsa_knorm_phase(const Params& p, int li) {
  const int tid = tidx();
  for (int u0 = blockIdx.x * NT + tid; u0 < T_ * 64; u0 += gridDim.x * NT * 4) {
    u32x4v raw[4];
#pragma unroll
    for (int q = 0; q < 4; ++q) {
      const int u = u0 + q * gridDim.x * NT;
      const int piece = u & 7, head = (u >> 3) & 3, br = (u >> 5) & 1, row = u >> 6;
      raw[q] = *(const u32x4v*)(p.proj + (size_t)row * LD_ODD + 1536 + br * 512 + head * 64 + piece * 8);
    }
    asm volatile("" ::: "memory");
#pragma unroll
    for (int q = 0; q < 4; ++q) {
      const int u = u0 + q * gridDim.x * NT;
      const int piece = u & 7, head = (u >> 3) & 3, br = (u >> 5) & 1, row = u >> 6;
      float f[8]; unpack8(make_uint4(raw[q][0], raw[q][1], raw[q][2], raw[q][3]), f);
      float ss = 0.f;
#pragma unroll
      for (int e = 0; e < 8; ++e) ss += f[e] * f[e];
      ss += __shfl_xor(ss, 1); ss += __shfl_xor(ss, 2); ss += __shfl_xor(ss, 4);
      const float rs = rsqrtf(ss * (1.f / 64.f) + EPSF);
      const float* kg = p.nsa_kg + (li * 3 + 1 + br) * 64 + piece * 8;
#pragma unroll
      for (int e = 0; e < 8; ++e) f[e] *= rs * kg[e];
      *(uint4*)(p.proj + (size_t)row * LD_ODD + 1536 + br * 512 + head * 64 + piece * 8) = pack8(f);
    }
  }
}

DI void nsa_item(const Params& p, int li, int item, char* smem) {
  float* impA = (float*)(smem + 2 * KVBUF);
  float* impB = impA + 8448;
  float* imp = impB + 8448;
  unsigned* selm = (unsigned*)(imp + 64 * 33);
  const int tid = tidx(), lane = tid & 63, wv = tid >> 6, lr = lane & 31, hh = lane >> 5;
  const int w = lr & 3;
  const int tt = item & 31, g = (item >> 5) & 3, b = item >> 7;
  const int t0 = tt * 64; const int cur = t0 >> 6;
  const int hd = g * 4 + w;
  const int tokl = 8 * wv + (lr >> 2);
  const int tq = t0 + tokl;
  const u16* pb = p.proj + (size_t)b * S_ * LD_ODD;
  const u16* prow = pb + (size_t)tq * LD_ODD;
  bf16x8 qf[4];
  load_q(prow + g * 256 + w * 64, p.nsa_qg + li * 64, hh, qf);
  const float slope2 = fexp2(-0.5f * (float)(hd + 1)) * LOG2E;
  const float g0 = fsigmoid(bf2f(prow[2560 + 0 + g * 4 + w]));
  const float g1 = fsigmoid(bf2f(prow[2560 + 16 + g * 4 + w]));
  const float g2 = fsigmoid(bf2f(prow[2560 + 32 + g * 4 + w]));
  f32x16 ot[2]; ot[0] = zero16(); ot[1] = zero16();
  {
    const u16* kb = p.kcmp + (size_t)(b * 4 + g) * 128 * 64;
    const u16* vb = p.vcmp + (size_t)(b * 4 + g) * 128 * 64;
    const float sk = 16.f * slope2;
    const int limc = min((tq - 31) >> 4, 126);
    const int nst = (1024 > t0) ? 1 : 2;
    {
      KVRegs<512> rg0;
      kv_load<512>(tid, kb, vb, 64, 0, 0, 128, rg0);
      __syncthreads();
      kv_store<512>(tid, rg0, nullptr, (u16*)smem, (u16*)smem + 64 * 72);
      if (nst > 1) {
        kv_load<512>(tid, kb, vb, 64, 64, 0, 128, rg0);
        kv_store<512>(tid, rg0, nullptr, (u16*)(smem + KVBUF), (u16*)(smem + KVBUF) + 64 * 72);
      }
    }
    __syncthreads();
    float m = -1e30f, l = 0.f;
#pragma unroll
    for (int st = 0; st < 2; ++st) {
      if (st >= nst) continue;
      const u16* Ks = (const u16*)(smem + st * KVBUF);
      f32x16 s[2]; float mx;
      const float sb = slope2 * (float)(1024 * st + 31) + sk * (float)(4 * hh);
      score_stage(qf, Ks, lane, sk, sb, 0, limc - 64 * st, s, mx);
      const float mn = fmaxf(m, mx);
      float ls = 0.f;
#pragma unroll
      for (int sub = 0; sub < 2; ++sub)
#pragma unroll
        for (int i = 0; i < 16; ++i) ls += fexp2(s[sub][i] - mn);
      l = l * fexp2(m - mn) + ls;
      m = mn;
    }
    const float lt = l + __shfl_xor(l, 32);
    const float inv = lt > 0.f ? 1.f / lt : 0.f;
    f32x16 o[2]; o[0] = zero16(); o[1] = zero16();
#pragma unroll
    for (int st = 0; st < 2; ++st) {
      if (st >= nst) {
#pragma unroll
        for (int G = 0; G < 16; ++G) {
          if ((G & 1) == hh) { impA[(w * 64 + tokl) * 33 + 16 * st + G] = 0.f; impB[(w * 64 + tokl) * 33 + 16 * st + G] = 0.f; }
        }
        continue;
      }
      const u16* Ks = (const u16*)(smem + st * KVBUF); const u16* Vts = Ks + 64 * 72;
      f32x16 s[2]; float mx;
      const float sb = slope2 * (float)(1024 * st + 31) + sk * (float)(4 * hh);
      score_stage(qf, Ks, lane, sk, sb, 0, limc - 64 * st, s, mx);
#pragma unroll
      for (int sub = 0; sub < 2; ++sub)
#pragma unroll
        for (int i = 0; i < 16; ++i) s[sub][i] = fexp2(s[sub][i] - m) * inv;
#pragma unroll
      for (int sub = 0; sub < 2; ++sub)
#pragma unroll
        for (int q4 = 0; q4 < 4; ++q4) {
          const int G = 16 * st + 8 * sub + 2 * q4 + hh;
          impA[(w * 64 + tokl) * 33 + G] = (s[sub][4 * q4] + s[sub][4 * q4 + 1]) + (s[sub][4 * q4 + 2] + s[sub][4 * q4 + 3]);
          impB[(w * 64 + tokl) * 33 + G] = s[sub][4 * q4 + 3];
        }
      pv_stage(s, Vts, o, lane);
    }
#pragma unroll
    for (int dt = 0; dt < 2; ++dt)
#pragma unroll
      for (int i = 0; i < 16; ++i) ot[dt][i] += g0 * o[dt][i];
  }
  const u16* kbs = pb + 1536 + g * 64; const u16* vbs = pb + 1792 + g * 64;
  KVRegs<512> rg;
  kv_load<512>(tid, kbs, vbs, LD_ODD, 0, 0, S_, rg);
  __syncthreads();
  for (int idx = tid; idx < 2048; idx += NT) {
    const int tok = idx >> 5, mm = idx & 31;
    float a = 0.f;
#pragma unroll
    for (int ww = 0; ww < 4; ++ww) a += impA[(ww * 64 + tok) * 33 + mm] + (mm > 0 ? impB[(ww * 64 + tok) * 33 + mm - 1] : 0.f);
    imp[tok * 33 + mm] = a;
  }
  __syncthreads();
  float* ots = impA + tid;
#pragma unroll
  for (int dt = 0; dt < 2; ++dt)
#pragma unroll
    for (int i = 0; i < 16; ++i) ots[(dt * 16 + i) * NT] = ot[dt][i];
  {
    const int tok = tid >> 3, sub8 = tid & 7;
    unsigned sel = 1u | (1u << cur) | (cur > 0 ? (1u << (cur - 1)) : 0u);
    const int cnt = __popc(sel);
    float cv[4];
#pragma unroll
    for (int e = 0; e < 4; ++e) cv[e] = imp[tok * 33 + sub8 * 4 + e];
    for (int r = cnt; r < 8; ++r) {
      float bv = -1.f; int bi = 64;
#pragma unroll
      for (int e = 0; e < 4; ++e) {
        const int mm = sub8 * 4 + e;
        const bool ok = (mm <= cur) && !((sel >> mm) & 1u);
        if (ok && cv[e] > bv) { bv = cv[e]; bi = mm; }
      }
#pragma unroll
      for (int off = 1; off < 8; off <<= 1) {
        const float ov = __shfl_xor(bv, off); const int oi = __shfl_xor(bi, off);
        if (ov > bv || (ov == bv && oi < bi)) { bv = ov; bi = oi; }
      }
      if (bi < 64) sel |= 1u << bi;
    }
    if (sub8 == 0) selm[tok] = sel;
  }
  __syncthreads();
  const unsigned myMask = selm[tokl];
  unsigned uni = 0u;
#pragma unroll 8
  for (int i = 0; i < 64; ++i) uni |= selm[i];
  {
    f32x16 o[2]; o[0] = zero16(); o[1] = zero16();
    float m = -1e30f, l = 0.f;
    const float* kg = nullptr;
    unsigned rem = uni & (uni - 1u);
    int mb = 0;
    int mbn = rem ? __builtin_ctz(rem) : -1;
    kv_store<512>(tid, rg, kg, (u16*)smem, (u16*)smem + 64 * 72);
    if (mbn >= 0) kv_load<512>(tid, kbs, vbs, LD_ODD, 64 * mbn, 0, S_, rg);
    __syncthreads();
    int par = 0;
#pragma unroll 1
    while (true) {
      u16* Ks = (u16*)(smem + par * KVBUF); u16* Vts = Ks + 64 * 72;
      int mbn2 = -1;
      if (mbn >= 0) {
        u16* Kn = (u16*)(smem + (par ^ 1) * KVBUF);
        kv_store<512>(tid, rg, kg, Kn, Kn + 64 * 72);
        rem &= rem - 1u;
        mbn2 = rem ? __builtin_ctz(rem) : -1;
        if (mbn2 >= 0) kv_load<512>(tid, kbs, vbs, LD_ODD, 64 * mbn2, 0, S_, rg);
      }
      const bool selb = (myMask >> mb) & 1u;
      const float sb = slope2 * (float)(64 * mb) + slope2 * (float)(4 * hh);
      if (__any(selb)) flash_stage(qf, Ks, Vts, o, m, l, lane, slope2, sb, 0, selb ? (tq - 64 * mb) : -1);
      __syncthreads();
      if (mbn < 0) break;
      mb = mbn; mbn = mbn2; par ^= 1;
    }
    const float lt = l + __shfl_xor(l, 32);
    const float sc = g1 / lt;
#pragma unroll
    for (int dt = 0; dt < 2; ++dt)
#pragma unroll
      for (int i = 0; i < 16; ++i) ots[(dt * 16 + i) * NT] += sc * o[dt][i];
  }
  {
    f32x16 o[2]; o[0] = zero16(); o[1] = zero16();
    float m = -1e30f, l = 0.f;
    const u16* kb = pb + 2048 + g * 64; const u16* vb = pb + 2304 + g * 64;
    const float* kg = nullptr;
    const int mlo = (t0 - 511) < 0 ? 0 : ((t0 - 511) >> 6);
    kv_load<512>(tid, kb, vb, LD_ODD, 64 * mlo, 0, S_, rg);
    kv_store<512>(tid, rg, kg, (u16*)smem, (u16*)smem + 64 * 72);
    if (mlo + 1 <= cur) kv_load<512>(tid, kb, vb, LD_ODD, 64 * (mlo + 1), 0, S_, rg);
    __syncthreads();
#pragma unroll 1
    for (int mb = mlo; mb <= cur; ++mb) {
      const int par = (mb - mlo) & 1;
      u16* Ks = (u16*)(smem + par * KVBUF); u16* Vts = Ks + 64 * 72;
      if (mb + 1 <= cur) { u16* Kn = (u16*)(smem + (par ^ 1) * KVBUF); kv_store<512>(tid, rg, kg, Kn, Kn + 64 * 72); }
      if (mb + 2 <= cur) kv_load<512>(tid, kb, vb, LD_ODD, 64 * (mb + 2), 0, S_, rg);
      const int lim = tq - 64 * mb;
      const float sb = slope2 * (float)(64 * mb) + slope2 * (float)(4 * hh);
      flash_stage(qf, Ks, Vts, o, m, l, lane, slope2, sb, lim - 511, lim);
      __syncthreads();
    }
    const float lt = l + __shfl_xor(l, 32);
    const float sc = g2 / lt;
    u16* orow = p.hbuf + (size_t)(b * S_ + tq) * 1024 + g * 256 + w * 64;
#pragma unroll
    for (int dt = 0; dt < 2; ++dt)
#pragma unroll
      for (int q4 = 0; q4 < 4; ++q4) {
        const float a0 = ots[(dt * 16 + 4 * q4 + 0) * NT] + sc * o[dt][4 * q4 + 0], a1 = ots[(dt * 16 + 4 * q4 + 1) * NT] + sc * o[dt][4 * q4 + 1];
        const float a2 = ots[(dt * 16 + 4 * q4 + 2) * NT] + sc * o[dt][4 * q4 + 2], a3 = ots[(dt * 16 + 4 * q4 + 3) * NT] + sc * o[dt][4 * q4 + 3];
        uint2 ov; ov.x = pack2(a0, a1); ov.y = pack2(a2, a3);
        *(uint2*)(orow + dt * 32 + 8 * q4 + 4 * hh) = ov;
      }
  }
  __syncthreads();
}

DI void run_phase(const Params& p, int ph, char* smem) {
  if (ph == 0) { prep_phase(p, smem); return; }
  const int l = (ph - 1) >> 3, s = (ph - 1) & 7, li = l >> 1;
  const bool even = (l & 1) == 0;
  const float* xin = (l == 0) ? p.x : p.out;
  switch (s) {
    case 0: rmsnorm_phase(xin, p.attn_norm + l * 1024, p.hbuf); break;
    case 1:
      if (even) gemm_phase<0>(p.hbuf, p.wt_hy_in + (size_t)li * 3584 * 1024, 1024, 14, p.proj, LD_EVEN, nullptr, nullptr, smem);
      else gemm_phase<0>(p.hbuf, p.wt_nsa_in + (size_t)li * 2816 * 1024, 1024, 11, p.proj, LD_ODD, nullptr, nullptr, smem);
      break;
    case 2:
      if (even) {
        for (int item = blockIdx.x; item < 256 + 3072; item += gridDim.x) {
          if (item < 256) hgrn_item(p, li, item, smem); else dilated_item(p, li, item - 256, smem);
        }
      } else {
        for (int item = blockIdx.x; item < 256; item += gridDim.x) compress_item(p, li, item, smem);
        nsa_knorm_phase(p, li);
      }
      break;
    case 3:
      if (even) post_even_phase(p, li);
      else {
        for (int item = blockIdx.x; item < 2048; item += gridDim.x) {
          const int r = item / gridDim.x, i = item % gridDim.x;
          int it2 = item;
          if (gridDim.x == 256) {
            const int c = (i + 4 * (r >> 1)) & 31;
            const int tt = (r & 1) ? 31 - c : c;
            it2 = ((i >> 5) + 8 * r) * 32 + tt;
          }
          nsa_item(p, li, it2, smem);
        }
      }
      break;
    case 4:
      gemm_phase<1>(p.hbuf, (even ? p.wt_hy_out : p.wt_nsa_out) + (size_t)li * 1048576, 1024, 4, nullptr, 0, xin, p.out, smem);
      break;
    case 5: rmsnorm_phase(p.out, p.ffn_norm + l * 1024, p.hbuf); break;
    case 6: gemm_phase<2>(p.hbuf, p.wt_gu + (size_t)l * 5632 * 1024, 1024, 22, p.proj, DFF, nullptr, nullptr, smem); break;
    case 7: gemm_phase<1>(p.proj, p.wt_dn + (size_t)l * 1024 * 2816, 2816, 4, nullptr, 0, p.out, p.out, smem, true); break;
  }
}

constexpr int DYN_LDS = 131072;
extern __shared__ __attribute__((aligned(16))) char dyn_smem[];
__global__ void __launch_bounds__(512) mk_forward(Params p) {
  char* smem = dyn_smem;
  __shared__ uint4 xb_words;
  cg::grid_group grid = cg::this_grid();
  if (__builtin_amdgcn_workitem_id_x() == 0) xb_words = make_uint4(0u, 0u, 0u, 0u);
  __syncthreads();
  const XcdBarrier xb = xcd_barrier_post(p.bar, (volatile LAS unsigned*)&xb_words);
  for (int ph = p.phase_lo; ph < p.phase_hi; ++ph) {
    run_phase(p, ph, smem);
    if (ph + 1 < p.phase_hi) {
      if (p.phase_hi < 0) grid.sync();
      xcd_barrier(xb);
    }
  }
}

extern "C" void kernel_launch(void* const* d_in, const int* in_sizes, int n_in, void* d_out, int out_size,
                              void* d_ws, size_t ws_size, hipStream_t stream) {
  static int grid_blocks = 0;
  if (!grid_blocks) {
    int dev = 0, cus = 0, per_cu = 0;
    hipGetDevice(&dev);
    hipDeviceGetAttribute(&cus, hipDeviceAttributeMultiprocessorCount, dev);
    hipFuncSetAttribute((const void*)mk_forward, hipFuncAttributeMaxDynamicSharedMemorySize, DYN_LDS);
    hipOccupancyMaxActiveBlocksPerMultiprocessor(&per_cu, mk_forward, 512, DYN_LDS);
    if (per_cu > 1) per_cu = 1;
    if (per_cu < 1) per_cu = 1;
    grid_blocks = cus * per_cu;
  }
  Params p;
  memset(&p, 0, sizeof(p));
  p.x = (const float*)d_in[0]; p.attn_norm = (const float*)d_in[1]; p.ffn_norm = (const float*)d_in[2];
  p.hy_w_in = (const float*)d_in[3]; p.hy_lb = (const float*)d_in[4]; p.hy_og = (const float*)d_in[5];
  p.hy_qg = (const float*)d_in[6]; p.hy_kg = (const float*)d_in[7]; p.hy_w_out = (const float*)d_in[8];
  p.nsa_w_in = (const float*)d_in[9]; p.nsa_qg = (const float*)d_in[10]; p.nsa_kg = (const float*)d_in[11];
  p.cmp_pe = (const float*)d_in[12]; p.cmp_w1 = (const float*)d_in[13]; p.cmp_w2 = (const float*)d_in[14];
  p.nsa_w_out = (const float*)d_in[15]; p.ffn_g = (const float*)d_in[16]; p.ffn_u = (const float*)d_in[17]; p.ffn_d = (const float*)d_in[18];
  p.out = (float*)d_out;
  char* ws = (char*)d_ws; size_t off = 0;
  auto take = [&](size_t bytes) { char* r = ws + off; off += (bytes + 255) & ~(size_t)255; return r; };
  p.wt_hy_in = (u16*)take((size_t)2 * 3584 * 1024 * 2);
  p.wt_hy_out = (u16*)take((size_t)2 * 1048576 * 2);
  p.wt_nsa_in = (u16*)take((size_t)2 * 2816 * 1024 * 2);
  p.wt_nsa_out = (u16*)take((size_t)2 * 1048576 * 2);
  p.wt_gu = (u16*)take((size_t)4 * 5632 * 1024 * 2);
  p.wt_dn = (u16*)take((size_t)4 * 1024 * 2816 * 2);
  p.wt_c1 = (u16*)take((size_t)4 * 128 * 2048 * 2);
  p.wt_c2 = (u16*)take((size_t)4 * 64 * 128 * 2);
  p.c1 = (float*)take(4 * 128 * 4);
  p.lb = (float*)take(2 * 512 * 4);
  p.lse = (float*)take((size_t)3 * T_ * 8 * 4);
  p.proj = (u16*)take((size_t)T_ * 3584 * 2);
  p.hbuf = (u16*)take((size_t)T_ * 1024 * 2);
  p.obr = (u16*)take((size_t)3 * T_ * 512 * 2);
  p.kcmp = (u16*)take((size_t)16 * 4 * 128 * 64 * 2);
  p.vcmp = (u16*)take((size_t)16 * 4 * 128 * 64 * 2);
  p.bar = (unsigned*)take(XCD_BAR_WORDS * 4);
  if (off > ws_size) { fprintf(stderr, "workspace too small: need %zu have %zu\n", off, ws_size); return; }
  const int NPH = 33;
  hipMemsetAsync(p.bar, 0, XCD_BAR_WORDS * 4, stream);
#if MK_MULTI
  for (int ph = 0; ph < NPH; ++ph) {
    p.phase_lo = ph; p.phase_hi = ph + 1;
    hipLaunchKernelGGL(mk_forward, dim3(grid_blocks), dim3(512), DYN_LDS, stream, p);
  }
#else
  p.phase_lo = 0; p.phase_hi = NPH;
  void* args[] = {&p};
  hipError_t e = hipLaunchCooperativeKernel((void*)mk_forward, dim3(grid_blocks), dim3(512), args, DYN_LDS, stream);
  if (e != hipSuccess) fprintf(stderr, "cooperative launch failed: %s (grid %d)\n", hipGetErrorString(e), grid_blocks);
#endif
}
```

```cpp
#include <hip/hip_runtime.h>
#include <hip/hip_cooperative_groups.h>
#include <cstdio>
#include <cstdint>
#include <cstring>
namespace cg = cooperative_groups;

typedef unsigned short u16;
using bf16x8 = __attribute__((ext_vector_type(8))) short;
using f32x16 = __attribute__((ext_vector_type(16))) float;
using u32x4v = __attribute__((ext_vector_type(4))) unsigned;
#define DI __device__ __forceinline__
#define MFMA32(a, b, c) __builtin_amdgcn_mfma_f32_32x32x16_bf16((a), (b), (c), 0, 0, 0)

#ifndef MK_MULTI
#define MK_MULTI 0
#endif

constexpr int T_ = 32768, S_ = 2048;
constexpr float EPSF = 1e-6f;
constexpr float LOG2E = 1.4426950408889634f, LN2 = 0.6931471805599453f;
constexpr int LD_EVEN = 3584, LD_ODD = 2816, DFF = 2816;
constexpr int NT = 512;
#define LAS __attribute__((address_space(3)))
using f32x4v = __attribute__((ext_vector_type(4))) float;

struct Params {
  const float* x; const float* attn_norm; const float* ffn_norm;
  const float* hy_w_in; const float* hy_lb; const float* hy_og; const float* hy_qg; const float* hy_kg; const float* hy_w_out;
  const float* nsa_w_in; const float* nsa_qg; const float* nsa_kg; const float* cmp_pe; const float* cmp_w1; const float* cmp_w2; const float* nsa_w_out;
  const float* ffn_g; const float* ffn_u; const float* ffn_d;
  float* out;
  u16* wt_hy_in; u16* wt_hy_out; u16* wt_nsa_in; u16* wt_nsa_out; u16* wt_gu; u16* wt_dn; u16* wt_c1; u16* wt_c2;
  float* c1; float* lb; float* lse;
  u16* proj; u16* hbuf; u16* obr; u16* kcmp; u16* vcmp;
  unsigned* bar;
  int phase_lo; int phase_hi;
};

DI int tidx() { int t = __builtin_amdgcn_workitem_id_x(); asm volatile("" : "+v"(t)); return t; }
DI float bf2f(u16 h) { return __uint_as_float(((unsigned)h) << 16); }
typedef __bf16 bf16x2_t __attribute__((ext_vector_type(2)));
typedef float f32x2_t __attribute__((ext_vector_type(2)));
DI unsigned pack2(float a, float b) { f32x2_t v = {a, b}; bf16x2_t r = __builtin_convertvector(v, bf16x2_t); return __builtin_bit_cast(unsigned, r); }
DI u16 f2bf(float x) { return (u16)(pack2(x, 0.f) & 0xffffu); }
DI float fsigmoid(float x) { return __builtin_amdgcn_rcpf(1.f + __expf(-x)); }
DI float fsilu(float x) { return x * __builtin_amdgcn_rcpf(1.f + __expf(-x)); }
DI float fexp2(float x) { return __builtin_amdgcn_exp2f(x); }
DI void unpack8(uint4 v, float (&f)[8]) {
  f[0] = __uint_as_float(v.x << 16); f[1] = __uint_as_float(v.x & 0xffff0000u);
  f[2] = __uint_as_float(v.y << 16); f[3] = __uint_as_float(v.y & 0xffff0000u);
  f[4] = __uint_as_float(v.z << 16); f[5] = __uint_as_float(v.z & 0xffff0000u);
  f[6] = __uint_as_float(v.w << 16); f[7] = __uint_as_float(v.w & 0xffff0000u);
}
DI uint4 pack8(const float (&f)[8]) {
  uint4 o; o.x = pack2(f[0], f[1]); o.y = pack2(f[2], f[3]); o.z = pack2(f[4], f[5]); o.w = pack2(f[6], f[7]); return o;
}
DI bf16x8 as_bf16x8(uint4 v) { u32x4v t; t[0] = v.x; t[1] = v.y; t[2] = v.z; t[3] = v.w; return __builtin_bit_cast(bf16x8, t); }
DI f32x16 zero16() { f32x16 z;
#pragma unroll
  for (int i = 0; i < 16; ++i) z[i] = 0.f; return z; }


#define XB_TMO      128
#define XB_XCNT(j)  (256  + 64 * (j))
#define XB_XSUB(j)  (1280 + 64 * (j))
#define XB_XGEN(j)  (2304 + 64 * (j))
#define XB_TOP      3328
#define XB_TOPGEN   3392
#define XCD_BAR_WORDS 3456
#define XB_SPIN_CAP (1u << 18)
DI unsigned xb_ld(unsigned* p) { return __hip_atomic_load(p, __ATOMIC_RELAXED, __HIP_MEMORY_SCOPE_AGENT); }
DI unsigned xb_add(unsigned* p, unsigned v) { return __hip_atomic_fetch_add(p, v, __ATOMIC_RELAXED, __HIP_MEMORY_SCOPE_AGENT); }
DI unsigned xb_xcc_id() { return (unsigned)__builtin_amdgcn_s_getreg((3 << 11) | 20) & 0xFu; }
#define XB_SPIN(cond, bar) do { unsigned _sp = 0; while (cond) { __builtin_amdgcn_s_sleep(1); \
    if ((++_sp & 255u) == 0u) { if (xb_ld(&(bar)[XB_TMO])) break; if (_sp > XB_SPIN_CAP) { atomicAdd(&(bar)[XB_TMO], 1u); break; } } } } while (0)
struct XcdBarrier { unsigned* bar; unsigned x; volatile LAS unsigned* st; };
DI XcdBarrier xcd_barrier_post(unsigned* bar, volatile LAS unsigned* st) {
  XcdBarrier b; b.bar = bar; b.x = xb_xcc_id(); b.st = st;
  if (__builtin_amdgcn_workitem_id_x() == 0) (void)xb_add(&bar[XB_XCNT(b.x)], 1u);
  return b;
}
DI void xcd_barrier_complete(unsigned* bar, unsigned x, unsigned& nloc, unsigned& nx) {
  const unsigned G = gridDim.x * gridDim.y * gridDim.z;
  unsigned sum, cnt, mine, sp = 0u;
  for (;;) {
    sum = 0u; cnt = 0u; mine = 0u;
#pragma unroll
    for (unsigned j = 0; j < 16; ++j) { const unsigned c = xb_ld(&bar[XB_XCNT(j)]); sum += c; cnt += (c > 0u) ? 1u : 0u; mine = (j == x) ? c : mine; }
    if (sum == G) break;
    __builtin_amdgcn_s_sleep(1);
    if ((++sp & 255u) == 0u) { if (xb_ld(&bar[XB_TMO])) break; if (sp > XB_SPIN_CAP) { atomicAdd(&bar[XB_TMO], 1u); break; } }
  }
  nloc = mine > 0u ? mine : 1u; nx = cnt > 0u ? cnt : 1u;
}
DI void xcd_barrier(const XcdBarrier& b) {
  asm volatile("s_waitcnt vmcnt(0)" ::: "memory");
  __syncthreads();
  if (__builtin_amdgcn_workitem_id_x() == 0) {
    unsigned* bar = b.bar;
    __builtin_amdgcn_s_waitcnt(0);
    unsigned nloc = b.st[0], nx = b.st[1];
    if (nloc == 0u) { xcd_barrier_complete(bar, b.x, nloc, nx); b.st[0] = nloc; b.st[1] = nx; }
    const unsigned old = xb_add(&bar[XB_XSUB(b.x)], 1u);
    const unsigned gen = old / nloc;
    if (old + 1u == (gen + 1u) * nloc) {
      __builtin_amdgcn_fence(__ATOMIC_RELEASE, "agent");
      asm volatile("s_waitcnt vmcnt(0)" ::: "memory");
      const unsigned og = xb_add(&bar[XB_TOP], 1u);
      const unsigned tg = og / nx;
      if (og + 1u == (tg + 1u) * nx) xb_add(&bar[XB_TOPGEN], 1u);
      else XB_SPIN(xb_ld(&bar[XB_TOPGEN]) == tg, bar);
      __builtin_amdgcn_fence(__ATOMIC_ACQUIRE, "agent");
      xb_add(&bar[XB_XGEN(b.x)], 1u);
      asm volatile("s_waitcnt vmcnt(0)" ::: "memory");
    } else {
      XB_SPIN(xb_ld(&bar[XB_XGEN(b.x)]) == gen, bar);
      __builtin_amdgcn_fence(__ATOMIC_ACQUIRE, "agent");
      asm volatile("s_waitcnt vmcnt(0)" ::: "memory");
    }
  }
  __syncthreads();
}

struct PrepDesc { const float* src; u16* dst; int K, N, mode, tk, tn; };
DI PrepDesc prep_desc(const Params& p, int tile) {
  constexpr int G0 = 1792, G1 = 2304, G2 = 3712, G3 = 4224, G4 = 7040, G5 = 9856, G6 = 12672, G7 = 12928;
  PrepDesc d; int Np, lt; d.mode = 0;
  if (tile < G0) { int i = tile / 896; lt = tile % 896; d.src = p.hy_w_in + (size_t)i * 1024 * 3584; d.dst = p.wt_hy_in + (size_t)i * 3584 * 1024; d.K = 1024; d.N = 3584; Np = 3584; }
  else if (tile < G1) { int t = tile - G0; int i = t / 256; lt = t % 256; d.src = p.hy_w_out + (size_t)i * 1048576; d.dst = p.wt_hy_out + (size_t)i * 1048576; d.K = 1024; d.N = 1024; Np = 1024; }
  else if (tile < G2) { int t = tile - G1; int i = t / 704; lt = t % 704; d.src = p.nsa_w_in + (size_t)i * 1024 * 2608; d.dst = p.wt_nsa_in + (size_t)i * 2816 * 1024; d.K = 1024; d.N = 2608; Np = 2816; }
  else if (tile < G3) { int t = tile - G2; int i = t / 256; lt = t % 256; d.src = p.nsa_w_out + (size_t)i * 1048576; d.dst = p.wt_nsa_out + (size_t)i * 1048576; d.K = 1024; d.N = 1024; Np = 1024; }
  else if (tile < G4) { int t = tile - G3; int i = t / 704; lt = t % 704; d.src = p.ffn_g + (size_t)i * 1024 * 2816; d.dst = p.wt_gu + (size_t)i * 5632 * 1024; d.K = 1024; d.N = 2816; Np = 2816; d.mode = 1; }
  else if (tile < G5) { int t = tile - G4; int i = t / 704; lt = t % 704; d.src = p.ffn_u + (size_t)i * 1024 * 2816; d.dst = p.wt_gu + (size_t)i * 5632 * 1024; d.K = 1024; d.N = 2816; Np = 2816; d.mode = 2; }
  else if (tile < G6) { int t = tile - G5; int i = t / 704; lt = t % 704; d.src = p.ffn_d + (size_t)i * 2816 * 1024; d.dst = p.wt_dn + (size_t)i * 1024 * 2816; d.K = 2816; d.N = 1024; Np = 1024; }
  else if (tile < G7) { int t = tile - G6; int i = t / 64; lt = t % 64; d.src = p.cmp_w1 + (size_t)i * 2048 * 128; d.dst = p.wt_c1 + (size_t)i * 128 * 2048; d.K = 2048; d.N = 128; Np = 128; }
  else { int t = tile - G7; int i = t / 2; lt = t % 2; d.src = p.cmp_w2 + (size_t)i * 128 * 64; d.dst = p.wt_c2 + (size_t)i * 64 * 128; d.K = 128; d.N = 64; Np = 64; }
  const int ntn = Np / 64;
  d.tk = lt / ntn; d.tn = lt % ntn;
  return d;
}
DI void prep_load(const PrepDesc& d, int tid, float (&rv)[8]) {
  const int c = tid & 63; const int n = d.tn * 64 + c; const int nc = n < d.N ? n : d.N - 1;
#pragma unroll
  for (int j = 0; j < 8; ++j) {
    const int r = (tid >> 6) + 8 * j;
    rv[j] = d.src[(size_t)(d.tk * 64 + r) * d.N + nc];
  }
}

DI void prep_phase(const Params& p, char* smem) {
  float* sm = (float*)smem;
  constexpr int G8 = 12936;
  const int tid = tidx();
  float rv[8];
  int tile = blockIdx.x;
  asm volatile("" : "+s"(tile));
  if (tile < G8) { const PrepDesc d0 = prep_desc(p, tile); prep_load(d0, tid, rv); }
  for (; tile < G8; tile += gridDim.x) {
    const PrepDesc d = prep_desc(p, tile);
    __syncthreads();
#pragma unroll
    for (int j = 0; j < 8; ++j) sm[((tid >> 6) + 8 * j) * 65 + (tid & 63)] = rv[j];
    __syncthreads();
    if (tile + (int)gridDim.x < G8) { const PrepDesc dn = prep_desc(p, tile + gridDim.x); prep_load(dn, tid, rv); }
    const int nl = tid >> 3, kp = tid & 7;
    const int n = d.tn * 64 + nl;
    int nd = n;
    if (d.mode == 1) nd = (n >> 4) * 32 + (n & 15);
    else if (d.mode == 2) nd = (n >> 4) * 32 + 16 + (n & 15);
    float v[8];
#pragma unroll
    for (int j = 0; j < 8; ++j) v[j] = sm[(kp * 8 + j) * 65 + nl];
    *(uint4*)(d.dst + (size_t)nd * d.K + d.tk * 64 + kp * 8) = pack8(v);
  }
  __syncthreads();
  if (blockIdx.x < 4) {
    const int mi = blockIdx.x;
    const float* pe = p.cmp_pe + (size_t)mi * 2048;
    const float* w1 = p.cmp_w1 + (size_t)mi * 2048 * 128;
    const int tq_ = tidx();
    const int o = tq_ & 127, half = tq_ >> 7;
    float a0 = 0.f, a1 = 0.f, a2 = 0.f, a3 = 0.f;
    for (int k = half * 512; k < half * 512 + 512; k += 4) {
      a0 += pe[k] * w1[(size_t)k * 128 + o]; a1 += pe[k + 1] * w1[(size_t)(k + 1) * 128 + o];
      a2 += pe[k + 2] * w1[(size_t)(k + 2) * 128 + o]; a3 += pe[k + 3] * w1[(size_t)(k + 3) * 128 + o];
    }
    sm[tq_] = (a0 + a1) + (a2 + a3);
    __syncthreads();
    if (tq_ < 128) p.c1[mi * 128 + tq_] = (sm[tq_] + sm[tq_ + 128]) + (sm[tq_ + 256] + sm[tq_ + 384]);
    __syncthreads();
  }
  if (blockIdx.x == 4 || (gridDim.x <= 4 && blockIdx.x == 0)) {
    for (int c = tidx(); c < 512; c += NT) {
      float l0 = p.hy_lb[c], l1 = p.hy_lb[512 + c];
      float mx = fmaxf(l0, l1); float e0 = __expf(l0 - mx), e1 = __expf(l1 - mx); float inv = 1.f / (e0 + e1);
      float p0 = e0 * inv, p1 = e1 * inv;
      p.lb[c] = p0 - p0; p.lb[512 + c] = (p0 + p1) - p0;
    }
  }
}

DI void rmsnorm_phase(const float* x, const float* __restrict__ g, u16* h) {
  const int t_ = tidx();
  const int wave = t_ >> 6, lane = t_ & 63;
  const int stride = gridDim.x * 8;
  int row = blockIdx.x * 8 + wave;
  float4 v[4], nv[4];
  float4 gg[4];
#pragma unroll
  for (int j = 0; j < 4; ++j) gg[j] = ((const float4*)g)[lane + 64 * j];
  if (row < T_) {
    const float4* xr = (const float4*)(x + (size_t)row * 1024);
#pragma unroll
    for (int j = 0; j < 4; ++j) v[j] = xr[lane + 64 * j];
  }
  while (row < T_) {
    const int nrow = row + stride;
    if (nrow < T_) {
      const float4* xr = (const float4*)(x + (size_t)nrow * 1024);
#pragma unroll
      for (int j = 0; j < 4; ++j) nv[j] = xr[lane + 64 * j];
    }
    float ss = 0.f;
#pragma unroll
    for (int j = 0; j < 4; ++j) ss += v[j].x * v[j].x + v[j].y * v[j].y + v[j].z * v[j].z + v[j].w * v[j].w;
#pragma unroll
    for (int off = 32; off >= 1; off >>= 1) ss += __shfl_xor(ss, off);
    const float rs = rsqrtf(ss * (1.f / 1024.f) + EPSF);
#pragma unroll
    for (int j = 0; j < 4; ++j) {
      uint2 o; o.x = pack2(v[j].x * rs * gg[j].x, v[j].y * rs * gg[j].y); o.y = pack2(v[j].z * rs * gg[j].z, v[j].w * rs * gg[j].w);
      *(uint2*)(h + (size_t)row * 1024 + (lane + 64 * j) * 4) = o;
    }
#pragma unroll
    for (int j = 0; j < 4; ++j) v[j] = nv[j];
    row = nrow;
  }
}

DI int lds_byte(int r, int c) { const int st = (r >> 4) * 2 + (c >> 5), rr = r & 15, cc = c & 31, ob = rr * 64 + cc * 2; return st * 1024 + (ob ^ (((ob >> 9) & 1) << 5)); }
DI void stage_rc(int b, int& R, int& C) { const int st = b / 1024, sb = b % 1024, swz = sb ^ (((sb >> 9) & 1) << 5); R = (st >> 1) * 16 + swz / 64; C = (st & 1) * 32 + (swz % 64) / 2; }

template <int EPI>
DI void gemm_phase(const u16* A, const u16* Bt, const int K, const int nN, u16* outb, const int ldc, const float* res, float* outf, char* smem, const bool rev = false) {
  constexpr int HTB = 16384;
  const int tid = tidx();
  const int wid = tid >> 6, lane = tid & 63, wr = wid >> 2, wc = wid & 3, fr = lane & 15, fq = lane >> 4;
  const int nM = 128, nwg = nM * nN, nt = K / 64;
  int sR0, sC0, sR1, sC1; stage_rc(tid * 16, sR0, sC0); stage_rc(tid * 16 + 8192, sR1, sC1);
  const unsigned vo0 = (unsigned)((sR0 * K + sC0) * 2), vo1 = (unsigned)((sR1 * K + sC1) * 2);
#define SA_(b, h) (smem + ((b) * 2 + (h)) * HTB)
#define SB_(b, h) (smem + (4 + (b) * 2 + (h)) * HTB)
#define STAGE(P, BASE, br, kt) do { const char* _g = (const char*)((BASE) + (size_t)(br) * K + (size_t)(kt) * 64); \
    unsigned _o0 = vo0, _o1 = vo1; asm volatile("" : "+v"(_o0), "+v"(_o1)); \
    __builtin_amdgcn_global_load_lds((const unsigned*)(_g + _o0), (LAS unsigned*)((P) + tid * 16), 16, 0, 0); \
    __builtin_amdgcn_global_load_lds((const unsigned*)(_g + _o1), (LAS unsigned*)((P) + tid * 16 + 8192), 16, 0, 0); } while (0)
  const int ob_ = fr * 64 + fq * 16, swz_ = ob_ ^ (((ob_ >> 9) & 1) << 5);
  const int aoff = wr * 8192 + swz_, boff = wc * 4096 + swz_;
#define LDA(dst, b, h) _Pragma("unroll") for (int m = 0; m < 4; ++m) _Pragma("unroll") for (int k = 0; k < 2; ++k) \
    dst[m][k] = *(const bf16x8*)(SA_(b, h) + aoff + m * 2048 + k * 1024)
#define LDB(dst, b, h) _Pragma("unroll") for (int n = 0; n < 2; ++n) _Pragma("unroll") for (int k = 0; k < 2; ++k) \
    dst[n][k] = *(const bf16x8*)(SB_(b, h) + boff + n * 2048 + k * 1024)
#define MMA(ai, bj, At_, Bx_) do { __builtin_amdgcn_s_setprio(1); \
    _Pragma("unroll") for (int m = 0; m < 4; ++m) _Pragma("unroll") for (int n = 0; n < 2; ++n) _Pragma("unroll") for (int k = 0; k < 2; ++k) \
      acc[ai][bj][m][n] = __builtin_amdgcn_mfma_f32_16x16x32_bf16(Bx_[n][k], At_[m][k], acc[ai][bj][m][n], 0, 0, 0); \
    __builtin_amdgcn_s_setprio(0); } while (0)
#define WAIT_V(n) asm volatile("s_waitcnt vmcnt(" #n ")" ::: "memory")
#define WAIT_L(n) asm volatile("s_waitcnt lgkmcnt(" #n ")" ::: "memory")
#define BAR __builtin_amdgcn_s_barrier()
#define SCHED __builtin_amdgcn_sched_barrier(0)
  auto tile_of = [&](long Lq, int& brow_, int& bcol_, int& pn_) {
    int wgid = (int)Lq;
    { const int q = nwg / 8, r = nwg % 8, xcd = wgid % 8, off = wgid / 8; wgid = (xcd < r ? xcd * (q + 1) : r * (q + 1) + (xcd - r) * q) + off; }
    const int nig = 8 * nN, gid = wgid / nig, fm = gid * 8, gsz = (nM - fm) < 8 ? (nM - fm) : 8;
    const int pm = fm + ((wgid % nig) % gsz);
    pn_ = (wgid % nig) / gsz; brow_ = (rev ? (nM - 1 - pm) : pm) * 256; bcol_ = pn_ * 256;
  };
#define STAGE7(br_, bc_) do { STAGE(SB_(0, 0), Bt, bc_, 0); STAGE(SA_(0, 0), A, br_, 0); STAGE(SB_(0, 1), Bt, (bc_) + 128, 0); STAGE(SA_(0, 1), A, (br_) + 128, 0); \
    STAGE(SB_(1, 0), Bt, bc_, 1); STAGE(SA_(1, 0), A, br_, 1); STAGE(SB_(1, 1), Bt, (bc_) + 128, 1); } while (0)
  long L = blockIdx.x;
  bool have = L < nwg;
  int brow = 0, bcol = 0, pn = 0;
  __syncthreads();
  if (have) { tile_of(L, brow, bcol, pn); STAGE7(brow, bcol); }
  while (have) {
    f32x4v acc[2][2][4][2];
#pragma unroll
    for (int a = 0; a < 2; ++a)
#pragma unroll
      for (int b = 0; b < 2; ++b)
#pragma unroll
        for (int m = 0; m < 4; ++m)
#pragma unroll
          for (int n = 0; n < 2; ++n) acc[a][b][m][n] = (f32x4v){0.f, 0.f, 0.f, 0.f};
    bf16x8 At[4][2], B0[2][2], B1[2][2];
    if (wr == 1) BAR;
    WAIT_V(0); BAR;
    BAR;
    for (int t = 0; t < nt - 2; t += 2) {
      LDB(B0, 0, 0); SCHED; LDA(At, 0, 0); STAGE(SA_(1, 1), A, brow + 128, t + 1);
      WAIT_L(8); BAR; WAIT_L(0); MMA(0, 0, At, B0); BAR; SCHED;
      LDB(B1, 0, 1); STAGE(SB_(0, 0), Bt, bcol, t + 2);
      BAR; WAIT_L(0); MMA(0, 1, At, B1); BAR;
      LDA(At, 0, 1); STAGE(SA_(0, 0), A, brow, t + 2);
      BAR; WAIT_L(0); MMA(1, 0, At, B0); BAR; SCHED;
      STAGE(SB_(0, 1), Bt, bcol + 128, t + 2);
      WAIT_V(6); BAR; MMA(1, 1, At, B1); BAR;
      LDB(B0, 1, 0); SCHED; LDA(At, 1, 0); STAGE(SA_(0, 1), A, brow + 128, t + 2);
      WAIT_L(8); BAR; WAIT_L(0); MMA(0, 0, At, B0); BAR; SCHED;
      LDB(B1, 1, 1); STAGE(SB_(1, 0), Bt, bcol, t + 3);
      BAR; WAIT_L(0); MMA(0, 1, At, B1); BAR;
      LDA(At, 1, 1); STAGE(SA_(1, 0), A, brow, t + 3);
      BAR; WAIT_L(0); MMA(1, 0, At, B0); BAR; SCHED;
      STAGE(SB_(1, 1), Bt, bcol + 128, t + 3);
      WAIT_V(6); BAR; MMA(1, 1, At, B1); BAR;
    }
    { LDB(B0, 0, 0); LDA(At, 0, 0); STAGE(SA_(1, 1), A, brow + 128, nt - 1);
      BAR; WAIT_L(0); MMA(0, 0, At, B0); BAR;
      LDB(B1, 0, 1); BAR; WAIT_L(0); MMA(0, 1, At, B1); BAR;
      LDA(At, 0, 1); WAIT_V(4); BAR; WAIT_L(0); MMA(1, 0, At, B0); MMA(1, 1, At, B1); BAR; }
    { LDB(B0, 1, 0); LDA(At, 1, 0); WAIT_V(2); BAR; WAIT_L(0); MMA(0, 0, At, B0); BAR;
      LDB(B1, 1, 1); WAIT_V(0); BAR; WAIT_L(0); MMA(0, 1, At, B1); BAR;
      LDA(At, 1, 1); BAR; WAIT_L(0); MMA(1, 0, At, B0); MMA(1, 1, At, B1); BAR; }
    if (wr == 0) BAR;
    const long Ln = L + gridDim.x;
    const bool haven = Ln < nwg;
    int browN = 0, bcolN = 0, pnN = 0;
    if (haven) { tile_of(Ln, browN, bcolN, pnN); STAGE7(browN, bcolN); }
    int tid2 = tid; asm volatile("" : "+v"(tid2));
    const int fr2 = tid2 & 15, fq2 = (tid2 >> 4) & 3, wc2 = (tid2 >> 6) & 3, wr2 = tid2 >> 8;
    if (EPI == 1) {
#pragma unroll
      for (int am = 0; am < 4; ++am) {
        const int ai = am >> 1, m0 = (am & 1) * 2;
        f32x4v rb[2][2][2];
        const float* rbase = res + (size_t)(brow + ai * 128 + wr2 * 64 + m0 * 16 + fr2) * 1024 + bcol + wc2 * 32 + fq2 * 4;
        float* obase = outf + (size_t)(brow + ai * 128 + wr2 * 64 + m0 * 16 + fr2) * 1024 + bcol + wc2 * 32 + fq2 * 4;
#pragma unroll
        for (int m = 0; m < 2; ++m)
#pragma unroll
          for (int bj = 0; bj < 2; ++bj)
#pragma unroll
            for (int n = 0; n < 2; ++n) rb[m][bj][n] = *(const f32x4v*)(rbase + (size_t)m * 16 * 1024 + bj * 128 + n * 16);
        asm volatile("" ::: "memory");
#pragma unroll
        for (int m = 0; m < 2; ++m)
#pragma unroll
          for (int bj = 0; bj < 2; ++bj)
#pragma unroll
            for (int n = 0; n < 2; ++n) *(f32x4v*)(obase + (size_t)m * 16 * 1024 + bj * 128 + n * 16) = rb[m][bj][n] + acc[ai][bj][m0 + m][n];
        asm volatile("" ::: "memory");
      }
    } else {
#pragma unroll
    for (int ai = 0; ai < 2; ++ai)
#pragma unroll
      for (int m = 0; m < 4; ++m) {
        const size_t row = (size_t)(brow + ai * 128 + wr2 * 64 + m * 16 + fr2);
#pragma unroll
        for (int bj = 0; bj < 2; ++bj) {
          const int cb = bcol + bj * 128 + wc2 * 32 + fq2 * 4;
          if (EPI == 0) {
#pragma unroll
            for (int n = 0; n < 2; ++n) {
              uint2 o; o.x = pack2(acc[ai][bj][m][n][0], acc[ai][bj][m][n][1]); o.y = pack2(acc[ai][bj][m][n][2], acc[ai][bj][m][n][3]);
              *(uint2*)(outb + row * ldc + cb + n * 16) = o;
            }
          } else {
            const f32x4v gv = acc[ai][bj][m][0], uv = acc[ai][bj][m][1];
            uint2 o; o.x = pack2(fsilu(gv[0]) * uv[0], fsilu(gv[1]) * uv[1]); o.y = pack2(fsilu(gv[2]) * uv[2], fsilu(gv[3]) * uv[3]);
            *(uint2*)(outb + row * DFF + ((bcol + bj * 128 + wc2 * 32) >> 1) + fq2 * 4) = o;
          }
        }
      }
    }
    L = Ln; have = haven; brow = browN; bcol = bcolN; pn = pnN;
  }
  __syncthreads();
#undef STAGE7
#undef SA_
#undef SB_
#undef STAGE
#undef LDA
#undef LDB
#undef MMA
}

#define MFMA16(a, b, c) __builtin_amdgcn_mfma_f32_16x16x32_bf16((a), (b), (c), 0, 0, 0)
DI void hgrn_item(const Params& p, int li, int item, char* smem) {
  const int tid = tidx(), lane = tid & 63, w = tid >> 6, fr = lane & 15, fq = lane >> 4;
  const int kk = w >> 1, vt = w & 1;
  const int vs = item & 3, h = (item >> 2) & 3, b = item >> 4;
  const int tg = tid & 3, kch = tid >> 2;
  const int sv = tid >> 5, vv = tid & 31;
  const float lbv = p.lb[li * 512 + h * 128 + kch];
  const u16* base = p.proj + (size_t)b * S_ * LD_EVEN;
  const u16* pq = base + (size_t)(4 * tg) * LD_EVEN + h * 128 + kch;
  const u16* pv = base + (size_t)sv * LD_EVEN + 1024 + h * 128 + vs * 32 + vv;
  struct HRegs { unsigned q0, q1, q2, q3, f0, f1, f2, f3, v; };
  auto hload = [&](int c, HRegs& r) {
    const u16* pq2 = pq + (size_t)c * 16 * LD_EVEN;
    r.q0 = pq2[0]; r.q1 = pq2[LD_EVEN]; r.q2 = pq2[2 * LD_EVEN]; r.q3 = pq2[3 * LD_EVEN];
    r.f0 = pq2[512]; r.f1 = pq2[LD_EVEN + 512]; r.f2 = pq2[2 * LD_EVEN + 512]; r.f3 = pq2[3 * LD_EVEN + 512];
    r.v = pv[(size_t)c * 16 * LD_EVEN];
  };
  HRegs ra, rb;
  hload(0, ra); hload(1, rb);
  f32x4v S0 = {0.f, 0.f, 0.f, 0.f}, S1 = {0.f, 0.f, 0.f, 0.f};
  const f32x4v z4 = {0.f, 0.f, 0.f, 0.f};
  __syncthreads();
  constexpr int HBUF = 16896;
  auto prep = [&](const HRegs& rr, int par) {
    u16* Qt_ = (u16*)(smem + par * HBUF); u16* Kt_ = Qt_ + 16 * 136; u16* Kh_ = Kt_ + 16 * 136; u16* Vt_ = Kh_ + 128 * 24; float* Pc_ = (float*)(Vt_ + 32 * 24);
    float qv[4], kv[4], cs[4];
    const unsigned rq[4] = {rr.q0, rr.q1, rr.q2, rr.q3}, rf[4] = {rr.f0, rr.f1, rr.f2, rr.f3};
    float cp = 1.f;
#pragma unroll
    for (int i = 0; i < 4; ++i) {
      const float f = lbv + (1.f - lbv) * fsigmoid(__uint_as_float(rf[i] << 16));
      cp *= f; cs[i] = cp; kv[i] = 1.f - f; qv[i] = fsilu(__uint_as_float(rq[i] << 16));
    }
    const int bl = lane & ~3;
    const float t0 = __shfl(cp, bl), t1 = __shfl(cp, bl + 1), t2 = __shfl(cp, bl + 2), t3 = __shfl(cp, bl + 3);
    const float pre = (tg > 0 ? t0 : 1.f) * (tg > 1 ? t1 : 1.f) * (tg > 2 ? t2 : 1.f);
    const float PC = (t0 * t1) * (t2 * t3);
    float kh[4];
#pragma unroll
    for (int i = 0; i < 4; ++i) {
      const float P = fmaxf(pre * cs[i], 1e-30f);
      const float rP = __builtin_amdgcn_rcpf(P);
      const int t = 4 * tg + i;
      Qt_[t * 136 + kch] = f2bf(qv[i] * P);
      const float kr = kv[i] * rP;
      Kt_[t * 136 + kch] = f2bf(kr);
      kh[i] = kr * PC;
    }
    uint2 k2; k2.x = pack2(kh[0], kh[1]); k2.y = pack2(kh[2], kh[3]);
    *(uint2*)(Kh_ + kch * 24 + 4 * tg) = k2;
    if (tg == 0) Pc_[kch] = PC;
    Vt_[vv * 24 + sv] = (u16)rr.v;
  };
  auto mfma = [&](int par) {
    const u16* Qt_ = (const u16*)(smem + par * HBUF); const u16* Kt_ = Qt_ + 16 * 136; const u16* Kh_ = Kt_ + 16 * 136; const u16* Vt_ = Kh_ + 128 * 24;
    const float* Pc_ = (const float*)(Vt_ + 32 * 24);
    float* Op_ = (float*)(smem + 4 * HBUF) + par * 2048;
    const uint2 v2 = *(const uint2*)(Vt_ + (16 * vt + fr) * 24 + 4 * fq);
    const bf16x8 vb = as_bf16x8(make_uint4(v2.x, v2.y, 0u, 0u));
    const u16* qrow = Qt_ + fr * 136 + 32 * kk + 4 * fq;
    const uint2 qa = *(const uint2*)qrow, qb = *(const uint2*)(qrow + 16);
    const bf16x8 qfrag = as_bf16x8(make_uint4(qa.x, qa.y, qb.x, qb.y));
    const bf16x8 sfrag = as_bf16x8(make_uint4(pack2(S0[0], S0[1]), pack2(S0[2], S0[3]), pack2(S1[0], S1[1]), pack2(S1[2], S1[3])));
    f32x4v acc = MFMA16(qfrag, sfrag, z4);
    if (kk == 0) {
      f32x4v sa = z4;
#pragma unroll
      for (int ks = 0; ks < 4; ++ks) {
        const bf16x8 kf = *(const bf16x8*)(Kt_ + fr * 136 + 32 * ks + 8 * fq);
        const bf16x8 qf2 = *(const bf16x8*)(Qt_ + fr * 136 + 32 * ks + 8 * fq);
        sa = MFMA16(kf, qf2, sa);
      }
#pragma unroll
      for (int j = 0; j < 4; ++j) sa[j] = (4 * fq + j <= fr) ? sa[j] : 0.f;
      const bf16x8 afrag = as_bf16x8(make_uint4(pack2(sa[0], sa[1]), pack2(sa[2], sa[3]), 0u, 0u));
      acc = MFMA16(afrag, vb, acc);
    }
#pragma unroll
    for (int j = 0; j < 4; ++j) Op_[(w * 16 + 4 * fq + j) * 16 + fr] = acc[j];
    const float* pc0 = Pc_ + 32 * kk + 4 * fq;
#pragma unroll
    for (int j = 0; j < 4; ++j) { S0[j] *= pc0[j]; S1[j] *= pc0[16 + j]; }
    const uint2 h0 = *(const uint2*)(Kh_ + (32 * kk + fr) * 24 + 4 * fq);
    const uint2 h1v = *(const uint2*)(Kh_ + (32 * kk + 16 + fr) * 24 + 4 * fq);
    S0 = MFMA16(as_bf16x8(make_uint4(h0.x, h0.y, 0u, 0u)), vb, S0);
    S1 = MFMA16(as_bf16x8(make_uint4(h1v.x, h1v.y, 0u, 0u)), vb, S1);
  };
  auto reduce = [&](int c, int par) {
    const float* Op_ = (const float*)(smem + 4 * HBUF) + par * 2048;
    const int t = tid >> 5, v = tid & 31, vtt = v >> 4, vl = v & 15;
    float o = 0.f;
#pragma unroll
    for (int q = 0; q < 4; ++q) o += Op_[((2 * q + vtt) * 16 + t) * 16 + vl];
    p.hbuf[(size_t)(b * S_ + c * 16 + t) * 1024 + h * 128 + vs * 32 + v] = f2bf(o);
  };
  prep(ra, 0); prep(rb, 1); hload(2, ra); hload(3, rb);
  __syncthreads();
#pragma unroll 1
  for (int P = 0; P < 64; P += 2) {
    mfma(0); mfma(1);
    prep(ra, 2); prep(rb, 3);
    if (P + 2 < 64) { hload(2 * P + 4, ra); hload(2 * P + 5, rb); }
    __syncthreads();
    reduce(2 * P, 0); reduce(2 * P + 1, 1);
    mfma(2); mfma(3);
    if (P + 2 < 64) { prep(ra, 0); prep(rb, 1); if (P + 3 < 64) { hload(2 * P + 6, ra); hload(2 * P + 7, rb); } }
    __syncthreads();
    reduce(2 * P + 2, 2); reduce(2 * P + 3, 3);
  }
  __syncthreads();
}

struct QRaw { u32x4v r[4]; };
DI void load_q_raw(const u16* qrow, int hh, QRaw& q) {
#pragma unroll
  for (int kk = 0; kk < 4; ++kk) q.r[kk] = *(const u32x4v*)(qrow + kk * 16 + hh * 8);
}
DI void make_q(const QRaw& q, const float* __restrict__ gain, int hh, bf16x8 (&qf)[4]) {
  float f[4][8]; float ss = 0.f;
#pragma unroll
  for (int kk = 0; kk < 4; ++kk) {
    unpack8(make_uint4(q.r[kk][0], q.r[kk][1], q.r[kk][2], q.r[kk][3]), f[kk]);
#pragma unroll
    for (int j = 0; j < 8; ++j) ss += f[kk][j] * f[kk][j];
  }
  ss += __shfl_xor(ss, 32);
  const float rs = rsqrtf(ss * (1.f / 64.f) + EPSF) * (0.125f * LOG2E);
#pragma unroll
  for (int kk = 0; kk < 4; ++kk) {
#pragma unroll
    for (int j = 0; j < 8; ++j) f[kk][j] *= rs * gain[kk * 16 + hh * 8 + j];
    qf[kk] = as_bf16x8(pack8(f[kk]));
  }
}

constexpr int VS = 68;
constexpr int KVBUF = 18432;
template <int NTH> struct KVRegs { u32x4v r[NTH == 256 ? 4 : 2]; };
DI void kv_ld2(const u16* src, size_t stride, int ra, int rb, int rlo, int rhi, int dp, u32x4v& x0, u32x4v& x1) {
  const int ca = ra < rlo ? rlo : ra, cb = rb < rlo ? rlo : rb;
  x0 = *(const u32x4v*)(src + (size_t)ca * stride + dp * 8);
  x1 = *(const u32x4v*)(src + (size_t)cb * stride + dp * 8);
}
template <int NTH>
DI void kv_load(int tid, const u16* kb, const u16* vb, size_t stride, int r0, int rlo, int rhi, KVRegs<NTH>& rg) {
  const int dp = tid & 7, kq = (tid & 255) >> 3;
  if (NTH == 256) {
    kv_ld2(kb, stride, r0 + kq, r0 + kq + 32, rlo, rhi, dp, rg.r[0], rg.r[1]);
    kv_ld2(vb, stride, r0 + 2 * kq, r0 + 2 * kq + 1, rlo, rhi, dp, rg.r[2], rg.r[3]);
  } else {
    if (tid < 256) kv_ld2(kb, stride, r0 + kq, r0 + kq + 32, rlo, rhi, dp, rg.r[0], rg.r[1]);
    else kv_ld2(vb, stride, r0 + 2 * kq, r0 + 2 * kq + 1, rlo, rhi, dp, rg.r[0], rg.r[1]);
  }
}
DI void k_store1(u32x4v x, int key, int dp, const float* __restrict__ kgain, u16* Ks) {
  uint4 kv = make_uint4(x[0], x[1], x[2], x[3]);
  if (kgain) {
    float f[8]; unpack8(kv, f);
    float ss = 0.f;
#pragma unroll
    for (int e = 0; e < 8; ++e) ss += f[e] * f[e];
    ss += __shfl_xor(ss, 1); ss += __shfl_xor(ss, 2); ss += __shfl_xor(ss, 4);
    const float rs = rsqrtf(ss * (1.f / 64.f) + EPSF);
#pragma unroll
    for (int e = 0; e < 8; ++e) f[e] *= rs * kgain[dp * 8 + e];
    kv = pack8(f);
  }
  *(uint4*)(Ks + key * 72 + dp * 8) = kv;
}
DI void v_store2(u32x4v v0, u32x4v v1, int kp, int dp, u16* Vts) {
  unsigned* vd = (unsigned*)(Vts + (dp * 8) * VS + 2 * kp);
#pragma unroll
  for (int d = 0; d < 4; ++d) {
    vd[(2 * d) * (VS / 2)] = (v0[d] & 0xffffu) | (v1[d] << 16);
    vd[(2 * d + 1) * (VS / 2)] = (v0[d] >> 16) | (v1[d] & 0xffff0000u);
  }
}
template <int NTH>
DI void kv_store(int tid, const KVRegs<NTH>& rg, const float* __restrict__ kgain, u16* Ks, u16* Vts) {
  const int dp = tid & 7, kq = (tid & 255) >> 3;
  if (NTH == 256) {
    k_store1(rg.r[0], kq, dp, kgain, Ks); k_store1(rg.r[1], kq + 32, dp, kgain, Ks);
    v_store2(rg.r[2], rg.r[3], kq, dp, Vts);
  } else {
    if (tid < 256) { k_store1(rg.r[0], kq, dp, kgain, Ks); k_store1(rg.r[1], kq + 32, dp, kgain, Ks); }
    else v_store2(rg.r[0], rg.r[1], kq, dp, Vts);
  }
}

DI void score_stage(const bf16x8 (&qf)[4], const u16* Ks, int lane, float sk, float sb, int lower, int lim, f32x16 (&s)[2], float& mx) {
  const int lr = lane & 31, hh = lane >> 5;
#pragma unroll
  for (int sub = 0; sub < 2; ++sub) {
#pragma unroll
    for (int i = 0; i < 16; ++i) s[sub][i] = fmaf(sk, (float)(sub * 32 + (i & 3) + 8 * (i >> 2)), sb);
#pragma unroll
    for (int kk = 0; kk < 4; ++kk) {
      bf16x8 kf = *(const bf16x8*)(Ks + (sub * 32 + lr) * 72 + kk * 16 + hh * 8);
      s[sub] = MFMA32(kf, qf[kk], s[sub]);
    }
  }
  if (lim < lower) { lower = 64; lim = 64; }
  const bool full = (lower <= 0) && (lim >= 63);
  if (!__all(full)) {
    const int lo2 = lower - 4 * hh; const unsigned rng = (unsigned)(lim - lower);
#pragma unroll
    for (int sub = 0; sub < 2; ++sub)
#pragma unroll
      for (int i = 0; i < 16; ++i) {
        const int kc = sub * 32 + (i & 3) + 8 * (i >> 2);
        s[sub][i] = ((unsigned)(kc - lo2) <= rng) ? s[sub][i] : -INFINITY;
      }
  }
  mx = -INFINITY;
#pragma unroll
  for (int sub = 0; sub < 2; ++sub)
#pragma unroll
    for (int i = 0; i < 16; ++i) mx = fmaxf(mx, s[sub][i]);
  mx = fmaxf(mx, __shfl_xor(mx, 32));
}

DI void pv_stage(const f32x16 (&s)[2], const u16* Vts, f32x16 (&o)[2], int lane) {
  const int lr = lane & 31, hh = lane >> 5;
#pragma unroll
  for (int sub = 0; sub < 2; ++sub)
#pragma unroll
    for (int st = 0; st < 2; ++st) {
      uint4 pk;
      pk.x = pack2(s[sub][8 * st + 0], s[sub][8 * st + 1]); pk.y = pack2(s[sub][8 * st + 2], s[sub][8 * st + 3]);
      pk.z = pack2(s[sub][8 * st + 4], s[sub][8 * st + 5]); pk.w = pack2(s[sub][8 * st + 6], s[sub][8 * st + 7]);
      const bf16x8 pf = as_bf16x8(pk);
#pragma unroll
      for (int dt = 0; dt < 2; ++dt) {
        const u16* vp = Vts + (dt * 32 + lr) * VS + sub * 32 + 16 * st + 4 * hh;
        const uint2 lo = *(const uint2*)vp, hi = *(const uint2*)(vp + 8);
        const bf16x8 vf = as_bf16x8(make_uint4(lo.x, lo.y, hi.x, hi.y));
        o[dt] = MFMA32(vf, pf, o[dt]);
      }
    }
}

DI void flash_stage(const bf16x8 (&qf)[4], const u16* Ks, const u16* Vts, f32x16 (&o)[2], float& m, float& l, int lane,
                    float sk, float sb, int lower, int lim) {
  f32x16 s[2]; float mx;
  score_stage(qf, Ks, lane, sk, sb, lower, lim, s, mx);
  const float mn = fmaxf(m, mx);
  const float alpha = fexp2(m - mn);
  const bool same = (mn == m);
  m = mn;
  float ls = 0.f;
#pragma unroll
  for (int sub = 0; sub < 2; ++sub)
#pragma unroll
    for (int i = 0; i < 16; ++i) { const float pv = fexp2(s[sub][i] - mn); s[sub][i] = pv; ls += pv; }
  l = l * alpha + ls;
  if (!__all(same)) {
#pragma unroll
    for (int dt = 0; dt < 2; ++dt)
#pragma unroll
      for (int i = 0; i < 16; ++i) o[dt][i] *= alpha;
  }
  pv_stage(s, Vts, o, lane);
}

DI void dilated_item(const Params& p, int li, int pairitem, char* smem) {
  const int tfull = tidx();
  const int half = tfull >> 8, tid = tfull & 255;
  const int item = pairitem * 2 + half;
  char* kvb = smem + half * (2 * KVBUF);
  const int lane = tid & 63, w = tid >> 6, lr = lane & 31, hh = lane >> 5;
  const int idx16 = item & 15; const int br = (item >> 4) % 3; const int hb = (item / 48) & 7; const int b = item / 384;
  const int d = br == 0 ? 1 : (br == 1 ? 4 : 16);
  const int tile = idx16 / d, resid = idx16 % d;
  const int st0 = (d >= 2 && tile == 0) ? 2 : 0;
  const int u0 = tile * 128;
  const int uq = u0 + 32 * w + lr; const int tq = uq * d + resid;
  const u16* prow = p.proj + (size_t)(b * S_ + tq) * LD_EVEN;
  bf16x8 qf[4];
  QRaw qr; load_q_raw(prow + 2048 + hb * 64, hh, qr);
  const float slope2 = fexp2(-(float)(hb + 1)) * LOG2E;
  const float sk = slope2 * (float)d;
  const u16* kb = p.proj + (size_t)(b * S_ + resid) * LD_EVEN + 2560 + hb * 64;
  const u16* vb = kb + 512;
  const size_t stride = (size_t)d * LD_EVEN;
  const float* kg = p.hy_kg + li * 64;
  f32x16 o[2]; o[0] = zero16(); o[1] = zero16();
  float m = -1e30f, l = 0.f;
  const int uw = u0 + 32 * w;
  KVRegs<256> rg;
  kv_load<256>(tid, kb, vb, stride, u0 - 128 + 64 * st0, 0, 1 << 30, rg);
  make_q(qr, p.hy_qg + li * 64, hh, qf);
  __syncthreads();
  kv_store<256>(tid, rg, kg, (u16*)(kvb + (st0 & 1) * KVBUF), (u16*)(kvb + (st0 & 1) * KVBUF) + 64 * 72);
  kv_load<256>(tid, kb, vb, stride, u0 - 64 + 64 * st0, 0, 1 << 30, rg);
  __syncthreads();
#pragma unroll 1
  for (int st = st0; st < 4; ++st) {
    const int ub = u0 - 128 + 64 * st;
    u16* Ks = (u16*)(kvb + (st & 1) * KVBUF); u16* Vts = Ks + 64 * 72;
    if (st + 1 < 4) { u16* Kn = (u16*)(kvb + ((st + 1) & 1) * KVBUF); kv_store<256>(tid, rg, kg, Kn, Kn + 64 * 72); }
    if (st + 2 < 4) kv_load<256>(tid, kb, vb, stride, ub + 128, 0, 1 << 30, rg);
    if (ub + 63 >= 0 && ub <= uw + 31 && ub + 63 >= uw - 128) {
      const int lim = uq - ub;
      const int lower = max(lim - 128, -ub);
      const float sb = slope2 * (float)(ub * d + resid) + sk * (float)(4 * hh);
      flash_stage(qf, Ks, Vts, o, m, l, lane, sk, sb, lower, lim);
    }
    __syncthreads();
  }
  const float lt = l + __shfl_xor(l, 32);
  const float inv = 1.f / lt;
  const size_t trow = (size_t)br * T_ + (size_t)b * S_ + tq;
  if (hh == 0) p.lse[trow * 8 + hb] = (m + log2f(lt)) * LN2;
  u16* orow = p.obr + trow * 512 + hb * 64;
#pragma unroll
  for (int dt = 0; dt < 2; ++dt)
#pragma unroll
    for (int q4 = 0; q4 < 4; ++q4) {
      uint2 ov; ov.x = pack2(o[dt][4 * q4] * inv, o[dt][4 * q4 + 1] * inv); ov.y = pack2(o[dt][4 * q4 + 2] * inv, o[dt][4 * q4 + 3] * inv);
      *(uint2*)(orow + dt * 32 + 8 * q4 + 4 * hh) = ov;
    }
}

DI void post_even_phase(const Params& p, int li) {
  const int tid = tidx();
  const int rsel = tid >> 7, c8 = tid & 127;
  const int c = c8 * 8;
  const int nit = T_ / 4, step = gridDim.x;
  int it = blockIdx.x;
  if (c8 < 64) {
    float og[8];
#pragma unroll
    for (int j = 0; j < 8; ++j) og[j] = p.hy_og[li * 512 + c + j];
    u32x4v raw = {0u, 0u, 0u, 0u}, graw = {0u, 0u, 0u, 0u}, nraw = raw, ngraw = raw;
    if (it < nit) { const int t = it * 4 + rsel; raw = *(const u32x4v*)(p.hbuf + (size_t)t * 1024 + c); graw = *(const u32x4v*)(p.proj + (size_t)t * LD_EVEN + 1536 + c); }
    while (it < nit) {
      const int t = it * 4 + rsel, itn = it + step;
      if (itn < nit) { const int tn = itn * 4 + rsel; nraw = *(const u32x4v*)(p.hbuf + (size_t)tn * 1024 + c); ngraw = *(const u32x4v*)(p.proj + (size_t)tn * LD_EVEN + 1536 + c); }
      float o[8], gt[8], val[8];
      unpack8(make_uint4(raw[0], raw[1], raw[2], raw[3]), o); unpack8(make_uint4(graw[0], graw[1], graw[2], graw[3]), gt);
      float ss = 0.f;
#pragma unroll
      for (int j = 0; j < 8; ++j) ss += o[j] * o[j];
      ss += __shfl_xor(ss, 1); ss += __shfl_xor(ss, 2); ss += __shfl_xor(ss, 4); ss += __shfl_xor(ss, 8);
      const float rs = rsqrtf(ss * (1.f / 128.f) + EPSF);
#pragma unroll
      for (int j = 0; j < 8; ++j) val[j] = o[j] * rs * og[j] * fsilu(gt[j]);
      *(uint4*)(p.hbuf + (size_t)t * 1024 + c) = pack8(val);
      raw = nraw; graw = ngraw; it = itn;
    }
  } else {
    const int cb = c - 512, hb = cb >> 6;
    float l0 = 0.f, l1 = 0.f, l2 = 0.f, nl0 = 0.f, nl1 = 0.f, nl2 = 0.f;
    u32x4v a4 = {0u, 0u, 0u, 0u}, b4 = a4, c4 = a4, na4 = a4, nb4 = a4, nc4 = a4;
    if (it < nit) {
      const size_t t = (size_t)(it * 4 + rsel);
      l0 = p.lse[(t) * 8 + hb]; l1 = p.lse[((size_t)T_ + t) * 8 + hb]; l2 = p.lse[((size_t)2 * T_ + t) * 8 + hb];
      a4 = *(const u32x4v*)(p.obr + t * 512 + cb); b4 = *(const u32x4v*)(p.obr + ((size_t)T_ + t) * 512 + cb); c4 = *(const u32x4v*)(p.obr + ((size_t)2 * T_ + t) * 512 + cb);
    }
    while (it < nit) {
      const int t = it * 4 + rsel, itn = it + step;
      if (itn < nit) {
        const size_t tn = (size_t)(itn * 4 + rsel);
        nl0 = p.lse[(tn) * 8 + hb]; nl1 = p.lse[((size_t)T_ + tn) * 8 + hb]; nl2 = p.lse[((size_t)2 * T_ + tn) * 8 + hb];
        na4 = *(const u32x4v*)(p.obr + tn * 512 + cb); nb4 = *(const u32x4v*)(p.obr + ((size_t)T_ + tn) * 512 + cb); nc4 = *(const u32x4v*)(p.obr + ((size_t)2 * T_ + tn) * 512 + cb);
      }
      const float mx = fmaxf(l0, fmaxf(l1, l2));
      float w0 = __expf(l0 - mx), w1 = __expf(l1 - mx), w2 = __expf(l2 - mx);
      const float inv = 1.f / (w0 + w1 + w2);
      w0 *= inv; w1 *= inv; w2 *= inv;
      float a[8], bq[8], cq[8], val[8];
      unpack8(make_uint4(a4[0], a4[1], a4[2], a4[3]), a); unpack8(make_uint4(b4[0], b4[1], b4[2], b4[3]), bq); unpack8(make_uint4(c4[0], c4[1], c4[2], c4[3]), cq);
#pragma unroll
      for (int j = 0; j < 8; ++j) val[j] = w0 * a[j] + w1 * bq[j] + w2 * cq[j];
      *(uint4*)(p.hbuf + (size_t)t * 1024 + c) = pack8(val);
      l0 = nl0; l1 = nl1; l2 = nl2; a4 = na4; b4 = nb4; c4 = nc4; it = itn;
    }
  }
}

DI void compress_item(const Params& p, int li, int pairitem, char* smem) {
  const int tfull = tidx();
  const int half = tfull >> 8, tid = tfull & 255;
  const int item = pairitem * 2 + half;
  u16* hs = (u16*)(smem + half * 17408);
  float* outs = (float*)(smem + half * 17408 + 32 * 136 * 2);
  const int lane = tid & 63, w = tid >> 6, lr = lane & 31, hh = lane >> 5;
  const int nt = item & 3, g = (item >> 2) & 3, b = (item >> 4) & 15, kv = item >> 8;
  const int n = nt * 32 + lr; const int nc = n > 126 ? 126 : n;
  const int col = 1024 + kv * 256 + g * 64;
  const u16* arow = p.proj + (size_t)(b * S_ + 16 * nc) * LD_ODD + col;
  const u16* w1t = p.wt_c1 + (size_t)(li * 2 + kv) * 128 * 2048 + (size_t)(32 * w + lr) * 2048;
  f32x16 acc = zero16();
#pragma unroll 1
  for (int k0 = 0; k0 < 128; k0 += 8) {
    u32x4v fa[8], fb[8];
#pragma unroll
    for (int j = 0; j < 8; ++j) {
      const int ks = k0 + j;
      const int lidx = ks >> 2, dd = (ks & 3) * 16 + hh * 8;
      fa[j] = *(const u32x4v*)(arow + (size_t)lidx * LD_ODD + dd);
      fb[j] = *(const u32x4v*)(w1t + ks * 16 + hh * 8);
    }
    asm volatile("" ::: "memory");
#pragma unroll
    for (int j = 0; j < 8; ++j) acc = MFMA32(__builtin_bit_cast(bf16x8, fa[j]), __builtin_bit_cast(bf16x8, fb[j]), acc);
  }
  const float cb = p.c1[(li * 2 + kv) * 128 + 32 * w + lr];
  __syncthreads();
#pragma unroll
  for (int i = 0; i < 16; ++i) {
    const int r = (i & 3) + 8 * (i >> 2) + 4 * hh;
    hs[r * 136 + 32 * w + lr] = f2bf(fsilu(acc[i] + cb));
  }
  __syncthreads();
  if (w < 2) {
    const u16* w2t = p.wt_c2 + (size_t)(li * 2 + kv) * 64 * 128 + (size_t)(w * 32 + lr) * 128;
    f32x16 a2 = zero16();
    u32x4v fb2[8];
#pragma unroll
    for (int kk = 0; kk < 8; ++kk) fb2[kk] = *(const u32x4v*)(w2t + kk * 16 + hh * 8);
    asm volatile("" ::: "memory");
#pragma unroll
    for (int kk = 0; kk < 8; ++kk) {
      const bf16x8 a = *(const bf16x8*)(hs + lr * 136 + kk * 16 + hh * 8);
      a2 = MFMA32(a, __builtin_bit_cast(bf16x8, fb2[kk]), a2);
    }
#pragma unroll
    for (int i = 0; i < 16; ++i) {
      const int r = (i & 3) + 8 * (i >> 2) + 4 * hh;
      outs[r * 65 + w * 32 + lr] = a2[i];
    }
  }
  __syncthreads();
  {
    const int r = tid >> 3, c8 = tid & 7;
    float v[8]; float ss = 0.f;
#pragma unroll
    for (int j = 0; j < 8; ++j) { v[j] = outs[r * 65 + c8 * 8 + j]; ss += v[j] * v[j]; }
    ss += __shfl_xor(ss, 1); ss += __shfl_xor(ss, 2); ss += __shfl_xor(ss, 4);
    if (kv == 0) {
      const float rs = rsqrtf(ss * (1.f / 64.f) + EPSF);
#pragma unroll
      for (int j = 0; j < 8; ++j) v[j] *= rs * p.nsa_kg[(li * 3 + 0) * 64 + c8 * 8 + j];
    }
    const int nn = nt * 32 + r;
    if (nn >= 127) {
#pragma unroll
      for (int j = 0; j < 8; ++j) v[j] = 0.f;
    }
    u16* dst = (kv == 0 ? p.kcmp : p.vcmp) + ((size_t)(b * 4 + g) * 128 + nn) * 64 + c8 * 8;
    *(uint4*)dst = pack8(v);
  }
  __syncthreads();
}

DI void nsa_knorm_phase(const Params& p, int li) {
  const int tid = tidx();
  for (int u0 = blockIdx.x * NT + tid; u0 < T_ * 64; u0 += gridDim.x * NT * 4) {
    u32x4v raw[4];
#pragma unroll
    for (int q = 0; q < 4; ++q) {
      const int u = u0 + q * gridDim.x * NT;
      const int piece = u & 7, head = (u >> 3) & 3, br = (u >> 5) & 1, row = u >> 6;
      raw[q] = *(const u32x4v*)(p.proj + (size_t)row * LD_ODD + 1536 + br * 512 + head * 64 + piece * 8);
    }
    asm volatile("" ::: "memory");
#pragma unroll
    for (int q = 0; q < 4; ++q) {
      const int u = u0 + q * gridDim.x * NT;
      const int piece = u & 7, head = (u >> 3) & 3, br = (u >> 5) & 1, row = u >> 6;
      float f[8]; unpack8(make_uint4(raw[q][0], raw[q][1], raw[q][2], raw[q][3]), f);
      float ss = 0.f;
#pragma unroll
      for (int e = 0; e < 8; ++e) ss += f[e] * f[e];
      ss += __shfl_xor(ss, 1); ss += __shfl_xor(ss, 2); ss += __shfl_xor(ss, 4);
      const float rs = rsqrtf(ss * (1.f / 64.f) + EPSF);
      const float* kg = p.nsa_kg + (li * 3 + 1 + br) * 64 + piece * 8;
#pragma unroll
      for (int e = 0; e < 8; ++e) f[e] *= rs * kg[e];
      *(uint4*)(p.proj + (size_t)row * LD_ODD + 1536 + br * 512 + head * 64 + piece * 8) = pack8(f);
    }
  }
}

DI void nsa_item(const Params& p, int li, int item, char* smem) {
  float* impA = (float*)(smem + 2 * KVBUF);
  float* impB = impA + 8448;
  float* imp = impB + 8448;
  unsigned* selm = (unsigned*)(imp + 64 * 33);
  const int tid = tidx(), lane = tid & 63, wv = tid >> 6, lr = lane & 31, hh = lane >> 5;
  const int w = lr & 3;
  const int tt = item & 31, g = (item >> 5) & 3, b = item >> 7;
  const int t0 = tt * 64; const int cur = t0 >> 6;
  const int hd = g * 4 + w;
  const int tokl = 8 * wv + (lr >> 2);
  const int tq = t0 + tokl;
  const u16* pb = p.proj + (size_t)b * S_ * LD_ODD;
  const u16* prow = pb + (size_t)tq * LD_ODD;
  bf16x8 qf[4];
  QRaw qr; load_q_raw(prow + g * 256 + w * 64, hh, qr);
  const unsigned gr0 = prow[2560 + 0 + g * 4 + w], gr1 = prow[2560 + 16 + g * 4 + w], gr2 = prow[2560 + 32 + g * 4 + w];
  KVRegs<512> rgc;
  kv_load<512>(tid, p.kcmp + (size_t)(b * 4 + g) * 128 * 64, p.vcmp + (size_t)(b * 4 + g) * 128 * 64, 64, 0, 0, 128, rgc);
  make_q(qr, p.nsa_qg + li * 64, hh, qf);
  const float slope2 = fexp2(-0.5f * (float)(hd + 1)) * LOG2E;
  const float g0 = fsigmoid(__uint_as_float(gr0 << 16));
  const float g1 = fsigmoid(__uint_as_float(gr1 << 16));
  const float g2 = fsigmoid(__uint_as_float(gr2 << 16));
  f32x16 ot[2]; ot[0] = zero16(); ot[1] = zero16();
  {
    const u16* kb = p.kcmp + (size_t)(b * 4 + g) * 128 * 64;
    const u16* vb = p.vcmp + (size_t)(b * 4 + g) * 128 * 64;
    const float sk = 16.f * slope2;
    const int limc = min((tq - 31) >> 4, 126);
    const int nst = (1024 > t0) ? 1 : 2;
    {
      __syncthreads();
      kv_store<512>(tid, rgc, nullptr, (u16*)smem, (u16*)smem + 64 * 72);
      if (nst > 1) {
        kv_load<512>(tid, kb, vb, 64, 64, 0, 128, rgc);
        kv_store<512>(tid, rgc, nullptr, (u16*)(smem + KVBUF), (u16*)(smem + KVBUF) + 64 * 72);
      }
    }
    __syncthreads();
    float m = -1e30f, l = 0.f;
#pragma unroll
    for (int st = 0; st < 2; ++st) {
      if (st >= nst) continue;
      const u16* Ks = (const u16*)(smem + st * KVBUF);
      f32x16 s[2]; float mx;
      const float sb = slope2 * (float)(1024 * st + 31) + sk * (float)(4 * hh);
      score_stage(qf, Ks, lane, sk, sb, 0, limc - 64 * st, s, mx);
      const float mn = fmaxf(m, mx);
      float ls = 0.f;
#pragma unroll
      for (int sub = 0; sub < 2; ++sub)
#pragma unroll
        for (int i = 0; i < 16; ++i) ls += fexp2(s[sub][i] - mn);
      l = l * fexp2(m - mn) + ls;
      m = mn;
    }
    const float lt = l + __shfl_xor(l, 32);
    const float inv = lt > 0.f ? 1.f / lt : 0.f;
    f32x16 o[2]; o[0] = zero16(); o[1] = zero16();
#pragma unroll
    for (int st = 0; st < 2; ++st) {
      if (st >= nst) {
#pragma unroll
        for (int G = 0; G < 16; ++G) {
          if ((G & 1) == hh) { impA[(w * 64 + tokl) * 33 + 16 * st + G] = 0.f; impB[(w * 64 + tokl) * 33 + 16 * st + G] = 0.f; }
        }
        continue;
      }
      const u16* Ks = (const u16*)(smem + st * KVBUF); const u16* Vts = Ks + 64 * 72;
      f32x16 s[2]; float mx;
      const float sb = slope2 * (float)(1024 * st + 31) + sk * (float)(4 * hh);
      score_stage(qf, Ks, lane, sk, sb, 0, limc - 64 * st, s, mx);
#pragma unroll
      for (int sub = 0; sub < 2; ++sub)
#pragma unroll
        for (int i = 0; i < 16; ++i) s[sub][i] = fexp2(s[sub][i] - m) * inv;
#pragma unroll
      for (int sub = 0; sub < 2; ++sub)
#pragma unroll
        for (int q4 = 0; q4 < 4; ++q4) {
          const int G = 16 * st + 8 * sub + 2 * q4 + hh;
          impA[(w * 64 + tokl) * 33 + G] = (s[sub][4 * q4] + s[sub][4 * q4 + 1]) + (s[sub][4 * q4 + 2] + s[sub][4 * q4 + 3]);
          impB[(w * 64 + tokl) * 33 + G] = s[sub][4 * q4 + 3];
        }
      pv_stage(s, Vts, o, lane);
    }
#pragma unroll
    for (int dt = 0; dt < 2; ++dt)
#pragma unroll
      for (int i = 0; i < 16; ++i) ot[dt][i] += g0 * o[dt][i];
  }
  const u16* kbs = pb + 1536 + g * 64; const u16* vbs = pb + 1792 + g * 64;
  KVRegs<512> rg;
  kv_load<512>(tid, kbs, vbs, LD_ODD, 0, 0, S_, rg);
  __syncthreads();
  for (int idx = tid; idx < 2048; idx += NT) {
    const int tok = idx >> 5, mm = idx & 31;
    float a = 0.f;
#pragma unroll
    for (int ww = 0; ww < 4; ++ww) a += impA[(ww * 64 + tok) * 33 + mm] + (mm > 0 ? impB[(ww * 64 + tok) * 33 + mm - 1] : 0.f);
    imp[tok * 33 + mm] = a;
  }
  __syncthreads();
  float* ots = impA + tid;
#pragma unroll
  for (int dt = 0; dt < 2; ++dt)
#pragma unroll
    for (int i = 0; i < 16; ++i) ots[(dt * 16 + i) * NT] = ot[dt][i];
  {
    const int tok = tid >> 3, sub8 = tid & 7;
    unsigned sel = 1u | (1u << cur) | (cur > 0 ? (1u << (cur - 1)) : 0u);
    const int cnt = __popc(sel);
    float cv[4];
#pragma unroll
    for (int e = 0; e < 4; ++e) cv[e] = imp[tok * 33 + sub8 * 4 + e];
    for (int r = cnt; r < 8; ++r) {
      float bv = -1.f; int bi = 64;
#pragma unroll
      for (int e = 0; e < 4; ++e) {
        const int mm = sub8 * 4 + e;
        const bool ok = (mm <= cur) && !((sel >> mm) & 1u);
        if (ok && cv[e] > bv) { bv = cv[e]; bi = mm; }
      }
#pragma unroll
      for (int off = 1; off < 8; off <<= 1) {
        const float ov = __shfl_xor(bv, off); const int oi = __shfl_xor(bi, off);
        if (ov > bv || (ov == bv && oi < bi)) { bv = ov; bi = oi; }
      }
      if (bi < 64) sel |= 1u << bi;
    }
    if (sub8 == 0) selm[tok] = sel;
  }
  __syncthreads();
  const unsigned myMask = selm[tokl];
  unsigned uni = 0u;
#pragma unroll 8
  for (int i = 0; i < 64; ++i) uni |= selm[i];
  {
    f32x16 o[2]; o[0] = zero16(); o[1] = zero16();
    float m = -1e30f, l = 0.f;
    const float* kg = nullptr;
    unsigned rem = uni & (uni - 1u);
    int mb = 0;
    int mbn = rem ? __builtin_ctz(rem) : -1;
    kv_store<512>(tid, rg, kg, (u16*)smem, (u16*)smem + 64 * 72);
    if (mbn >= 0) kv_load<512>(tid, kbs, vbs, LD_ODD, 64 * mbn, 0, S_, rg);
    __syncthreads();
    int par = 0;
#pragma unroll 1
    while (true) {
      u16* Ks = (u16*)(smem + par * KVBUF); u16* Vts = Ks + 64 * 72;
      int mbn2 = -1;
      if (mbn >= 0) {
        u16* Kn = (u16*)(smem + (par ^ 1) * KVBUF);
        kv_store<512>(tid, rg, kg, Kn, Kn + 64 * 72);
        rem &= rem - 1u;
        mbn2 = rem ? __builtin_ctz(rem) : -1;
        if (mbn2 >= 0) kv_load<512>(tid, kbs, vbs, LD_ODD, 64 * mbn2, 0, S_, rg);
      }
      const bool selb = (myMask >> mb) & 1u;
      const float sb = slope2 * (float)(64 * mb) + slope2 * (float)(4 * hh);
      if (__any(selb)) flash_stage(qf, Ks, Vts, o, m, l, lane, slope2, sb, 0, selb ? (tq - 64 * mb) : -1);
      __syncthreads();
      if (mbn < 0) break;
      mb = mbn; mbn = mbn2; par ^= 1;
    }
    const float lt = l + __shfl_xor(l, 32);
    const float sc = g1 / lt;
#pragma unroll
    for (int dt = 0; dt < 2; ++dt)
#pragma unroll
      for (int i = 0; i < 16; ++i) ots[(dt * 16 + i) * NT] += sc * o[dt][i];
  }
  {
    f32x16 o[2]; o[0] = zero16(); o[1] = zero16();
    float m = -1e30f, l = 0.f;
    const u16* kb = pb + 2048 + g * 64; const u16* vb = pb + 2304 + g * 64;
    const float* kg = nullptr;
    const int mlo = (t0 - 511) < 0 ? 0 : ((t0 - 511) >> 6);
    kv_load<512>(tid, kb, vb, LD_ODD, 64 * mlo, 0, S_, rg);
    kv_store<512>(tid, rg, kg, (u16*)smem, (u16*)smem + 64 * 72);
    if (mlo + 1 <= cur) kv_load<512>(tid, kb, vb, LD_ODD, 64 * (mlo + 1), 0, S_, rg);
    __syncthreads();
#pragma unroll 1
    for (int mb = mlo; mb <= cur; ++mb) {
      const int par = (mb - mlo) & 1;
      u16* Ks = (u16*)(smem + par * KVBUF); u16* Vts = Ks + 64 * 72;
      if (mb + 1 <= cur) { u16* Kn = (u16*)(smem + (par ^ 1) * KVBUF); kv_store<512>(tid, rg, kg, Kn, Kn + 64 * 72); }
      if (mb + 2 <= cur) kv_load<512>(tid, kb, vb, LD_ODD, 64 * (mb + 2), 0, S_, rg);
      const int lim = tq - 64 * mb;
      const float sb = slope2 * (float)(64 * mb) + slope2 * (float)(4 * hh);
      flash_stage(qf, Ks, Vts, o, m, l, lane, slope2, sb, lim - 511, lim);
      __syncthreads();
    }
    const float lt = l + __shfl_xor(l, 32);
    const float sc = g2 / lt;
    u16* orow = p.hbuf + (size_t)(b * S_ + tq) * 1024 + g * 256 + w * 64;
#pragma unroll
    for (int dt = 0; dt < 2; ++dt)
#pragma unroll
      for (int q4 = 0; q4 < 4; ++q4) {
        const float a0 = ots[(dt * 16 + 4 * q4 + 0) * NT] + sc * o[dt][4 * q4 + 0], a1 = ots[(dt * 16 + 4 * q4 + 1) * NT] + sc * o[dt][4 * q4 + 1];
        const float a2 = ots[(dt * 16 + 4 * q4 + 2) * NT] + sc * o[dt][4 * q4 + 2], a3 = ots[(dt * 16 + 4 * q4 + 3) * NT] + sc * o[dt][4 * q4 + 3];
        uint2 ov; ov.x = pack2(a0, a1); ov.y = pack2(a2, a3);
        *(uint2*)(orow + dt * 32 + 8 * q4 + 4 * hh) = ov;
      }
  }
  __syncthreads();
}

DI void run_phase(const Params& p, int ph, char* smem) {
  if (ph == 0) { prep_phase(p, smem); return; }
  const int l = (ph - 1) >> 3, s = (ph - 1) & 7, li = l >> 1;
  const bool even = (l & 1) == 0;
  const float* xin = (l == 0) ? p.x : p.out;
  switch (s) {
    case 0: rmsnorm_phase(xin, p.attn_norm + l * 1024, p.hbuf); break;
    case 1:
      if (even) gemm_phase<0>(p.hbuf, p.wt_hy_in + (size_t)li * 3584 * 1024, 1024, 14, p.proj, LD_EVEN, nullptr, nullptr, smem);
      else gemm_phase<0>(p.hbuf, p.wt_nsa_in + (size_t)li * 2816 * 1024, 1024, 11, p.proj, LD_ODD, nullptr, nullptr, smem);
      break;
    case 2:
      if (even) {
        for (int item = blockIdx.x; item < 256 + 3072; item += gridDim.x) {
          if (item < 256) hgrn_item(p, li, item, smem); else dilated_item(p, li, item - 256, smem);
        }
      } else {
        for (int item = blockIdx.x; item < 256; item += gridDim.x) compress_item(p, li, item, smem);
        nsa_knorm_phase(p, li);
      }
      break;
    case 3:
      if (even) post_even_phase(p, li);
      else {
        for (int item = blockIdx.x; item < 2048; item += gridDim.x) {
          const int r = item / gridDim.x, i = item % gridDim.x;
          int it2 = item;
          if (gridDim.x == 256) {
            const int c = (i + 4 * (r >> 1)) & 31;
            const int tt = (r & 1) ? 31 - c : c;
            it2 = ((i >> 5) + 8 * r) * 32 + tt;
          }
          nsa_item(p, li, it2, smem);
        }
      }
      break;
    case 4:
      gemm_phase<1>(p.hbuf, (even ? p.wt_hy_out : p.wt_nsa_out) + (size_t)li * 1048576, 1024, 4, nullptr, 0, xin, p.out, smem);
      break;
    case 5: rmsnorm_phase(p.out, p.ffn_norm + l * 1024, p.hbuf); break;
    case 6: gemm_phase<2>(p.hbuf, p.wt_gu + (size_t)l * 5632 * 1024, 1024, 22, p.proj, DFF, nullptr, nullptr, smem); break;
    case 7: gemm_phase<1>(p.proj, p.wt_dn + (size_t)l * 1024 * 2816, 2816, 4, nullptr, 0, p.out, p.out, smem, true); break;
  }
}

constexpr int DYN_LDS = 131072;
extern __shared__ __attribute__((aligned(16))) char dyn_smem[];
__global__ void __launch_bounds__(512) mk_forward(Params p) {
  char* smem = dyn_smem;
  __shared__ uint4 xb_words;
  cg::grid_group grid = cg::this_grid();
  if (__builtin_amdgcn_workitem_id_x() == 0) xb_words = make_uint4(0u, 0u, 0u, 0u);
  __syncthreads();
  const XcdBarrier xb = xcd_barrier_post(p.bar, (volatile LAS unsigned*)&xb_words);
  for (int ph = p.phase_lo; ph < p.phase_hi; ++ph) {
    run_phase(p, ph, smem);
    if (ph + 1 < p.phase_hi) {
      if (p.phase_hi < 0) grid.sync();
      xcd_barrier(xb);
    }
  }
}

extern "C" void kernel_launch(void* const* d_in, const int* in_sizes, int n_in, void* d_out, int out_size,
                              void* d_ws, size_t ws_size, hipStream_t stream) {
  static int grid_blocks = 0;
  if (!grid_blocks) {
    int dev = 0, cus = 0, per_cu = 0;
    hipGetDevice(&dev);
    hipDeviceGetAttribute(&cus, hipDeviceAttributeMultiprocessorCount, dev);
    hipFuncSetAttribute((const void*)mk_forward, hipFuncAttributeMaxDynamicSharedMemorySize, DYN_LDS);
    hipOccupancyMaxActiveBlocksPerMultiprocessor(&per_cu, mk_forward, 512, DYN_LDS);
    if (per_cu > 1) per_cu = 1;
    if (per_cu < 1) per_cu = 1;
    grid_blocks = cus * per_cu;
  }
  Params p;
  memset(&p, 0, sizeof(p));
  p.x = (const float*)d_in[0]; p.attn_norm = (const float*)d_in[1]; p.ffn_norm = (const float*)d_in[2];
  p.hy_w_in = (const float*)d_in[3]; p.hy_lb = (const float*)d_in[4]; p.hy_og = (const float*)d_in[5];
  p.hy_qg = (const float*)d_in[6]; p.hy_kg = (const float*)d_in[7]; p.hy_w_out = (const float*)d_in[8];
  p.nsa_w_in = (const float*)d_in[9]; p.nsa_qg = (const float*)d_in[10]; p.nsa_kg = (const float*)d_in[11];
  p.cmp_pe = (const float*)d_in[12]; p.cmp_w1 = (const float*)d_in[13]; p.cmp_w2 = (const float*)d_in[14];
  p.nsa_w_out = (const float*)d_in[15]; p.ffn_g = (const float*)d_in[16]; p.ffn_u = (const float*)d_in[17]; p.ffn_d = (const float*)d_in[18];
  p.out = (float*)d_out;
  char* ws = (char*)d_ws; size_t off = 0;
  auto take = [&](size_t bytes) { char* r = ws + off; off += (bytes + 255) & ~(size_t)255; return r; };
  p.wt_hy_in = (u16*)take((size_t)2 * 3584 * 1024 * 2);
  p.wt_hy_out = (u16*)take((size_t)2 * 1048576 * 2);
  p.wt_nsa_in = (u16*)take((size_t)2 * 2816 * 1024 * 2);
  p.wt_nsa_out = (u16*)take((size_t)2 * 1048576 * 2);
  p.wt_gu = (u16*)take((size_t)4 * 5632 * 1024 * 2);
  p.wt_dn = (u16*)take((size_t)4 * 1024 * 2816 * 2);
  p.wt_c1 = (u16*)take((size_t)4 * 128 * 2048 * 2);
  p.wt_c2 = (u16*)take((size_t)4 * 64 * 128 * 2);
  p.c1 = (float*)take(4 * 128 * 4);
  p.lb = (float*)take(2 * 512 * 4);
  p.lse = (float*)take((size_t)3 * T_ * 8 * 4);
  p.proj = (u16*)take((size_t)T_ * 3584 * 2);
  p.hbuf = (u16*)take((size_t)T_ * 1024 * 2);
  p.obr = (u16*)take((size_t)3 * T_ * 512 * 2);
  p.kcmp = (u16*)take((size_t)16 * 4 * 128 * 64 * 2);
  p.vcmp = (u16*)take((size_t)16 * 4 * 128 * 64 * 2);
  p.bar = (unsigned*)take(XCD_BAR_WORDS * 4);
  if (off > ws_size) { fprintf(stderr, "workspace too small: need %zu have %zu\n", off, ws_size); return; }
  const int NPH = 33;
  hipMemsetAsync(p.bar, 0, XCD_BAR_WORDS * 4, stream);
#if MK_MULTI
  for (int ph = 0; ph < NPH; ++ph) {
    p.phase_lo = ph; p.phase_hi = ph + 1;
    hipLaunchKernelGGL(mk_forward, dim3(grid_blocks), dim3(512), DYN_LDS, stream, p);
  }
#else
  p.phase_lo = 0; p.phase_hi = NPH;
  void* args[] = {&p};
  hipError_t e = hipLaunchCooperativeKernel((void*)mk_forward, dim3(grid_blocks), dim3(512), args, DYN_LDS, stream);
  if (e != hipSuccess) fprintf(stderr, "cooperative launch failed: %s (grid %d)\n", hipGetErrorString(e), grid_blocks);
#endif
}
```

```cpp
#include <hip/hip_runtime.h>
#include <hip/hip_cooperative_groups.h>
#include <cstdio>
#include <cstdint>
#include <cstring>
namespace cg = cooperative_groups;

typedef unsigned short u16;
using bf16x8 = __attribute__((ext_vector_type(8))) short;
using f32x16 = __attribute__((ext_vector_type(16))) float;
using u32x4v = __attribute__((ext_vector_type(4))) unsigned;
#define DI __device__ __forceinline__
#define MFMA32(a, b, c) __builtin_amdgcn_mfma_f32_32x32x16_bf16((a), (b), (c), 0, 0, 0)

#ifndef MK_MULTI
#define MK_MULTI 0
#endif

constexpr int T_ = 32768, S_ = 2048;
constexpr float EPSF = 1e-6f;
constexpr float LOG2E = 1.4426950408889634f, LN2 = 0.6931471805599453f;
constexpr int LD_EVEN = 3584, LD_ODD = 2816, DFF = 2816;
constexpr int NT = 512;
#define LAS __attribute__((address_space(3)))
using f32x4v = __attribute__((ext_vector_type(4))) float;

struct Params {
  const float* x; const float* attn_norm; const float* ffn_norm;
  const float* hy_w_in; const float* hy_lb; const float* hy_og; const float* hy_qg; const float* hy_kg; const float* hy_w_out;
  const float* nsa_w_in; const float* nsa_qg; const float* nsa_kg; const float* cmp_pe; const float* cmp_w1; const float* cmp_w2; const float* nsa_w_out;
  const float* ffn_g; const float* ffn_u; const float* ffn_d;
  float* out;
  u16* wt_hy_in; u16* wt_hy_out; u16* wt_nsa_in; u16* wt_nsa_out; u16* wt_gu; u16* wt_dn; u16* wt_c1; u16* wt_c2;
  float* c1; float* lb; float* lse;
  u16* proj; u16* hbuf; u16* obr; u16* kcmp; u16* vcmp;
  unsigned* bar;
  int phase_lo; int phase_hi;
};

DI int tidx() { int t = __builtin_amdgcn_workitem_id_x(); asm volatile("" : "+v"(t)); return t; }
DI float bf2f(u16 h) { return __uint_as_float(((unsigned)h) << 16); }
typedef __bf16 bf16x2_t __attribute__((ext_vector_type(2)));
typedef float f32x2_t __attribute__((ext_vector_type(2)));
DI unsigned pack2(float a, float b) { f32x2_t v = {a, b}; bf16x2_t r = __builtin_convertvector(v, bf16x2_t); return __builtin_bit_cast(unsigned, r); }
DI u16 f2bf(float x) { return (u16)(pack2(x, 0.f) & 0xffffu); }
DI float fsigmoid(float x) { return __builtin_amdgcn_rcpf(1.f + __expf(-x)); }
DI float fsilu(float x) { return x * __builtin_amdgcn_rcpf(1.f + __expf(-x)); }
DI float fexp2(float x) { return __builtin_amdgcn_exp2f(x); }
DI void unpack8(uint4 v, float (&f)[8]) {
  f[0] = __uint_as_float(v.x << 16); f[1] = __uint_as_float(v.x & 0xffff0000u);
  f[2] = __uint_as_float(v.y << 16); f[3] = __uint_as_float(v.y & 0xffff0000u);
  f[4] = __uint_as_float(v.z << 16); f[5] = __uint_as_float(v.z & 0xffff0000u);
  f[6] = __uint_as_float(v.w << 16); f[7] = __uint_as_float(v.w & 0xffff0000u);
}
DI uint4 pack8(const float (&f)[8]) {
  uint4 o; o.x = pack2(f[0], f[1]); o.y = pack2(f[2], f[3]); o.z = pack2(f[4], f[5]); o.w = pack2(f[6], f[7]); return o;
}
DI bf16x8 as_bf16x8(uint4 v) { u32x4v t; t[0] = v.x; t[1] = v.y; t[2] = v.z; t[3] = v.w; return __builtin_bit_cast(bf16x8, t); }
DI f32x16 zero16() { f32x16 z;
#pragma unroll
  for (int i = 0; i < 16; ++i) z[i] = 0.f; return z; }


#define XB_TMO      128
#define XB_XCNT(j)  (256  + 64 * (j))
#define XB_XSUB(j)  (1280 + 64 * (j))
#define XB_XGEN(j)  (2304 + 64 * (j))
#define XB_TOP      3328
#define XB_TOPGEN   3392
#define XCD_BAR_WORDS 3456
#define XB_SPIN_CAP (1u << 18)
DI unsigned xb_ld(unsigned* p) { return __hip_atomic_load(p, __ATOMIC_RELAXED, __HIP_MEMORY_SCOPE_AGENT); }
DI unsigned xb_add(unsigned* p, unsigned v) { return __hip_atomic_fetch_add(p, v, __ATOMIC_RELAXED, __HIP_MEMORY_SCOPE_AGENT); }
DI unsigned xb_xcc_id() { return (unsigned)__builtin_amdgcn_s_getreg((3 << 11) | 20) & 0xFu; }
#define XB_SPIN(cond, bar) do { unsigned _sp = 0; while (cond) { __builtin_amdgcn_s_sleep(1); \
    if ((++_sp & 255u) == 0u) { if (xb_ld(&(bar)[XB_TMO])) break; if (_sp > XB_SPIN_CAP) { atomicAdd(&(bar)[XB_TMO], 1u); break; } } } } while (0)
struct XcdBarrier { unsigned* bar; unsigned x; volatile LAS unsigned* st; };
DI XcdBarrier xcd_barrier_post(unsigned* bar, volatile LAS unsigned* st) {
  XcdBarrier b; b.bar = bar; b.x = xb_xcc_id(); b.st = st;
  if (__builtin_amdgcn_workitem_id_x() == 0) (void)xb_add(&bar[XB_XCNT(b.x)], 1u);
  return b;
}
DI void xcd_barrier_complete(unsigned* bar, unsigned x, unsigned& nloc, unsigned& nx) {
  const unsigned G = gridDim.x * gridDim.y * gridDim.z;
  unsigned sum, cnt, mine, sp = 0u;
  for (;;) {
    sum = 0u; cnt = 0u; mine = 0u;
#pragma unroll
    for (unsigned j = 0; j < 16; ++j) { const unsigned c = xb_ld(&bar[XB_XCNT(j)]); sum += c; cnt += (c > 0u) ? 1u : 0u; mine = (j == x) ? c : mine; }
    if (sum == G) break;
    __builtin_amdgcn_s_sleep(1);
    if ((++sp & 255u) == 0u) { if (xb_ld(&bar[XB_TMO])) break; if (sp > XB_SPIN_CAP) { atomicAdd(&bar[XB_TMO], 1u); break; } }
  }
  nloc = mine > 0u ? mine : 1u; nx = cnt > 0u ? cnt : 1u;
}
DI void xcd_barrier(const XcdBarrier& b) {
  asm volatile("s_waitcnt vmcnt(0)" ::: "memory");
  __syncthreads();
  if (__builtin_amdgcn_workitem_id_x() == 0) {
    unsigned* bar = b.bar;
    __builtin_amdgcn_s_waitcnt(0);
    unsigned nloc = b.st[0], nx = b.st[1];
    if (nloc == 0u) { xcd_barrier_complete(bar, b.x, nloc, nx); b.st[0] = nloc; b.st[1] = nx; }
    const unsigned old = xb_add(&bar[XB_XSUB(b.x)], 1u);
    const unsigned gen = old / nloc;
    if (old + 1u == (gen + 1u) * nloc) {
      __builtin_amdgcn_fence(__ATOMIC_RELEASE, "agent");
      asm volatile("s_waitcnt vmcnt(0)" ::: "memory");
      const unsigned og = xb_add(&bar[XB_TOP], 1u);
      const unsigned tg = og / nx;
      if (og + 1u == (tg + 1u) * nx) xb_add(&bar[XB_TOPGEN], 1u);
      else XB_SPIN(xb_ld(&bar[XB_TOPGEN]) == tg, bar);
      __builtin_amdgcn_fence(__ATOMIC_ACQUIRE, "agent");
      xb_add(&bar[XB_XGEN(b.x)], 1u);
      asm volatile("s_waitcnt vmcnt(0)" ::: "memory");
    } else {
      XB_SPIN(xb_ld(&bar[XB_XGEN(b.x)]) == gen, bar);
      __builtin_amdgcn_fence(__ATOMIC_ACQUIRE, "agent");
      asm volatile("s_waitcnt vmcnt(0)" ::: "memory");
    }
  }
  __syncthreads();
}

struct PrepDesc { const float* src; u16* dst; int K, N, mode, tk, tn; };
DI PrepDesc prep_desc(const Params& p, int tile) {
  constexpr int G0 = 1792, G1 = 2304, G2 = 3712, G3 = 4224, G4 = 7040, G5 = 9856, G6 = 12672, G7 = 12928;
  PrepDesc d; int Np, lt; d.mode = 0;
  if (tile < G0) { int i = tile / 896; lt = tile % 896; d.src = p.hy_w_in + (size_t)i * 1024 * 3584; d.dst = p.wt_hy_in + (size_t)i * 3584 * 1024; d.K = 1024; d.N = 3584; Np = 3584; }
  else if (tile < G1) { int t = tile - G0; int i = t / 256; lt = t % 256; d.src = p.hy_w_out + (size_t)i * 1048576; d.dst = p.wt_hy_out + (size_t)i * 1048576; d.K = 1024; d.N = 1024; Np = 1024; }
  else if (tile < G2) { int t = tile - G1; int i = t / 704; lt = t % 704; d.src = p.nsa_w_in + (size_t)i * 1024 * 2608; d.dst = p.wt_nsa_in + (size_t)i * 2816 * 1024; d.K = 1024; d.N = 2608; Np = 2816; }
  else if (tile < G3) { int t = tile - G2; int i = t / 256; lt = t % 256; d.src = p.nsa_w_out + (size_t)i * 1048576; d.dst = p.wt_nsa_out + (size_t)i * 1048576; d.K = 1024; d.N = 1024; Np = 1024; }
  else if (tile < G4) { int t = tile - G3; int i = t / 704; lt = t % 704; d.src = p.ffn_g + (size_t)i * 1024 * 2816; d.dst = p.wt_gu + (size_t)i * 5632 * 1024; d.K = 1024; d.N = 2816; Np = 2816; d.mode = 1; }
  else if (tile < G5) { int t = tile - G4; int i = t / 704; lt = t % 704; d.src = p.ffn_u + (size_t)i * 1024 * 2816; d.dst = p.wt_gu + (size_t)i * 5632 * 1024; d.K = 1024; d.N = 2816; Np = 2816; d.mode = 2; }
  else if (tile < G6) { int t = tile - G5; int i = t / 704; lt = t % 704; d.src = p.ffn_d + (size_t)i * 2816 * 1024; d.dst = p.wt_dn + (size_t)i * 1024 * 2816; d.K = 2816; d.N = 1024; Np = 1024; }
  else if (tile < G7) { int t = tile - G6; int i = t / 64; lt = t % 64; d.src = p.cmp_w1 + (size_t)i * 2048 * 128; d.dst = p.wt_c1 + (size_t)i * 128 * 2048; d.K = 2048; d.N = 128; Np = 128; }
  else { int t = tile - G7; int i = t / 2; lt = t % 2; d.src = p.cmp_w2 + (size_t)i * 128 * 64; d.dst = p.wt_c2 + (size_t)i * 64 * 128; d.K = 128; d.N = 64; Np = 64; }
  const int ntn = Np / 64;
  d.tk = lt / ntn; d.tn = lt % ntn;
  return d;
}
DI void prep_load(const PrepDesc& d, int tid, float (&rv)[8]) {
  const int c = tid & 63; const int n = d.tn * 64 + c; const int nc = n < d.N ? n : d.N - 1;
#pragma unroll
  for (int j = 0; j < 8; ++j) {
    const int r = (tid >> 6) + 8 * j;
    rv[j] = d.src[(size_t)(d.tk * 64 + r) * d.N + nc];
  }
}

DI void prep_phase(const Params& p, char* smem) {
  float* sm = (float*)smem;
  constexpr int G8 = 12936;
  const int tid = tidx();
  float rv[8];
  int tile = blockIdx.x;
  asm volatile("" : "+s"(tile));
  if (tile < G8) { const PrepDesc d0 = prep_desc(p, tile); prep_load(d0, tid, rv); }
  for (; tile < G8; tile += gridDim.x) {
    const PrepDesc d = prep_desc(p, tile);
    __syncthreads();
#pragma unroll
    for (int j = 0; j < 8; ++j) sm[((tid >> 6) + 8 * j) * 65 + (tid & 63)] = rv[j];
    __syncthreads();
    if (tile + (int)gridDim.x < G8) { const PrepDesc dn = prep_desc(p, tile + gridDim.x); prep_load(dn, tid, rv); }
    const int nl = tid >> 3, kp = tid & 7;
    const int n = d.tn * 64 + nl;
    int nd = n;
    if (d.mode == 1) nd = (n >> 4) * 32 + (n & 15);
    else if (d.mode == 2) nd = (n >> 4) * 32 + 16 + (n & 15);
    float v[8];
#pragma unroll
    for (int j = 0; j < 8; ++j) v[j] = sm[(kp * 8 + j) * 65 + nl];
    *(uint4*)(d.dst + (size_t)nd * d.K + d.tk * 64 + kp * 8) = pack8(v);
  }
  __syncthreads();
  if (blockIdx.x < 4) {
    const int mi = blockIdx.x;
    const float* pe = p.cmp_pe + (size_t)mi * 2048;
    const float* w1 = p.cmp_w1 + (size_t)mi * 2048 * 128;
    const int tq_ = tidx();
    const int o = tq_ & 127, half = tq_ >> 7;
    float a0 = 0.f, a1 = 0.f, a2 = 0.f, a3 = 0.f;
    for (int k = half * 512; k < half * 512 + 512; k += 4) {
      a0 += pe[k] * w1[(size_t)k * 128 + o]; a1 += pe[k + 1] * w1[(size_t)(k + 1) * 128 + o];
      a2 += pe[k + 2] * w1[(size_t)(k + 2) * 128 + o]; a3 += pe[k + 3] * w1[(size_t)(k + 3) * 128 + o];
    }
    sm[tq_] = (a0 + a1) + (a2 + a3);
    __syncthreads();
    if (tq_ < 128) p.c1[mi * 128 + tq_] = (sm[tq_] + sm[tq_ + 128]) + (sm[tq_ + 256] + sm[tq_ + 384]);
    __syncthreads();
  }
  if (blockIdx.x == 4 || (gridDim.x <= 4 && blockIdx.x == 0)) {
    for (int c = tidx(); c < 512; c += NT) {
      float l0 = p.hy_lb[c], l1 = p.hy_lb[512 + c];
      float mx = fmaxf(l0, l1); float e0 = __expf(l0 - mx), e1 = __expf(l1 - mx); float inv = 1.f / (e0 + e1);
      float p0 = e0 * inv, p1 = e1 * inv;
      p.lb[c] = p0 - p0; p.lb[512 + c] = (p0 + p1) - p0;
    }
  }
}

DI void rmsnorm_phase(const float* x, const float* __restrict__ g, u16* h) {
  const int t_ = tidx();
  const int wave = t_ >> 6, lane = t_ & 63;
  const int stride = gridDim.x * 8;
  int row = blockIdx.x * 8 + wave;
  float4 v[4], nv[4];
  float4 gg[4];
#pragma unroll
  for (int j = 0; j < 4; ++j) gg[j] = ((const float4*)g)[lane + 64 * j];
  if (row < T_) {
    const float4* xr = (const float4*)(x + (size_t)row * 1024);
#pragma unroll
    for (int j = 0; j < 4; ++j) v[j] = xr[lane + 64 * j];
  }
  while (row < T_) {
    const int nrow = row + stride;
    if (nrow < T_) {
      const float4* xr = (const float4*)(x + (size_t)nrow * 1024);
#pragma unroll
      for (int j = 0; j < 4; ++j) nv[j] = xr[lane + 64 * j];
    }
    float ss = 0.f;
#pragma unroll
    for (int j = 0; j < 4; ++j) ss += v[j].x * v[j].x + v[j].y * v[j].y + v[j].z * v[j].z + v[j].w * v[j].w;
#pragma unroll
    for (int off = 32; off >= 1; off >>= 1) ss += __shfl_xor(ss, off);
    const float rs = rsqrtf(ss * (1.f / 1024.f) + EPSF);
#pragma unroll
    for (int j = 0; j < 4; ++j) {
      uint2 o; o.x = pack2(v[j].x * rs * gg[j].x, v[j].y * rs * gg[j].y); o.y = pack2(v[j].z * rs * gg[j].z, v[j].w * rs * gg[j].w);
      *(uint2*)(h + (size_t)row * 1024 + (lane + 64 * j) * 4) = o;
    }
#pragma unroll
    for (int j = 0; j < 4; ++j) v[j] = nv[j];
    row = nrow;
  }
}

DI int lds_byte(int r, int c) { const int st = (r >> 4) * 2 + (c >> 5), rr = r & 15, cc = c & 31, ob = rr * 64 + cc * 2; return st * 1024 + (ob ^ (((ob >> 9) & 1) << 5)); }
DI void stage_rc(int b, int& R, int& C) { const int st = b / 1024, sb = b % 1024, swz = sb ^ (((sb >> 9) & 1) << 5); R = (st >> 1) * 16 + swz / 64; C = (st & 1) * 32 + (swz % 64) / 2; }

template <int EPI>
DI void gemm_phase(const u16* A, const u16* Bt, const int K, const int nN, u16* outb, const int ldc, const float* res, float* outf, char* smem, const bool rev = false) {
  constexpr int HTB = 16384;
  const int tid = tidx();
  const int wid = tid >> 6, lane = tid & 63, wr = wid >> 2, wc = wid & 3, fr = lane & 15, fq = lane >> 4;
  const int nM = 128, nwg = nM * nN, nt = K / 64;
  int sR0, sC0, sR1, sC1; stage_rc(tid * 16, sR0, sC0); stage_rc(tid * 16 + 8192, sR1, sC1);
  const unsigned vo0 = (unsigned)((sR0 * K + sC0) * 2), vo1 = (unsigned)((sR1 * K + sC1) * 2);
#define SA_(b, h) (smem + ((b) * 2 + (h)) * HTB)
#define SB_(b, h) (smem + (4 + (b) * 2 + (h)) * HTB)
#define STAGE(P, BASE, br, kt) do { const char* _g = (const char*)((BASE) + (size_t)(br) * K + (size_t)(kt) * 64); \
    unsigned _o0 = vo0, _o1 = vo1; asm volatile("" : "+v"(_o0), "+v"(_o1)); \
    __builtin_amdgcn_global_load_lds((const unsigned*)(_g + _o0), (LAS unsigned*)((P) + tid * 16), 16, 0, 0); \
    __builtin_amdgcn_global_load_lds((const unsigned*)(_g + _o1), (LAS unsigned*)((P) + tid * 16 + 8192), 16, 0, 0); } while (0)
  const int ob_ = fr * 64 + fq * 16, swz_ = ob_ ^ (((ob_ >> 9) & 1) << 5);
  const int aoff = wr * 8192 + swz_, boff = wc * 4096 + swz_;
#define LDA(dst, b, h) _Pragma("unroll") for (int m = 0; m < 4; ++m) _Pragma("unroll") for (int k = 0; k < 2; ++k) \
    dst[m][k] = *(const bf16x8*)(SA_(b, h) + aoff + m * 2048 + k * 1024)
#define LDB(dst, b, h) _Pragma("unroll") for (int n = 0; n < 2; ++n) _Pragma("unroll") for (int k = 0; k < 2; ++k) \
    dst[n][k] = *(const bf16x8*)(SB_(b, h) + boff + n * 2048 + k * 1024)
#define MMA(ai, bj, At_, Bx_) do { __builtin_amdgcn_s_setprio(1); \
    _Pragma("unroll") for (int m = 0; m < 4; ++m) _Pragma("unroll") for (int n = 0; n < 2; ++n) _Pragma("unroll") for (int k = 0; k < 2; ++k) \
      acc[ai][bj][m][n] = __builtin_amdgcn_mfma_f32_16x16x32_bf16(Bx_[n][k], At_[m][k], acc[ai][bj][m][n], 0, 0, 0); \
    __builtin_amdgcn_s_setprio(0); } while (0)
#define WAIT_V(n) asm volatile("s_waitcnt vmcnt(" #n ")" ::: "memory")
#define WAIT_L(n) asm volatile("s_waitcnt lgkmcnt(" #n ")" ::: "memory")
#define BAR __builtin_amdgcn_s_barrier()
#define SCHED __builtin_amdgcn_sched_barrier(0)
  auto tile_of = [&](long Lq, int& brow_, int& bcol_, int& pn_) {
    int wgid = (int)Lq;
    { const int q = nwg / 8, r = nwg % 8, xcd = wgid % 8, off = wgid / 8; wgid = (xcd < r ? xcd * (q + 1) : r * (q + 1) + (xcd - r) * q) + off; }
    const int nig = 8 * nN, gid = wgid / nig, fm = gid * 8, gsz = (nM - fm) < 8 ? (nM - fm) : 8;
    const int pm = fm + ((wgid % nig) % gsz);
    pn_ = (wgid % nig) / gsz; brow_ = (rev ? (nM - 1 - pm) : pm) * 256; bcol_ = pn_ * 256;
  };
#define STAGE7(br_, bc_) do { STAGE(SB_(0, 0), Bt, bc_, 0); STAGE(SA_(0, 0), A, br_, 0); STAGE(SB_(0, 1), Bt, (bc_) + 128, 0); STAGE(SA_(0, 1), A, (br_) + 128, 0); \
    STAGE(SB_(1, 0), Bt, bc_, 1); STAGE(SA_(1, 0), A, br_, 1); STAGE(SB_(1, 1), Bt, (bc_) + 128, 1); } while (0)
  long L = blockIdx.x;
  bool have = L < nwg;
  int brow = 0, bcol = 0, pn = 0;
  __syncthreads();
  if (have) { tile_of(L, brow, bcol, pn); STAGE7(brow, bcol); }
  while (have) {
    f32x4v acc[2][2][4][2];
#pragma unroll
    for (int a = 0; a < 2; ++a)
#pragma unroll
      for (int b = 0; b < 2; ++b)
#pragma unroll
        for (int m = 0; m < 4; ++m)
#pragma unroll
          for (int n = 0; n < 2; ++n) acc[a][b][m][n] = (f32x4v){0.f, 0.f, 0.f, 0.f};
    bf16x8 At[4][2], B0[2][2], B1[2][2];
    if (wr == 1) BAR;
    WAIT_V(0); BAR;
    BAR;
    for (int t = 0; t < nt - 2; t += 2) {
      LDB(B0, 0, 0); SCHED; LDA(At, 0, 0); STAGE(SA_(1, 1), A, brow + 128, t + 1);
      WAIT_L(8); BAR; WAIT_L(0); MMA(0, 0, At, B0); BAR; SCHED;
      LDB(B1, 0, 1); STAGE(SB_(0, 0), Bt, bcol, t + 2);
      BAR; WAIT_L(0); MMA(0, 1, At, B1); BAR;
      LDA(At, 0, 1); STAGE(SA_(0, 0), A, brow, t + 2);
      BAR; WAIT_L(0); MMA(1, 0, At, B0); BAR; SCHED;
      STAGE(SB_(0, 1), Bt, bcol + 128, t + 2);
      WAIT_V(6); BAR; MMA(1, 1, At, B1); BAR;
      LDB(B0, 1, 0); SCHED; LDA(At, 1, 0); STAGE(SA_(0, 1), A, brow + 128, t + 2);
      WAIT_L(8); BAR; WAIT_L(0); MMA(0, 0, At, B0); BAR; SCHED;
      LDB(B1, 1, 1); STAGE(SB_(1, 0), Bt, bcol, t + 3);
      BAR; WAIT_L(0); MMA(0, 1, At, B1); BAR;
      LDA(At, 1, 1); STAGE(SA_(1, 0), A, brow, t + 3);
      BAR; WAIT_L(0); MMA(1, 0, At, B0); BAR; SCHED;
      STAGE(SB_(1, 1), Bt, bcol + 128, t + 3);
      WAIT_V(6); BAR; MMA(1, 1, At, B1); BAR;
    }
    { LDB(B0, 0, 0); LDA(At, 0, 0); STAGE(SA_(1, 1), A, brow + 128, nt - 1);
      BAR; WAIT_L(0); MMA(0, 0, At, B0); BAR;
      LDB(B1, 0, 1); BAR; WAIT_L(0); MMA(0, 1, At, B1); BAR;
      LDA(At, 0, 1); WAIT_V(4); BAR; WAIT_L(0); MMA(1, 0, At, B0); MMA(1, 1, At, B1); BAR; }
    { LDB(B0, 1, 0); LDA(At, 1, 0); WAIT_V(2); BAR; WAIT_L(0); MMA(0, 0, At, B0); BAR;
      LDB(B1, 1, 1); WAIT_V(0); BAR; WAIT_L(0); MMA(0, 1, At, B1); BAR;
      LDA(At, 1, 1); BAR; WAIT_L(0); MMA(1, 0, At, B0); MMA(1, 1, At, B1); BAR; }
    if (wr == 0) BAR;
    const long Ln = L + gridDim.x;
    const bool haven = Ln < nwg;
    int browN = 0, bcolN = 0, pnN = 0;
    if (haven) { tile_of(Ln, browN, bcolN, pnN); STAGE7(browN, bcolN); }
    int tid2 = tid; asm volatile("" : "+v"(tid2));
    const int fr2 = tid2 & 15, fq2 = (tid2 >> 4) & 3, wc2 = (tid2 >> 6) & 3, wr2 = tid2 >> 8;
    if (EPI == 1) {
#pragma unroll
      for (int am = 0; am < 4; ++am) {
        const int ai = am >> 1, m0 = (am & 1) * 2;
        f32x4v rb[2][2][2];
        const float* rbase = res + (size_t)(brow + ai * 128 + wr2 * 64 + m0 * 16 + fr2) * 1024 + bcol + wc2 * 32 + fq2 * 4;
        float* obase = outf + (size_t)(brow + ai * 128 + wr2 * 64 + m0 * 16 + fr2) * 1024 + bcol + wc2 * 32 + fq2 * 4;
#pragma unroll
        for (int m = 0; m < 2; ++m)
#pragma unroll
          for (int bj = 0; bj < 2; ++bj)
#pragma unroll
            for (int n = 0; n < 2; ++n) rb[m][bj][n] = *(const f32x4v*)(rbase + (size_t)m * 16 * 1024 + bj * 128 + n * 16);
        asm volatile("" ::: "memory");
#pragma unroll
        for (int m = 0; m < 2; ++m)
#pragma unroll
          for (int bj = 0; bj < 2; ++bj)
#pragma unroll
            for (int n = 0; n < 2; ++n) *(f32x4v*)(obase + (size_t)m * 16 * 1024 + bj * 128 + n * 16) = rb[m][bj][n] + acc[ai][bj][m0 + m][n];
        asm volatile("" ::: "memory");
      }
    } else {
#pragma unroll
    for (int ai = 0; ai < 2; ++ai)
#pragma unroll
      for (int m = 0; m < 4; ++m) {
        const size_t row = (size_t)(brow + ai * 128 + wr2 * 64 + m * 16 + fr2);
#pragma unroll
        for (int bj = 0; bj < 2; ++bj) {
          const int cb = bcol + bj * 128 + wc2 * 32 + fq2 * 4;
          if (EPI == 0) {
#pragma unroll
            for (int n = 0; n < 2; ++n) {
              uint2 o; o.x = pack2(acc[ai][bj][m][n][0], acc[ai][bj][m][n][1]); o.y = pack2(acc[ai][bj][m][n][2], acc[ai][bj][m][n][3]);
              *(uint2*)(outb + row * ldc + cb + n * 16) = o;
            }
          } else {
            const f32x4v gv = acc[ai][bj][m][0], uv = acc[ai][bj][m][1];
            uint2 o; o.x = pack2(fsilu(gv[0]) * uv[0], fsilu(gv[1]) * uv[1]); o.y = pack2(fsilu(gv[2]) * uv[2], fsilu(gv[3]) * uv[3]);
            *(uint2*)(outb + row * DFF + ((bcol + bj * 128 + wc2 * 32) >> 1) + fq2 * 4) = o;
          }
        }
      }
    }
    L = Ln; have = haven; brow = browN; bcol = bcolN; pn = pnN;
  }
  __syncthreads();
#undef STAGE7
#undef SA_
#undef SB_
#undef STAGE
#undef LDA
#undef LDB
#undef MMA
}

#define MFMA16(a, b, c) __builtin_amdgcn_mfma_f32_16x16x32_bf16((a), (b), (c), 0, 0, 0)
DI void hgrn_item(const Params& p, int li, int item, char* smem) {
  const int tid = tidx(), lane = tid & 63, w = tid >> 6, fr = lane & 15, fq = lane >> 4;
  const int kk = w >> 1, vt = w & 1;
  const int vs = item & 3, h = (item >> 2) & 3, b = item >> 4;
  const int tg = tid & 3, kch = tid >> 2;
  const int sv = tid >> 5, vv = tid & 31;
  const float lbv = p.lb[li * 512 + h * 128 + kch];
  const u16* base = p.proj + (size_t)b * S_ * LD_EVEN;
  const u16* pq = base + (size_t)(4 * tg) * LD_EVEN + h * 128 + kch;
  const u16* pv = base + (size_t)sv * LD_EVEN + 1024 + h * 128 + vs * 32 + vv;
  struct HRegs { unsigned q0, q1, q2, q3, f0, f1, f2, f3, v; };
  auto hload = [&](int c, HRegs& r) {
    const u16* pq2 = pq + (size_t)c * 16 * LD_EVEN;
    r.q0 = pq2[0]; r.q1 = pq2[LD_EVEN]; r.q2 = pq2[2 * LD_EVEN]; r.q3 = pq2[3 * LD_EVEN];
    r.f0 = pq2[512]; r.f1 = pq2[LD_EVEN + 512]; r.f2 = pq2[2 * LD_EVEN + 512]; r.f3 = pq2[3 * LD_EVEN + 512];
    r.v = pv[(size_t)c * 16 * LD_EVEN];
  };
  HRegs ra, rb;
  hload(0, ra); hload(1, rb);
  f32x4v S0 = {0.f, 0.f, 0.f, 0.f}, S1 = {0.f, 0.f, 0.f, 0.f};
  const f32x4v z4 = {0.f, 0.f, 0.f, 0.f};
  __syncthreads();
  constexpr int HBUF = 16896;
  auto prep = [&](const HRegs& rr, int par) {
    u16* Qt_ = (u16*)(smem + par * HBUF); u16* Kt_ = Qt_ + 16 * 136; u16* Kh_ = Kt_ + 16 * 136; u16* Vt_ = Kh_ + 128 * 24; float* Pc_ = (float*)(Vt_ + 32 * 24);
    float qv[4], kv[4], cs[4];
    const unsigned rq[4] = {rr.q0, rr.q1, rr.q2, rr.q3}, rf[4] = {rr.f0, rr.f1, rr.f2, rr.f3};
    float cp = 1.f;
#pragma unroll
    for (int i = 0; i < 4; ++i) {
      const float f = lbv + (1.f - lbv) * fsigmoid(__uint_as_float(rf[i] << 16));
      cp *= f; cs[i] = cp; kv[i] = 1.f - f; qv[i] = fsilu(__uint_as_float(rq[i] << 16));
    }
    const int bl = lane & ~3;
    const float t0 = __shfl(cp, bl), t1 = __shfl(cp, bl + 1), t2 = __shfl(cp, bl + 2), t3 = __shfl(cp, bl + 3);
    const float pre = (tg > 0 ? t0 : 1.f) * (tg > 1 ? t1 : 1.f) * (tg > 2 ? t2 : 1.f);
    const float PC = (t0 * t1) * (t2 * t3);
    float kh[4];
#pragma unroll
    for (int i = 0; i < 4; ++i) {
      const float P = fmaxf(pre * cs[i], 1e-30f);
      const float rP = __builtin_amdgcn_rcpf(P);
      const int t = 4 * tg + i;
      Qt_[t * 136 + kch] = f2bf(qv[i] * P);
      const float kr = kv[i] * rP;
      Kt_[t * 136 + kch] = f2bf(kr);
      kh[i] = kr * PC;
    }
    uint2 k2; k2.x = pack2(kh[0], kh[1]); k2.y = pack2(kh[2], kh[3]);
    *(uint2*)(Kh_ + kch * 24 + 4 * tg) = k2;
    if (tg == 0) Pc_[kch] = PC;
    Vt_[vv * 24 + sv] = (u16)rr.v;
  };
  auto mfma = [&](int par) {
    const u16* Qt_ = (const u16*)(smem + par * HBUF); const u16* Kt_ = Qt_ + 16 * 136; const u16* Kh_ = Kt_ + 16 * 136; const u16* Vt_ = Kh_ + 128 * 24;
    const float* Pc_ = (const float*)(Vt_ + 32 * 24);
    float* Op_ = (float*)(smem + 4 * HBUF) + par * 2048;
    const uint2 v2 = *(const uint2*)(Vt_ + (16 * vt + fr) * 24 + 4 * fq);
    const bf16x8 vb = as_bf16x8(make_uint4(v2.x, v2.y, 0u, 0u));
    const u16* qrow = Qt_ + fr * 136 + 32 * kk + 4 * fq;
    const uint2 qa = *(const uint2*)qrow, qb = *(const uint2*)(qrow + 16);
    const bf16x8 qfrag = as_bf16x8(make_uint4(qa.x, qa.y, qb.x, qb.y));
    const bf16x8 sfrag = as_bf16x8(make_uint4(pack2(S0[0], S0[1]), pack2(S0[2], S0[3]), pack2(S1[0], S1[1]), pack2(S1[2], S1[3])));
    f32x4v acc = MFMA16(qfrag, sfrag, z4);
    if (kk == 0) {
      f32x4v sa = z4;
#pragma unroll
      for (int ks = 0; ks < 4; ++ks) {
        const bf16x8 kf = *(const bf16x8*)(Kt_ + fr * 136 + 32 * ks + 8 * fq);
        const bf16x8 qf2 = *(const bf16x8*)(Qt_ + fr * 136 + 32 * ks + 8 * fq);
        sa = MFMA16(kf, qf2, sa);
      }
#pragma unroll
      for (int j = 0; j < 4; ++j) sa[j] = (4 * fq + j <= fr) ? sa[j] : 0.f;
      const bf16x8 afrag = as_bf16x8(make_uint4(pack2(sa[0], sa[1]), pack2(sa[2], sa[3]), 0u, 0u));
      acc = MFMA16(afrag, vb, acc);
    }
#pragma unroll
    for (int j = 0; j < 4; ++j) Op_[(w * 16 + 4 * fq + j) * 16 + fr] = acc[j];
    const float* pc0 = Pc_ + 32 * kk + 4 * fq;
#pragma unroll
    for (int j = 0; j < 4; ++j) { S0[j] *= pc0[j]; S1[j] *= pc0[16 + j]; }
    const uint2 h0 = *(const uint2*)(Kh_ + (32 * kk + fr) * 24 + 4 * fq);
    const uint2 h1v = *(const uint2*)(Kh_ + (32 * kk + 16 + fr) * 24 + 4 * fq);
    S0 = MFMA16(as_bf16x8(make_uint4(h0.x, h0.y, 0u, 0u)), vb, S0);
    S1 = MFMA16(as_bf16x8(make_uint4(h1v.x, h1v.y, 0u, 0u)), vb, S1);
  };
  auto reduce = [&](int c, int par) {
    const float* Op_ = (const float*)(smem + 4 * HBUF) + par * 2048;
    const int t = tid >> 5, v = tid & 31, vtt = v >> 4, vl = v & 15;
    float o = 0.f;
#pragma unroll
    for (int q = 0; q < 4; ++q) o += Op_[((2 * q + vtt) * 16 + t) * 16 + vl];
    p.hbuf[(size_t)(b * S_ + c * 16 + t) * 1024 + h * 128 + vs * 32 + v] = f2bf(o);
  };
  prep(ra, 0); prep(rb, 1); hload(2, ra); hload(3, rb);
  __syncthreads();
#pragma unroll 1
  for (int P = 0; P < 64; P += 2) {
    mfma(0); mfma(1);
    prep(ra, 2); prep(rb, 3);
    if (P + 2 < 64) { hload(2 * P + 4, ra); hload(2 * P + 5, rb); }
    __syncthreads();
    reduce(2 * P, 0); reduce(2 * P + 1, 1);
    mfma(2); mfma(3);
    if (P + 2 < 64) { prep(ra, 0); prep(rb, 1); if (P + 3 < 64) { hload(2 * P + 6, ra); hload(2 * P + 7, rb); } }
    __syncthreads();
    reduce(2 * P + 2, 2); reduce(2 * P + 3, 3);
  }
  __syncthreads();
}

struct QRaw { u32x4v r[4]; };
DI void load_q_raw(const u16* qrow, int hh, QRaw& q) {
#pragma unroll
  for (int kk = 0; kk < 4; ++kk) q.r[kk] = *(const u32x4v*)(qrow + kk * 16 + hh * 8);
}
DI void make_q(const QRaw& q, const float* __restrict__ gain, int hh, bf16x8 (&qf)[4]) {
  float f[4][8]; float ss = 0.f;
#pragma unroll
  for (int kk = 0; kk < 4; ++kk) {
    unpack8(make_uint4(q.r[kk][0], q.r[kk][1], q.r[kk][2], q.r[kk][3]), f[kk]);
#pragma unroll
    for (int j = 0; j < 8; ++j) ss += f[kk][j] * f[kk][j];
  }
  ss += __shfl_xor(ss, 32);
  const float rs = rsqrtf(ss * (1.f / 64.f) + EPSF) * (0.125f * LOG2E);
#pragma unroll
  for (int kk = 0; kk < 4; ++kk) {
#pragma unroll
    for (int j = 0; j < 8; ++j) f[kk][j] *= rs * gain[kk * 16 + hh * 8 + j];
    qf[kk] = as_bf16x8(pack8(f[kk]));
  }
}

constexpr int VS = 68;
constexpr int KVBUF = 18432;
template <int NTH> struct KVRegs { u32x4v r[NTH == 256 ? 4 : 2]; };
DI void kv_ld2(const u16* src, size_t stride, int ra, int rb, int rlo, int rhi, int dp, u32x4v& x0, u32x4v& x1) {
  const int ca = ra < rlo ? rlo : ra, cb = rb < rlo ? rlo : rb;
  x0 = *(const u32x4v*)(src + (size_t)ca * stride + dp * 8);
  x1 = *(const u32x4v*)(src + (size_t)cb * stride + dp * 8);
}
template <int NTH>
DI void kv_load(int tid, const u16* kb, const u16* vb, size_t stride, int r0, int rlo, int rhi, KVRegs<NTH>& rg) {
  const int dp = tid & 7, kq = (tid & 255) >> 3;
  if (NTH == 256) {
    kv_ld2(kb, stride, r0 + kq, r0 + kq + 32, rlo, rhi, dp, rg.r[0], rg.r[1]);
    kv_ld2(vb, stride, r0 + 2 * kq, r0 + 2 * kq + 1, rlo, rhi, dp, rg.r[2], rg.r[3]);
  } else {
    if (tid < 256) kv_ld2(kb, stride, r0 + kq, r0 + kq + 32, rlo, rhi, dp, rg.r[0], rg.r[1]);
    else kv_ld2(vb, stride, r0 + 2 * kq, r0 + 2 * kq + 1, rlo, rhi, dp, rg.r[0], rg.r[1]);
  }
}
DI void k_store1(u32x4v x, int key, int dp, const float* __restrict__ kgain, u16* Ks) {
  uint4 kv = make_uint4(x[0], x[1], x[2], x[3]);
  if (kgain) {
    float f[8]; unpack8(kv, f);
    float ss = 0.f;
#pragma unroll
    for (int e = 0; e < 8; ++e) ss += f[e] * f[e];
    ss += __shfl_xor(ss, 1); ss += __shfl_xor(ss, 2); ss += __shfl_xor(ss, 4);
    const float rs = rsqrtf(ss * (1.f / 64.f) + EPSF);
#pragma unroll
    for (int e = 0; e < 8; ++e) f[e] *= rs * kgain[dp * 8 + e];
    kv = pack8(f);
  }
  *(uint4*)(Ks + key * 72 + dp * 8) = kv;
}
DI void v_store2(u32x4v v0, u32x4v v1, int kp, int dp, u16* Vts) {
  unsigned* vd = (unsigned*)(Vts + (dp * 8) * VS + 2 * kp);
#pragma unroll
  for (int d = 0; d < 4; ++d) {
    vd[(2 * d) * (VS / 2)] = (v0[d] & 0xffffu) | (v1[d] << 16);
    vd[(2 * d + 1) * (VS / 2)] = (v0[d] >> 16) | (v1[d] & 0xffff0000u);
  }
}
template <int NTH>
DI void kv_store(int tid, const KVRegs<NTH>& rg, const float* __restrict__ kgain, u16* Ks, u16* Vts) {
  const int dp = tid & 7, kq = (tid & 255) >> 3;
  if (NTH == 256) {
    k_store1(rg.r[0], kq, dp, kgain, Ks); k_store1(rg.r[1], kq + 32, dp, kgain, Ks);
    v_store2(rg.r[2], rg.r[3], kq, dp, Vts);
  } else {
    if (tid < 256) { k_store1(rg.r[0], kq, dp, kgain, Ks); k_store1(rg.r[1], kq + 32, dp, kgain, Ks); }
    else v_store2(rg.r[0], rg.r[1], kq, dp, Vts);
  }
}

DI void score_stage(const bf16x8 (&qf)[4], const u16* Ks, int lane, float sk, float sb, int lower, int lim, f32x16 (&s)[2], float& mx) {
  const int lr = lane & 31, hh = lane >> 5;
#pragma unroll
  for (int sub = 0; sub < 2; ++sub) {
#pragma unroll
    for (int i = 0; i < 16; ++i) s[sub][i] = fmaf(sk, (float)(sub * 32 + (i & 3) + 8 * (i >> 2)), sb);
#pragma unroll
    for (int kk = 0; kk < 4; ++kk) {
      bf16x8 kf = *(const bf16x8*)(Ks + (sub * 32 + lr) * 72 + kk * 16 + hh * 8);
      s[sub] = MFMA32(kf, qf[kk], s[sub]);
    }
  }
  if (lim < lower) { lower = 64; lim = 64; }
  const bool full = (lower <= 0) && (lim >= 63);
  if (!__all(full)) {
    const int lo2 = lower - 4 * hh; const unsigned rng = (unsigned)(lim - lower);
#pragma unroll
    for (int sub = 0; sub < 2; ++sub)
#pragma unroll
      for (int i = 0; i < 16; ++i) {
        const int kc = sub * 32 + (i & 3) + 8 * (i >> 2);
        s[sub][i] = ((unsigned)(kc - lo2) <= rng) ? s[sub][i] : -INFINITY;
      }
  }
  mx = -INFINITY;
#pragma unroll
  for (int sub = 0; sub < 2; ++sub)
#pragma unroll
    for (int i = 0; i < 16; ++i) mx = fmaxf(mx, s[sub][i]);
  mx = fmaxf(mx, __shfl_xor(mx, 32));
}

DI void pv_stage(const f32x16 (&s)[2], const u16* Vts, f32x16 (&o)[2], int lane) {
  const int lr = lane & 31, hh = lane >> 5;
#pragma unroll
  for (int sub = 0; sub < 2; ++sub)
#pragma unroll
    for (int st = 0; st < 2; ++st) {
      uint4 pk;
      pk.x = pack2(s[sub][8 * st + 0], s[sub][8 * st + 1]); pk.y = pack2(s[sub][8 * st + 2], s[sub][8 * st + 3]);
      pk.z = pack2(s[sub][8 * st + 4], s[sub][8 * st + 5]); pk.w = pack2(s[sub][8 * st + 6], s[sub][8 * st + 7]);
      const bf16x8 pf = as_bf16x8(pk);
#pragma unroll
      for (int dt = 0; dt < 2; ++dt) {
        const u16* vp = Vts + (dt * 32 + lr) * VS + sub * 32 + 16 * st + 4 * hh;
        const uint2 lo = *(const uint2*)vp, hi = *(const uint2*)(vp + 8);
        const bf16x8 vf = as_bf16x8(make_uint4(lo.x, lo.y, hi.x, hi.y));
        o[dt] = MFMA32(vf, pf, o[dt]);
      }
    }
}

DI void flash_stage(const bf16x8 (&qf)[4], const u16* Ks, const u16* Vts, f32x16 (&o)[2], float& m, float& l, int lane,
                    float sk, float sb, int lower, int lim) {
  f32x16 s[2]; float mx;
  score_stage(qf, Ks, lane, sk, sb, lower, lim, s, mx);
  const float mn = fmaxf(m, mx);
  const float alpha = fexp2(m - mn);
  const bool same = (mn == m);
  m = mn;
  float ls = 0.f;
#pragma unroll
  for (int sub = 0; sub < 2; ++sub)
#pragma unroll
    for (int i = 0; i < 16; ++i) { const float pv = fexp2(s[sub][i] - mn); s[sub][i] = pv; ls += pv; }
  l = l * alpha + ls;
  if (!__all(same)) {
#pragma unroll
    for (int dt = 0; dt < 2; ++dt)
#pragma unroll
      for (int i = 0; i < 16; ++i) o[dt][i] *= alpha;
  }
  pv_stage(s, Vts, o, lane);
}

DI void dilated_item(const Params& p, int li, int pairitem, char* smem) {
  const int tfull = tidx();
  const int half = tfull >> 8, tid = tfull & 255;
  const int item = pairitem * 2 + half;
  char* kvb = smem + half * (2 * KVBUF);
  const int lane = tid & 63, w = tid >> 6, lr = lane & 31, hh = lane >> 5;
  const int idx16 = item & 15; const int br = (item >> 4) % 3; const int hb = (item / 48) & 7; const int b = item / 384;
  const int d = br == 0 ? 1 : (br == 1 ? 4 : 16);
  const int tile = idx16 / d, resid = idx16 % d;
  const int st0 = (d >= 2 && tile == 0) ? 2 : 0;
  const int u0 = tile * 128;
  const int uq = u0 + 32 * w + lr; const int tq = uq * d + resid;
  const u16* prow = p.proj + (size_t)(b * S_ + tq) * LD_EVEN;
  bf16x8 qf[4];
  QRaw qr; load_q_raw(prow + 2048 + hb * 64, hh, qr);
  const float slope2 = fexp2(-(float)(hb + 1)) * LOG2E;
  const float sk = slope2 * (float)d;
  const u16* kb = p.proj + (size_t)(b * S_ + resid) * LD_EVEN + 2560 + hb * 64;
  const u16* vb = kb + 512;
  const size_t stride = (size_t)d * LD_EVEN;
  const float* kg = p.hy_kg + li * 64;
  f32x16 o[2]; o[0] = zero16(); o[1] = zero16();
  float m = -1e30f, l = 0.f;
  const int uw = u0 + 32 * w;
  KVRegs<256> rg;
  kv_load<256>(tid, kb, vb, stride, u0 - 128 + 64 * st0, 0, 1 << 30, rg);
  make_q(qr, p.hy_qg + li * 64, hh, qf);
  __syncthreads();
  kv_store<256>(tid, rg, kg, (u16*)(kvb + (st0 & 1) * KVBUF), (u16*)(kvb + (st0 & 1) * KVBUF) + 64 * 72);
  kv_load<256>(tid, kb, vb, stride, u0 - 64 + 64 * st0, 0, 1 << 30, rg);
  __syncthreads();
#pragma unroll 1
  for (int st = st0; st < 4; ++st) {
    const int ub = u0 - 128 + 64 * st;
    u16* Ks = (u16*)(kvb + (st & 1) * KVBUF); u16* Vts = Ks + 64 * 72;
    if (st + 1 < 4) { u16* Kn = (u16*)(kvb + ((st + 1) & 1) * KVBUF); kv_store<256>(tid, rg, kg, Kn, Kn + 64 * 72); }
    if (st + 2 < 4) kv_load<256>(tid, kb, vb, stride, ub + 128, 0, 1 << 30, rg);
    if (ub + 63 >= 0 && ub <= uw + 31 && ub + 63 >= uw - 128) {
      const int lim = uq - ub;
      const int lower = max(lim - 128, -ub);
      const float sb = slope2 * (float)(ub * d + resid) + sk * (float)(4 * hh);
      flash_stage(qf, Ks, Vts, o, m, l, lane, sk, sb, lower, lim);
    }
    __syncthreads();
  }
  const float lt = l + __shfl_xor(l, 32);
  const float inv = 1.f / lt;
  const size_t trow = (size_t)br * T_ + (size_t)b * S_ + tq;
  if (hh == 0) p.lse[trow * 8 + hb] = (m + log2f(lt)) * LN2;
  u16* orow = p.obr + trow * 512 + hb * 64;
#pragma unroll
  for (int dt = 0; dt < 2; ++dt)
#pragma unroll
    for (int q4 = 0; q4 < 4; ++q4) {
      uint2 ov; ov.x = pack2(o[dt][4 * q4] * inv, o[dt][4 * q4 + 1] * inv); ov.y = pack2(o[dt][4 * q4 + 2] * inv, o[dt][4 * q4 + 3] * inv);
      *(uint2*)(orow + dt * 32 + 8 * q4 + 4 * hh) = ov;
    }
}

DI void post_even_phase(const Params& p, int li) {
  const int tid = tidx();
  const int rsel = tid >> 7, c8 = tid & 127;
  const int c = c8 * 8;
  const int nit = T_ / 4, step = gridDim.x;
  int it = blockIdx.x;
  if (c8 < 64) {
    float og[8];
#pragma unroll
    for (int j = 0; j < 8; ++j) og[j] = p.hy_og[li * 512 + c + j];
    u32x4v raw = {0u, 0u, 0u, 0u}, graw = {0u, 0u, 0u, 0u}, nraw = raw, ngraw = raw;
    if (it < nit) { const int t = it * 4 + rsel; raw = *(const u32x4v*)(p.hbuf + (size_t)t * 1024 + c); graw = *(const u32x4v*)(p.proj + (size_t)t * LD_EVEN + 1536 + c); }
    while (it < nit) {
      const int t = it * 4 + rsel, itn = it + step;
      if (itn < nit) { const int tn = itn * 4 + rsel; nraw = *(const u32x4v*)(p.hbuf + (size_t)tn * 1024 + c); ngraw = *(const u32x4v*)(p.proj + (size_t)tn * LD_EVEN + 1536 + c); }
      float o[8], gt[8], val[8];
      unpack8(make_uint4(raw[0], raw[1], raw[2], raw[3]), o); unpack8(make_uint4(graw[0], graw[1], graw[2], graw[3]), gt);
      float ss = 0.f;
#pragma unroll
      for (int j = 0; j < 8; ++j) ss += o[j] * o[j];
      ss += __shfl_xor(ss, 1); ss += __shfl_xor(ss, 2); ss += __shfl_xor(ss, 4); ss += __shfl_xor(ss, 8);
      const float rs = rsqrtf(ss * (1.f / 128.f) + EPSF);
#pragma unroll
      for (int j = 0; j < 8; ++j) val[j] = o[j] * rs * og[j] * fsilu(gt[j]);
      *(uint4*)(p.hbuf + (size_t)t * 1024 + c) = pack8(val);
      raw = nraw; graw = ngraw; it = itn;
    }
  } else {
    const int cb = c - 512, hb = cb >> 6;
    float l0 = 0.f, l1 = 0.f, l2 = 0.f, nl0 = 0.f, nl1 = 0.f, nl2 = 0.f;
    u32x4v a4 = {0u, 0u, 0u, 0u}, b4 = a4, c4 = a4, na4 = a4, nb4 = a4, nc4 = a4;
    if (it < nit) {
      const size_t t = (size_t)(it * 4 + rsel);
      l0 = p.lse[(t) * 8 + hb]; l1 = p.lse[((size_t)T_ + t) * 8 + hb]; l2 = p.lse[((size_t)2 * T_ + t) * 8 + hb];
      a4 = *(const u32x4v*)(p.obr + t * 512 + cb); b4 = *(const u32x4v*)(p.obr + ((size_t)T_ + t) * 512 + cb); c4 = *(const u32x4v*)(p.obr + ((size_t)2 * T_ + t) * 512 + cb);
    }
    while (it < nit) {
      const int t = it * 4 + rsel, itn = it + step;
      if (itn < nit) {
        const size_t tn = (size_t)(itn * 4 + rsel);
        nl0 = p.lse[(tn) * 8 + hb]; nl1 = p.lse[((size_t)T_ + tn) * 8 + hb]; nl2 = p.lse[((size_t)2 * T_ + tn) * 8 + hb];
        na4 = *(const u32x4v*)(p.obr + tn * 512 + cb); nb4 = *(const u32x4v*)(p.obr + ((size_t)T_ + tn) * 512 + cb); nc4 = *(const u32x4v*)(p.obr + ((size_t)2 * T_ + tn) * 512 + cb);
      }
      const float mx = fmaxf(l0, fmaxf(l1, l2));
      float w0 = __expf(l0 - mx), w1 = __expf(l1 - mx), w2 = __expf(l2 - mx);
      const float inv = 1.f / (w0 + w1 + w2);
      w0 *= inv; w1 *= inv; w2 *= inv;
      float a[8], bq[8], cq[8], val[8];
      unpack8(make_uint4(a4[0], a4[1], a4[2], a4[3]), a); unpack8(make_uint4(b4[0], b4[1], b4[2], b4[3]), bq); unpack8(make_uint4(c4[0], c4[1], c4[2], c4[3]), cq);
#pragma unroll
      for (int j = 0; j < 8; ++j) val[j] = w0 * a[j] + w1 * bq[j] + w2 * cq[j];
      *(uint4*)(p.hbuf + (size_t)t * 1024 + c) = pack8(val);
      l0 = nl0; l1 = nl1; l2 = nl2; a4 = na4; b4 = nb4; c4 = nc4; it = itn;
    }
  }
}

DI void compress_item(const Params& p, int li, int pairitem, char* smem) {
  const int tfull = tidx();
  const int half = tfull >> 8, tid = tfull & 255;
  const int item = pairitem * 2 + half;
  u16* hs = (u16*)(smem + half * 17408);
  float* outs = (float*)(smem + half * 17408 + 32 * 136 * 2);
  const int lane = tid & 63, w = tid >> 6, lr = lane & 31, hh = lane >> 5;
  const int nt = item & 3, g = (item >> 2) & 3, b = (item >> 4) & 15, kv = item >> 8;
  const int n = nt * 32 + lr; const int nc = n > 126 ? 126 : n;
  const int col = 1024 + kv * 256 + g * 64;
  const u16* arow = p.proj + (size_t)(b * S_ + 16 * nc) * LD_ODD + col;
  const u16* w1t = p.wt_c1 + (size_t)(li * 2 + kv) * 128 * 2048 + (size_t)(32 * w + lr) * 2048;
  f32x16 acc = zero16();
#pragma unroll 1
  for (int k0 = 0; k0 < 128; k0 += 8) {
    u32x4v fa[8], fb[8];
#pragma unroll
    for (int j = 0; j < 8; ++j) {
      const int ks = k0 + j;
      const int lidx = ks >> 2, dd = (ks & 3) * 16 + hh * 8;
      fa[j] = *(const u32x4v*)(arow + (size_t)lidx * LD_ODD + dd);
      fb[j] = *(const u32x4v*)(w1t + ks * 16 + hh * 8);
    }
    asm volatile("" ::: "memory");
#pragma unroll
    for (int j = 0; j < 8; ++j) acc = MFMA32(__builtin_bit_cast(bf16x8, fa[j]), __builtin_bit_cast(bf16x8, fb[j]), acc);
  }
  const float cb = p.c1[(li * 2 + kv) * 128 + 32 * w + lr];
  __syncthreads();
#pragma unroll
  for (int i = 0; i < 16; ++i) {
    const int r = (i & 3) + 8 * (i >> 2) + 4 * hh;
    hs[r * 136 + 32 * w + lr] = f2bf(fsilu(acc[i] + cb));
  }
  __syncthreads();
  if (w < 2) {
    const u16* w2t = p.wt_c2 + (size_t)(li * 2 + kv) * 64 * 128 + (size_t)(w * 32 + lr) * 128;
    f32x16 a2 = zero16();
    u32x4v fb2[8];
#pragma unroll
    for (int kk = 0; kk < 8; ++kk) fb2[kk] = *(const u32x4v*)(w2t + kk * 16 + hh * 8);
    asm volatile("" ::: "memory");
#pragma unroll
    for (int kk = 0; kk < 8; ++kk) {
      const bf16x8 a = *(const bf16x8*)(hs + lr * 136 + kk * 16 + hh * 8);
      a2 = MFMA32(a, __builtin_bit_cast(bf16x8, fb2[kk]), a2);
    }
#pragma unroll
    for (int i = 0; i < 16; ++i) {
      const int r = (i & 3) + 8 * (i >> 2) + 4 * hh;
      outs[r * 65 + w * 32 + lr] = a2[i];
    }
  }
  __syncthreads();
  {
    const int r = tid >> 3, c8 = tid & 7;
    float v[8]; float ss = 0.f;
#pragma unroll
    for (int j = 0; j < 8; ++j) { v[j] = outs[r * 65 + c8 * 8 + j]; ss += v[j] * v[j]; }
    ss += __shfl_xor(ss, 1); ss += __shfl_xor(ss, 2); ss += __shfl_xor(ss, 4);
    if (kv == 0) {
      const float rs = rsqrtf(ss * (1.f / 64.f) + EPSF);
#pragma unroll
      for (int j = 0; j < 8; ++j) v[j] *= rs * p.nsa_kg[(li * 3 + 0) * 64 + c8 * 8 + j];
    }
    const int nn = nt * 32 + r;
    if (nn >= 127) {
#pragma unroll
      for (int j = 0; j < 8; ++j) v[j] = 0.f;
    }
    u16* dst = (kv == 0 ? p.kcmp : p.vcmp) + ((size_t)(b * 4 + g) * 128 + nn) * 64 + c8 * 8;
    *(uint4*)dst = pack8(v);
  }
  __syncthreads();
}

DI void nsa_knorm_phase(const Params& p, int li) {
  const int tid = tidx();
  for (int u0 = blockIdx.x * NT + tid; u0 < T_ * 64; u0 += gridDim.x * NT * 4) {
    u32x4v raw[4];
#pragma unroll
    for (int q = 0; q < 4; ++q) {
      const int u = u0 + q * gridDim.x * NT;
      const int piece = u & 7, head = (u >> 3) & 3, br = (u >> 5) & 1, row = u >> 6;
      raw[q] = *(const u32x4v*)(p.proj + (size_t)row * LD_ODD + 1536 + br * 512 + head * 64 + piece * 8);
    }
    asm volatile("" ::: "memory");
#pragma unroll
    for (int q = 0; q < 4; ++q) {
      const int u = u0 + q * gridDim.x * NT;
      const int piece = u & 7, head = (u >> 3) & 3, br = (u >> 5) & 1, row = u >> 6;
      float f[8]; unpack8(make_uint4(raw[q][0], raw[q][1], raw[q][2], raw[q][3]), f);
      float ss = 0.f;
#pragma unroll
      for (int e = 0; e < 8; ++e) ss += f[e] * f[e];
      ss += __shfl_xor(ss, 1); ss += __shfl_xor(ss, 2); ss += __shfl_xor(ss, 4);
      const float rs = rsqrtf(ss * (1.f / 64.f) + EPSF);
      const float* kg = p.nsa_kg + (li * 3 + 1 + br) * 64 + piece * 8;
#pragma unroll
      for (int e = 0; e < 8; ++e) f[e] *= rs * kg[e];
      *(uint4*)(p.proj + (size_t)row * LD_ODD + 1536 + br * 512 + head * 64 + piece * 8) = pack8(f);
    }
  }
}

DI void nsa_item(const Params& p, int li, int item, char* smem) {
  float* impA = (float*)(smem + 2 * KVBUF);
  float* impB = impA + 8448;
  float* imp = impB + 8448;
  unsigned* selm = (unsigned*)(imp + 64 * 33);
  const int tid = tidx(), lane = tid & 63, wv = tid >> 6, lr = lane & 31, hh = lane >> 5;
  const int w = lr & 3;
  const int tt = item & 31, g = (item >> 5) & 3, b = item >> 7;
  const int t0 = tt * 64; const int cur = t0 >> 6;
  const int hd = g * 4 + w;
  const int tokl = 8 * wv + (lr >> 2);
  const int tq = t0 + tokl;
  const u16* pb = p.proj + (size_t)b * S_ * LD_ODD;
  const u16* prow = pb + (size_t)tq * LD_ODD;
  bf16x8 qf[4];
  QRaw qr; load_q_raw(prow + g * 256 + w * 64, hh, qr);
  const unsigned gr0 = prow[2560 + 0 + g * 4 + w], gr1 = prow[2560 + 16 + g * 4 + w], gr2 = prow[2560 + 32 + g * 4 + w];
  KVRegs<512> rgc;
  kv_load<512>(tid, p.kcmp + (size_t)(b * 4 + g) * 128 * 64, p.vcmp + (size_t)(b * 4 + g) * 128 * 64, 64, 0, 0, 128, rgc);
  make_q(qr, p.nsa_qg + li * 64, hh, qf);
  const float slope2 = fexp2(-0.5f * (float)(hd + 1)) * LOG2E;
  const float g0 = fsigmoid(__uint_as_float(gr0 << 16));
  const float g1 = fsigmoid(__uint_as_float(gr1 << 16));
  const float g2 = fsigmoid(__uint_as_float(gr2 << 16));
  f32x16 ot[2]; ot[0] = zero16(); ot[1] = zero16();
  {
    const u16* kb = p.kcmp + (size_t)(b * 4 + g) * 128 * 64;
    const u16* vb = p.vcmp + (size_t)(b * 4 + g) * 128 * 64;
    const float sk = 16.f * slope2;
    const int limc = min((tq - 31) >> 4, 126);
    const int nst = (1024 > t0) ? 1 : 2;
    {
      __syncthreads();
      kv_store<512>(tid, rgc, nullptr, (u16*)smem, (u16*)smem + 64 * 72);
      if (nst > 1) {
        kv_load<512>(tid, kb, vb, 64, 64, 0, 128, rgc);
        kv_store<512>(tid, rgc, nullptr, (u16*)(smem + KVBUF), (u16*)(smem + KVBUF) + 64 * 72);
      }
    }
    __syncthreads();
    float m = -1e30f, l = 0.f;
#pragma unroll
    for (int st = 0; st < 2; ++st) {
      if (st >= nst) continue;
      const u16* Ks = (const u16*)(smem + st * KVBUF);
      f32x16 s[2]; float mx;
      const float sb = slope2 * (float)(1024 * st + 31) + sk * (float)(4 * hh);
      score_stage(qf, Ks, lane, sk, sb, 0, limc - 64 * st, s, mx);
      const float mn = fmaxf(m, mx);
      float ls = 0.f;
#pragma unroll
      for (int sub = 0; sub < 2; ++sub)
#pragma unroll
        for (int i = 0; i < 16; ++i) ls += fexp2(s[sub][i] - mn);
      l = l * fexp2(m - mn) + ls;
      m = mn;
    }
    const float lt = l + __shfl_xor(l, 32);
    const float inv = lt > 0.f ? 1.f / lt : 0.f;
    f32x16 o[2]; o[0] = zero16(); o[1] = zero16();
#pragma unroll
    for (int st = 0; st < 2; ++st) {
      if (st >= nst) {
#pragma unroll
        for (int G = 0; G < 16; ++G) {
          if ((G & 1) == hh) { impA[(w * 64 + tokl) * 33 + 16 * st + G] = 0.f; impB[(w * 64 + tokl) * 33 + 16 * st + G] = 0.f; }
        }
        continue;
      }
      const u16* Ks = (const u16*)(smem + st * KVBUF); const u16* Vts = Ks + 64 * 72;
      f32x16 s[2]; float mx;
      const float sb = slope2 * (float)(1024 * st + 31) + sk * (float)(4 * hh);
      score_stage(qf, Ks, lane, sk, sb, 0, limc - 64 * st, s, mx);
#pragma unroll
      for (int sub = 0; sub < 2; ++sub)
#pragma unroll
        for (int i = 0; i < 16; ++i) s[sub][i] = fexp2(s[sub][i] - m) * inv;
#pragma unroll
      for (int sub = 0; sub < 2; ++sub)
#pragma unroll
        for (int q4 = 0; q4 < 4; ++q4) {
          const int G = 16 * st + 8 * sub + 2 * q4 + hh;
          impA[(w * 64 + tokl) * 33 + G] = (s[sub][4 * q4] + s[sub][4 * q4 + 1]) + (s[sub][4 * q4 + 2] + s[sub][4 * q4 + 3]);
          impB[(w * 64 + tokl) * 33 + G] = s[sub][4 * q4 + 3];
        }
      pv_stage(s, Vts, o, lane);
    }
#pragma unroll
    for (int dt = 0; dt < 2; ++dt)
#pragma unroll
      for (int i = 0; i < 16; ++i) ot[dt][i] += g0 * o[dt][i];
  }
  const u16* kbs = pb + 1536 + g * 64; const u16* vbs = pb + 1792 + g * 64;
  KVRegs<512> rg;
  kv_load<512>(tid, kbs, vbs, LD_ODD, 0, 0, S_, rg);
  __syncthreads();
  for (int idx = tid; idx < 2048; idx += NT) {
    const int tok = idx >> 5, mm = idx & 31;
    float a = 0.f;
#pragma unroll
    for (int ww = 0; ww < 4; ++ww) a += impA[(ww * 64 + tok) * 33 + mm] + (mm > 0 ? impB[(ww * 64 + tok) * 33 + mm - 1] : 0.f);
    imp[tok * 33 + mm] = a;
  }
  __syncthreads();
  float* ots = impA + tid;
#pragma unroll
  for (int dt = 0; dt < 2; ++dt)
#pragma unroll
    for (int i = 0; i < 16; ++i) ots[(dt * 16 + i) * NT] = ot[dt][i];
  {
    const int tok = tid >> 3, sub8 = tid & 7;
    unsigned sel = 1u | (1u << cur) | (cur > 0 ? (1u << (cur - 1)) : 0u);
    const int cnt = __popc(sel);
    float cv[4];
#pragma unroll
    for (int e = 0; e < 4; ++e) cv[e] = imp[tok * 33 + sub8 * 4 + e];
    for (int r = cnt; r < 8; ++r) {
      float bv = -1.f; int bi = 64;
#pragma unroll
      for (int e = 0; e < 4; ++e) {
        const int mm = sub8 * 4 + e;
        const bool ok = (mm <= cur) && !((sel >> mm) & 1u);
        if (ok && cv[e] > bv) { bv = cv[e]; bi = mm; }
      }
#pragma unroll
      for (int off = 1; off < 8; off <<= 1) {
        const float ov = __shfl_xor(bv, off); const int oi = __shfl_xor(bi, off);
        if (ov > bv || (ov == bv && oi < bi)) { bv = ov; bi = oi; }
      }
      if (bi < 64) sel |= 1u << bi;
    }
    if (sub8 == 0) selm[tok] = sel;
  }
  __syncthreads();
  const unsigned myMask = selm[tokl];
  unsigned uni = 0u;
#pragma unroll 8
  for (int i = 0; i < 64; ++i) uni |= selm[i];
  {
    f32x16 o[2]; o[0] = zero16(); o[1] = zero16();
    float m = -1e30f, l = 0.f;
    const float* kg = nullptr;
    unsigned rem = uni & (uni - 1u);
    int mb = 0;
    int mbn = rem ? __builtin_ctz(rem) : -1;
    kv_store<512>(tid, rg, kg, (u16*)smem, (u16*)smem + 64 * 72);
    if (mbn >= 0) kv_load<512>(tid, kbs, vbs, LD_ODD, 64 * mbn, 0, S_, rg);
    __syncthreads();
    int par = 0;
#pragma unroll 1
    while (true) {
      u16* Ks = (u16*)(smem + par * KVBUF); u16* Vts = Ks + 64 * 72;
      int mbn2 = -1;
      if (mbn >= 0) {
        u16* Kn = (u16*)(smem + (par ^ 1) * KVBUF);
        kv_store<512>(tid, rg, kg, Kn, Kn + 64 * 72);
        rem &= rem - 1u;
        mbn2 = rem ? __builtin_ctz(rem) : -1;
        if (mbn2 >= 0) kv_load<512>(tid, kbs, vbs, LD_ODD, 64 * mbn2, 0, S_, rg);
      }
      const bool selb = (myMask >> mb) & 1u;
      const float sb = selb ? slope2 * (float)(64 * mb) + slope2 * (float)(4 * hh) : -INFINITY;
      if (__any(selb)) flash_stage(qf, Ks, Vts, o, m, l, lane, slope2, sb, 0, (mb == cur) ? (tq - 64 * mb) : 63);
      __syncthreads();
      if (mbn < 0) break;
      mb = mbn; mbn = mbn2; par ^= 1;
    }
    const float lt = l + __shfl_xor(l, 32);
    const float sc = g1 / lt;
#pragma unroll
    for (int dt = 0; dt < 2; ++dt)
#pragma unroll
      for (int i = 0; i < 16; ++i) ots[(dt * 16 + i) * NT] += sc * o[dt][i];
  }
  {
    f32x16 o[2]; o[0] = zero16(); o[1] = zero16();
    float m = -1e30f, l = 0.f;
    const u16* kb = pb + 2048 + g * 64; const u16* vb = pb + 2304 + g * 64;
    const float* kg = nullptr;
    const int mlo = (t0 - 511) < 0 ? 0 : ((t0 - 511) >> 6);
    kv_load<512>(tid, kb, vb, LD_ODD, 64 * mlo, 0, S_, rg);
    kv_store<512>(tid, rg, kg, (u16*)smem, (u16*)smem + 64 * 72);
    if (mlo + 1 <= cur) kv_load<512>(tid, kb, vb, LD_ODD, 64 * (mlo + 1), 0, S_, rg);
    __syncthreads();
#pragma unroll 1
    for (int mb = mlo; mb <= cur; ++mb) {
      const int par = (mb - mlo) & 1;
      u16* Ks = (u16*)(smem + par * KVBUF); u16* Vts = Ks + 64 * 72;
      if (mb + 1 <= cur) { u16* Kn = (u16*)(smem + (par ^ 1) * KVBUF); kv_store<512>(tid, rg, kg, Kn, Kn + 64 * 72); }
      if (mb + 2 <= cur) kv_load<512>(tid, kb, vb, LD_ODD, 64 * (mb + 2), 0, S_, rg);
      const int lim = tq - 64 * mb;
      const float sb = slope2 * (float)(64 * mb) + slope2 * (float)(4 * hh);
      flash_stage(qf, Ks, Vts, o, m, l, lane, slope2, sb, lim - 511, lim);
      __syncthreads();
    }
    const float lt = l + __shfl_xor(l, 32);
    const float sc = g2 / lt;
    u16* orow = p.hbuf + (size_t)(b * S_ + tq) * 1024 + g * 256 + w * 64;
#pragma unroll
    for (int dt = 0; dt < 2; ++dt)
#pragma unroll
      for (int q4 = 0; q4 < 4; ++q4) {
        const float a0 = ots[(dt * 16 + 4 * q4 + 0) * NT] + sc * o[dt][4 * q4 + 0], a1 = ots[(dt * 16 + 4 * q4 + 1) * NT] + sc * o[dt][4 * q4 + 1];
        const float a2 = ots[(dt * 16 + 4 * q4 + 2) * NT] + sc * o[dt][4 * q4 + 2], a3 = ots[(dt * 16 + 4 * q4 + 3) * NT] + sc * o[dt][4 * q4 + 3];
        uint2 ov; ov.x = pack2(a0, a1); ov.y = pack2(a2, a3);
        *(uint2*)(orow + dt * 32 + 8 * q4 + 4 * hh) = ov;
      }
  }
  __syncthreads();
}

DI void run_phase(const Params& p, int ph, char* smem) {
  if (ph == 0) { prep_phase(p, smem); return; }
  const int l = (ph - 1) >> 3, s = (ph - 1) & 7, li = l >> 1;
  const bool even = (l & 1) == 0;
  const float* xin = (l == 0) ? p.x : p.out;
  switch (s) {
    case 0: rmsnorm_phase(xin, p.attn_norm + l * 1024, p.hbuf); break;
    case 1:
      if (even) gemm_phase<0>(p.hbuf, p.wt_hy_in + (size_t)li * 3584 * 1024, 1024, 14, p.proj, LD_EVEN, nullptr, nullptr, smem);
      else gemm_phase<0>(p.hbuf, p.wt_nsa_in + (size_t)li * 2816 * 1024, 1024, 11, p.proj, LD_ODD, nullptr, nullptr, smem);
      break;
    case 2:
      if (even) {
        for (int item = blockIdx.x; item < 256 + 3072; item += gridDim.x) {
          if (item < 256) hgrn_item(p, li, item, smem); else dilated_item(p, li, item - 256, smem);
        }
      } else {
        for (int item = blockIdx.x; item < 256; item += gridDim.x) compress_item(p, li, item, smem);
        nsa_knorm_phase(p, li);
      }
      break;
    case 3:
      if (even) post_even_phase(p, li);
      else {
        for (int item = blockIdx.x; item < 2048; item += gridDim.x) {
          const int r = item / gridDim.x, i = item % gridDim.x;
          int it2 = item;
          if (gridDim.x == 256) {
            const int c = (i + 4 * (r >> 1)) & 31;
            const int tt = (r & 1) ? 31 - c : c;
            it2 = ((i >> 5) + 8 * r) * 32 + tt;
          }
          nsa_item(p, li, it2, smem);
        }
      }
      break;
    case 4:
      gemm_phase<1>(p.hbuf, (even ? p.wt_hy_out : p.wt_nsa_out) + (size_t)li * 1048576, 1024, 4, nullptr, 0, xin, p.out, smem);
      break;
    case 5: rmsnorm_phase(p.out, p.ffn_norm + l * 1024, p.hbuf); break;
    case 6: gemm_phase<2>(p.hbuf, p.wt_gu + (size_t)l * 5632 * 1024, 1024, 22, p.proj, DFF, nullptr, nullptr, smem); break;
    case 7: gemm_phase<1>(p.proj, p.wt_dn + (size_t)l * 1024 * 2816, 2816, 4, nullptr, 0, p.out, p.out, smem, true); break;
  }
}

constexpr int DYN_LDS = 131072;
extern __shared__ __attribute__((aligned(16))) char dyn_smem[];
__global__ void __launch_bounds__(512) mk_forward(Params p) {
  char* smem = dyn_smem;
  __shared__ uint4 xb_words;
  cg::grid_group grid = cg::this_grid();
  if (__builtin_amdgcn_workitem_id_x() == 0) xb_words = make_uint4(0u, 0u, 0u, 0u);
  __syncthreads();
  const XcdBarrier xb = xcd_barrier_post(p.bar, (volatile LAS unsigned*)&xb_words);
  for (int ph = p.phase_lo; ph < p.phase_hi; ++ph) {
    run_phase(p, ph, smem);
    if (ph + 1 < p.phase_hi) {
      if (p.phase_hi < 0) grid.sync();
      xcd_barrier(xb);
    }
  }
}

extern "C" void kernel_launch(void* const* d_in, const int* in_sizes, int n_in, void* d_out, int out_size,
                              void* d_ws, size_t ws_size, hipStream_t stream) {
  static int grid_blocks = 0;
  if (!grid_blocks) {
    int dev = 0, cus = 0, per_cu = 0;
    hipGetDevice(&dev);
    hipDeviceGetAttribute(&cus, hipDeviceAttributeMultiprocessorCount, dev);
    hipFuncSetAttribute((const void*)mk_forward, hipFuncAttributeMaxDynamicSharedMemorySize, DYN_LDS);
    hipOccupancyMaxActiveBlocksPerMultiprocessor(&per_cu, mk_forward, 512, DYN_LDS);
    if (per_cu > 1) per_cu = 1;
    if (per_cu < 1) per_cu = 1;
    grid_blocks = cus * per_cu;
  }
  Params p;
  memset(&p, 0, sizeof(p));
  p.x = (const float*)d_in[0]; p.attn_norm = (const float*)d_in[1]; p.ffn_norm = (const float*)d_in[2];
  p.hy_w_in = (const float*)d_in[3]; p.hy_lb = (const float*)d_in[4]; p.hy_og = (const float*)d_in[5];
  p.hy_qg = (const float*)d_in[6]; p.hy_kg = (const float*)d_in[7]; p.hy_w_out = (const float*)d_in[8];
  p.nsa_w_in = (const float*)d_in[9]; p.nsa_qg = (const float*)d_in[10]; p.nsa_kg = (const float*)d_in[11];
  p.cmp_pe = (const float*)d_in[12]; p.cmp_w1 = (const float*)d_in[13]; p.cmp_w2 = (const float*)d_in[14];
  p.nsa_w_out = (const float*)d_in[15]; p.ffn_g = (const float*)d_in[16]; p.ffn_u = (const float*)d_in[17]; p.ffn_d = (const float*)d_in[18];
  p.out = (float*)d_out;
  char* ws = (char*)d_ws; size_t off = 0;
  auto take = [&](size_t bytes) { char* r = ws + off; off += (bytes + 255) & ~(size_t)255; return r; };
  p.wt_hy_in = (u16*)take((size_t)2 * 3584 * 1024 * 2);
  p.wt_hy_out = (u16*)take((size_t)2 * 1048576 * 2);
  p.wt_nsa_in = (u16*)take((size_t)2 * 2816 * 1024 * 2);
  p.wt_nsa_out = (u16*)take((size_t)2 * 1048576 * 2);
  p.wt_gu = (u16*)take((size_t)4 * 5632 * 1024 * 2);
  p.wt_dn = (u16*)take((size_t)4 * 1024 * 2816 * 2);
  p.wt_c1 = (u16*)take((size_t)4 * 128 * 2048 * 2);
  p.wt_c2 = (u16*)take((size_t)4 * 64 * 128 * 2);
  p.c1 = (float*)take(4 * 128 * 4);
  p.lb = (float*)take(2 * 512 * 4);
  p.lse = (float*)take((size_t)3 * T_ * 8 * 4);
  p.proj = (u16*)take((size_t)T_ * 3584 * 2);
  p.hbuf = (u16*)take((size_t)T_ * 1024 * 2);
  p.obr = (u16*)take((size_t)3 * T_ * 512 * 2);
  p.kcmp = (u16*)take((size_t)16 * 4 * 128 * 64 * 2);
  p.vcmp = (u16*)take((size_t)16 * 4 * 128 * 64 * 2);
  p.bar = (unsigned*)take(XCD_BAR_WORDS * 4);
  if (off > ws_size) { fprintf(stderr, "workspace too small: need %zu have %zu\n", off, ws_size); return; }
  const int NPH = 33;
  hipMemsetAsync(p.bar, 0, XCD_BAR_WORDS * 4, stream);
#if MK_MULTI
  for (int ph = 0; ph < NPH; ++ph) {
    p.phase_lo = ph; p.phase_hi = ph + 1;
    hipLaunchKernelGGL(mk_forward, dim3(grid_blocks), dim3(512), DYN_LDS, stream, p);
  }
#else
  p.phase_lo = 0; p.phase_hi = NPH;
  void* args[] = {&p};
  hipError_t e = hipLaunchCooperativeKernel((void*)mk_forward, dim3(grid_blocks), dim3(512), args, DYN_LDS, stream);
  if (e != hipSuccess) fprintf(stderr, "cooperative launch failed: %s (grid %d)\n", hipGetErrorString(e), grid_blocks);
#endif
}
```
